# Optimizing an MI355X kernel written in HIP

```python
import jax
import jax.numpy as jnp
from jax import lax
import numpy as np

D_MODEL = 1024
BATCH = 8
SEQ = 2048
DEPTH = 2

GRID_W = 64
CTX_LEN = 256
EPS = 1e-6

FNET_WIDTH = 256
FNET_GROUPS = 4
FNET_GDIM = FNET_WIDTH // FNET_GROUPS

GLA_HEADS = 4
GLA_DV = 64
GLA_DK = 32
GLA_WIDTH = GLA_HEADS * GLA_DV
GLA_QK = GLA_HEADS * GLA_DK
GLA_GATE_RANK = 16
GLA_GATE_NORM = 16.0
GLA_CHUNK = 64

ATT_HEADS = 8
ATT_KV_HEADS = 2
ATT_HDIM = 64
ATT_WIDTH = ATT_HEADS * ATT_HDIM
ATT_KV_WIDTH = ATT_KV_HEADS * ATT_HDIM
ROPE_AXIS_DIM = ATT_HDIM // 2
ROPE_FREQS = ROPE_AXIS_DIM // 2
ROPE_THETA = 10000.0
Q_BLOCK = 128

D_MIX = FNET_WIDTH + GLA_WIDTH + ATT_WIDTH
IN_SIZES = (FNET_WIDTH, GLA_QK, GLA_QK, GLA_WIDTH, GLA_WIDTH, GLA_GATE_RANK, GLA_GATE_RANK, ATT_WIDTH, ATT_KV_WIDTH, ATT_KV_WIDTH)
D_IN = FNET_WIDTH + 2 * GLA_QK + 2 * GLA_WIDTH + 2 * GLA_GATE_RANK + ATT_WIDTH + 2 * ATT_KV_WIDTH

N_EXPERTS = 16
N_GROUPS = 4
EXPERTS_PER_GROUP = N_EXPERTS // N_GROUPS
TOP_K = 2
D_EXPERT = 512

kernel_name = 'hybrid_fnet_gla_gqa_moe_dit'


def rms_norm(x, w):
    xf = x.astype(jnp.float32)
    y = xf * lax.rsqrt(jnp.mean(xf * xf, axis=-1, keepdims=True) + EPS)
    return (y * w.astype(jnp.float32)).astype(x.dtype)


def split_proj(p):
    idx = []
    acc = 0
    for s in IN_SIZES[:-1]:
        acc += s
        idx.append(acc)
    return jnp.split(p, idx, axis=-1)


def axial_rope_tables(row, col):
    inv = ROPE_THETA ** (-jnp.arange(ROPE_FREQS, dtype=jnp.float32) * 2.0 / ROPE_AXIS_DIM)
    ang = jnp.stack([row.astype(jnp.float32)[:, None] * inv, col.astype(jnp.float32)[:, None] * inv], axis=1)
    return jnp.cos(ang)[:, None], jnp.sin(ang)[:, None]


def apply_axial_rope(x, cos, sin):
    xf = x.astype(jnp.float32).reshape(x.shape[:-1] + (2, 2, ROPE_FREQS))
    x1 = xf[..., 0, :]
    x2 = xf[..., 1, :]
    out = jnp.stack([x1 * cos - x2 * sin, x2 * cos + x1 * sin], axis=-2)
    return out.reshape(x.shape).astype(x.dtype)


def fourier_mix(u):
    b, n, _ = u.shape
    ug = u.astype(jnp.float32).reshape(b, n, FNET_GROUPS, FNET_GDIM).transpose(0, 2, 1, 3)
    f = jnp.fft.fft2(ug, norm='ortho').real
    return f.transpose(0, 2, 1, 3).reshape(b, n, FNET_WIDTH).astype(u.dtype)


def gla_heads(parts, w_up, b_up):
    gq, gk, gv, gdf, gdb = parts[1], parts[2], parts[3], parts[5], parts[6]
    b, n, _ = gq.shape

    def heads(t, d):
        return t.astype(jnp.float32).reshape(b, n, GLA_HEADS, d).transpose(0, 2, 1, 3)

    q = heads(gq, GLA_DK) * (GLA_DK ** -0.5)
    k = heads(gk, GLA_DK)
    v = heads(gv, GLA_DV)
    la_f = heads(jax.nn.log_sigmoid((gdf @ w_up[0] + b_up[0]).astype(jnp.float32)) / GLA_GATE_NORM, GLA_DK)
    la_b = heads(jax.nn.log_sigmoid((gdb @ w_up[1] + b_up[1]).astype(jnp.float32)) / GLA_GATE_NORM, GLA_DK)
    return q, k, v, la_f, la_b


def gla_chunk_scan(q, k, v, log_a, s0):
    b, h, n, dk = q.shape
    dv = v.shape[-1]
    nc = n // GLA_CHUNK

    def to_chunks(t):
        return t.reshape(b, h, nc, GLA_CHUNK, t.shape[-1]).transpose(2, 0, 1, 3, 4)

    mask = jnp.tril(jnp.ones((GLA_CHUNK, GLA_CHUNK), dtype=bool))

    def step(s, inp):
        qi, ki, vi, ai = inp
        cum = jnp.cumsum(ai, axis=-2)
        last = cum[..., -1:, :]
        q_t = qi * jnp.exp(cum)
        k_t = ki * jnp.exp(-cum)
        att = jnp.where(mask, jnp.einsum('bhik,bhjk->bhij', q_t, k_t), 0.0)
        o = jnp.einsum('bhij,bhjv->bhiv', att, vi) + jnp.einsum('bhik,bhkv->bhiv', q_t, s)
        s_new = jnp.exp(last)[..., 0, :, None] * s + jnp.einsum('bhjk,bhjv->bhkv', ki * jnp.exp(last - cum), vi)
        return s_new, o

    s_fin, oc = lax.scan(step, s0, (to_chunks(q), to_chunks(k), to_chunks(v), to_chunks(log_a)))
    o = oc.transpose(1, 2, 0, 3, 4).reshape(b, h, n, dv)
    return o, s_fin


def gla_bidir(q, k, v, la_f, la_b, s0_f, s0_b):
    o_f, s_f = gla_chunk_scan(q, k, v, la_f, s0_f)
    o_b, s_b = gla_chunk_scan(jnp.flip(q, 2), jnp.flip(k, 2), jnp.flip(v, 2), jnp.flip(la_b, 2), s0_b)
    return o_f + jnp.flip(o_b, 2), s_f, s_b


def gla_out(o, g, w_norm):
    b, h, n, dv = o.shape
    o = rms_norm(o, w_norm).transpose(0, 2, 1, 3).reshape(b, n, h * dv)
    return o.astype(g.dtype) * jax.nn.silu(g)


def attn_heads(parts, qn, kn, rope):
    aq, ak, av = parts[7], parts[8], parts[9]
    b, n, _ = aq.shape
    q = rms_norm(aq.reshape(b, n, ATT_HEADS, ATT_HDIM), qn)
    k = rms_norm(ak.reshape(b, n, ATT_KV_HEADS, ATT_HDIM), kn)
    v = av.reshape(b, n, ATT_KV_HEADS, ATT_HDIM)
    if rope is not None:
        q = apply_axial_rope(q, rope[0], rope[1])
        k = apply_axial_rope(k, rope[0], rope[1])
    return q, k, v


def gqa_blocks(q, k, v):
    b, n, h, hd = q.shape
    g = h // ATT_KV_HEADS
    nb = n // Q_BLOCK
    qb = q.reshape(b, nb, Q_BLOCK, ATT_KV_HEADS, g, hd).transpose(1, 0, 3, 4, 2, 5)
    kt = k.transpose(0, 2, 1, 3)
    vt = v.transpose(0, 2, 1, 3)
    scale = hd ** -0.5

    def one_block(qi):
        s = jnp.einsum('bkgqd,bkmd->bkgqm', qi, kt).astype(jnp.float32) * scale
        p = jax.nn.softmax(s, axis=-1).astype(vt.dtype)
        return jnp.einsum('bkgqm,bkmd->bkgqd', p, vt)

    ob = lax.map(one_block, qb)
    return ob.transpose(1, 0, 4, 2, 3, 5).reshape(b, n, h * hd)


def moe_ffn(h, w_router, b_router, w_gate, w_up, w_down):
    n_tok = h.shape[0]
    s = jax.nn.sigmoid(jnp.matmul(h, w_router).astype(jnp.float32))
    sel = (s + b_router.astype(jnp.float32)).reshape(n_tok, N_GROUPS, EXPERTS_PER_GROUP)
    grp_score = jnp.sum(lax.top_k(sel, TOP_K)[0], axis=-1)
    g_idx = jnp.argmax(grp_score, axis=-1)
    in_grp = sel[jnp.arange(n_tok), g_idx]
    loc = lax.top_k(in_grp, TOP_K)[1]
    e_idx = g_idx[:, None] * EXPERTS_PER_GROUP + loc
    w = jnp.take_along_axis(s, e_idx, axis=-1)
    w = w / jnp.sum(w, axis=-1, keepdims=True)
    gate = jnp.sum(w[..., None] * jax.nn.one_hot(e_idx, N_EXPERTS, dtype=jnp.float32), axis=1).astype(h.dtype)
    out = jnp.zeros_like(h)
    for e in range(N_EXPERTS):
        a = jax.nn.silu(h @ w_gate[e]) * (h @ w_up[e])
        out = out + gate[:, e:e + 1] * (a @ w_down[e])
    return out


def setup_inputs(seed: int = 0) -> dict:
    key = jax.random.key(seed)
    ks = jax.random.split(key, 24)

    def nrm(k, shape, s):
        return jax.random.normal(k, shape, jnp.float32) * s

    def gain(k, shape):
        return 1.0 + 0.02 * jax.random.normal(k, shape, jnp.float32)

    return {
        'x': nrm(ks[0], (BATCH, SEQ, D_MODEL), 1.0),
        'c': nrm(ks[1], (BATCH, D_MODEL), 1.0),
        'ctx': nrm(ks[2], (BATCH, CTX_LEN, D_MODEL), 1.0),
        'c_ctx': nrm(ks[3], (D_MODEL,), 1.0),
        'w_ada': nrm(ks[4], (DEPTH, D_MODEL, 6 * D_MODEL), 0.5 * D_MODEL ** -0.5),
        'b_ada': nrm(ks[5], (DEPTH, 6 * D_MODEL), 0.02),
        'norm_mix': gain(ks[6], (DEPTH, D_MODEL)),
        'norm_ffn': gain(ks[7], (DEPTH, D_MODEL)),
        'w_in': nrm(ks[8], (DEPTH, D_MODEL, D_IN), D_MODEL ** -0.5),
        'w_gla_gate_up': nrm(ks[9], (DEPTH, 2, GLA_GATE_RANK, GLA_QK), GLA_GATE_RANK ** -0.5),
        'b_gla_gate': nrm(ks[10], (DEPTH, 2, GLA_QK), 0.1),
        'gla_norm': gain(ks[11], (DEPTH, GLA_DV)),
        'q_norm': gain(ks[12], (DEPTH, ATT_HDIM)),
        'k_norm': gain(ks[13], (DEPTH, ATT_HDIM)),
        'w_out': nrm(ks[14], (DEPTH, D_MIX, D_MODEL), D_MIX ** -0.5),
        'w_router': nrm(ks[15], (D_MODEL, N_EXPERTS), D_MODEL ** -0.5),
        'b_router': nrm(ks[16], (N_EXPERTS,), 0.01),
        'w_exp_gate': nrm(ks[17], (DEPTH, N_EXPERTS, D_MODEL, D_EXPERT), D_MODEL ** -0.5),
        'w_exp_up': nrm(ks[18], (DEPTH, N_EXPERTS, D_MODEL, D_EXPERT), D_MODEL ** -0.5),
        'w_exp_down': nrm(ks[19], (DEPTH, N_EXPERTS, D_EXPERT, D_MODEL), D_EXPERT ** -0.5),
        'final_norm': gain(ks[20], (D_MODEL,)),
    }


def reference(x, c, ctx, c_ctx, w_ada, b_ada, norm_mix, norm_ffn, w_in, w_gla_gate_up, b_gla_gate, gla_norm, q_norm, k_norm, w_out, w_router, b_router, w_exp_gate, w_exp_up, w_exp_down, final_norm):
    b, n, d = x.shape
    m = ctx.shape[1]
    rows = n // GRID_W
    row = jnp.repeat(jnp.arange(rows), GRID_W)
    col = jnp.tile(jnp.arange(GRID_W), rows)
    rope = axial_rope_tables(row, col)
    silu_c = jax.nn.silu(c)
    silu_cc = jax.nn.silu(c_ctx)
    xc = ctx
    for l in range(DEPTH):
        ctx_out = l < DEPTH - 1
        mod_x = (silu_c @ w_ada[l] + b_ada[l])[:, None, :]
        mod_k = (silu_cc @ w_ada[l] + b_ada[l])[None, None, :]
        shx1, scx1, gx1, shx2, scx2, gx2 = jnp.split(mod_x, 6, axis=-1)
        shk1, sck1, gk1, shk2, sck2, gk2 = jnp.split(mod_k, 6, axis=-1)

        hx = rms_norm(x, norm_mix[l]) * (1.0 + scx1) + shx1
        hk = rms_norm(xc, norm_mix[l]) * (1.0 + sck1) + shk1
        px = split_proj(hx @ w_in[l])
        pk = split_proj(hk @ w_in[l])

        gla_x = gla_heads(px, w_gla_gate_up[l], b_gla_gate[l])
        gla_k = gla_heads(pk, w_gla_gate_up[l], b_gla_gate[l])
        s_zero = jnp.zeros((b, GLA_HEADS, GLA_DK, GLA_DV), jnp.float32)
        ok_gla, s_f, s_b = gla_bidir(*gla_k, s_zero, s_zero)
        ox_gla, _, _ = gla_bidir(*gla_x, s_f, s_b)

        qx, kx, vx = attn_heads(px, q_norm[l], k_norm[l], rope)
        qk_, kk_, vk_ = attn_heads(pk, q_norm[l], k_norm[l], None)
        ox_att = gqa_blocks(qx, jnp.concatenate([kk_, kx], axis=1), jnp.concatenate([vk_, vx], axis=1))

        ox = jnp.concatenate([fourier_mix(px[0]), gla_out(ox_gla, px[4], gla_norm[l]), ox_att], axis=-1) @ w_out[l]
        x = x + gx1 * ox
        if ctx_out:
            ok = jnp.concatenate([fourier_mix(pk[0]), gla_out(ok_gla, pk[4], gla_norm[l]), gqa_blocks(qk_, kk_, vk_)], axis=-1) @ w_out[l]
            xc = xc + gk1 * ok

        hx2 = rms_norm(x, norm_ffn[l]) * (1.0 + scx2) + shx2
        if ctx_out:
            hk2 = rms_norm(xc, norm_ffn[l]) * (1.0 + sck2) + shk2
            tokens = jnp.concatenate([hx2.reshape(b * n, d), hk2.reshape(b * m, d)], axis=0)
            y = moe_ffn(tokens, w_router, b_router, w_exp_gate[l], w_exp_up[l], w_exp_down[l])
            x = x + gx2 * y[:b * n].reshape(b, n, d)
            xc = xc + gk2 * y[b * n:].reshape(b, m, d)
        else:
            y = moe_ffn(hx2.reshape(b * n, d), w_router, b_router, w_exp_gate[l], w_exp_up[l], w_exp_down[l])
            x = x + gx2 * y.reshape(b, n, d)
    return rms_norm(x, final_norm)
```

```cpp
#include <hip/hip_runtime.h>
#include <hip/hip_cooperative_groups.h>
#include <cstdio>
#include <cstdint>
namespace cg = cooperative_groups;

typedef unsigned short bf16_t;
typedef float f32x4 __attribute__((ext_vector_type(4)));

constexpr int D = 1024, BATCH = 8, SEQ = 2048, CTXL = 256, DEPTH = 2;
constexpr int NL = BATCH * SEQ, NC = BATCH * CTXL, NTOK = NL + NC;
constexpr int DIN = 1824;
constexpr int C_FN = 0, C_GQ = 256, C_GK = 384, C_GV = 512, C_GG = 768, C_GDF = 1024, C_GDB = 1040, C_AQ = 1056, C_AK = 1568, C_AV = 1696;
constexpr int KEYS = CTXL + SEQ;
constexpr int NCHK = 36;
constexpr int NEXP = 16, DEXP = 512;
constexpr float EPS = 1e-6f;
constexpr float QSCALE = 0.125f * 1.4426950408889634f;
constexpr int NWAVES = 8, NTHREADS = 512;
constexpr int LDS_BYTES = 147456;

constexpr size_t MiB = 1u << 20;
constexpr size_t WS_CTL = 0;
constexpr size_t WS_MODP = 1 * MiB;
constexpr size_t WS_MOD = 9 * MiB;
constexpr size_t WS_TAB = 10 * MiB;
constexpr size_t WS_XC = 11 * MiB;
constexpr size_t WS_HB = 19 * MiB;
constexpr size_t WS_YFTL = 55 * MiB;
constexpr size_t WS_YFTC = 71 * MiB;
constexpr size_t WS_GQK = 73 * MiB;
constexpr size_t WS_GV = 82 * MiB;
constexpr size_t WS_GG = 91 * MiB;
constexpr size_t WS_GD = 100 * MiB;
constexpr size_t WS_AQ = 102 * MiB;
constexpr size_t WS_AK = 120 * MiB;
constexpr size_t WS_AVT = 125 * MiB;
constexpr size_t WS_AST = 130 * MiB;
constexpr size_t WS_DEC = 149 * MiB;
constexpr size_t WS_ROUTE = 150 * MiB;
constexpr size_t WS_Y = 151 * MiB;
constexpr size_t WS_END = 223 * MiB;

struct Params {
    const float *x, *c, *ctx, *c_ctx, *w_ada, *b_ada, *norm_mix, *norm_ffn, *w_in, *w_gup, *b_gg, *gla_norm, *q_norm, *k_norm, *w_out, *w_router, *b_router, *w_eg, *w_eu, *w_ed, *final_norm;
    float* out;
    unsigned char* ws;
};

__device__ __forceinline__ float bf2f(bf16_t v) { return __uint_as_float((unsigned)v << 16); }
__device__ __forceinline__ bf16_t f2bf(float f) { unsigned u = __float_as_uint(f); return (bf16_t)((u + 0x7fffu + ((u >> 16) & 1u)) >> 16); }
__device__ __forceinline__ float wave_sum(float v) {
#pragma unroll
    for (int o = 1; o < 64; o <<= 1) v += __shfl_xor(v, o);
    return v;
}
__device__ __forceinline__ float siluf(float v) { return v / (1.f + expf(-v)); }
__device__ __forceinline__ float sigmoidf(float v) { return 1.f / (1.f + expf(-v)); }
__device__ __forceinline__ float logsigmoidf(float z) { return fminf(z, 0.f) - log1pf(expf(-fabsf(z))); }
__device__ __forceinline__ void sincos_r(float x, float& s, float& c) {
    const float k = rintf(x * 0.63661977236758134f);
    float r = fmaf(k, -1.57079625129699707031f, x); r = fmaf(k, -7.54978995489188216e-8f, r);
    const int q = ((int)k) & 3;
    const float r2 = r * r;
    float sp = fmaf(r2, 2.7557314297e-6f, -1.9841270114e-4f); sp = fmaf(sp, r2, 8.3333337680e-3f); sp = fmaf(sp, r2, -1.6666667163e-1f); sp = fmaf(sp * r2, r, r);
    float cp = fmaf(r2, 2.4801587642e-5f, -1.3888889225e-3f); cp = fmaf(cp, r2, 4.1666667908e-2f); cp = fmaf(cp, r2, -0.5f); cp = fmaf(cp, r2, 1.f);
    const float ss = (q & 1) ? cp : sp, cc = (q & 1) ? sp : cp;
    s = (q & 2) ? -ss : ss; c = ((q + 1) & 2) ? -cc : cc;
}
struct RowInfo { int b, t, bidx, isctx; };
__device__ __forceinline__ RowInfo row_info(int r) { RowInfo ri; if (r < NL) { ri.b = r >> 11; ri.t = r & 2047; ri.bidx = ri.b; ri.isctx = 0; } else { const int q = r - NL; ri.b = q >> 8; ri.t = q & 255; ri.bidx = 8; ri.isctx = 1; } return ri; }

#define GW (blockIdx.x * NWAVES + (threadIdx.x >> 6))
#define NGW (gridDim.x * NWAVES)
#define GT (blockIdx.x * NTHREADS + threadIdx.x)
#define NGT (gridDim.x * NTHREADS)

__device__ void p0a(const Params& p) {
    const int lane = threadIdx.x & 63;
    float* MODP = (float*)(p.ws + WS_MODP);
    for (int it = GW; it < 2 * 16 * 96; it += NGW) {
        const int l = it / (16 * 96), kc = (it / 96) % 16, cb = it % 96, col = cb * 64 + lane;
        float acc[9];
#pragma unroll
        for (int j = 0; j < 9; ++j) acc[j] = 0.f;
        for (int kk = 0; kk < 64; ++kk) {
            const int k = kc * 64 + kk;
            const float w = p.w_ada[((size_t)l * D + k) * 6144 + col];
#pragma unroll
            for (int j = 0; j < 9; ++j) { const float cv = (j < 8) ? p.c[j * D + k] : p.c_ctx[k]; acc[j] = fmaf(siluf(cv), w, acc[j]); }
        }
#pragma unroll
        for (int j = 0; j < 9; ++j) MODP[((size_t)(l * 16 + kc) * 9 + j) * 6144 + col] = acc[j];
    }
    float* TAB = (float*)(p.ws + WS_TAB);
    for (int i = GT; i < 2048 + 1024; i += NGT) {
        if (i < 2048) { float s, c; sincos_r((float)i * (6.283185307179586f / 2048.f), s, c); TAB[i] = c; }
        else { const int q = i - 2048, pos = q >> 4, f = q & 15; const float inv = exp2f(-(float)f * (13.287712379549449f / 16.f)); float s, c; sincos_r((float)pos * inv, s, c); TAB[2048 + 2 * q] = c; TAB[2048 + 2 * q + 1] = s; }
    }
}
__device__ void p0b(const Params& p) {
    const float* MODP = (const float*)(p.ws + WS_MODP);
    float* MOD = (float*)(p.ws + WS_MOD);
    for (int i = GT; i < 2 * 9 * 6144; i += NGT) {
        const int l = i / (9 * 6144), j = (i / 6144) % 9, col = i % 6144;
        float s = p.b_ada[l * 6144 + col];
        for (int kc = 0; kc < 16; ++kc) s += MODP[((size_t)(l * 16 + kc) * 9 + j) * 6144 + col];
        MOD[i] = s;
    }
}

__device__ __forceinline__ float* xrow_ptr(const Params& p, int r) { return r < NL ? p.out + (size_t)r * D : (float*)(p.ws + WS_XC) + (size_t)(r - NL) * D; }
__device__ __forceinline__ const float* xin_ptr(const Params& p, int r) { return r < NL ? p.x + (size_t)r * D : p.ctx + (size_t)(r - NL) * D; }

__device__ void p1_norm1(const Params& p, int l) {
    const int lane = threadIdx.x & 63;
    const float* MOD = (const float*)(p.ws + WS_MOD);
    bf16_t* HB = (bf16_t*)(p.ws + WS_HB);
    const bf16_t* Y = (const bf16_t*)(p.ws + WS_Y);
    for (int r = GW; r < NTOK; r += NGW) {
        const RowInfo ri = row_info(r);
        f32x4 v[4]; float ss = 0.f;
#pragma unroll
        for (int j = 0; j < 4; ++j) {
            const int col = 4 * lane + 256 * j;
            if (l == 0) v[j] = *(const f32x4*)(xin_ptr(p, r) + col);
            else {
                float* xr = xrow_ptr(p, r) + col; v[j] = *(const f32x4*)xr;
                const f32x4 g2 = *(const f32x4*)(MOD + ((size_t)(l - 1) * 9 + ri.bidx) * 6144 + 5 * D + col);
                const bf16_t* y0 = Y + (size_t)(2 * r) * D + col; const bf16_t* y1 = y0 + D;
#pragma unroll
                for (int e = 0; e < 4; ++e) v[j][e] += g2[e] * (bf2f(y0[e]) + bf2f(y1[e]));
                *(f32x4*)xr = v[j];
            }
            ss += v[j][0] * v[j][0] + v[j][1] * v[j][1] + v[j][2] * v[j][2] + v[j][3] * v[j][3];
        }
        const float rstd = rsqrtf(wave_sum(ss) * (1.f / D) + EPS);
        const float* mod = MOD + ((size_t)l * 9 + ri.bidx) * 6144;
#pragma unroll
        for (int j = 0; j < 4; ++j) {
            const int col = 4 * lane + 256 * j;
            const f32x4 nw = *(const f32x4*)(p.norm_mix + l * D + col), sh = *(const f32x4*)(mod + col), sc = *(const f32x4*)(mod + D + col);
            bf16_t* o = HB + (size_t)r * D + col;
#pragma unroll
            for (int e = 0; e < 4; ++e) o[e] = f2bf(v[j][e] * rstd * nw[e] * (1.f + sc[e]) + sh[e]);
        }
    }
}

__device__ void p2_inproj_golden(const Params& p, int l, float* lds) {
    const int lane = threadIdx.x & 63, wave = threadIdx.x >> 6;
    float* hrow = lds + wave * 2880;
    float* orow = hrow + 1024;
    const bf16_t* HB = (const bf16_t*)(p.ws + WS_HB);
    const float* TAB = (const float*)(p.ws + WS_TAB);
    bf16_t* YFTL = (bf16_t*)(p.ws + WS_YFTL); bf16_t* YFTC = (bf16_t*)(p.ws + WS_YFTC);
    bf16_t* GQK = (bf16_t*)(p.ws + WS_GQK); bf16_t* GV = (bf16_t*)(p.ws + WS_GV); bf16_t* GG = (bf16_t*)(p.ws + WS_GG); bf16_t* GD = (bf16_t*)(p.ws + WS_GD);
    bf16_t* AQ = (bf16_t*)(p.ws + WS_AQ); bf16_t* AK = (bf16_t*)(p.ws + WS_AK); bf16_t* AVT = (bf16_t*)(p.ws + WS_AVT);
    const float* W = p.w_in + (size_t)l * D * DIN;
    for (int r = GW; r < NTOK; r += NGW) {
        const RowInfo ri = row_info(r);
        for (int k = lane; k < D; k += 64) hrow[k] = bf2f(HB[(size_t)r * D + k]);
        __builtin_amdgcn_s_waitcnt(0);
        float acc[29];
#pragma unroll
        for (int i = 0; i < 29; ++i) acc[i] = 0.f;
#pragma unroll 1
        for (int k = 0; k < D; ++k) {
            const float h = hrow[k]; const float* wr = W + (size_t)k * DIN + lane;
#pragma unroll
            for (int i = 0; i < 28; ++i) acc[i] = fmaf(h, wr[64 * i], acc[i]);
            if (lane < 32) acc[28] = fmaf(h, wr[64 * 28], acc[28]);
        }
#pragma unroll
        for (int i = 0; i < 28; ++i) orow[64 * i + lane] = acc[i];
        if (lane < 32) orow[64 * 28 + lane] = acc[28];
        __builtin_amdgcn_s_waitcnt(0);
        {
            const int j = lane;
#pragma unroll 1
            for (int g = 0; g < 4; ++g) {
                float yr = 0.f, ys = 0.f;
#pragma unroll 4
                for (int c = 0; c < 64; ++c) { const int m = ((j * c) & 63) * 32; const float u = orow[C_FN + g * 64 + c]; yr = fmaf(u, TAB[m], yr); ys = fmaf(u, TAB[(m - 512) & 2047], ys); }
                if (!ri.isctx) { bf16_t* o = YFTL + (((size_t)ri.b * 256 + g * 64 + j) * 2) * SEQ + ri.t; o[0] = f2bf(yr); o[SEQ] = f2bf(ys); }
                else { bf16_t* o = YFTC + (((size_t)ri.b * 256 + g * 64 + j) * 2) * CTXL + ri.t; o[0] = f2bf(yr); o[CTXL] = f2bf(ys); }
            }
        }
        for (int i = lane; i < 128; i += 64) { GQK[(size_t)r * 256 + i] = f2bf(orow[C_GQ + i] * 0.17677669529663687f); GQK[(size_t)r * 256 + 128 + i] = f2bf(orow[C_GK + i]); }
        for (int i = lane; i < 256; i += 64) { GV[(size_t)r * 256 + i] = f2bf(orow[C_GV + i]); GG[(size_t)r * 256 + i] = f2bf(orow[C_GG + i]); }
        if (lane < 32) GD[(size_t)r * 32 + lane] = f2bf(orow[C_GDF + lane]);
        {
            const int d = lane, axis = d >> 5, half = (d >> 4) & 1, f = d & 15;
            const int pos = axis == 0 ? (ri.t >> 6) : (ri.t & 63);
            const float cs = TAB[2048 + 2 * (pos * 16 + f)], sn = TAB[2048 + 2 * (pos * 16 + f) + 1];
#pragma unroll 1
            for (int h = 0; h < 10; ++h) {
                const int base = h < 8 ? C_AQ + h * 64 : C_AK + (h - 8) * 64;
                const float* nw = h < 8 ? p.q_norm + l * 64 : p.k_norm + l * 64;
                const float v = orow[base + d], vp = orow[base + (d ^ 16)];
                const float rs = rsqrtf(wave_sum(v * v) * (1.f / 64.f) + EPS);
                float xv = v * rs * nw[d], xp = vp * rs * nw[d ^ 16], o = xv;
                if (!ri.isctx) o = half == 0 ? xv * cs - xp * sn : xv * cs + xp * sn;
                if (h < 8) AQ[(size_t)r * 512 + h * 64 + d] = f2bf(o * QSCALE);
                else AK[((size_t)ri.b * KEYS + (ri.isctx ? ri.t : CTXL + ri.t)) * 128 + (h - 8) * 64 + d] = f2bf(o);
            }
            for (int kvh = 0; kvh < 2; ++kvh) AVT[(((size_t)ri.b * 2 + kvh) * 64 + d) * KEYS + (ri.isctx ? ri.t : CTXL + ri.t)] = f2bf(orow[C_AV + kvh * 64 + d]);
        }
        __builtin_amdgcn_s_waitcnt(0);
    }
}

__device__ void attn_golden_wave(const Params& p, int b, int h, int qrow, int nkeys) {
    const bf16_t* AQ = (const bf16_t*)(p.ws + WS_AQ); const bf16_t* AK = (const bf16_t*)(p.ws + WS_AK); const bf16_t* AVT = (const bf16_t*)(p.ws + WS_AVT);
    bf16_t* MIX = (bf16_t*)(p.ws + WS_HB);
    const int kvh = h >> 2, d = threadIdx.x & 63;
    const float q = bf2f(AQ[(size_t)qrow * 512 + h * 64 + d]);
    float o = 0.f, m = -1e30f, lsum = 0.f;
    const bf16_t* kb = AK + (size_t)b * KEYS * 128 + kvh * 64 + d;
    const bf16_t* vb = AVT + (((size_t)b * 2 + kvh) * 64 + d) * KEYS;
#pragma unroll 4
    for (int key = 0; key < nkeys; ++key) {
        const float s = wave_sum(q * bf2f(kb[(size_t)key * 128]));
        const float mn = fmaxf(m, s), a = exp2f(m - mn), pe = exp2f(s - mn);
        lsum = lsum * a + pe; m = mn;
        o = fmaf(o, a, pe * bf2f(vb[key]));
    }
    MIX[(size_t)qrow * D + 512 + h * 64 + d] = f2bf(o / lsum);
}

__device__ void gla_stage(const Params& p, int l, int b, int cs, int h, float* cumF, float* cumB, float* sq, float* sk, float* sv) {
    const int tid = threadIdx.x;
    const bf16_t* GQK = (const bf16_t*)(p.ws + WS_GQK); const bf16_t* GV = (const bf16_t*)(p.ws + WS_GV); const bf16_t* GD = (const bf16_t*)(p.ws + WS_GD);
    const int row0 = cs < 4 ? NL + b * CTXL + cs * 64 : b * SEQ + (cs - 4) * 64;
    for (int i = tid; i < 64 * 32 * 2; i += NTHREADS) {
        const int dir = i >> 11, tok = (i >> 5) & 63, k = i & 31;
        const float* wu = p.w_gup + ((size_t)(l * 2 + dir) * 16) * 128 + h * 32 + k;
        float z = p.b_gg[(l * 2 + dir) * 128 + h * 32 + k];
#pragma unroll
        for (int rr = 0; rr < 16; ++rr) z = fmaf(bf2f(GD[(size_t)(row0 + tok) * 32 + dir * 16 + rr]), wu[rr * 128], z);
        (dir == 0 ? cumF : cumB)[tok * 32 + k] = logsigmoidf(z) * (1.f / 16.f);
    }
    for (int i = tid; i < 64 * 32; i += NTHREADS) { const int tok = i >> 5, k = i & 31; sq[i] = bf2f(GQK[(size_t)(row0 + tok) * 256 + h * 32 + k]); sk[i] = bf2f(GQK[(size_t)(row0 + tok) * 256 + 128 + h * 32 + k]); }
    for (int i = tid; i < 64 * 64; i += NTHREADS) { const int tok = i >> 6, v = i & 63; sv[i] = bf2f(GV[(size_t)(row0 + tok) * 256 + h * 64 + v]); }
    __syncthreads();
    if (tid < 32) { float a = 0.f; for (int t = 0; t < 64; ++t) { a += cumF[t * 32 + tid]; cumF[t * 32 + tid] = a; } }
    else if (tid < 64) { const int k = tid - 32; float a = 0.f; for (int t = 63; t >= 0; --t) { a += cumB[t * 32 + k]; cumB[t * 32 + k] = a; } }
    __syncthreads();
}

__device__ void p3_mixers_golden(const Params& p, int l, float* lds) {
    const float* TAB = (const float*)(p.ws + WS_TAB);
    bf16_t* MIX = (bf16_t*)(p.ws + WS_HB);
    for (int i = GW; i < BATCH * 8 * SEQ; i += NGW) { const int q = i & 2047, h = (i >> 11) & 7, b = i >> 14; attn_golden_wave(p, b, h, b * SEQ + q, KEYS); }
    if (l == 0) for (int i = GW; i < BATCH * 8 * CTXL; i += NGW) { const int q = i & 255, h = (i >> 8) & 7, b = i >> 11; attn_golden_wave(p, b, h, NL + b * CTXL + q, CTXL); }
    {
        const bf16_t* YFTL = (const bf16_t*)(p.ws + WS_YFTL);
        const float scale = 1.f / sqrtf(64.f * SEQ);
        for (int i = GT; i < BATCH * 256 * SEQ; i += NGT) {
            const int k = i & 2047, j = (i >> 11) & 255, b = i >> 19;
            const bf16_t* yr = YFTL + (((size_t)b * 256 + j) * 2) * SEQ; const bf16_t* ys = yr + SEQ;
            float acc = 0.f;
            for (int t = 0; t < SEQ; ++t) { const int m = (k * t) & 2047; acc = fmaf(TAB[m], bf2f(yr[t]), acc); acc = fmaf(-TAB[(m - 512) & 2047], bf2f(ys[t]), acc); }
            MIX[(size_t)(b * SEQ + k) * D + j] = f2bf(acc * scale);
        }
    }
    if (l == 0) {
        const bf16_t* YFTC = (const bf16_t*)(p.ws + WS_YFTC);
        const float scale = 1.f / sqrtf(64.f * CTXL);
        for (int i = GT; i < BATCH * 256 * CTXL; i += NGT) {
            const int k = i & 255, j = (i >> 8) & 255, b = i >> 16;
            const bf16_t* yr = YFTC + (((size_t)b * 256 + j) * 2) * CTXL; const bf16_t* ys = yr + CTXL;
            float acc = 0.f;
            for (int t = 0; t < CTXL; ++t) { const int m = ((k * t) & 255) * 8; acc = fmaf(TAB[m], bf2f(yr[t]), acc); acc = fmaf(-TAB[(m - 512) & 2047], bf2f(ys[t]), acc); }
            MIX[(size_t)(NL + b * CTXL + k) * D + j] = f2bf(acc * scale);
        }
    }
    {
        float* cumF = lds; float* cumB = cumF + 2048; float* sq = cumB + 2048; float* sk = sq + 2048; float* sv = sk + 2048;
        float* AST = (float*)(p.ws + WS_AST); float* DEC = (float*)(p.ws + WS_DEC);
        for (int it = blockIdx.x; it < BATCH * NCHK * 4; it += gridDim.x) {
            const int h = it & 3, cs = (it >> 2) % NCHK, b = it / (4 * NCHK);
            __syncthreads();
            gla_stage(p, l, b, cs, h, cumF, cumB, sq, sk, sv);
            for (int i = threadIdx.x; i < 2 * 2048; i += NTHREADS) {
                const int dir = i >> 11, k = (i >> 6) & 31, v = i & 63;
                const float* cum = dir == 0 ? cumF : cumB; const float last = dir == 0 ? cum[63 * 32 + k] : cum[k];
                float a = 0.f;
                for (int t = 0; t < 64; ++t) a = fmaf(sk[t * 32 + k] * expf(last - cum[t * 32 + k]), sv[t * 64 + v], a);
                AST[((((size_t)b * NCHK + cs) * 4 + h) * 2 + dir) * 2048 + k * 64 + v] = a;
                if (v == 0) DEC[((((size_t)b * NCHK + cs) * 4 + h) * 2 + dir) * 32 + k] = expf(last);
            }
        }
    }
}

__device__ void p4_gla_out_golden(const Params& p, int l, float* lds) {
    float* cumF = lds; float* cumB = cumF + 2048; float* sq = cumB + 2048; float* sk = sq + 2048; float* sv = sk + 2048;
    float* Sf = sv + 4096; float* Sb = Sf + 2048; float* att = Sb + 2048; float* ob = att + 4096;
    const float* AST = (const float*)(p.ws + WS_AST); const float* DEC = (const float*)(p.ws + WS_DEC);
    const bf16_t* GG = (const bf16_t*)(p.ws + WS_GG);
    bf16_t* MIX = (bf16_t*)(p.ws + WS_HB);
    const int tid = threadIdx.x;
    for (int it = blockIdx.x; it < BATCH * NCHK * 4; it += gridDim.x) {
        const int h = it & 3, cs = (it >> 2) % NCHK, b = it / (4 * NCHK);
        if (l == 1 && cs < 4) continue;
        __syncthreads();
        gla_stage(p, l, b, cs, h, cumF, cumB, sq, sk, sv);
        for (int i = tid; i < 2048; i += NTHREADS) {
            const int k = i >> 6;
            float s = 0.f;
            for (int c = 0; c < cs; ++c) { const size_t id = (((size_t)b * NCHK + c) * 4 + h) * 2 + 0; s = DEC[id * 32 + k] * s + AST[id * 2048 + i]; }
            Sf[i] = s;
            s = 0.f;
            if (cs < 4) { for (int c = 3; c > cs; --c) { const size_t id = (((size_t)b * NCHK + c) * 4 + h) * 2 + 1; s = DEC[id * 32 + k] * s + AST[id * 2048 + i]; } }
            else { for (int c = 3; c >= 0; --c) { const size_t id = (((size_t)b * NCHK + c) * 4 + h) * 2 + 1; s = DEC[id * 32 + k] * s + AST[id * 2048 + i]; }
                   for (int c = NCHK - 1; c > cs; --c) { const size_t id = (((size_t)b * NCHK + c) * 4 + h) * 2 + 1; s = DEC[id * 32 + k] * s + AST[id * 2048 + i]; } }
            Sb[i] = s;
        }
        for (int i = tid; i < 4096; i += NTHREADS) {
            const int ti = i >> 6, tj = i & 63;
            float a = 0.f;
            if (tj <= ti) for (int k = 0; k < 32; ++k) a = fmaf(sq[ti * 32 + k] * sk[tj * 32 + k], expf(cumF[ti * 32 + k] - cumF[tj * 32 + k]), a);
            if (tj >= ti) for (int k = 0; k < 32; ++k) a = fmaf(sq[ti * 32 + k] * sk[tj * 32 + k], expf(cumB[ti * 32 + k] - cumB[tj * 32 + k]), a);
            att[i] = a;
        }
        __syncthreads();
        for (int i = tid; i < 4096; i += NTHREADS) {
            const int ti = i >> 6, v = i & 63;
            float a = 0.f;
            for (int tj = 0; tj < 64; ++tj) a = fmaf(att[ti * 64 + tj], sv[tj * 64 + v], a);
            for (int k = 0; k < 32; ++k) a = fmaf(sq[ti * 32 + k], expf(cumF[ti * 32 + k]) * Sf[k * 64 + v] + expf(cumB[ti * 32 + k]) * Sb[k * 64 + v], a);
            ob[i] = a;
        }
        __syncthreads();
        const int row0 = cs < 4 ? NL + b * CTXL + cs * 64 : b * SEQ + (cs - 4) * 64;
        for (int i = tid; i < 4096; i += NTHREADS) {
            const int ti = i >> 6, v = i & 63;
            float ss = 0.f;
            for (int vv = 0; vv < 64; ++vv) ss = fmaf(ob[ti * 64 + vv], ob[ti * 64 + vv], ss);
            const float rs = rsqrtf(ss * (1.f / 64.f) + EPS);
            const float g = bf2f(GG[(size_t)(row0 + ti) * 256 + h * 64 + v]);
            MIX[(size_t)(row0 + ti) * D + 256 + h * 64 + v] = f2bf(ob[i] * rs * p.gla_norm[l * 64 + v] * siluf(g));
        }
    }
}

__device__ void p5_outproj_golden(const Params& p, int l, float* lds) {
    const int lane = threadIdx.x & 63, wave = threadIdx.x >> 6;
    float* mrow = lds + wave * 1024;
    const bf16_t* MIX = (const bf16_t*)(p.ws + WS_HB);
    const float* MOD = (const float*)(p.ws + WS_MOD);
    const float* W = p.w_out + (size_t)l * D * D;
    const int nrows = l == 0 ? NTOK : NL;
    for (int r = GW; r < nrows; r += NGW) {
        const RowInfo ri = row_info(r);
        for (int k = lane; k < D; k += 64) mrow[k] = bf2f(MIX[(size_t)r * D + k]);
        __builtin_amdgcn_s_waitcnt(0);
        float acc[16];
#pragma unroll
        for (int i = 0; i < 16; ++i) acc[i] = 0.f;
        for (int k = 0; k < D; ++k) { const float m = mrow[k]; const float* wr = W + (size_t)k * D + lane;
#pragma unroll
            for (int i = 0; i < 16; ++i) acc[i] = fmaf(m, wr[64 * i], acc[i]); }
        const float* g1 = MOD + ((size_t)l * 9 + ri.bidx) * 6144 + 2 * D;
        const float* xs = l == 0 ? xin_ptr(p, r) : xrow_ptr(p, r);
        float* xd = xrow_ptr(p, r);
#pragma unroll
        for (int i = 0; i < 16; ++i) { const int col = 64 * i + lane; xd[col] = xs[col] + g1[col] * acc[i]; }
        __builtin_amdgcn_s_waitcnt(0);
    }
}

__device__ void p6_norm2_router(const Params& p, int l) {
    const int lane = threadIdx.x & 63;
    const float* MOD = (const float*)(p.ws + WS_MOD);
    bf16_t* HB = (bf16_t*)(p.ws + WS_HB);
    f32x4* ROUTE = (f32x4*)(p.ws + WS_ROUTE);
    const int nrows = l == 0 ? NTOK : NL;
    for (int r = GW; r < nrows; r += NGW) {
        const RowInfo ri = row_info(r);
        const float* xr = xrow_ptr(p, r);
        f32x4 v[4]; float ss = 0.f;
#pragma unroll
        for (int j = 0; j < 4; ++j) { v[j] = *(const f32x4*)(xr + 4 * lane + 256 * j); ss += v[j][0] * v[j][0] + v[j][1] * v[j][1] + v[j][2] * v[j][2] + v[j][3] * v[j][3]; }
        const float rstd = rsqrtf(wave_sum(ss) * (1.f / D) + EPS);
        const float* mod = MOD + ((size_t)l * 9 + ri.bidx) * 6144;
        float lg[16];
#pragma unroll
        for (int e = 0; e < 16; ++e) lg[e] = 0.f;
#pragma unroll
        for (int j = 0; j < 4; ++j) {
            const int col = 4 * lane + 256 * j;
            const f32x4 nw = *(const f32x4*)(p.norm_ffn + l * D + col), sh = *(const f32x4*)(mod + 3 * D + col), sc = *(const f32x4*)(mod + 4 * D + col);
            bf16_t* o = HB + (size_t)r * D + col;
#pragma unroll
            for (int e = 0; e < 4; ++e) {
                const float hv = v[j][e] * rstd * nw[e] * (1.f + sc[e]) + sh[e];
                o[e] = f2bf(hv);
                const f32x4* wr = (const f32x4*)(p.w_router + (size_t)(col + e) * 16);
#pragma unroll
                for (int q = 0; q < 4; ++q) { const f32x4 w4 = wr[q]; lg[4 * q] = fmaf(hv, w4[0], lg[4 * q]); lg[4 * q + 1] = fmaf(hv, w4[1], lg[4 * q + 1]); lg[4 * q + 2] = fmaf(hv, w4[2], lg[4 * q + 2]); lg[4 * q + 3] = fmaf(hv, w4[3], lg[4 * q + 3]); }
            }
        }
        float s[16], sel[16];
#pragma unroll
        for (int e = 0; e < 16; ++e) { s[e] = sigmoidf(wave_sum(lg[e])); sel[e] = s[e] + p.b_router[e]; }
        int bestg = 0; float bestscore = -1e30f;
#pragma unroll
        for (int g = 0; g < 4; ++g) {
            float m1 = -1e30f, m2 = -1e30f;
#pragma unroll
            for (int i = 0; i < 4; ++i) { const float vsel = sel[4 * g + i]; if (vsel > m1) { m2 = m1; m1 = vsel; } else if (vsel > m2) m2 = vsel; }
            const float gs = m1 + m2;
            if (gs > bestscore) { bestscore = gs; bestg = g; }
        }
        int i1 = 0, i2 = 0; float m1 = -1e30f, m2 = -1e30f, s1 = 0.f, s2 = 0.f;
#pragma unroll
        for (int g = 0; g < 4; ++g) if (g == bestg) {
#pragma unroll
            for (int i = 0; i < 4; ++i) { const float vsel = sel[4 * g + i]; if (vsel > m1) { m1 = vsel; i1 = i; s1 = s[4 * g + i]; } }
#pragma unroll
            for (int i = 0; i < 4; ++i) { const float vsel = sel[4 * g + i]; if (i != i1 && vsel > m2) { m2 = vsel; i2 = i; s2 = s[4 * g + i]; } }
        }
        if (lane == 0) { f32x4 rt; rt[0] = __int_as_float(bestg * 4 + i1); rt[1] = __int_as_float(bestg * 4 + i2); rt[2] = s1 / (s1 + s2); rt[3] = s2 / (s1 + s2); ROUTE[r] = rt; }
    }
}

__device__ void p78_moe_golden(const Params& p, int l, float* lds) {
    const int lane = threadIdx.x & 63, wave = threadIdx.x >> 6;
    float* hrow = lds + wave * 1536; float* arow = hrow + 1024;
    const bf16_t* HB = (const bf16_t*)(p.ws + WS_HB);
    const f32x4* ROUTE = (const f32x4*)(p.ws + WS_ROUTE);
    bf16_t* Y = (bf16_t*)(p.ws + WS_Y);
    const int nrows = l == 0 ? NTOK : NL;
    for (int it = GW; it < nrows * 2; it += NGW) {
        const int r = it >> 1, slot = it & 1;
        const f32x4 rt = ROUTE[r];
        const int e = __float_as_int(rt[slot]); const float wgt = rt[2 + slot];
        for (int k = lane; k < D; k += 64) hrow[k] = bf2f(HB[(size_t)r * D + k]);
        __builtin_amdgcn_s_waitcnt(0);
        const float* Wg = p.w_eg + ((size_t)(l * NEXP + e) * D) * DEXP; const float* Wu = p.w_eu + ((size_t)(l * NEXP + e) * D) * DEXP; const float* Wd = p.w_ed + ((size_t)(l * NEXP + e) * DEXP) * D;
        float ag[8], au[8];
#pragma unroll
        for (int i = 0; i < 8; ++i) { ag[i] = 0.f; au[i] = 0.f; }
        for (int k = 0; k < D; ++k) { const float hv = hrow[k]; const float* g = Wg + (size_t)k * DEXP + lane; const float* u = Wu + (size_t)k * DEXP + lane;
#pragma unroll
            for (int i = 0; i < 8; ++i) { ag[i] = fmaf(hv, g[64 * i], ag[i]); au[i] = fmaf(hv, u[64 * i], au[i]); } }
#pragma unroll
        for (int i = 0; i < 8; ++i) arow[64 * i + lane] = siluf(ag[i]) * au[i];
        __builtin_amdgcn_s_waitcnt(0);
        float acc[16];
#pragma unroll
        for (int i = 0; i < 16; ++i) acc[i] = 0.f;
        for (int j = 0; j < DEXP; ++j) { const float a = arow[j]; const float* wr = Wd + (size_t)j * D + lane;
#pragma unroll
            for (int i = 0; i < 16; ++i) acc[i] = fmaf(a, wr[64 * i], acc[i]); }
#pragma unroll
        for (int i = 0; i < 16; ++i) Y[(size_t)it * D + 64 * i + lane] = f2bf(wgt * acc[i]);
        __builtin_amdgcn_s_waitcnt(0);
    }
}

__device__ void p9_final(const Params& p) {
    const int lane = threadIdx.x & 63;
    const float* MOD = (const float*)(p.ws + WS_MOD);
    const bf16_t* Y = (const bf16_t*)(p.ws + WS_Y);
    for (int r = GW; r < NL; r += NGW) {
        const RowInfo ri = row_info(r);
        float* xr = p.out + (size_t)r * D;
        f32x4 v[4]; float ss = 0.f;
#pragma unroll
        for (int j = 0; j < 4; ++j) {
            const int col = 4 * lane + 256 * j;
            v[j] = *(const f32x4*)(xr + col);
            const f32x4 g2 = *(const f32x4*)(MOD + ((size_t)(DEPTH - 1) * 9 + ri.bidx) * 6144 + 5 * D + col);
            const bf16_t* y0 = Y + (size_t)(2 * r) * D + col; const bf16_t* y1 = y0 + D;
#pragma unroll
            for (int e = 0; e < 4; ++e) v[j][e] += g2[e] * (bf2f(y0[e]) + bf2f(y1[e]));
            ss += v[j][0] * v[j][0] + v[j][1] * v[j][1] + v[j][2] * v[j][2] + v[j][3] * v[j][3];
        }
        const float rstd = rsqrtf(wave_sum(ss) * (1.f / D) + EPS);
#pragma unroll
        for (int j = 0; j < 4; ++j) { const int col = 4 * lane + 256 * j; const f32x4 nw = *(const f32x4*)(p.final_norm + col); f32x4 o;
#pragma unroll
            for (int e = 0; e < 4; ++e) o[e] = v[j][e] * rstd * nw[e];
            *(f32x4*)(xr + col) = o; }
    }
}

__global__ void __launch_bounds__(NTHREADS) mega(Params p) {
    extern __shared__ __attribute__((aligned(16))) unsigned char lds_raw[];
    float* lds = (float*)lds_raw;
    cg::grid_group grid = cg::this_grid();
    p0a(p); grid.sync();
    p0b(p); grid.sync();
#define LAYER(l) do { p1_norm1(p, l); grid.sync(); p2_inproj_golden(p, l, lds); grid.sync(); p3_mixers_golden(p, l, lds); grid.sync(); p4_gla_out_golden(p, l, lds); grid.sync(); \
        p5_outproj_golden(p, l, lds); grid.sync(); p6_norm2_router(p, l); grid.sync(); p78_moe_golden(p, l, lds); grid.sync(); } while (0)
    LAYER(0);
    LAYER(1);
#undef LAYER
    p9_final(p);
}

extern "C" void kernel_launch(void* const* d_in, const int* in_sizes, int n_in, void* d_out, int out_size, void* d_ws, size_t ws_size, hipStream_t stream) {
    static int grid_blocks = 0;
    if (!grid_blocks) {
        int dev = 0, cus = 0, per_cu = 0;
        hipGetDevice(&dev);
        hipDeviceGetAttribute(&cus, hipDeviceAttributeMultiprocessorCount, dev);
        hipFuncSetAttribute((const void*)mega, hipFuncAttributeMaxDynamicSharedMemorySize, LDS_BYTES);
        hipOccupancyMaxActiveBlocksPerMultiprocessor(&per_cu, (const void*)mega, NTHREADS, LDS_BYTES);
        if (per_cu < 1) { fprintf(stderr, "occupancy query says %d blocks/CU\n", per_cu); per_cu = 1; }
        grid_blocks = cus;
        if (n_in != 21 || ws_size < WS_END) fprintf(stderr, "unexpected n_in %d / ws_size %zu\n", n_in, ws_size);
    }
    Params p{};
    const float** f = (const float**)&p;
    for (int i = 0; i < 21; ++i) f[i] = (const float*)d_in[i];
    p.out = (float*)d_out; p.ws = (unsigned char*)d_ws;
    void* args[] = {&p};
    hipError_t e = hipLaunchCooperativeKernel((const void*)mega, dim3(grid_blocks), dim3(NTHREADS), args, LDS_BYTES, stream);
    if (e != hipSuccess) fprintf(stderr, "cooperative launch failed: %s (grid %d)\n", hipGetErrorString(e), grid_blocks);
}
```

```cpp
#include <hip/hip_runtime.h>
#include <hip/hip_cooperative_groups.h>
#include <cstdio>
#include <cstdint>
namespace cg = cooperative_groups;

typedef unsigned short bf16_t;
typedef float f32x4 __attribute__((ext_vector_type(4)));

constexpr int D = 1024, BATCH = 8, SEQ = 2048, CTXL = 256, DEPTH = 2;
constexpr int NL = BATCH * SEQ, NC = BATCH * CTXL, NTOK = NL + NC;
constexpr int DIN = 1824;
constexpr int C_FN = 0, C_GQ = 256, C_GK = 384, C_GV = 512, C_GG = 768, C_GDF = 1024, C_GDB = 1040, C_AQ = 1056, C_AK = 1568, C_AV = 1696;
constexpr int KEYS = CTXL + SEQ;
constexpr int NCHK = 36;
constexpr int NEXP = 16, DEXP = 512;
constexpr float EPS = 1e-6f;
constexpr float QSCALE = 0.125f * 1.4426950408889634f;
constexpr int NWAVES = 8, NTHREADS = 512;
#define GOLDEN_FNET 0
#define GOLDEN_ATTN 0
constexpr int LDS_BYTES = 147456;

constexpr size_t MiB = 1u << 20;
constexpr size_t WS_CTL = 0;
constexpr size_t WS_MODP = 151 * MiB;
constexpr size_t WS_MOD = 9 * MiB;
constexpr size_t WS_TAB = 10 * MiB;
constexpr size_t WS_XC = 11 * MiB;
constexpr size_t WS_HB = 19 * MiB;
constexpr size_t WS_YFTL = 55 * MiB;
constexpr size_t WS_YFTC = 71 * MiB;
constexpr size_t WS_GQK = 73 * MiB;
constexpr size_t WS_GV = 82 * MiB;
constexpr size_t WS_GG = 91 * MiB;
constexpr size_t WS_GD = 100 * MiB;
constexpr size_t WS_AQ = 102 * MiB;
constexpr size_t WS_AK = 120 * MiB;
constexpr size_t WS_AVT = 125 * MiB;
constexpr size_t WS_AST = 130 * MiB;
constexpr size_t WS_DEC = 149 * MiB;
constexpr size_t WS_ROUTE = 150 * MiB;
constexpr size_t WS_Y = 151 * MiB;
constexpr size_t WS_WIN = 223 * MiB;
constexpr size_t WS_WOUT = 232 * MiB;
constexpr size_t WS_WGU = 236 * MiB;
constexpr size_t WS_WD = 268 * MiB;
constexpr size_t WS_DMAT = 284 * MiB;
constexpr size_t WS_DMATC = 300 * MiB;
constexpr size_t WS_LIST = 301 * MiB;
constexpr size_t WS_END = 304 * MiB;
constexpr size_t WS_ACT = WS_YFTL;
constexpr int CW_CNT = 8192;
constexpr int NIN = 2304;

struct Params {
    const float *x, *c, *ctx, *c_ctx, *w_ada, *b_ada, *norm_mix, *norm_ffn, *w_in, *w_gup, *b_gg, *gla_norm, *q_norm, *k_norm, *w_out, *w_router, *b_router, *w_eg, *w_eu, *w_ed, *final_norm;
    float* out;
    unsigned char* ws;
};

__device__ __forceinline__ float bf2f(bf16_t v) { return __uint_as_float((unsigned)v << 16); }
__device__ __forceinline__ bf16_t f2bf(float f) { unsigned u = __float_as_uint(f); return (bf16_t)((u + 0x7fffu + ((u >> 16) & 1u)) >> 16); }
__device__ __forceinline__ float wave_sum(float v) {
#pragma unroll
    for (int o = 1; o < 64; o <<= 1) v += __shfl_xor(v, o);
    return v;
}
__device__ __forceinline__ float siluf(float v) { return v / (1.f + expf(-v)); }
__device__ __forceinline__ float sigmoidf(float v) { return 1.f / (1.f + expf(-v)); }
__device__ __forceinline__ float logsigmoidf(float z) { return fminf(z, 0.f) - log1pf(expf(-fabsf(z))); }
__device__ __forceinline__ void sincos_r(float x, float& s, float& c) {
    const float k = rintf(x * 0.63661977236758134f);
    float r = fmaf(k, -1.57079625129699707031f, x); r = fmaf(k, -7.54978995489188216e-8f, r);
    const int q = ((int)k) & 3;
    const float r2 = r * r;
    float sp = fmaf(r2, 2.7557314297e-6f, -1.9841270114e-4f); sp = fmaf(sp, r2, 8.3333337680e-3f); sp = fmaf(sp, r2, -1.6666667163e-1f); sp = fmaf(sp * r2, r, r);
    float cp = fmaf(r2, 2.4801587642e-5f, -1.3888889225e-3f); cp = fmaf(cp, r2, 4.1666667908e-2f); cp = fmaf(cp, r2, -0.5f); cp = fmaf(cp, r2, 1.f);
    const float ss = (q & 1) ? cp : sp, cc = (q & 1) ? sp : cp;
    s = (q & 2) ? -ss : ss; c = ((q + 1) & 2) ? -cc : cc;
}
struct RowInfo { int b, t, bidx, isctx; };
__device__ __forceinline__ RowInfo row_info(int r) { RowInfo ri; if (r < NL) { ri.b = r >> 11; ri.t = r & 2047; ri.bidx = ri.b; ri.isctx = 0; } else { const int q = r - NL; ri.b = q >> 8; ri.t = q & 255; ri.bidx = 8; ri.isctx = 1; } return ri; }

__device__ __forceinline__ int otid() { int t = threadIdx.x; asm volatile("" : "+v"(t)); return t; }
__device__ __forceinline__ int obid() { int b = blockIdx.x; asm volatile("" : "+s"(b)); return b; }
#define PHASE_IDS const int tidx = otid(); const int bidx_ = obid(); (void)tidx; (void)bidx_
#define GW (bidx_ * NWAVES + (tidx >> 6))
#define NGW (gridDim.x * NWAVES)
#define GT (bidx_ * NTHREADS + tidx)
#define NGT (gridDim.x * NTHREADS)

__device__ void p0a(const Params& p) { PHASE_IDS;
    const int lane = tidx & 63;
    float* MODP = (float*)(p.ws + WS_MODP);
    for (int it = GW; it < 2 * 16 * 96; it += NGW) {
        const int l = it / (16 * 96), kc = (it / 96) % 16, cb = it % 96, col = cb * 64 + lane;
        float acc[9];
#pragma unroll
        for (int j = 0; j < 9; ++j) acc[j] = 0.f;
        for (int kk = 0; kk < 64; ++kk) {
            const int k = kc * 64 + kk;
            const float w = p.w_ada[((size_t)l * D + k) * 6144 + col];
#pragma unroll
            for (int j = 0; j < 9; ++j) { const float cv = (j < 8) ? p.c[j * D + k] : p.c_ctx[k]; acc[j] = fmaf(siluf(cv), w, acc[j]); }
        }
#pragma unroll
        for (int j = 0; j < 9; ++j) MODP[((size_t)(l * 16 + kc) * 9 + j) * 6144 + col] = acc[j];
    }
    float* TAB = (float*)(p.ws + WS_TAB);
    for (int i = GT; i < 2048 + 1024; i += NGT) {
        if (i < 2048) { float s, c; sincos_r((float)i * (6.283185307179586f / 2048.f), s, c); TAB[i] = c; }
        else { const int q = i - 2048, pos = q >> 4, f = q & 15; const float inv = exp2f(-(float)f * (13.287712379549449f / 16.f)); float s, c; sincos_r((float)pos * inv, s, c); TAB[2048 + 2 * q] = c; TAB[2048 + 2 * q + 1] = s; }
    }
}
__device__ void p0b(const Params& p) { PHASE_IDS;
    const float* MODP = (const float*)(p.ws + WS_MODP);
    float* MOD = (float*)(p.ws + WS_MOD);
    for (int i = GT; i < 2 * 9 * 6144; i += NGT) {
        const int l = i / (9 * 6144), j = (i / 6144) % 9, col = i % 6144;
        float s = p.b_ada[l * 6144 + col];
        for (int kc = 0; kc < 16; ++kc) s += MODP[((size_t)(l * 16 + kc) * 9 + j) * 6144 + col];
        MOD[i] = s;
    }
}

__device__ __forceinline__ float* xrow_ptr(const Params& p, int r) { return r < NL ? p.out + (size_t)r * D : (float*)(p.ws + WS_XC) + (size_t)(r - NL) * D; }
__device__ __forceinline__ const float* xin_ptr(const Params& p, int r) { return r < NL ? p.x + (size_t)r * D : p.ctx + (size_t)(r - NL) * D; }

__device__ void p1_norm1(const Params& p, int l) { PHASE_IDS;
    const int lane = tidx & 63;
    const float* MOD = (const float*)(p.ws + WS_MOD);
    bf16_t* HB = (bf16_t*)(p.ws + WS_HB);
    const bf16_t* Y = (const bf16_t*)(p.ws + WS_Y);
    for (int r = GW; r < NTOK; r += NGW) {
        const RowInfo ri = row_info(r);
        f32x4 v[4]; float ss = 0.f;
#pragma unroll
        for (int j = 0; j < 4; ++j) {
            const int col = 4 * lane + 256 * j;
            if (l == 0) v[j] = *(const f32x4*)(xin_ptr(p, r) + col);
            else {
                float* xr = xrow_ptr(p, r) + col; v[j] = *(const f32x4*)xr;
                const f32x4 g2 = *(const f32x4*)(MOD + ((size_t)(l - 1) * 9 + ri.bidx) * 6144 + 5 * D + col);
                const bf16_t* y0 = Y + (size_t)(2 * r) * D + col; const bf16_t* y1 = y0 + D;
#pragma unroll
                for (int e = 0; e < 4; ++e) v[j][e] += g2[e] * (bf2f(y0[e]) + bf2f(y1[e]));
                *(f32x4*)xr = v[j];
            }
            ss += v[j][0] * v[j][0] + v[j][1] * v[j][1] + v[j][2] * v[j][2] + v[j][3] * v[j][3];
        }
        const float rstd = rsqrtf(wave_sum(ss) * (1.f / D) + EPS);
        const float* mod = MOD + ((size_t)l * 9 + ri.bidx) * 6144;
#pragma unroll
        for (int j = 0; j < 4; ++j) {
            const int col = 4 * lane + 256 * j;
            const f32x4 nw = *(const f32x4*)(p.norm_mix + l * D + col), sh = *(const f32x4*)(mod + col), sc = *(const f32x4*)(mod + D + col);
            bf16_t* o = HB + (size_t)r * D + col;
#pragma unroll
            for (int e = 0; e < 4; ++e) o[e] = f2bf(v[j][e] * rstd * nw[e] * (1.f + sc[e]) + sh[e]);
        }
    }
}

__device__ void p2_inproj_golden(const Params& p, int l, float* lds) { PHASE_IDS;
    const int lane = tidx & 63, wave = tidx >> 6;
    float* hrow = lds + wave * 2880;
    float* orow = hrow + 1024;
    const bf16_t* HB = (const bf16_t*)(p.ws + WS_HB);
    const float* TAB = (const float*)(p.ws + WS_TAB);
    bf16_t* YFTL = (bf16_t*)(p.ws + WS_YFTL); bf16_t* YFTC = (bf16_t*)(p.ws + WS_YFTC);
    bf16_t* GQK = (bf16_t*)(p.ws + WS_GQK); bf16_t* GV = (bf16_t*)(p.ws + WS_GV); bf16_t* GG = (bf16_t*)(p.ws + WS_GG); bf16_t* GD = (bf16_t*)(p.ws + WS_GD);
    bf16_t* AQ = (bf16_t*)(p.ws + WS_AQ); bf16_t* AK = (bf16_t*)(p.ws + WS_AK); bf16_t* AVT = (bf16_t*)(p.ws + WS_AVT);
    const float* W = p.w_in + (size_t)l * D * DIN;
    for (int r = GW; r < NTOK; r += NGW) {
        const RowInfo ri = row_info(r);
        for (int k = lane; k < D; k += 64) hrow[k] = bf2f(HB[(size_t)r * D + k]);
        __builtin_amdgcn_s_waitcnt(0);
        float acc[29];
#pragma unroll
        for (int i = 0; i < 29; ++i) acc[i] = 0.f;
#pragma unroll 1
        for (int k = 0; k < D; ++k) {
            const float h = hrow[k]; const float* wr = W + (size_t)k * DIN + lane;
#pragma unroll
            for (int i = 0; i < 28; ++i) acc[i] = fmaf(h, wr[64 * i], acc[i]);
            if (lane < 32) acc[28] = fmaf(h, wr[64 * 28], acc[28]);
        }
#pragma unroll
        for (int i = 0; i < 28; ++i) orow[64 * i + lane] = acc[i];
        if (lane < 32) orow[64 * 28 + lane] = acc[28];
        __builtin_amdgcn_s_waitcnt(0);
        {
            const int j = lane;
#pragma unroll 1
            for (int g = 0; g < 4; ++g) {
                float yr = 0.f, ys = 0.f;
#pragma unroll 4
                for (int c = 0; c < 64; ++c) { const int m = ((j * c) & 63) * 32; const float u = orow[C_FN + g * 64 + c]; yr = fmaf(u, TAB[m], yr); ys = fmaf(u, TAB[(m - 512) & 2047], ys); }
                if (!ri.isctx) { bf16_t* o = YFTL + (((size_t)ri.b * 256 + g * 64 + j) * 2) * SEQ + ri.t; o[0] = f2bf(yr); o[SEQ] = f2bf(ys); }
                else { bf16_t* o = YFTC + (((size_t)ri.b * 256 + g * 64 + j) * 2) * CTXL + ri.t; o[0] = f2bf(yr); o[CTXL] = f2bf(ys); }
            }
        }
        for (int i = lane; i < 128; i += 64) { GQK[(size_t)r * 256 + i] = f2bf(orow[C_GQ + i] * 0.17677669529663687f); GQK[(size_t)r * 256 + 128 + i] = f2bf(orow[C_GK + i]); }
        for (int i = lane; i < 256; i += 64) { GV[(size_t)r * 256 + i] = f2bf(orow[C_GV + i]); GG[(size_t)r * 256 + i] = f2bf(orow[C_GG + i]); }
        if (lane < 32) GD[(size_t)r * 32 + lane] = f2bf(orow[C_GDF + lane]);
        {
            const int d = lane, axis = d >> 5, half = (d >> 4) & 1, f = d & 15;
            const int pos = axis == 0 ? (ri.t >> 6) : (ri.t & 63);
            const float cs = TAB[2048 + 2 * (pos * 16 + f)], sn = TAB[2048 + 2 * (pos * 16 + f) + 1];
#pragma unroll 1
            for (int h = 0; h < 10; ++h) {
                const int base = h < 8 ? C_AQ + h * 64 : C_AK + (h - 8) * 64;
                const float* nw = h < 8 ? p.q_norm + l * 64 : p.k_norm + l * 64;
                const float v = orow[base + d], vp = orow[base + (d ^ 16)];
                const float rs = rsqrtf(wave_sum(v * v) * (1.f / 64.f) + EPS);
                float xv = v * rs * nw[d], xp = vp * rs * nw[d ^ 16], o = xv;
                if (!ri.isctx) o = half == 0 ? xv * cs - xp * sn : xv * cs + xp * sn;
                if (h < 8) AQ[(size_t)r * 512 + h * 64 + d] = f2bf(o * QSCALE);
                else AK[((size_t)ri.b * KEYS + (ri.isctx ? ri.t : CTXL + ri.t)) * 128 + (h - 8) * 64 + d] = f2bf(o);
            }
            for (int kvh = 0; kvh < 2; ++kvh) AVT[(((size_t)ri.b * 2 + kvh) * 64 + d) * KEYS + (ri.isctx ? ri.t : CTXL + ri.t)] = f2bf(orow[C_AV + kvh * 64 + d]);
        }
        __builtin_amdgcn_s_waitcnt(0);
    }
}

__device__ void attn_golden_wave(const Params& p, int b, int h, int qrow, int nkeys) { PHASE_IDS;
    const bf16_t* AQ = (const bf16_t*)(p.ws + WS_AQ); const bf16_t* AK = (const bf16_t*)(p.ws + WS_AK); const bf16_t* AVT = (const bf16_t*)(p.ws + WS_AVT);
    bf16_t* MIX = (bf16_t*)(p.ws + WS_HB);
    const int kvh = h >> 2, d = tidx & 63;
    const float q = bf2f(AQ[(size_t)qrow * 512 + h * 64 + d]);
    float o = 0.f, m = -1e30f, lsum = 0.f;
    const bf16_t* kb = AK + (size_t)b * KEYS * 128 + kvh * 64 + d;
    const bf16_t* vb = AVT + (((size_t)b * 2 + kvh) * 64 + d) * KEYS;
#pragma unroll 4
    for (int key = 0; key < nkeys; ++key) {
        const float s = wave_sum(q * bf2f(kb[(size_t)key * 128]));
        const float mn = fmaxf(m, s), a = exp2f(m - mn), pe = exp2f(s - mn);
        lsum = lsum * a + pe; m = mn;
        o = fmaf(o, a, pe * bf2f(vb[key]));
    }
    MIX[(size_t)qrow * D + 512 + h * 64 + d] = f2bf(o / lsum);
}

__device__ void gla_stage(const Params& p, int l, int b, int cs, int h, float* cumF, float* cumB, float* sq, float* sk, float* sv) { PHASE_IDS;
    const int tid = tidx;
    const bf16_t* GQK = (const bf16_t*)(p.ws + WS_GQK); const bf16_t* GV = (const bf16_t*)(p.ws + WS_GV); const bf16_t* GD = (const bf16_t*)(p.ws + WS_GD);
    const int row0 = cs < 4 ? NL + b * CTXL + cs * 64 : b * SEQ + (cs - 4) * 64;
    for (int i = tid; i < 64 * 32 * 2; i += NTHREADS) {
        const int dir = i >> 11, tok = (i >> 5) & 63, k = i & 31;
        const float* wu = p.w_gup + ((size_t)(l * 2 + dir) * 16) * 128 + h * 32 + k;
        float z = p.b_gg[(l * 2 + dir) * 128 + h * 32 + k];
#pragma unroll
        for (int rr = 0; rr < 16; ++rr) z = fmaf(bf2f(GD[(size_t)(row0 + tok) * 32 + dir * 16 + rr]), wu[rr * 128], z);
        (dir == 0 ? cumF : cumB)[tok * 32 + k] = logsigmoidf(z) * (1.f / 16.f);
    }
    for (int i = tid; i < 64 * 32; i += NTHREADS) { const int tok = i >> 5, k = i & 31; sq[i] = bf2f(GQK[(size_t)(row0 + tok) * 256 + h * 32 + k]); sk[i] = bf2f(GQK[(size_t)(row0 + tok) * 256 + 128 + h * 32 + k]); }
    for (int i = tid; i < 64 * 64; i += NTHREADS) { const int tok = i >> 6, v = i & 63; sv[i] = bf2f(GV[(size_t)(row0 + tok) * 256 + h * 64 + v]); }
    __syncthreads();
    if (tid < 32) { float a = 0.f; for (int t = 0; t < 64; ++t) { a += cumF[t * 32 + tid]; cumF[t * 32 + tid] = a; } }
    else if (tid < 64) { const int k = tid - 32; float a = 0.f; for (int t = 63; t >= 0; --t) { a += cumB[t * 32 + k]; cumB[t * 32 + k] = a; } }
    __syncthreads();
}

__device__ void p3_mixers_golden(const Params& p, int l, float* lds) { PHASE_IDS;
    const float* TAB = (const float*)(p.ws + WS_TAB);
    bf16_t* MIX = (bf16_t*)(p.ws + WS_HB);
    if (GOLDEN_ATTN) for (int i = GW; i < BATCH * 8 * SEQ; i += NGW) { const int q = i & 2047, h = (i >> 11) & 7, b = i >> 14; attn_golden_wave(p, b, h, b * SEQ + q, KEYS); }
    if (GOLDEN_ATTN && l == 0) for (int i = GW; i < BATCH * 8 * CTXL; i += NGW) { const int q = i & 255, h = (i >> 8) & 7, b = i >> 11; attn_golden_wave(p, b, h, NL + b * CTXL + q, CTXL); }
    if (GOLDEN_FNET) {
        const bf16_t* YFTL = (const bf16_t*)(p.ws + WS_YFTL);
        const float scale = 1.f / sqrtf(64.f * SEQ);
        for (int i = GT; i < BATCH * 256 * SEQ; i += NGT) {
            const int k = i & 2047, j = (i >> 11) & 255, b = i >> 19;
            const bf16_t* yr = YFTL + (((size_t)b * 256 + j) * 2) * SEQ; const bf16_t* ys = yr + SEQ;
            float acc = 0.f;
            for (int t = 0; t < SEQ; ++t) { const int m = (k * t) & 2047; acc = fmaf(TAB[m], bf2f(yr[t]), acc); acc = fmaf(-TAB[(m - 512) & 2047], bf2f(ys[t]), acc); }
            MIX[(size_t)(b * SEQ + k) * D + j] = f2bf(acc * scale);
        }
    }
    if (GOLDEN_FNET && l == 0) {
        const bf16_t* YFTC = (const bf16_t*)(p.ws + WS_YFTC);
        const float scale = 1.f / sqrtf(64.f * CTXL);
        for (int i = GT; i < BATCH * 256 * CTXL; i += NGT) {
            const int k = i & 255, j = (i >> 8) & 255, b = i >> 16;
            const bf16_t* yr = YFTC + (((size_t)b * 256 + j) * 2) * CTXL; const bf16_t* ys = yr + CTXL;
            float acc = 0.f;
            for (int t = 0; t < CTXL; ++t) { const int m = ((k * t) & 255) * 8; acc = fmaf(TAB[m], bf2f(yr[t]), acc); acc = fmaf(-TAB[(m - 512) & 2047], bf2f(ys[t]), acc); }
            MIX[(size_t)(NL + b * CTXL + k) * D + j] = f2bf(acc * scale);
        }
    }
    {
        float* cumF = lds; float* cumB = cumF + 2048; float* sq = cumB + 2048; float* sk = sq + 2048; float* sv = sk + 2048;
        float* AST = (float*)(p.ws + WS_AST); float* DEC = (float*)(p.ws + WS_DEC);
        for (int it = bidx_; it < BATCH * NCHK * 4; it += gridDim.x) {
            const int h = it & 3, cs = (it >> 2) % NCHK, b = it / (4 * NCHK);
            __syncthreads();
            gla_stage(p, l, b, cs, h, cumF, cumB, sq, sk, sv);
            for (int i = tidx; i < 2 * 2048; i += NTHREADS) {
                const int dir = i >> 11, k = (i >> 6) & 31, v = i & 63;
                const float* cum = dir == 0 ? cumF : cumB; const float last = dir == 0 ? cum[63 * 32 + k] : cum[k];
                float a = 0.f;
                for (int t = 0; t < 64; ++t) a = fmaf(sk[t * 32 + k] * expf(last - cum[t * 32 + k]), sv[t * 64 + v], a);
                AST[((((size_t)b * NCHK + cs) * 4 + h) * 2 + dir) * 2048 + k * 64 + v] = a;
                if (v == 0) DEC[((((size_t)b * NCHK + cs) * 4 + h) * 2 + dir) * 32 + k] = expf(last);
            }
        }
    }
}

__device__ void p4_gla_out_golden(const Params& p, int l, float* lds) { PHASE_IDS;
    float* cumF = lds; float* cumB = cumF + 2048; float* sq = cumB + 2048; float* sk = sq + 2048; float* sv = sk + 2048;
    float* Sf = sv + 4096; float* Sb = Sf + 2048; float* att = Sb + 2048; float* ob = att + 4096;
    const float* AST = (const float*)(p.ws + WS_AST); const float* DEC = (const float*)(p.ws + WS_DEC);
    const bf16_t* GG = (const bf16_t*)(p.ws + WS_GG);
    bf16_t* MIX = (bf16_t*)(p.ws + WS_HB);
    const int tid = tidx;
    for (int it = bidx_; it < BATCH * NCHK * 4; it += gridDim.x) {
        const int h = it & 3, cs = (it >> 2) % NCHK, b = it / (4 * NCHK);
        if (l == 1 && cs < 4) continue;
        __syncthreads();
        gla_stage(p, l, b, cs, h, cumF, cumB, sq, sk, sv);
        for (int i = tid; i < 2048; i += NTHREADS) {
            const int k = i >> 6;
            float s = 0.f;
            for (int c = 0; c < cs; ++c) { const size_t id = (((size_t)b * NCHK + c) * 4 + h) * 2 + 0; s = DEC[id * 32 + k] * s + AST[id * 2048 + i]; }
            Sf[i] = s;
            s = 0.f;
            if (cs < 4) { for (int c = 3; c > cs; --c) { const size_t id = (((size_t)b * NCHK + c) * 4 + h) * 2 + 1; s = DEC[id * 32 + k] * s + AST[id * 2048 + i]; } }
            else { for (int c = 3; c >= 0; --c) { const size_t id = (((size_t)b * NCHK + c) * 4 + h) * 2 + 1; s = DEC[id * 32 + k] * s + AST[id * 2048 + i]; }
                   for (int c = NCHK - 1; c > cs; --c) { const size_t id = (((size_t)b * NCHK + c) * 4 + h) * 2 + 1; s = DEC[id * 32 + k] * s + AST[id * 2048 + i]; } }
            Sb[i] = s;
        }
        for (int i = tid; i < 4096; i += NTHREADS) {
            const int ti = i >> 6, tj = i & 63;
            float a = 0.f;
            if (tj <= ti) for (int k = 0; k < 32; ++k) a = fmaf(sq[ti * 32 + k] * sk[tj * 32 + k], expf(cumF[ti * 32 + k] - cumF[tj * 32 + k]), a);
            if (tj >= ti) for (int k = 0; k < 32; ++k) a = fmaf(sq[ti * 32 + k] * sk[tj * 32 + k], expf(cumB[ti * 32 + k] - cumB[tj * 32 + k]), a);
            att[i] = a;
        }
        __syncthreads();
        for (int i = tid; i < 4096; i += NTHREADS) {
            const int ti = i >> 6, v = i & 63;
            float a = 0.f;
            for (int tj = 0; tj < 64; ++tj) a = fmaf(att[ti * 64 + tj], sv[tj * 64 + v], a);
            for (int k = 0; k < 32; ++k) a = fmaf(sq[ti * 32 + k], expf(cumF[ti * 32 + k]) * Sf[k * 64 + v] + expf(cumB[ti * 32 + k]) * Sb[k * 64 + v], a);
            ob[i] = a;
        }
        __syncthreads();
        const int row0 = cs < 4 ? NL + b * CTXL + cs * 64 : b * SEQ + (cs - 4) * 64;
        for (int i = tid; i < 4096; i += NTHREADS) {
            const int ti = i >> 6, v = i & 63;
            float ss = 0.f;
            for (int vv = 0; vv < 64; ++vv) ss = fmaf(ob[ti * 64 + vv], ob[ti * 64 + vv], ss);
            const float rs = rsqrtf(ss * (1.f / 64.f) + EPS);
            const float g = bf2f(GG[(size_t)(row0 + ti) * 256 + h * 64 + v]);
            MIX[(size_t)(row0 + ti) * D + 256 + h * 64 + v] = f2bf(ob[i] * rs * p.gla_norm[l * 64 + v] * siluf(g));
        }
    }
}

__device__ void p5_outproj_golden(const Params& p, int l, float* lds) { PHASE_IDS;
    const int lane = tidx & 63, wave = tidx >> 6;
    float* mrow = lds + wave * 1024;
    const bf16_t* MIX = (const bf16_t*)(p.ws + WS_HB);
    const float* MOD = (const float*)(p.ws + WS_MOD);
    const float* W = p.w_out + (size_t)l * D * D;
    const int nrows = l == 0 ? NTOK : NL;
    for (int r = GW; r < nrows; r += NGW) {
        const RowInfo ri = row_info(r);
        for (int k = lane; k < D; k += 64) mrow[k] = bf2f(MIX[(size_t)r * D + k]);
        __builtin_amdgcn_s_waitcnt(0);
        float acc[16];
#pragma unroll
        for (int i = 0; i < 16; ++i) acc[i] = 0.f;
        for (int k = 0; k < D; ++k) { const float m = mrow[k]; const float* wr = W + (size_t)k * D + lane;
#pragma unroll
            for (int i = 0; i < 16; ++i) acc[i] = fmaf(m, wr[64 * i], acc[i]); }
        const float* g1 = MOD + ((size_t)l * 9 + ri.bidx) * 6144 + 2 * D;
        const float* xs = l == 0 ? xin_ptr(p, r) : xrow_ptr(p, r);
        float* xd = xrow_ptr(p, r);
#pragma unroll
        for (int i = 0; i < 16; ++i) { const int col = 64 * i + lane; xd[col] = xs[col] + g1[col] * acc[i]; }
        __builtin_amdgcn_s_waitcnt(0);
    }
}

__device__ void p6_norm2_router(const Params& p, int l, float* lds) { PHASE_IDS;
    const int lane = tidx & 63;
    const float* MOD = (const float*)(p.ws + WS_MOD);
    bf16_t* HB = (bf16_t*)(p.ws + WS_HB);
    f32x4* ROUTE = (f32x4*)(p.ws + WS_ROUTE);
    const int nrows = l == 0 ? NTOK : NL;
    const int rpb = (nrows + (int)gridDim.x - 1) / (int)gridDim.x, rbeg = bidx_ * rpb, rend = (rbeg + rpb < nrows) ? rbeg + rpb : nrows;
    int* lcnt = (int*)lds; int* lbase = lcnt + 16; int* rroute = lbase + 16;
    if (tidx < 16) lcnt[tidx] = 0;
    __syncthreads();
    for (int r = rbeg + (tidx >> 6); r < rend; r += NWAVES) {
        const RowInfo ri = row_info(r);
        const float* xr = xrow_ptr(p, r);
        f32x4 v[4]; float ss = 0.f;
#pragma unroll
        for (int j = 0; j < 4; ++j) { v[j] = *(const f32x4*)(xr + 4 * lane + 256 * j); ss += v[j][0] * v[j][0] + v[j][1] * v[j][1] + v[j][2] * v[j][2] + v[j][3] * v[j][3]; }
        const float rstd = rsqrtf(wave_sum(ss) * (1.f / D) + EPS);
        const float* mod = MOD + ((size_t)l * 9 + ri.bidx) * 6144;
        float lg[16];
#pragma unroll
        for (int e = 0; e < 16; ++e) lg[e] = 0.f;
#pragma unroll
        for (int j = 0; j < 4; ++j) {
            const int col = 4 * lane + 256 * j;
            const f32x4 nw = *(const f32x4*)(p.norm_ffn + l * D + col), sh = *(const f32x4*)(mod + 3 * D + col), sc = *(const f32x4*)(mod + 4 * D + col);
            bf16_t* o = HB + (size_t)r * D + col;
#pragma unroll
            for (int e = 0; e < 4; ++e) {
                const float hv = v[j][e] * rstd * nw[e] * (1.f + sc[e]) + sh[e];
                o[e] = f2bf(hv);
                const f32x4* wr = (const f32x4*)(p.w_router + (size_t)(col + e) * 16);
#pragma unroll
                for (int q = 0; q < 4; ++q) { const f32x4 w4 = wr[q]; lg[4 * q] = fmaf(hv, w4[0], lg[4 * q]); lg[4 * q + 1] = fmaf(hv, w4[1], lg[4 * q + 1]); lg[4 * q + 2] = fmaf(hv, w4[2], lg[4 * q + 2]); lg[4 * q + 3] = fmaf(hv, w4[3], lg[4 * q + 3]); }
            }
        }
        float s[16], sel[16];
#pragma unroll
        for (int e = 0; e < 16; ++e) { s[e] = sigmoidf(wave_sum(lg[e])); sel[e] = s[e] + p.b_router[e]; }
        int bestg = 0; float bestscore = -1e30f;
#pragma unroll
        for (int g = 0; g < 4; ++g) {
            float m1 = -1e30f, m2 = -1e30f;
#pragma unroll
            for (int i = 0; i < 4; ++i) { const float vsel = sel[4 * g + i]; if (vsel > m1) { m2 = m1; m1 = vsel; } else if (vsel > m2) m2 = vsel; }
            const float gs = m1 + m2;
            if (gs > bestscore) { bestscore = gs; bestg = g; }
        }
        int i1 = 0, i2 = 0; float m1 = -1e30f, m2 = -1e30f, s1 = 0.f, s2 = 0.f;
#pragma unroll
        for (int g = 0; g < 4; ++g) if (g == bestg) {
#pragma unroll
            for (int i = 0; i < 4; ++i) { const float vsel = sel[4 * g + i]; if (vsel > m1) { m1 = vsel; i1 = i; s1 = s[4 * g + i]; } }
#pragma unroll
            for (int i = 0; i < 4; ++i) { const float vsel = sel[4 * g + i]; if (i != i1 && vsel > m2) { m2 = vsel; i2 = i; s2 = s[4 * g + i]; } }
        }
        if (lane == 0) { const int e1 = bestg * 4 + i1, e2 = bestg * 4 + i2; f32x4 rt; rt[0] = __int_as_float(e1); rt[1] = __int_as_float(e2); rt[2] = s1 / (s1 + s2); rt[3] = s2 / (s1 + s2); ROUTE[r] = rt;
            rroute[r - rbeg] = e1 | (e2 << 8); atomicAdd(&lcnt[e1], 1); atomicAdd(&lcnt[e2], 1); }
    }
    __syncthreads();
    unsigned* ctl = (unsigned*)(p.ws + WS_CTL);
    if (tidx < 16) { lbase[tidx] = (int)__hip_atomic_fetch_add(ctl + CW_CNT + (l * NEXP + tidx) * 64, (unsigned)lcnt[tidx], __ATOMIC_RELAXED, __HIP_MEMORY_SCOPE_AGENT); lcnt[tidx] = 0; }
    __syncthreads();
    int* LIST = (int*)(p.ws + WS_LIST) + (size_t)l * NEXP * NTOK;
    if (tidx < rend - rbeg) {
        const int rr = rroute[tidx], r = rbeg + tidx;
#pragma unroll
        for (int slot = 0; slot < 2; ++slot) { const int e = (rr >> (8 * slot)) & 255; const int pos = lbase[e] + atomicAdd(&lcnt[e], 1); LIST[e * NTOK + pos] = 2 * r + slot; }
    }
    __syncthreads();
}


__device__ void p78_moe_golden(const Params& p, int l, float* lds) { PHASE_IDS;
    const int lane = tidx & 63, wave = tidx >> 6;
    float* hrow = lds + wave * 1536; float* arow = hrow + 1024;
    const bf16_t* HB = (const bf16_t*)(p.ws + WS_HB);
    const f32x4* ROUTE = (const f32x4*)(p.ws + WS_ROUTE);
    bf16_t* Y = (bf16_t*)(p.ws + WS_Y);
    const int nrows = l == 0 ? NTOK : NL;
    for (int it = GW; it < nrows * 2; it += NGW) {
        const int r = it >> 1, slot = it & 1;
        const f32x4 rt = ROUTE[r];
        const int e = __float_as_int(rt[slot]); const float wgt = rt[2 + slot];
        for (int k = lane; k < D; k += 64) hrow[k] = bf2f(HB[(size_t)r * D + k]);
        __builtin_amdgcn_s_waitcnt(0);
        const float* Wg = p.w_eg + ((size_t)(l * NEXP + e) * D) * DEXP; const float* Wu = p.w_eu + ((size_t)(l * NEXP + e) * D) * DEXP; const float* Wd = p.w_ed + ((size_t)(l * NEXP + e) * DEXP) * D;
        float ag[8], au[8];
#pragma unroll
        for (int i = 0; i < 8; ++i) { ag[i] = 0.f; au[i] = 0.f; }
        for (int k = 0; k < D; ++k) { const float hv = hrow[k]; const float* g = Wg + (size_t)k * DEXP + lane; const float* u = Wu + (size_t)k * DEXP + lane;
#pragma unroll
            for (int i = 0; i < 8; ++i) { ag[i] = fmaf(hv, g[64 * i], ag[i]); au[i] = fmaf(hv, u[64 * i], au[i]); } }
#pragma unroll
        for (int i = 0; i < 8; ++i) arow[64 * i + lane] = siluf(ag[i]) * au[i];
        __builtin_amdgcn_s_waitcnt(0);
        float acc[16];
#pragma unroll
        for (int i = 0; i < 16; ++i) acc[i] = 0.f;
        for (int j = 0; j < DEXP; ++j) { const float a = arow[j]; const float* wr = Wd + (size_t)j * D + lane;
#pragma unroll
            for (int i = 0; i < 16; ++i) acc[i] = fmaf(a, wr[64 * i], acc[i]); }
#pragma unroll
        for (int i = 0; i < 16; ++i) Y[(size_t)it * D + 64 * i + lane] = f2bf(wgt * acc[i]);
        __builtin_amdgcn_s_waitcnt(0);
    }
}

__device__ void p9_final(const Params& p) { PHASE_IDS;
    const int lane = tidx & 63;
    const float* MOD = (const float*)(p.ws + WS_MOD);
    const bf16_t* Y = (const bf16_t*)(p.ws + WS_Y);
    for (int r = GW; r < NL; r += NGW) {
        const RowInfo ri = row_info(r);
        float* xr = p.out + (size_t)r * D;
        f32x4 v[4]; float ss = 0.f;
#pragma unroll
        for (int j = 0; j < 4; ++j) {
            const int col = 4 * lane + 256 * j;
            v[j] = *(const f32x4*)(xr + col);
            const f32x4 g2 = *(const f32x4*)(MOD + ((size_t)(DEPTH - 1) * 9 + ri.bidx) * 6144 + 5 * D + col);
            const bf16_t* y0 = Y + (size_t)(2 * r) * D + col; const bf16_t* y1 = y0 + D;
#pragma unroll
            for (int e = 0; e < 4; ++e) v[j][e] += g2[e] * (bf2f(y0[e]) + bf2f(y1[e]));
            ss += v[j][0] * v[j][0] + v[j][1] * v[j][1] + v[j][2] * v[j][2] + v[j][3] * v[j][3];
        }
        const float rstd = rsqrtf(wave_sum(ss) * (1.f / D) + EPS);
#pragma unroll
        for (int j = 0; j < 4; ++j) { const int col = 4 * lane + 256 * j; const f32x4 nw = *(const f32x4*)(p.final_norm + col); f32x4 o;
#pragma unroll
            for (int e = 0; e < 4; ++e) o[e] = v[j][e] * rstd * nw[e];
            *(f32x4*)(xr + col) = o; }
    }
}

namespace pg8 {
#define PG8_LAS __attribute__((address_space(3)))
typedef short bf16x8 __attribute__((ext_vector_type(8)));
typedef unsigned u32x4 __attribute__((ext_vector_type(4)));
typedef unsigned u32x2 __attribute__((ext_vector_type(2)));
constexpr int BM = 256, BK = 64, HALF = 128, HTB = HALF * BK * 2, STAGE_BYTES = 8 * HTB;
__host__ __device__ __forceinline__ int lds_byte(int r, int c) { const int st = (r >> 4) * 2 + (c >> 5), rr = r & 15, cc = c & 31, ob = rr * 64 + cc * 2; return st * 1024 + (ob ^ (((ob >> 9) & 1) << 5)); }
__host__ __device__ __forceinline__ void stage_rc(int b, int& R, int& C) { const int st = b / 1024, sb = b % 1024, swz = sb ^ (((sb >> 9) & 1) << 5); R = (st >> 1) * 16 + swz / 64; C = (st & 1) * 32 + (swz % 64) / 2; }
__host__ __device__ __forceinline__ int perm32(int rho) { const int n = rho >> 4, i = rho & 15; return 8 * (i >> 2) + 4 * n + (i & 3); }
__device__ __forceinline__ unsigned cvt_pk_bf16(float lo, float hi) { unsigned r; asm volatile("v_cvt_pk_bf16_f32 %0, %1, %2" : "=v"(r) : "v"(lo), "v"(hi)); return r; }

struct Unit { int pm, pn; unsigned a_off, b_off; int e, cnt; };

template <class Epi, class Sched>
__device__ __forceinline__ void gemm_phase(PG8_LAS unsigned char* lds, const bf16_t* A, const bf16_t* Bt, const int K, const Sched& S, const Epi& E) {
    const int tid = otid(), wid = __builtin_amdgcn_readfirstlane(tid >> 6), lane = tid & 63, wr = wid >> 2, wc = wid & 3, fr = lane & 15, fq = lane >> 4;
    const int nt = K / BK;
    int Ra[2]; unsigned Ca2[2], voffB[2];
#pragma unroll
    for (int i = 0; i < 2; ++i) { int R, C; stage_rc(tid * 16 + i * 8192, R, C); const int Rb = (R & ~31) + perm32(R & 31); Ra[i] = R; Ca2[i] = (unsigned)C * 2u; voffB[i] = (unsigned)(Rb * K + C) * 2u; }
    const size_t kstep = (size_t)(BK * 2);
    const size_t hstep = (size_t)HALF * K * 2;
    const unsigned ldsw = (unsigned)wid * 1024u;
    const int aoff = lds_byte(wr * 64 + fr, fq * 8), boff = lds_byte(wc * 32 + fr, fq * 8);
#define PG8_SA(b, h) (((b) * 2 + (h)) * HTB)
#define PG8_SB(b, h) ((4 + (b) * 2 + (h)) * HTB)
#define PG8_STAGE_B(bufoff, gbase) do { _Pragma("unroll") for (int _i = 0; _i < 2; ++_i) \
        __builtin_amdgcn_global_load_lds((const unsigned*)((const char*)(gbase) + voffB[_i]), (PG8_LAS unsigned*)(lds + (bufoff) + ldsw + _i * 8192), 16, 0, 0); } while (0)
#define PG8_STAGE_A(bufoff, kbyte, offs) do { _Pragma("unroll") for (int _i = 0; _i < 2; ++_i) \
        __builtin_amdgcn_global_load_lds((const unsigned*)(Ab + (size_t)(offs)[_i] + (size_t)(kbyte)), (PG8_LAS unsigned*)(lds + (bufoff) + ldsw + _i * 8192), 16, 0, 0); } while (0)
#define PG8_LDA(dst, b, h) do { _Pragma("unroll") for (int m = 0; m < 4; ++m) _Pragma("unroll") for (int k = 0; k < 2; ++k) dst[m][k] = *(const PG8_LAS bf16x8*)(lds + PG8_SA(b, h) + aoff + m * 2048 + k * 1024); } while (0)
#define PG8_LDB(dst, b, h) do { _Pragma("unroll") for (int n = 0; n < 2; ++n) _Pragma("unroll") for (int k = 0; k < 2; ++k) dst[n][k] = *(const PG8_LAS bf16x8*)(lds + PG8_SB(b, h) + boff + n * 2048 + k * 1024); } while (0)
#define PG8_MMA(ai, bj, At, Bt_) do { __builtin_amdgcn_s_setprio(1); _Pragma("unroll") for (int m = 0; m < 4; ++m) _Pragma("unroll") for (int n = 0; n < 2; ++n) _Pragma("unroll") for (int k = 0; k < 2; ++k) \
        acc[ai][bj][m][n] = __builtin_amdgcn_mfma_f32_16x16x32_bf16(Bt_[n][k], At[m][k], acc[ai][bj][m][n], 0, 0, 0); __builtin_amdgcn_s_setprio(0); } while (0)
#define PG8_WAIT_V(n) asm volatile("s_waitcnt vmcnt(" #n ")" ::: "memory")
#define PG8_WAIT_L(n) asm volatile("s_waitcnt lgkmcnt(" #n ")" ::: "memory")
#define PG8_BAR __builtin_amdgcn_s_barrier()
#define PG8_SCHED __builtin_amdgcn_sched_barrier(0)
    Unit cur, nxt; int ui = 0;
    if (!S.next(0, cur)) return;
    f32x4 acc[2][2][4][2];
#pragma unroll
    for (int a = 0; a < 2; ++a)
#pragma unroll
        for (int b = 0; b < 2; ++b)
#pragma unroll
            for (int m = 0; m < 4; ++m)
#pragma unroll
                for (int n = 0; n < 2; ++n) acc[a][b][m][n] = (f32x4){0.f, 0.f, 0.f, 0.f};
    bf16x8 At[4][2], B0[2][2], B1[2][2];
    const char* Ab = (const char*)A;
    unsigned ga0[2], ga1[2], gn0[2], gn1[2];
#pragma unroll
    for (int i = 0; i < 2; ++i) { ga0[i] = S.a_row_off(cur, Ra[i], K) + Ca2[i]; ga1[i] = S.a_row_off(cur, HALF + Ra[i], K) + Ca2[i]; }
    const char* cB = (const char*)Bt + cur.b_off;
    PG8_STAGE_B(PG8_SB(0, 0), cB); PG8_STAGE_B(PG8_SB(0, 1), cB + hstep); PG8_STAGE_A(PG8_SA(0, 0), 0, ga0); PG8_STAGE_A(PG8_SA(0, 1), 0, ga1);
    if (wr == 1) PG8_BAR;
    PG8_WAIT_V(2); PG8_BAR;
    PG8_STAGE_B(PG8_SB(1, 0), cB + kstep); PG8_STAGE_A(PG8_SA(1, 0), kstep, ga0); PG8_STAGE_B(PG8_SB(1, 1), cB + hstep + kstep);
    PG8_WAIT_V(6); PG8_BAR;
    for (;;) {
        const bool has_next = S.next(ui + 1, nxt);
        if (has_next) {
#pragma unroll
            for (int i = 0; i < 2; ++i) { gn0[i] = S.a_row_off(nxt, Ra[i], K) + Ca2[i]; gn1[i] = S.a_row_off(nxt, HALF + Ra[i], K) + Ca2[i]; }
        } else {
#pragma unroll
            for (int i = 0; i < 2; ++i) { gn0[i] = ga0[i]; gn1[i] = ga1[i]; }
        }
        const char* nB = has_next ? (const char*)Bt + nxt.b_off : cB;
        for (int t = 0; t < nt; t += 2) {
            const bool last = (t == nt - 2);
            const size_t k1 = (size_t)(t + 1) * kstep;
            unsigned o20[2], o21[2];
#pragma unroll
            for (int i = 0; i < 2; ++i) { o20[i] = last ? gn0[i] : ga0[i]; o21[i] = last ? gn1[i] : ga1[i]; }
            const size_t k2 = last ? 0 : (size_t)(t + 2) * kstep, k3 = k2 + kstep;
            const char* b2 = last ? nB : cB + (size_t)(t + 2) * kstep; const char* b3 = b2 + kstep;
            PG8_LDB(B0, 0, 0); PG8_LDB(B1, 0, 1); PG8_SCHED; PG8_LDA(At, 0, 0); PG8_STAGE_A(PG8_SA(1, 1), k1, ga1);
            PG8_WAIT_V(8); PG8_WAIT_L(0); PG8_BAR; PG8_MMA(0, 0, At, B0); PG8_MMA(0, 1, At, B1); PG8_BAR; PG8_SCHED;
            PG8_LDA(At, 0, 1); PG8_STAGE_B(PG8_SB(0, 0), b2); PG8_STAGE_B(PG8_SB(0, 1), b2 + hstep); PG8_STAGE_A(PG8_SA(0, 0), k2, o20);
            PG8_WAIT_V(8); PG8_WAIT_L(0); PG8_BAR; PG8_MMA(1, 0, At, B0); PG8_MMA(1, 1, At, B1); PG8_BAR; PG8_SCHED;
            PG8_LDB(B0, 1, 0); PG8_LDB(B1, 1, 1); PG8_SCHED; PG8_LDA(At, 1, 0); PG8_STAGE_A(PG8_SA(0, 1), k2, o21);
            PG8_WAIT_V(8); PG8_WAIT_L(0); PG8_BAR; PG8_MMA(0, 0, At, B0); PG8_MMA(0, 1, At, B1); PG8_BAR; PG8_SCHED;
            PG8_LDA(At, 1, 1); PG8_STAGE_B(PG8_SB(1, 0), b3); PG8_STAGE_B(PG8_SB(1, 1), b3 + hstep); PG8_STAGE_A(PG8_SA(1, 0), k3, o20);
            PG8_WAIT_V(8); PG8_WAIT_L(0); PG8_BAR; PG8_MMA(1, 0, At, B0); PG8_MMA(1, 1, At, B1); PG8_BAR; PG8_SCHED;
        }
        if (wr == 0) PG8_BAR;
        E(acc, cur, wr, wc, fr, fq);
        if (!has_next) break;
#pragma unroll
        for (int a = 0; a < 2; ++a)
#pragma unroll
            for (int b = 0; b < 2; ++b)
#pragma unroll
                for (int m = 0; m < 4; ++m)
#pragma unroll
                    for (int n = 0; n < 2; ++n) acc[a][b][m][n] = (f32x4){0.f, 0.f, 0.f, 0.f};
        cur = nxt; cB = nB; ++ui;
#pragma unroll
        for (int i = 0; i < 2; ++i) { ga0[i] = gn0[i]; ga1[i] = gn1[i]; }
        if (wr == 1) PG8_BAR;
    }
    PG8_WAIT_V(0);
    PG8_BAR;
#undef PG8_SA
#undef PG8_SB
#undef PG8_STAGE_A
#undef PG8_STAGE_B
#undef PG8_LDA
#undef PG8_LDB
#undef PG8_MMA
#undef PG8_WAIT_V
#undef PG8_WAIT_L
#undef PG8_BAR
#undef PG8_SCHED
}

struct PlainOrder {
    int nM, nN, nwg, G, c;
    __device__ void init(int M, int N, int G_, int c_) { nM = M / BM; nN = N / BM; nwg = nM * nN; G = G_; c = c_; }
    __device__ __forceinline__ bool next(int i, Unit& u) const {
        const int L = i * G + c; if (L >= nwg) return false;
        int wgid = L; { const int q = nwg / 8, r = nwg % 8, xcd = wgid % 8, off = wgid / 8; wgid = (xcd < r ? xcd * (q + 1) : r * (q + 1) + (xcd - r) * q) + off; }
        const int nig = 8 * nN, gid = wgid / nig, fm = gid * 8, gsz = (nM - fm) < 8 ? (nM - fm) : 8;
        u.pm = fm + ((wgid % nig) % gsz); u.pn = (wgid % nig) / gsz; u.a_off = 0; u.b_off = 0; u.e = 0; u.cnt = 256; return true;
    }
    __device__ __forceinline__ unsigned a_row_off(const Unit& u, int rl, int K) const { return (unsigned)((u.pm * BM + rl) * K) * 2u; }
};
}
struct PlainSched {
    pg8::PlainOrder o; int K;
    __device__ __forceinline__ bool next(int i, pg8::Unit& u) const { if (!o.next(i, u)) return false; u.b_off = (unsigned)(u.pn * 256 * K) * 2u; return true; }
    __device__ __forceinline__ unsigned a_row_off(const pg8::Unit& u, int rl, int K_) const { return o.a_row_off(u, rl, K_); }
};

struct EpiOutProj {
    const float* xs_lat; const float* xs_ctx; float* xd_lat; float* xd_ctx; const float* g1;
    __device__ __forceinline__ void operator()(const f32x4 (&acc)[2][2][4][2], const pg8::Unit& u, int wr, int wc, int fr, int fq) const {
        const int row0 = u.pm * 256 + wr * 64 + fr, col0 = u.pn * 256 + wc * 32 + 8 * fq;
        const bool isctx = u.pm >= 64; const int bidx = isctx ? 8 : (u.pm >> 3);
        const float* xs = isctx ? xs_ctx - (size_t)NL * D : xs_lat; float* xd = isctx ? xd_ctx - (size_t)NL * D : xd_lat;
        f32x4 g[2][2];
#pragma unroll
        for (int bj = 0; bj < 2; ++bj)
#pragma unroll
            for (int n = 0; n < 2; ++n) g[bj][n] = *(const f32x4*)(g1 + (size_t)bidx * 6144 + col0 + bj * 128 + 4 * n);
#pragma unroll
        for (int ai = 0; ai < 2; ++ai)
#pragma unroll
            for (int m = 0; m < 4; ++m) {
                const size_t ro = (size_t)(row0 + ai * 128 + m * 16) * D + col0;
#pragma unroll
                for (int bj = 0; bj < 2; ++bj)
#pragma unroll
                    for (int n = 0; n < 2; ++n) { const f32x4 xv = *(const f32x4*)(xs + ro + bj * 128 + 4 * n); *(f32x4*)(xd + ro + bj * 128 + 4 * n) = xv + g[bj][n] * acc[ai][bj][m][n]; }
            }
    }
};
__device__ __forceinline__ void p5_outproj_fast(const Params& p, int l, unsigned char* lds_raw) { PHASE_IDS;
    PlainSched S; S.K = D; S.o.init(l == 0 ? NTOK : NL, D, gridDim.x, bidx_);
    EpiOutProj E{l == 0 ? p.x : p.out, l == 0 ? p.ctx : (const float*)(p.ws + WS_XC), p.out, (float*)(p.ws + WS_XC), (const float*)(p.ws + WS_MOD) + (size_t)l * 9 * 6144 + 2 * D};
    pg8::gemm_phase((PG8_LAS unsigned char*)lds_raw, (const bf16_t*)(p.ws + WS_HB), (const bf16_t*)(p.ws + WS_WOUT) + (size_t)l * D * D, D, S, E);
}

#define PIN_ACC(acc) do { _Pragma("unroll") for (int a_ = 0; a_ < 2; ++a_) _Pragma("unroll") for (int b_ = 0; b_ < 2; ++b_) _Pragma("unroll") for (int m_ = 0; m_ < 4; ++m_) \
    asm volatile("" : "+v"(acc[a_][b_][m_][0]), "+v"(acc[a_][b_][m_][1])); } while (0)
struct EpiInProj {
    struct { unsigned char* ws; const float* q_norm; const float* k_norm; } p; int l;
    __device__ __forceinline__ void operator()(f32x4 (&acc)[2][2][4][2], const pg8::Unit& u, int wr, int wc, int fr, int fq) const {
        const int T = u.pn;
        const bool isctx = u.pm >= 64; const int b = isctx ? u.pm - 64 : (u.pm >> 3); const int t0 = (isctx ? 0 : (u.pm & 7) * 256) + wr * 64 + fr;
        const int row0 = u.pm * 256 + wr * 64 + fr;
        if (T <= 1) {
            bf16_t* dst; int ld;
            if (!isctx) { dst = (bf16_t*)(p.ws + WS_YFTL) + ((size_t)b * 256 * 2 + T) * SEQ; ld = SEQ; } else { dst = (bf16_t*)(p.ws + WS_YFTC) + ((size_t)b * 256 * 2 + T) * CTXL; ld = CTXL; }
            unsigned eo = (unsigned)((64 * wc + 8 * fq) * 2 * ld + t0);
#pragma unroll
            for (int bj = 0; bj < 2; ++bj)
#pragma unroll
                for (int n = 0; n < 2; ++n)
#pragma unroll
                    for (int e = 0; e < 4; ++e) { bf16_t* cp = dst + eo;
#pragma unroll
                        for (int ai = 0; ai < 2; ++ai)
#pragma unroll
                            for (int m = 0; m < 4; ++m) cp[ai * 128 + m * 16] = f2bf(acc[ai][bj][m][n][e]);
                        eo += (unsigned)(((n == 1 && e == 3) ? 25 : 1) * 2 * ld); asm volatile("" : "+v"(eo) :: "memory"); }
        } else if (T <= 4 || T == 8) {
            bf16_t* dst; int ld; float sc = 1.f;
            if (T == 2) { dst = (bf16_t*)(p.ws + WS_GQK); ld = 256; if (wc < 2) sc = 0.17677669529663687f; }
            else if (T == 3) { dst = (bf16_t*)(p.ws + WS_GV); ld = 256; } else if (T == 4) { dst = (bf16_t*)(p.ws + WS_GG); ld = 256; } else { dst = (bf16_t*)(p.ws + WS_GD); ld = 32; }
            if (T != 8 || wc == 0) {
#pragma unroll
                for (int ai = 0; ai < 2; ++ai)
#pragma unroll
                    for (int m = 0; m < 4; ++m) { const size_t r = row0 + ai * 128 + m * 16;
#pragma unroll
                        for (int bj = 0; bj < 2; ++bj) { if (T == 8 && bj == 1) continue;
                            const f32x4 v0 = acc[ai][bj][m][0] * sc, v1 = acc[ai][bj][m][1] * sc;
                            pg8::u32x4 w; w.x = pg8::cvt_pk_bf16(v0[0], v0[1]); w.y = pg8::cvt_pk_bf16(v0[2], v0[3]); w.z = pg8::cvt_pk_bf16(v1[0], v1[1]); w.w = pg8::cvt_pk_bf16(v1[2], v1[3]);
                            *(pg8::u32x4*)(dst + r * ld + 64 * wc + 32 * bj + 8 * fq) = w; } }
            }
        } else if (T == 7 && wc >= 2) {
            bf16_t* dst = (bf16_t*)(p.ws + WS_AVT) + ((size_t)(b * 2 + (wc - 2)) * 64) * KEYS + (isctx ? 0 : CTXL);
            unsigned eo = (unsigned)(8 * fq * KEYS + t0);
#pragma unroll
            for (int bj = 0; bj < 2; ++bj)
#pragma unroll
                for (int n = 0; n < 2; ++n)
#pragma unroll
                    for (int e = 0; e < 4; ++e) { bf16_t* cp = dst + eo;
#pragma unroll
                        for (int ai = 0; ai < 2; ++ai)
#pragma unroll
                            for (int m = 0; m < 4; ++m) cp[ai * 128 + m * 16] = f2bf(acc[ai][bj][m][n][e]);
                        eo += (unsigned)(((n == 1 && e == 3) ? 25 : 1) * KEYS); asm volatile("" : "+v"(eo) :: "memory"); }
        } else {
            const bool isq = T != 7;
            const float* nw = isq ? p.q_norm : p.k_norm;
            f32x4 w4[2][2];
#pragma unroll
            for (int bj = 0; bj < 2; ++bj)
#pragma unroll
                for (int n = 0; n < 2; ++n) w4[bj][n] = *(const f32x4*)(nw + 32 * bj + 8 * fq + 4 * n);
            const float osc = isq ? QSCALE : 1.f;
            const float* ROPE = (const float*)(p.ws + WS_TAB) + 2048;
            const int half = fq >> 1;
            const int rbase = row0 - t0;
            int t = t0;
#pragma unroll
            for (int ai = 0; ai < 2; ++ai)
#pragma unroll
                for (int m = 0; m < 4; ++m) {
                    float ss = 0.f;
#pragma unroll
                    for (int bj = 0; bj < 2; ++bj)
#pragma unroll
                        for (int n = 0; n < 2; ++n) { const f32x4 v = acc[ai][bj][m][n]; ss += v[0] * v[0] + v[1] * v[1] + v[2] * v[2] + v[3] * v[3]; }
                    ss += __shfl_xor(ss, 16); ss += __shfl_xor(ss, 32);
                    const float rs = rsqrtf(ss * (1.f / 64.f) + EPS);
                    bf16_t* dst = isq ? (bf16_t*)(p.ws + WS_AQ) + (size_t)(rbase + t) * 512 + ((T - 5) * 4 + wc) * 64
                                      : (bf16_t*)(p.ws + WS_AK) + ((size_t)b * KEYS + (isctx ? 0 : CTXL) + t) * 128 + wc * 64;
#pragma unroll
                    for (int bj = 0; bj < 2; ++bj) {
                        f32x4 o[2];
#pragma unroll
                        for (int n = 0; n < 2; ++n) {
                            const f32x4 xv = acc[ai][bj][m][n] * rs * w4[bj][n];
                            if (!isctx) {
                                const int pos = bj == 0 ? (t >> 6) : (t & 63);
                                const f32x4* rp = (const f32x4*)(ROPE + 2 * (pos * 16 + 8 * (fq & 1) + 4 * n));
                                const f32x4 cs01 = rp[0], cs23 = rp[1];
                                f32x4 xp;
#pragma unroll
                                for (int e = 0; e < 4; ++e) xp[e] = __shfl_xor(xv[e], 32);
                                const float sg = half == 0 ? -1.f : 1.f;
                                o[n][0] = xv[0] * cs01[0] + sg * xp[0] * cs01[1]; o[n][1] = xv[1] * cs01[2] + sg * xp[1] * cs01[3];
                                o[n][2] = xv[2] * cs23[0] + sg * xp[2] * cs23[1]; o[n][3] = xv[3] * cs23[2] + sg * xp[3] * cs23[3];
                            } else o[n] = xv;
                            o[n] = o[n] * osc;
                        }
                        pg8::u32x4 w; w.x = pg8::cvt_pk_bf16(o[0][0], o[0][1]); w.y = pg8::cvt_pk_bf16(o[0][2], o[0][3]); w.z = pg8::cvt_pk_bf16(o[1][0], o[1][1]); w.w = pg8::cvt_pk_bf16(o[1][2], o[1][3]);
                        *(pg8::u32x4*)(dst + 32 * bj + 8 * fq) = w;
                    }
                    t += (m == 3) ? 80 : 16; asm volatile("" : "+v"(t) :: "memory");
                }
        }
    }
};
__device__ __forceinline__ void p2_inproj_fast(const Params& p, int l, unsigned char* lds_raw) { PHASE_IDS;
    PlainSched S; S.K = D; S.o.init(NTOK, NIN, gridDim.x, bidx_);
    EpiInProj E{{p.ws, p.q_norm + l * 64, p.k_norm + l * 64}, l};
    pg8::gemm_phase((PG8_LAS unsigned char*)lds_raw, (const bf16_t*)(p.ws + WS_HB), (const bf16_t*)(p.ws + WS_WIN) + (size_t)l * NIN * D, D, S, E);
}

struct MoeSched {
    const int* list; const int* tab;
    int G, c, total; bool down;
    __device__ __forceinline__ bool next(int i, pg8::Unit& u) const {
        const int L = i * G + c; if (L >= total) return false;
        int e = 0;
#pragma unroll
        for (int q = 1; q < NEXP; ++q) if (L >= tab[q]) e = q;
        e = __builtin_amdgcn_readfirstlane(e);
        const int us = tab[e], sg = tab[17 + e], cn = tab[33 + e];
        const int rem = L - us, mtile = rem >> 2, pn = rem & 3;
        u.pm = mtile; u.pn = pn; u.e = e; u.cnt = __builtin_amdgcn_readfirstlane(cn - mtile * 256); u.a_off = (unsigned)__builtin_amdgcn_readfirstlane(sg + mtile * 256);
        u.b_off = down ? (unsigned)((e * 1024 + pn * 256) * DEXP) * 2u : (unsigned)((e * 1024 + pn * 256) * D) * 2u;
        return true;
    }
    __device__ __forceinline__ unsigned a_row_off(const pg8::Unit& u, int rl, int K) const {
        if (down) return (unsigned)((u.a_off + rl) * K) * 2u;
        const int idx = u.pm * 256 + (rl < u.cnt ? rl : u.cnt - 1);
        const int pair = list[u.e * NTOK + idx];
        return (unsigned)((pair >> 1) * K) * 2u;
    }
};
__device__ __forceinline__ int moe_tables(const unsigned* ctl, int l, int* tab, int tidx) {
    if (tidx == 0) { int u = 0, sgm = 0;
        for (int e = 0; e < NEXP; ++e) { const int n = (int)__hip_atomic_load(ctl + CW_CNT + (l * NEXP + e) * 64, __ATOMIC_RELAXED, __HIP_MEMORY_SCOPE_AGENT); const int mt = (n + 255) >> 8; tab[e] = u; tab[17 + e] = sgm; tab[33 + e] = n; u += mt * 4; sgm += mt * 256; }
        tab[16] = u; }
    __syncthreads();
    return __builtin_amdgcn_readfirstlane(tab[16]);
}
struct EpiGateUp {
    bf16_t* act;
    __device__ __forceinline__ void operator()(f32x4 (&acc)[2][2][4][2], const pg8::Unit& u, int wr, int wc, int fr, int fq) const {
        bf16_t* base = act + (size_t)(u.a_off + wr * 64 + fr) * DEXP + u.pn * 128 + wc * 32 + 8 * fq;
#pragma unroll
        for (int ai = 0; ai < 2; ++ai)
#pragma unroll
            for (int m = 0; m < 4; ++m) {
                f32x4 o[2];
#pragma unroll
                for (int n = 0; n < 2; ++n)
#pragma unroll
                    for (int e = 0; e < 4; ++e) { const float g = acc[ai][0][m][n][e]; o[n][e] = g * __builtin_amdgcn_rcpf(1.f + __expf(-g)) * acc[ai][1][m][n][e]; }
                pg8::u32x4 w; w.x = pg8::cvt_pk_bf16(o[0][0], o[0][1]); w.y = pg8::cvt_pk_bf16(o[0][2], o[0][3]); w.z = pg8::cvt_pk_bf16(o[1][0], o[1][1]); w.w = pg8::cvt_pk_bf16(o[1][2], o[1][3]);
                *(pg8::u32x4*)(base + (size_t)(ai * 128 + m * 16) * DEXP) = w;
            }
    }
};
struct EpiDown {
    bf16_t* Y; const int* list; const f32x4* route;
    __device__ __forceinline__ void operator()(f32x4 (&acc)[2][2][4][2], const pg8::Unit& u, int wr, int wc, int fr, int fq) const {
        int rl = wr * 64 + fr;
        const int col = u.pn * 256 + wc * 32 + 8 * fq;
#pragma unroll
        for (int ai = 0; ai < 2; ++ai)
#pragma unroll
            for (int m = 0; m < 4; ++m) {
                if (rl < u.cnt) {
                    const int pair = list[u.e * NTOK + u.pm * 256 + rl];
                    const float w = ((const float*)(route + (pair >> 1)))[2 + (pair & 1)];
                    bf16_t* dst = Y + (size_t)pair * D + col;
#pragma unroll
                    for (int bj = 0; bj < 2; ++bj) { const f32x4 v0 = acc[ai][bj][m][0] * w, v1 = acc[ai][bj][m][1] * w;
                        pg8::u32x4 o; o.x = pg8::cvt_pk_bf16(v0[0], v0[1]); o.y = pg8::cvt_pk_bf16(v0[2], v0[3]); o.z = pg8::cvt_pk_bf16(v1[0], v1[1]); o.w = pg8::cvt_pk_bf16(v1[2], v1[3]);
                        *(pg8::u32x4*)(dst + bj * 128) = o; }
                }
                rl += (m == 3) ? 80 : 16; asm volatile("" : "+v"(rl) :: "memory");
            }
    }
};
__device__ __forceinline__ void p7_gateup_fast(const Params& p, int l, unsigned char* lds_raw) { PHASE_IDS;
    int* tab = (int*)(lds_raw + pg8::STAGE_BYTES + 1024);
    MoeSched S; S.list = (const int*)(p.ws + WS_LIST) + (size_t)l * NEXP * NTOK; S.tab = tab; S.G = gridDim.x; S.c = bidx_; S.down = false; S.total = moe_tables((const unsigned*)(p.ws + WS_CTL), l, tab, tidx);
    EpiGateUp E{(bf16_t*)(p.ws + WS_ACT)};
    pg8::gemm_phase((PG8_LAS unsigned char*)lds_raw, (const bf16_t*)(p.ws + WS_HB), (const bf16_t*)(p.ws + WS_WGU), D, S, E);
}
__device__ __forceinline__ void p8_down_fast(const Params& p, int l, unsigned char* lds_raw) { PHASE_IDS;
    int* tab = (int*)(lds_raw + pg8::STAGE_BYTES + 1024);
    MoeSched S; S.list = (const int*)(p.ws + WS_LIST) + (size_t)l * NEXP * NTOK; S.tab = tab; S.G = gridDim.x; S.c = bidx_; S.down = true; S.total = moe_tables((const unsigned*)(p.ws + WS_CTL), l, tab, tidx);
    EpiDown E{(bf16_t*)(p.ws + WS_Y), (const int*)(p.ws + WS_LIST) + (size_t)l * NEXP * NTOK, (const f32x4*)(p.ws + WS_ROUTE)};
    pg8::gemm_phase((PG8_LAS unsigned char*)lds_raw, (const bf16_t*)(p.ws + WS_ACT), (const bf16_t*)(p.ws + WS_WD), DEXP, S, E);
}

struct FnetSched {
    int mtiles, nunits, G, c;
    __device__ __forceinline__ bool next(int i, pg8::Unit& u) const {
        const int L = i * G + c; if (L >= nunits) return false;
        u.e = L / mtiles; u.pm = L % mtiles; u.pn = 0; u.cnt = 256; u.a_off = 0; u.b_off = 0; return true;
    }
    __device__ __forceinline__ unsigned a_row_off(const pg8::Unit& u, int rl, int K) const { return (unsigned)((u.pm * 256 + rl) * K) * 2u; }
};
struct FnetSchedK { FnetSched s; int K;
    __device__ __forceinline__ bool next(int i, pg8::Unit& u) const { if (!s.next(i, u)) return false; u.b_off = (unsigned)(u.e * 256 * K) * 2u; return true; }
    __device__ __forceinline__ unsigned a_row_off(const pg8::Unit& u, int rl, int K_) const { return s.a_row_off(u, rl, K_); }
};
struct EpiFnet {
    bf16_t* mix; int row0, rows_per_b; float scale;
    __device__ __forceinline__ void operator()(f32x4 (&acc)[2][2][4][2], const pg8::Unit& u, int wr, int wc, int fr, int fq) const {
        bf16_t* base = mix + (size_t)(row0 + u.e * rows_per_b + u.pm * 256 + wr * 64 + fr) * D + wc * 32 + 8 * fq;
#pragma unroll
        for (int ai = 0; ai < 2; ++ai)
#pragma unroll
            for (int m = 0; m < 4; ++m)
#pragma unroll
                for (int bj = 0; bj < 2; ++bj) { const f32x4 v0 = acc[ai][bj][m][0] * scale, v1 = acc[ai][bj][m][1] * scale;
                    pg8::u32x4 o; o.x = pg8::cvt_pk_bf16(v0[0], v0[1]); o.y = pg8::cvt_pk_bf16(v0[2], v0[3]); o.z = pg8::cvt_pk_bf16(v1[0], v1[1]); o.w = pg8::cvt_pk_bf16(v1[2], v1[3]);
                    *(pg8::u32x4*)(base + (size_t)(ai * 128 + m * 16) * D + bj * 128) = o; }
    }
};
__device__ __forceinline__ void p3_fnet_fast(const Params& p, int l, unsigned char* lds_raw) { PHASE_IDS;
    {
        FnetSchedK S; S.s.mtiles = 8; S.s.nunits = 64; S.s.G = gridDim.x; S.s.c = bidx_; S.K = 4096;
        EpiFnet E{(bf16_t*)(p.ws + WS_HB), 0, SEQ, 0.0027621358640099515f};
        pg8::gemm_phase((PG8_LAS unsigned char*)lds_raw, (const bf16_t*)(p.ws + WS_DMAT), (const bf16_t*)(p.ws + WS_YFTL), 4096, S, E);
    }
    if (l == 0) {
        FnetSchedK S; S.s.mtiles = 1; S.s.nunits = 8; S.s.G = gridDim.x; S.s.c = (bidx_ + (int)gridDim.x - 64) % (int)gridDim.x; S.K = 512;
        EpiFnet E{(bf16_t*)(p.ws + WS_HB), NL, CTXL, 0.0078125f};
        pg8::gemm_phase((PG8_LAS unsigned char*)lds_raw, (const bf16_t*)(p.ws + WS_DMATC), (const bf16_t*)(p.ws + WS_YFTC), 512, S, E);
    }
}

typedef float f32x16 __attribute__((ext_vector_type(16)));
typedef short s16x4 __attribute__((ext_vector_type(4)));
__device__ __forceinline__ void attn_unit(unsigned char* ws, unsigned char* lds_raw, int b, int h, int qrow0, int nkt, int tid) {
    typedef pg8::bf16x8 bf16x8;
    const int lane = tid & 63, wid = tid >> 6, r32 = lane & 31, hi = lane >> 5, kvh = h >> 2;
    const bf16_t* AQ = (const bf16_t*)(ws + WS_AQ); const bf16_t* AK = (const bf16_t*)(ws + WS_AK); const bf16_t* AVT = (const bf16_t*)(ws + WS_AVT);
    bf16_t* MIX = (bf16_t*)(ws + WS_HB);
    const int srow = tid >> 3, sch = tid & 7;
    const bf16_t* kg = AK + ((size_t)b * KEYS + srow) * 128 + kvh * 64 + sch * 8;
    const bf16_t* vg = AVT + ((size_t)(b * 2 + kvh) * 64 + srow) * KEYS + sch * 8;
    const int kst = srow * 128 + ((sch ^ ((srow >> 1) & 7)) << 4);
    const int vst = srow * 128 + ((sch ^ ((srow >> 2) & 7)) << 4);
    const bool vswap = (srow >> 1) & 1;
    unsigned char* Kb = lds_raw; unsigned char* Vb = lds_raw + 16384;
    const int kx = (r32 >> 1) & 7, vx = (r32 >> 1) & 15;
    const int krd = r32 * 128;
    const int vrd = r32 * 128;
    bf16x8 qf[4];
    { const bf16_t* qp = AQ + (size_t)(qrow0 + wid * 32 + r32) * 512 + h * 64 + hi * 8;
#pragma unroll
      for (int s = 0; s < 4; ++s) qf[s] = *(const bf16x8*)(qp + s * 16); }
    f32x16 o0 = {}, o1 = {};
    float mrow = -1e30f, lrow = 0.f;
    pg8::u32x4 kreg = *(const pg8::u32x4*)kg, vreg = *(const pg8::u32x4*)vg;
    __syncthreads();
    *(pg8::u32x4*)(Kb + kst) = kreg; *(pg8::u32x4*)(Vb + vst) = vswap ? (pg8::u32x4){vreg.z, vreg.w, vreg.x, vreg.y} : vreg;
    __syncthreads();
    for (int t = 0; t < nkt; ++t) {
        const int cur = (t & 1) * 8192;
        if (t + 1 < nkt) { kreg = *(const pg8::u32x4*)(kg + (size_t)(t + 1) * 64 * 128); vreg = *(const pg8::u32x4*)(vg + (t + 1) * 64); }
        f32x16 p0 = {}, p1 = {};
#pragma unroll
        for (int s = 0; s < 4; ++s) {
            const bf16x8 k0 = *(const bf16x8*)(Kb + cur + krd + (((2 * s + hi) ^ kx) << 4));
            const bf16x8 k1 = *(const bf16x8*)(Kb + cur + 4096 + krd + (((2 * s + hi) ^ kx) << 4));
            p0 = __builtin_amdgcn_mfma_f32_32x32x16_bf16(k0, qf[s], p0, 0, 0, 0);
            p1 = __builtin_amdgcn_mfma_f32_32x32x16_bf16(k1, qf[s], p1, 0, 0, 0);
        }
        float mx = p0[0];
#pragma unroll
        for (int r = 1; r < 16; ++r) mx = fmaxf(mx, p0[r]);
#pragma unroll
        for (int r = 0; r < 16; ++r) mx = fmaxf(mx, p1[r]);
        { auto rr = __builtin_amdgcn_permlane32_swap(__float_as_uint(mx), __float_as_uint(mx), false, false); mx = fmaxf(__uint_as_float(rr[0]), __uint_as_float(rr[1])); }
        const float mn = fmaxf(mrow, mx), alpha = __builtin_amdgcn_exp2f(mrow - mn);
        mrow = mn;
        float sum = 0.f;
#pragma unroll
        for (int r = 0; r < 16; ++r) { p0[r] = __builtin_amdgcn_exp2f(p0[r] - mn); sum += p0[r]; }
#pragma unroll
        for (int r = 0; r < 16; ++r) { p1[r] = __builtin_amdgcn_exp2f(p1[r] - mn); sum += p1[r]; }
        lrow = lrow * alpha + sum;
#pragma unroll
        for (int r = 0; r < 16; ++r) { o0[r] *= alpha; o1[r] *= alpha; }
        bf16x8 pf[4];
#pragma unroll
        for (int s = 0; s < 2; ++s) {
            pg8::u32x4 w0, w1;
            w0.x = pg8::cvt_pk_bf16(p0[8 * s + 0], p0[8 * s + 1]); w0.y = pg8::cvt_pk_bf16(p0[8 * s + 2], p0[8 * s + 3]); w0.z = pg8::cvt_pk_bf16(p0[8 * s + 4], p0[8 * s + 5]); w0.w = pg8::cvt_pk_bf16(p0[8 * s + 6], p0[8 * s + 7]);
            w1.x = pg8::cvt_pk_bf16(p1[8 * s + 0], p1[8 * s + 1]); w1.y = pg8::cvt_pk_bf16(p1[8 * s + 2], p1[8 * s + 3]); w1.z = pg8::cvt_pk_bf16(p1[8 * s + 4], p1[8 * s + 5]); w1.w = pg8::cvt_pk_bf16(p1[8 * s + 6], p1[8 * s + 7]);
            pf[s] = __builtin_bit_cast(bf16x8, w0); pf[2 + s] = __builtin_bit_cast(bf16x8, w1);
        }
#pragma unroll
        for (int ks = 0; ks < 4; ++ks) {
            const s16x4 a0 = *(const s16x4*)(Vb + cur + vrd + (((4 * ks + hi) ^ vx) << 3));
            const s16x4 a1 = *(const s16x4*)(Vb + cur + vrd + (((4 * ks + 2 + hi) ^ vx) << 3));
            const s16x4 c0 = *(const s16x4*)(Vb + cur + 4096 + vrd + (((4 * ks + hi) ^ vx) << 3));
            const s16x4 c1 = *(const s16x4*)(Vb + cur + 4096 + vrd + (((4 * ks + 2 + hi) ^ vx) << 3));
            const bf16x8 va = {a0[0], a0[1], a0[2], a0[3], a1[0], a1[1], a1[2], a1[3]};
            const bf16x8 vc = {c0[0], c0[1], c0[2], c0[3], c1[0], c1[1], c1[2], c1[3]};
            o0 = __builtin_amdgcn_mfma_f32_32x32x16_bf16(va, pf[ks], o0, 0, 0, 0);
            o1 = __builtin_amdgcn_mfma_f32_32x32x16_bf16(vc, pf[ks], o1, 0, 0, 0);
        }
        if (t + 1 < nkt) { const int nx = 8192 - cur; *(pg8::u32x4*)(Kb + nx + kst) = kreg; *(pg8::u32x4*)(Vb + nx + vst) = vswap ? (pg8::u32x4){vreg.z, vreg.w, vreg.x, vreg.y} : vreg; }
        __syncthreads();
    }
    { auto rr = __builtin_amdgcn_permlane32_swap(__float_as_uint(lrow), __float_as_uint(lrow), false, false); lrow = __uint_as_float(rr[0]) + __uint_as_float(rr[1]); }
    const float inv = 1.f / lrow;
    bf16_t* op = MIX + (size_t)(qrow0 + wid * 32 + r32) * D + 512 + h * 64 + 4 * hi;
#pragma unroll
    for (int g = 0; g < 4; ++g) {
        pg8::u32x2 w0, w1;
        w0.x = pg8::cvt_pk_bf16(o0[4 * g] * inv, o0[4 * g + 1] * inv); w0.y = pg8::cvt_pk_bf16(o0[4 * g + 2] * inv, o0[4 * g + 3] * inv);
        w1.x = pg8::cvt_pk_bf16(o1[4 * g] * inv, o1[4 * g + 1] * inv); w1.y = pg8::cvt_pk_bf16(o1[4 * g + 2] * inv, o1[4 * g + 3] * inv);
        *(pg8::u32x2*)(op + 8 * g) = w0; *(pg8::u32x2*)(op + 32 + 8 * g) = w1;
    }
}
__device__ __forceinline__ void p3_attn_fast(const Params& p, int l, unsigned char* lds_raw) { PHASE_IDS;
    const int G = gridDim.x;
    const int skip = G >= 128 ? 64 : 0, Ga = G - skip;
    if (bidx_ >= skip)
        for (int u = bidx_ - skip; u < BATCH * 8 * 8; u += Ga) { const int qb = u & 7, h = (u >> 3) & 7, b = u >> 6; attn_unit(p.ws, lds_raw, b, h, b * SEQ + qb * 256, KEYS / 64, tidx); }
    if (l == 0) for (int u = bidx_; u < BATCH * 8; u += G) { const int h = u & 7, b = u >> 3; attn_unit(p.ws, lds_raw, b, h, NL + b * CTXL, CTXL / 64, tidx); }
}

#define LAS __attribute__((address_space(3)))
__device__ __forceinline__ void transpose_item(const float* W, int ldw, int k0, int n0, bf16_t* wt_row0, int ldt, float* scr, int lane) {
#pragma unroll 8
    for (int i = 0; i < 32; ++i) { const int kk = 2 * i + (lane >> 5); scr[kk * 33 + (lane & 31)] = W[(size_t)(k0 + kk) * ldw + n0 + (lane & 31)]; }
    __builtin_amdgcn_s_waitcnt(0); asm volatile("" ::: "memory");
    const int c = lane & 7;
#pragma unroll
    for (int j = 0; j < 4; ++j) { const int n = (lane >> 3) + 8 * j; const float* s = scr + (8 * c) * 33 + n;
        pg8::u32x4 o; o.x = pg8::cvt_pk_bf16(s[0 * 33], s[1 * 33]); o.y = pg8::cvt_pk_bf16(s[2 * 33], s[3 * 33]); o.z = pg8::cvt_pk_bf16(s[4 * 33], s[5 * 33]); o.w = pg8::cvt_pk_bf16(s[6 * 33], s[7 * 33]);
        *(pg8::u32x4*)(wt_row0 + (size_t)n * ldt + k0 + 8 * c) = o; }
    __builtin_amdgcn_s_waitcnt(0); asm volatile("" ::: "memory");
}
__host__ __device__ __forceinline__ int tile_pos(int lc) { return 128 * ((lc >> 5) & 1) + 32 * (lc >> 6) + (lc & 31); }
__device__ __forceinline__ int inproj_dest(int c) {
    int T, lc;
    if (c < C_GV) { T = 2; lc = c - C_GQ; } else if (c < C_GG) { T = 3; lc = c - C_GV; } else if (c < C_GDF) { T = 4; lc = c - C_GG; }
    else if (c < C_AQ) { T = 8; lc = c - C_GDF; } else if (c < C_AQ + 256) { T = 5; lc = c - C_AQ; } else if (c < C_AK) { T = 6; lc = c - C_AQ - 256; } else { T = 7; lc = c - C_AK; }
    return T * 256 + tile_pos(lc);
}
__device__ void convert_experts(const Params& p, int l, float* lds) { PHASE_IDS;
    const int lane = tidx & 63, wave = tidx >> 6;
    float* scr = lds + wave * 2112;
    bf16_t* WGU = (bf16_t*)(p.ws + WS_WGU); bf16_t* WD = (bf16_t*)(p.ws + WS_WD);
    for (int it = GW; it < 2 * NEXP * 16 * 16; it += NGW) {
        const int nb = it & 15, kb = (it >> 4) & 15, e = (it >> 8) & 15, part = it >> 12, n0 = nb * 32;
        const float* W = (part == 0 ? p.w_eg : p.w_eu) + (size_t)(l * NEXP + e) * D * DEXP;
        transpose_item(W, DEXP, kb * 64, n0, WGU + ((size_t)e * 1024 + (n0 >> 7) * 256 + part * 128 + (n0 & 127)) * D, D, scr, lane);
    }
    for (int it = GW; it < NEXP * 8 * 32; it += NGW) {
        const int nb = it & 31, kb = (it >> 5) & 7, e = it >> 8;
        transpose_item(p.w_ed + (size_t)(l * NEXP + e) * DEXP * D, D, kb * 64, nb * 32, WD + ((size_t)e * 1024 + nb * 32) * DEXP, DEXP, scr, lane);
    }
}
__device__ void p0a_fast(const Params& p, float* lds) { PHASE_IDS;
    const int lane = tidx & 63, wave = tidx >> 6;
    float* scr = lds + wave * 2112;
    bf16_t* WIN = (bf16_t*)(p.ws + WS_WIN); bf16_t* WOUT = (bf16_t*)(p.ws + WS_WOUT);
    for (int it = GW; it < 2 * 16 * 49; it += NGW) {
        const int nb = it % 49, kb = (it / 49) & 15, l = it / (49 * 16), n0 = 256 + nb * 32;
        transpose_item(p.w_in + (size_t)l * D * DIN, DIN, kb * 64, n0, WIN + ((size_t)l * NIN + inproj_dest(n0)) * D, D, scr, lane);
    }
    for (int it = GW; it < 2 * 16 * 32; it += NGW) {
        const int nb = it & 31, kb = (it >> 5) & 15, l = it >> 9;
        transpose_item(p.w_out + (size_t)l * D * D, D, kb * 64, nb * 32, WOUT + ((size_t)l * D + nb * 32) * D, D, scr, lane);
    }
    for (int it = GW; it < 2 * 16 * 4 * 4; it += NGW) {
        const int jq = it & 3, g = (it >> 2) & 3, kb = (it >> 4) & 15, l = it >> 8;
        const float* W = p.w_in + (size_t)l * D * DIN;
        float yr[16], ys[16];
#pragma unroll
        for (int jj = 0; jj < 16; ++jj) { yr[jj] = 0.f; ys[jj] = 0.f; }
        for (int half = 0; half < 2; ++half) {
            __builtin_amdgcn_s_waitcnt(0); asm volatile("" ::: "memory");
            for (int i = 0; i < 32; ++i) { const int kk = 2 * i + (lane >> 5); scr[kk * 33 + (lane & 31)] = W[(size_t)(kb * 64 + kk) * DIN + g * 64 + half * 32 + (lane & 31)]; }
            __builtin_amdgcn_s_waitcnt(0); asm volatile("" ::: "memory");
            for (int cc = 0; cc < 32; ++cc) {
                const float u = scr[lane * 33 + cc]; const int c = half * 32 + cc;
#pragma unroll
                for (int jj = 0; jj < 16; ++jj) { const int j = jq * 16 + jj; const int m = (j * c) & 63; float sn, cs; sincos_r((float)m * 0.09817477042468103f, sn, cs); yr[jj] = fmaf(u, cs, yr[jj]); ys[jj] = fmaf(u, sn, ys[jj]); }
            }
        }
#pragma unroll
        for (int jj = 0; jj < 16; ++jj) { const int j = jq * 16 + jj; const size_t row = (size_t)l * NIN + tile_pos(g * 64 + j);
            WIN[(row) * D + kb * 64 + lane] = f2bf(yr[jj]); WIN[(row + 256) * D + kb * 64 + lane] = f2bf(ys[jj]); }
    }
    for (int i = GT; i < 2 * 224 * (D / 8); i += NGT) {
        const int k8 = i & 127, lc = 32 + (i >> 7) % 224, l = i / (224 * 128);
        *(pg8::u32x4*)(WIN + ((size_t)l * NIN + 8 * 256 + tile_pos(lc)) * D + k8 * 8) = (pg8::u32x4){0u, 0u, 0u, 0u};
    }
    {
        bf16_t* DM = (bf16_t*)(p.ws + WS_DMAT);
        for (int i = GT; i < 2048 * 4096 / 8; i += NGT) {
            const int t8 = (i & 511) * 8, k = i >> 9; unsigned w[4];
#pragma unroll
            for (int q = 0; q < 4; ++q) { float v[2];
#pragma unroll
                for (int e = 0; e < 2; ++e) { const int tt = t8 + 2 * q + e, t = tt & 2047; const int m = (k * t) & 2047; float sn, cs; sincos_r((float)m * (6.283185307179586f / 2048.f), sn, cs); v[e] = tt < 2048 ? cs : -sn; }
                w[q] = pg8::cvt_pk_bf16(v[0], v[1]); }
            *(pg8::u32x4*)(DM + (size_t)k * 4096 + t8) = (pg8::u32x4){w[0], w[1], w[2], w[3]};
        }
        bf16_t* DC = (bf16_t*)(p.ws + WS_DMATC);
        for (int i = GT; i < 256 * 512 / 8; i += NGT) {
            const int t8 = (i & 63) * 8, k = i >> 6; unsigned w[4];
#pragma unroll
            for (int q = 0; q < 4; ++q) { float v[2];
#pragma unroll
                for (int e = 0; e < 2; ++e) { const int tt = t8 + 2 * q + e, t = tt & 255; const int m = (k * t) & 255; float sn, cs; sincos_r((float)m * (6.283185307179586f / 256.f), sn, cs); v[e] = tt < 256 ? cs : -sn; }
                w[q] = pg8::cvt_pk_bf16(v[0], v[1]); }
            *(pg8::u32x4*)(DC + (size_t)k * 512 + t8) = (pg8::u32x4){w[0], w[1], w[2], w[3]};
        }
    }
    convert_experts(p, 0, lds);
}

__global__ void __launch_bounds__(NTHREADS) mega(Params p) {
    extern __shared__ __attribute__((aligned(16))) unsigned char lds_raw[];
    float* lds = (float*)lds_raw;
    cg::grid_group grid = cg::this_grid();
    p0a(p); p0a_fast(p, lds); grid.sync();
    p0b(p); grid.sync();
#define LAYER(l) do { p1_norm1(p, l); if (l == 1) convert_experts(p, 1, lds); grid.sync(); p2_inproj_fast(p, l, lds_raw); grid.sync(); p3_fnet_fast(p, l, lds_raw); __syncthreads(); p3_attn_fast(p, l, lds_raw); __syncthreads(); p3_mixers_golden(p, l, lds); grid.sync(); p4_gla_out_golden(p, l, lds); grid.sync(); \
        p5_outproj_fast(p, l, lds_raw); grid.sync(); p6_norm2_router(p, l, lds); grid.sync(); p7_gateup_fast(p, l, lds_raw); grid.sync(); p8_down_fast(p, l, lds_raw); grid.sync(); } while (0)
    LAYER(0);
    LAYER(1);
#undef LAYER
    p9_final(p);
}

extern "C" void kernel_launch(void* const* d_in, const int* in_sizes, int n_in, void* d_out, int out_size, void* d_ws, size_t ws_size, hipStream_t stream) {
    static int grid_blocks = 0;
    if (!grid_blocks) {
        int dev = 0, cus = 0, per_cu = 0;
        hipGetDevice(&dev);
        hipDeviceGetAttribute(&cus, hipDeviceAttributeMultiprocessorCount, dev);
        hipFuncSetAttribute((const void*)mega, hipFuncAttributeMaxDynamicSharedMemorySize, LDS_BYTES);
        hipOccupancyMaxActiveBlocksPerMultiprocessor(&per_cu, (const void*)mega, NTHREADS, LDS_BYTES);
        if (per_cu < 1) { fprintf(stderr, "occupancy query says %d blocks/CU\n", per_cu); per_cu = 1; }
        grid_blocks = cus;
        if (n_in != 21 || ws_size < WS_END) fprintf(stderr, "unexpected n_in %d / ws_size %zu\n", n_in, ws_size);
    }
    hipMemsetAsync((char*)d_ws + WS_CTL, 0, 1 * MiB, stream);
    Params p{};
    const float** f = (const float**)&p;
    for (int i = 0; i < 21; ++i) f[i] = (const float*)d_in[i];
    p.out = (float*)d_out; p.ws = (unsigned char*)d_ws;
    void* args[] = {&p};
    hipError_t e = hipLaunchCooperativeKernel((const void*)mega, dim3(grid_blocks), dim3(NTHREADS), args, LDS_BYTES, stream);
    if (e != hipSuccess) fprintf(stderr, "cooperative launch failed: %s (grid %d)\n", hipGetErrorString(e), grid_blocks);
}
```

```cpp
#include <hip/hip_runtime.h>
#include <hip/hip_cooperative_groups.h>
#include <cstdio>
#include <cstdint>
namespace cg = cooperative_groups;

typedef unsigned short bf16_t;
typedef float f32x4 __attribute__((ext_vector_type(4)));

constexpr int D = 1024, BATCH = 8, SEQ = 2048, CTXL = 256, DEPTH = 2;
constexpr int NL = BATCH * SEQ, NC = BATCH * CTXL, NTOK = NL + NC;
constexpr int DIN = 1824;
constexpr int C_FN = 0, C_GQ = 256, C_GK = 384, C_GV = 512, C_GG = 768, C_GDF = 1024, C_GDB = 1040, C_AQ = 1056, C_AK = 1568, C_AV = 1696;
constexpr int KEYS = CTXL + SEQ;
constexpr int NCHK = 36;
constexpr int NEXP = 16, DEXP = 512;
constexpr float EPS = 1e-6f;
constexpr float QSCALE = 0.125f * 1.4426950408889634f;
constexpr int NWAVES = 8, NTHREADS = 512;
#define GOLDEN_FNET 0
#define GOLDEN_ATTN 0
#define GOLDEN_GLA 0
constexpr int LDS_BYTES = 147456;

constexpr size_t MiB = 1u << 20;
constexpr size_t WS_CTL = 0;
constexpr size_t WS_MODP = 151 * MiB;
constexpr size_t WS_MOD = 9 * MiB;
constexpr size_t WS_TAB = 10 * MiB;
constexpr size_t WS_XC = 11 * MiB;
constexpr size_t WS_HB = 19 * MiB;
constexpr size_t WS_YFTL = 55 * MiB;
constexpr size_t WS_YFTC = 71 * MiB;
constexpr size_t WS_GQK = 73 * MiB;
constexpr size_t WS_GV = 82 * MiB;
constexpr size_t WS_GG = 91 * MiB;
constexpr size_t WS_GD = 100 * MiB;
constexpr size_t WS_AQ = 102 * MiB;
constexpr size_t WS_AK = 120 * MiB;
constexpr size_t WS_AVT = 125 * MiB;
constexpr size_t WS_AST = 130 * MiB;
constexpr size_t WS_DEC = 149 * MiB;
constexpr size_t WS_ROUTE = 150 * MiB;
constexpr size_t WS_Y = 151 * MiB;
constexpr size_t WS_WIN = 223 * MiB;
constexpr size_t WS_WOUT = 232 * MiB;
constexpr size_t WS_WGU = 236 * MiB;
constexpr size_t WS_WD = 268 * MiB;
constexpr size_t WS_DMAT = 284 * MiB;
constexpr size_t WS_DMATC = 300 * MiB;
constexpr size_t WS_LIST = 301 * MiB;
constexpr size_t WS_ST = 304 * MiB;
constexpr size_t WS_END = 314 * MiB;
constexpr size_t WS_ACT = WS_YFTL;
constexpr int CW_CNT = 8192;
constexpr int NIN = 2304;

struct Params {
    const float *x, *c, *ctx, *c_ctx, *w_ada, *b_ada, *norm_mix, *norm_ffn, *w_in, *w_gup, *b_gg, *gla_norm, *q_norm, *k_norm, *w_out, *w_router, *b_router, *w_eg, *w_eu, *w_ed, *final_norm;
    float* out;
    unsigned char* ws;
};

__device__ __forceinline__ float bf2f(bf16_t v) { return __uint_as_float((unsigned)v << 16); }
__device__ __forceinline__ bf16_t f2bf(float f) { unsigned u = __float_as_uint(f); return (bf16_t)((u + 0x7fffu + ((u >> 16) & 1u)) >> 16); }
__device__ __forceinline__ float wave_sum(float v) {
#pragma unroll
    for (int o = 1; o < 64; o <<= 1) v += __shfl_xor(v, o);
    return v;
}
__device__ __forceinline__ float siluf(float v) { return v / (1.f + expf(-v)); }
__device__ __forceinline__ float sigmoidf(float v) { return 1.f / (1.f + expf(-v)); }
__device__ __forceinline__ float logsigmoidf(float z) { return fminf(z, 0.f) - log1pf(expf(-fabsf(z))); }
__device__ __forceinline__ void sincos_r(float x, float& s, float& c) {
    const float k = rintf(x * 0.63661977236758134f);
    float r = fmaf(k, -1.57079625129699707031f, x); r = fmaf(k, -7.54978995489188216e-8f, r);
    const int q = ((int)k) & 3;
    const float r2 = r * r;
    float sp = fmaf(r2, 2.7557314297e-6f, -1.9841270114e-4f); sp = fmaf(sp, r2, 8.3333337680e-3f); sp = fmaf(sp, r2, -1.6666667163e-1f); sp = fmaf(sp * r2, r, r);
    float cp = fmaf(r2, 2.4801587642e-5f, -1.3888889225e-3f); cp = fmaf(cp, r2, 4.1666667908e-2f); cp = fmaf(cp, r2, -0.5f); cp = fmaf(cp, r2, 1.f);
    const float ss = (q & 1) ? cp : sp, cc = (q & 1) ? sp : cp;
    s = (q & 2) ? -ss : ss; c = ((q + 1) & 2) ? -cc : cc;
}
struct RowInfo { int b, t, bidx, isctx; };
__device__ __forceinline__ RowInfo row_info(int r) { RowInfo ri; if (r < NL) { ri.b = r >> 11; ri.t = r & 2047; ri.bidx = ri.b; ri.isctx = 0; } else { const int q = r - NL; ri.b = q >> 8; ri.t = q & 255; ri.bidx = 8; ri.isctx = 1; } return ri; }

__device__ __forceinline__ int otid() { int t = threadIdx.x; asm volatile("" : "+v"(t)); return t; }
__device__ __forceinline__ int obid() { int b = blockIdx.x; asm volatile("" : "+s"(b)); return b; }
#define PHASE_IDS const int tidx = otid(); const int bidx_ = obid(); (void)tidx; (void)bidx_
#define GW (bidx_ * NWAVES + (tidx >> 6))
#define NGW (gridDim.x * NWAVES)
#define GT (bidx_ * NTHREADS + tidx)
#define NGT (gridDim.x * NTHREADS)

__device__ __forceinline__ void p0a(const Params& p) { PHASE_IDS;
    const int lane = tidx & 63;
    float* MODP = (float*)(p.ws + WS_MODP);
    for (int it = GW; it < 2 * 16 * 96; it += NGW) {
        const int l = it / (16 * 96), kc = (it / 96) % 16, cb = it % 96, col = cb * 64 + lane;
        float acc[9];
#pragma unroll
        for (int j = 0; j < 9; ++j) acc[j] = 0.f;
        for (int kk = 0; kk < 64; ++kk) {
            const int k = kc * 64 + kk;
            const float w = p.w_ada[((size_t)l * D + k) * 6144 + col];
#pragma unroll
            for (int j = 0; j < 9; ++j) { const float cv = (j < 8) ? p.c[j * D + k] : p.c_ctx[k]; acc[j] = fmaf(siluf(cv), w, acc[j]); }
        }
#pragma unroll
        for (int j = 0; j < 9; ++j) MODP[((size_t)(l * 16 + kc) * 9 + j) * 6144 + col] = acc[j];
    }
    float* TAB = (float*)(p.ws + WS_TAB);
    for (int i = GT; i < 2048 + 1024; i += NGT) {
        if (i < 2048) { float s, c; sincos_r((float)i * (6.283185307179586f / 2048.f), s, c); TAB[i] = c; }
        else { const int q = i - 2048, pos = q >> 4, f = q & 15; const float inv = exp2f(-(float)f * (13.287712379549449f / 16.f)); float s, c; sincos_r((float)pos * inv, s, c); TAB[2048 + 2 * q] = c; TAB[2048 + 2 * q + 1] = s; }
    }
}
__device__ __forceinline__ void p0b(const Params& p) { PHASE_IDS;
    const float* MODP = (const float*)(p.ws + WS_MODP);
    float* MOD = (float*)(p.ws + WS_MOD);
    for (int i = GT; i < 2 * 9 * 6144; i += NGT) {
        const int l = i / (9 * 6144), j = (i / 6144) % 9, col = i % 6144;
        float s = p.b_ada[l * 6144 + col];
        for (int kc = 0; kc < 16; ++kc) s += MODP[((size_t)(l * 16 + kc) * 9 + j) * 6144 + col];
        MOD[i] = s;
    }
}

__device__ __forceinline__ float* xrow_ptr(const Params& p, int r) { return r < NL ? p.out + (size_t)r * D : (float*)(p.ws + WS_XC) + (size_t)(r - NL) * D; }
__device__ __forceinline__ const float* xin_ptr(const Params& p, int r) { return r < NL ? p.x + (size_t)r * D : p.ctx + (size_t)(r - NL) * D; }

__device__ __forceinline__ void p1_norm1(const Params& p, int l) { PHASE_IDS;
    const int lane = tidx & 63;
    const float* MOD = (const float*)(p.ws + WS_MOD);
    bf16_t* HB = (bf16_t*)(p.ws + WS_HB);
    const bf16_t* Y = (const bf16_t*)(p.ws + WS_Y);
    for (int r = GW; r < NTOK; r += NGW) {
        const RowInfo ri = row_info(r);
        f32x4 v[4]; float ss = 0.f;
#pragma unroll
        for (int j = 0; j < 4; ++j) {
            const int col = 4 * lane + 256 * j;
            if (l == 0) v[j] = *(const f32x4*)(xin_ptr(p, r) + col);
            else {
                float* xr = xrow_ptr(p, r) + col; v[j] = *(const f32x4*)xr;
                const f32x4 g2 = *(const f32x4*)(MOD + ((size_t)(l - 1) * 9 + ri.bidx) * 6144 + 5 * D + col);
                const bf16_t* y0 = Y + (size_t)(2 * r) * D + col; const bf16_t* y1 = y0 + D;
#pragma unroll
                for (int e = 0; e < 4; ++e) v[j][e] += g2[e] * (bf2f(y0[e]) + bf2f(y1[e]));
                *(f32x4*)xr = v[j];
            }
            ss += v[j][0] * v[j][0] + v[j][1] * v[j][1] + v[j][2] * v[j][2] + v[j][3] * v[j][3];
        }
        const float rstd = rsqrtf(wave_sum(ss) * (1.f / D) + EPS);
        const float* mod = MOD + ((size_t)l * 9 + ri.bidx) * 6144;
#pragma unroll
        for (int j = 0; j < 4; ++j) {
            const int col = 4 * lane + 256 * j;
            const f32x4 nw = *(const f32x4*)(p.norm_mix + l * D + col), sh = *(const f32x4*)(mod + col), sc = *(const f32x4*)(mod + D + col);
            bf16_t* o = HB + (size_t)r * D + col;
#pragma unroll
            for (int e = 0; e < 4; ++e) o[e] = f2bf(v[j][e] * rstd * nw[e] * (1.f + sc[e]) + sh[e]);
        }
    }
}

__device__ __forceinline__ void p2_inproj_golden(const Params& p, int l, float* lds) { PHASE_IDS;
    const int lane = tidx & 63, wave = tidx >> 6;
    float* hrow = lds + wave * 2880;
    float* orow = hrow + 1024;
    const bf16_t* HB = (const bf16_t*)(p.ws + WS_HB);
    const float* TAB = (const float*)(p.ws + WS_TAB);
    bf16_t* YFTL = (bf16_t*)(p.ws + WS_YFTL); bf16_t* YFTC = (bf16_t*)(p.ws + WS_YFTC);
    bf16_t* GQK = (bf16_t*)(p.ws + WS_GQK); bf16_t* GV = (bf16_t*)(p.ws + WS_GV); bf16_t* GG = (bf16_t*)(p.ws + WS_GG); bf16_t* GD = (bf16_t*)(p.ws + WS_GD);
    bf16_t* AQ = (bf16_t*)(p.ws + WS_AQ); bf16_t* AK = (bf16_t*)(p.ws + WS_AK); bf16_t* AVT = (bf16_t*)(p.ws + WS_AVT);
    const float* W = p.w_in + (size_t)l * D * DIN;
    for (int r = GW; r < NTOK; r += NGW) {
        const RowInfo ri = row_info(r);
        for (int k = lane; k < D; k += 64) hrow[k] = bf2f(HB[(size_t)r * D + k]);
        __builtin_amdgcn_s_waitcnt(0);
        float acc[29];
#pragma unroll
        for (int i = 0; i < 29; ++i) acc[i] = 0.f;
#pragma unroll 1
        for (int k = 0; k < D; ++k) {
            const float h = hrow[k]; const float* wr = W + (size_t)k * DIN + lane;
#pragma unroll
            for (int i = 0; i < 28; ++i) acc[i] = fmaf(h, wr[64 * i], acc[i]);
            if (lane < 32) acc[28] = fmaf(h, wr[64 * 28], acc[28]);
        }
#pragma unroll
        for (int i = 0; i < 28; ++i) orow[64 * i + lane] = acc[i];
        if (lane < 32) orow[64 * 28 + lane] = acc[28];
        __builtin_amdgcn_s_waitcnt(0);
        {
            const int j = lane;
#pragma unroll 1
            for (int g = 0; g < 4; ++g) {
                float yr = 0.f, ys = 0.f;
#pragma unroll 4
                for (int c = 0; c < 64; ++c) { const int m = ((j * c) & 63) * 32; const float u = orow[C_FN + g * 64 + c]; yr = fmaf(u, TAB[m], yr); ys = fmaf(u, TAB[(m - 512) & 2047], ys); }
                if (!ri.isctx) { bf16_t* o = YFTL + (((size_t)ri.b * 256 + g * 64 + j) * 2) * SEQ + ri.t; o[0] = f2bf(yr); o[SEQ] = f2bf(ys); }
                else { bf16_t* o = YFTC + (((size_t)ri.b * 256 + g * 64 + j) * 2) * CTXL + ri.t; o[0] = f2bf(yr); o[CTXL] = f2bf(ys); }
            }
        }
        for (int i = lane; i < 128; i += 64) { GQK[(size_t)r * 256 + i] = f2bf(orow[C_GQ + i] * 0.17677669529663687f); GQK[(size_t)r * 256 + 128 + i] = f2bf(orow[C_GK + i]); }
        for (int i = lane; i < 256; i += 64) { GV[(size_t)r * 256 + i] = f2bf(orow[C_GV + i]); GG[(size_t)r * 256 + i] = f2bf(orow[C_GG + i]); }
        if (lane < 32) GD[(size_t)r * 32 + lane] = f2bf(orow[C_GDF + lane]);
        {
            const int d = lane, axis = d >> 5, half = (d >> 4) & 1, f = d & 15;
            const int pos = axis == 0 ? (ri.t >> 6) : (ri.t & 63);
            const float cs = TAB[2048 + 2 * (pos * 16 + f)], sn = TAB[2048 + 2 * (pos * 16 + f) + 1];
#pragma unroll 1
            for (int h = 0; h < 10; ++h) {
                const int base = h < 8 ? C_AQ + h * 64 : C_AK + (h - 8) * 64;
                const float* nw = h < 8 ? p.q_norm + l * 64 : p.k_norm + l * 64;
                const float v = orow[base + d], vp = orow[base + (d ^ 16)];
                const float rs = rsqrtf(wave_sum(v * v) * (1.f / 64.f) + EPS);
                float xv = v * rs * nw[d], xp = vp * rs * nw[d ^ 16], o = xv;
                if (!ri.isctx) o = half == 0 ? xv * cs - xp * sn : xv * cs + xp * sn;
                if (h < 8) AQ[(size_t)r * 512 + h * 64 + d] = f2bf(o * QSCALE);
                else AK[((size_t)ri.b * KEYS + (ri.isctx ? ri.t : CTXL + ri.t)) * 128 + (h - 8) * 64 + d] = f2bf(o);
            }
            for (int kvh = 0; kvh < 2; ++kvh) AVT[(((size_t)ri.b * 2 + kvh) * 64 + d) * KEYS + (ri.isctx ? ri.t : CTXL + ri.t)] = f2bf(orow[C_AV + kvh * 64 + d]);
        }
        __builtin_amdgcn_s_waitcnt(0);
    }
}

__device__ __forceinline__ void attn_golden_wave(const Params& p, int b, int h, int qrow, int nkeys) { PHASE_IDS;
    const bf16_t* AQ = (const bf16_t*)(p.ws + WS_AQ); const bf16_t* AK = (const bf16_t*)(p.ws + WS_AK); const bf16_t* AVT = (const bf16_t*)(p.ws + WS_AVT);
    bf16_t* MIX = (bf16_t*)(p.ws + WS_HB);
    const int kvh = h >> 2, d = tidx & 63;
    const float q = bf2f(AQ[(size_t)qrow * 512 + h * 64 + d]);
    float o = 0.f, m = -1e30f, lsum = 0.f;
    const bf16_t* kb = AK + (size_t)b * KEYS * 128 + kvh * 64 + d;
    const bf16_t* vb = AVT + (((size_t)b * 2 + kvh) * 64 + d) * KEYS;
#pragma unroll 4
    for (int key = 0; key < nkeys; ++key) {
        const float s = wave_sum(q * bf2f(kb[(size_t)key * 128]));
        const float mn = fmaxf(m, s), a = exp2f(m - mn), pe = exp2f(s - mn);
        lsum = lsum * a + pe; m = mn;
        o = fmaf(o, a, pe * bf2f(vb[key]));
    }
    MIX[(size_t)qrow * D + 512 + h * 64 + d] = f2bf(o / lsum);
}

__device__ __forceinline__ void gla_stage(const Params& p, int l, int b, int cs, int h, float* cumF, float* cumB, float* sq, float* sk, float* sv) { PHASE_IDS;
    const int tid = tidx;
    const bf16_t* GQK = (const bf16_t*)(p.ws + WS_GQK); const bf16_t* GV = (const bf16_t*)(p.ws + WS_GV); const bf16_t* GD = (const bf16_t*)(p.ws + WS_GD);
    const int row0 = cs < 4 ? NL + b * CTXL + cs * 64 : b * SEQ + (cs - 4) * 64;
    for (int i = tid; i < 64 * 32 * 2; i += NTHREADS) {
        const int dir = i >> 11, tok = (i >> 5) & 63, k = i & 31;
        const float* wu = p.w_gup + ((size_t)(l * 2 + dir) * 16) * 128 + h * 32 + k;
        float z = p.b_gg[(l * 2 + dir) * 128 + h * 32 + k];
#pragma unroll
        for (int rr = 0; rr < 16; ++rr) z = fmaf(bf2f(GD[(size_t)(row0 + tok) * 32 + dir * 16 + rr]), wu[rr * 128], z);
        (dir == 0 ? cumF : cumB)[tok * 32 + k] = logsigmoidf(z) * (1.f / 16.f);
    }
    for (int i = tid; i < 64 * 32; i += NTHREADS) { const int tok = i >> 5, k = i & 31; sq[i] = bf2f(GQK[(size_t)(row0 + tok) * 256 + h * 32 + k]); sk[i] = bf2f(GQK[(size_t)(row0 + tok) * 256 + 128 + h * 32 + k]); }
    for (int i = tid; i < 64 * 64; i += NTHREADS) { const int tok = i >> 6, v = i & 63; sv[i] = bf2f(GV[(size_t)(row0 + tok) * 256 + h * 64 + v]); }
    __syncthreads();
    if (tid < 32) { float a = 0.f; for (int t = 0; t < 64; ++t) { a += cumF[t * 32 + tid]; cumF[t * 32 + tid] = a; } }
    else if (tid < 64) { const int k = tid - 32; float a = 0.f; for (int t = 63; t >= 0; --t) { a += cumB[t * 32 + k]; cumB[t * 32 + k] = a; } }
    __syncthreads();
}

__device__ __forceinline__ void p3_mixers_golden(const Params& p, int l, float* lds) { PHASE_IDS;
    const float* TAB = (const float*)(p.ws + WS_TAB);
    bf16_t* MIX = (bf16_t*)(p.ws + WS_HB);
    if (GOLDEN_ATTN) for (int i = GW; i < BATCH * 8 * SEQ; i += NGW) { const int q = i & 2047, h = (i >> 11) & 7, b = i >> 14; attn_golden_wave(p, b, h, b * SEQ + q, KEYS); }
    if (GOLDEN_ATTN && l == 0) for (int i = GW; i < BATCH * 8 * CTXL; i += NGW) { const int q = i & 255, h = (i >> 8) & 7, b = i >> 11; attn_golden_wave(p, b, h, NL + b * CTXL + q, CTXL); }
    if (GOLDEN_FNET) {
        const bf16_t* YFTL = (const bf16_t*)(p.ws + WS_YFTL);
        const float scale = 1.f / sqrtf(64.f * SEQ);
        for (int i = GT; i < BATCH * 256 * SEQ; i += NGT) {
            const int k = i & 2047, j = (i >> 11) & 255, b = i >> 19;
            const bf16_t* yr = YFTL + (((size_t)b * 256 + j) * 2) * SEQ; const bf16_t* ys = yr + SEQ;
            float acc = 0.f;
            for (int t = 0; t < SEQ; ++t) { const int m = (k * t) & 2047; acc = fmaf(TAB[m], bf2f(yr[t]), acc); acc = fmaf(-TAB[(m - 512) & 2047], bf2f(ys[t]), acc); }
            MIX[(size_t)(b * SEQ + k) * D + j] = f2bf(acc * scale);
        }
    }
    if (GOLDEN_FNET && l == 0) {
        const bf16_t* YFTC = (const bf16_t*)(p.ws + WS_YFTC);
        const float scale = 1.f / sqrtf(64.f * CTXL);
        for (int i = GT; i < BATCH * 256 * CTXL; i += NGT) {
            const int k = i & 255, j = (i >> 8) & 255, b = i >> 16;
            const bf16_t* yr = YFTC + (((size_t)b * 256 + j) * 2) * CTXL; const bf16_t* ys = yr + CTXL;
            float acc = 0.f;
            for (int t = 0; t < CTXL; ++t) { const int m = ((k * t) & 255) * 8; acc = fmaf(TAB[m], bf2f(yr[t]), acc); acc = fmaf(-TAB[(m - 512) & 2047], bf2f(ys[t]), acc); }
            MIX[(size_t)(NL + b * CTXL + k) * D + j] = f2bf(acc * scale);
        }
    }
    if (GOLDEN_GLA) {
        float* cumF = lds; float* cumB = cumF + 2048; float* sq = cumB + 2048; float* sk = sq + 2048; float* sv = sk + 2048;
        float* AST = (float*)(p.ws + WS_AST); float* DEC = (float*)(p.ws + WS_DEC);
        for (int it = bidx_; it < BATCH * NCHK * 4; it += gridDim.x) {
            const int h = it & 3, cs = (it >> 2) % NCHK, b = it / (4 * NCHK);
            __syncthreads();
            gla_stage(p, l, b, cs, h, cumF, cumB, sq, sk, sv);
            for (int i = tidx; i < 2 * 2048; i += NTHREADS) {
                const int dir = i >> 11, k = (i >> 6) & 31, v = i & 63;
                const float* cum = dir == 0 ? cumF : cumB; const float last = dir == 0 ? cum[63 * 32 + k] : cum[k];
                float a = 0.f;
                for (int t = 0; t < 64; ++t) a = fmaf(sk[t * 32 + k] * expf(last - cum[t * 32 + k]), sv[t * 64 + v], a);
                AST[((((size_t)b * NCHK + cs) * 4 + h) * 2 + dir) * 2048 + k * 64 + v] = a;
                if (v == 0) DEC[((((size_t)b * NCHK + cs) * 4 + h) * 2 + dir) * 32 + k] = expf(last);
            }
        }
    }
}

__device__ __forceinline__ void p4_gla_out_golden(const Params& p, int l, float* lds) { PHASE_IDS;
    float* cumF = lds; float* cumB = cumF + 2048; float* sq = cumB + 2048; float* sk = sq + 2048; float* sv = sk + 2048;
    float* Sf = sv + 4096; float* Sb = Sf + 2048; float* att = Sb + 2048; float* ob = att + 4096;
    const float* AST = (const float*)(p.ws + WS_AST); const float* DEC = (const float*)(p.ws + WS_DEC);
    const bf16_t* GG = (const bf16_t*)(p.ws + WS_GG);
    bf16_t* MIX = (bf16_t*)(p.ws + WS_HB);
    const int tid = tidx;
    for (int it = bidx_; it < BATCH * NCHK * 4; it += gridDim.x) {
        const int h = it & 3, cs = (it >> 2) % NCHK, b = it / (4 * NCHK);
        if (l == 1 && cs < 4) continue;
        __syncthreads();
        gla_stage(p, l, b, cs, h, cumF, cumB, sq, sk, sv);
        for (int i = tid; i < 2048; i += NTHREADS) {
            const int k = i >> 6;
            float s = 0.f;
            for (int c = 0; c < cs; ++c) { const size_t id = (((size_t)b * NCHK + c) * 4 + h) * 2 + 0; s = DEC[id * 32 + k] * s + AST[id * 2048 + i]; }
            Sf[i] = s;
            s = 0.f;
            if (cs < 4) { for (int c = 3; c > cs; --c) { const size_t id = (((size_t)b * NCHK + c) * 4 + h) * 2 + 1; s = DEC[id * 32 + k] * s + AST[id * 2048 + i]; } }
            else { for (int c = 3; c >= 0; --c) { const size_t id = (((size_t)b * NCHK + c) * 4 + h) * 2 + 1; s = DEC[id * 32 + k] * s + AST[id * 2048 + i]; }
                   for (int c = NCHK - 1; c > cs; --c) { const size_t id = (((size_t)b * NCHK + c) * 4 + h) * 2 + 1; s = DEC[id * 32 + k] * s + AST[id * 2048 + i]; } }
            Sb[i] = s;
        }
        for (int i = tid; i < 4096; i += NTHREADS) {
            const int ti = i >> 6, tj = i & 63;
            float a = 0.f;
            if (tj <= ti) for (int k = 0; k < 32; ++k) a = fmaf(sq[ti * 32 + k] * sk[tj * 32 + k], expf(cumF[ti * 32 + k] - cumF[tj * 32 + k]), a);
            if (tj >= ti) for (int k = 0; k < 32; ++k) a = fmaf(sq[ti * 32 + k] * sk[tj * 32 + k], expf(cumB[ti * 32 + k] - cumB[tj * 32 + k]), a);
            att[i] = a;
        }
        __syncthreads();
        for (int i = tid; i < 4096; i += NTHREADS) {
            const int ti = i >> 6, v = i & 63;
            float a = 0.f;
            for (int tj = 0; tj < 64; ++tj) a = fmaf(att[ti * 64 + tj], sv[tj * 64 + v], a);
            for (int k = 0; k < 32; ++k) a = fmaf(sq[ti * 32 + k], expf(cumF[ti * 32 + k]) * Sf[k * 64 + v] + expf(cumB[ti * 32 + k]) * Sb[k * 64 + v], a);
            ob[i] = a;
        }
        __syncthreads();
        const int row0 = cs < 4 ? NL + b * CTXL + cs * 64 : b * SEQ + (cs - 4) * 64;
        for (int i = tid; i < 4096; i += NTHREADS) {
            const int ti = i >> 6, v = i & 63;
            float ss = 0.f;
            for (int vv = 0; vv < 64; ++vv) ss = fmaf(ob[ti * 64 + vv], ob[ti * 64 + vv], ss);
            const float rs = rsqrtf(ss * (1.f / 64.f) + EPS);
            const float g = bf2f(GG[(size_t)(row0 + ti) * 256 + h * 64 + v]);
            MIX[(size_t)(row0 + ti) * D + 256 + h * 64 + v] = f2bf(ob[i] * rs * p.gla_norm[l * 64 + v] * siluf(g));
        }
    }
}

__device__ __forceinline__ void p5_outproj_golden(const Params& p, int l, float* lds) { PHASE_IDS;
    const int lane = tidx & 63, wave = tidx >> 6;
    float* mrow = lds + wave * 1024;
    const bf16_t* MIX = (const bf16_t*)(p.ws + WS_HB);
    const float* MOD = (const float*)(p.ws + WS_MOD);
    const float* W = p.w_out + (size_t)l * D * D;
    const int nrows = l == 0 ? NTOK : NL;
    for (int r = GW; r < nrows; r += NGW) {
        const RowInfo ri = row_info(r);
        for (int k = lane; k < D; k += 64) mrow[k] = bf2f(MIX[(size_t)r * D + k]);
        __builtin_amdgcn_s_waitcnt(0);
        float acc[16];
#pragma unroll
        for (int i = 0; i < 16; ++i) acc[i] = 0.f;
        for (int k = 0; k < D; ++k) { const float m = mrow[k]; const float* wr = W + (size_t)k * D + lane;
#pragma unroll
            for (int i = 0; i < 16; ++i) acc[i] = fmaf(m, wr[64 * i], acc[i]); }
        const float* g1 = MOD + ((size_t)l * 9 + ri.bidx) * 6144 + 2 * D;
        const float* xs = l == 0 ? xin_ptr(p, r) : xrow_ptr(p, r);
        float* xd = xrow_ptr(p, r);
#pragma unroll
        for (int i = 0; i < 16; ++i) { const int col = 64 * i + lane; xd[col] = xs[col] + g1[col] * acc[i]; }
        __builtin_amdgcn_s_waitcnt(0);
    }
}

__device__ __forceinline__ void p6_norm2_router(const Params& p, int l, float* lds) { PHASE_IDS;
    const int lane = tidx & 63;
    const float* MOD = (const float*)(p.ws + WS_MOD);
    bf16_t* HB = (bf16_t*)(p.ws + WS_HB);
    f32x4* ROUTE = (f32x4*)(p.ws + WS_ROUTE);
    const int nrows = l == 0 ? NTOK : NL;
    const int rpb = (nrows + (int)gridDim.x - 1) / (int)gridDim.x, rbeg = bidx_ * rpb, rend = (rbeg + rpb < nrows) ? rbeg + rpb : nrows;
    int* lcnt = (int*)lds; int* lbase = lcnt + 16; int* rroute = lbase + 16;
    if (tidx < 16) lcnt[tidx] = 0;
    __syncthreads();
    for (int r = rbeg + (tidx >> 6); r < rend; r += NWAVES) {
        const RowInfo ri = row_info(r);
        const float* xr = xrow_ptr(p, r);
        f32x4 v[4]; float ss = 0.f;
#pragma unroll
        for (int j = 0; j < 4; ++j) { v[j] = *(const f32x4*)(xr + 4 * lane + 256 * j); ss += v[j][0] * v[j][0] + v[j][1] * v[j][1] + v[j][2] * v[j][2] + v[j][3] * v[j][3]; }
        const float rstd = rsqrtf(wave_sum(ss) * (1.f / D) + EPS);
        const float* mod = MOD + ((size_t)l * 9 + ri.bidx) * 6144;
        float lg[16];
#pragma unroll
        for (int e = 0; e < 16; ++e) lg[e] = 0.f;
#pragma unroll
        for (int j = 0; j < 4; ++j) {
            const int col = 4 * lane + 256 * j;
            const f32x4 nw = *(const f32x4*)(p.norm_ffn + l * D + col), sh = *(const f32x4*)(mod + 3 * D + col), sc = *(const f32x4*)(mod + 4 * D + col);
            bf16_t* o = HB + (size_t)r * D + col;
#pragma unroll
            for (int e = 0; e < 4; ++e) {
                const float hv = v[j][e] * rstd * nw[e] * (1.f + sc[e]) + sh[e];
                o[e] = f2bf(hv);
                const f32x4* wr = (const f32x4*)(p.w_router + (size_t)(col + e) * 16);
#pragma unroll
                for (int q = 0; q < 4; ++q) { const f32x4 w4 = wr[q]; lg[4 * q] = fmaf(hv, w4[0], lg[4 * q]); lg[4 * q + 1] = fmaf(hv, w4[1], lg[4 * q + 1]); lg[4 * q + 2] = fmaf(hv, w4[2], lg[4 * q + 2]); lg[4 * q + 3] = fmaf(hv, w4[3], lg[4 * q + 3]); }
            }
        }
        float s[16], sel[16];
#pragma unroll
        for (int e = 0; e < 16; ++e) { s[e] = sigmoidf(wave_sum(lg[e])); sel[e] = s[e] + p.b_router[e]; }
        int bestg = 0; float bestscore = -1e30f;
#pragma unroll
        for (int g = 0; g < 4; ++g) {
            float m1 = -1e30f, m2 = -1e30f;
#pragma unroll
            for (int i = 0; i < 4; ++i) { const float vsel = sel[4 * g + i]; if (vsel > m1) { m2 = m1; m1 = vsel; } else if (vsel > m2) m2 = vsel; }
            const float gs = m1 + m2;
            if (gs > bestscore) { bestscore = gs; bestg = g; }
        }
        int i1 = 0, i2 = 0; float m1 = -1e30f, m2 = -1e30f, s1 = 0.f, s2 = 0.f;
#pragma unroll
        for (int g = 0; g < 4; ++g) if (g == bestg) {
#pragma unroll
            for (int i = 0; i < 4; ++i) { const float vsel = sel[4 * g + i]; if (vsel > m1) { m1 = vsel; i1 = i; s1 = s[4 * g + i]; } }
#pragma unroll
            for (int i = 0; i < 4; ++i) { const float vsel = sel[4 * g + i]; if (i != i1 && vsel > m2) { m2 = vsel; i2 = i; s2 = s[4 * g + i]; } }
        }
        if (lane == 0) { const int e1 = bestg * 4 + i1, e2 = bestg * 4 + i2; f32x4 rt; rt[0] = __int_as_float(e1); rt[1] = __int_as_float(e2); rt[2] = s1 / (s1 + s2); rt[3] = s2 / (s1 + s2); ROUTE[r] = rt;
            rroute[r - rbeg] = e1 | (e2 << 8); atomicAdd(&lcnt[e1], 1); atomicAdd(&lcnt[e2], 1); }
    }
    __syncthreads();
    unsigned* ctl = (unsigned*)(p.ws + WS_CTL);
    if (tidx < 16) { lbase[tidx] = (int)__hip_atomic_fetch_add(ctl + CW_CNT + (l * NEXP + tidx) * 64, (unsigned)lcnt[tidx], __ATOMIC_RELAXED, __HIP_MEMORY_SCOPE_AGENT); lcnt[tidx] = 0; }
    __syncthreads();
    int* LIST = (int*)(p.ws + WS_LIST) + (size_t)l * NEXP * NTOK;
    if (tidx < rend - rbeg) {
        const int rr = rroute[tidx], r = rbeg + tidx;
#pragma unroll
        for (int slot = 0; slot < 2; ++slot) { const int e = (rr >> (8 * slot)) & 255; const int pos = lbase[e] + atomicAdd(&lcnt[e], 1); LIST[e * NTOK + pos] = 2 * r + slot; }
    }
    __syncthreads();
}


__device__ __forceinline__ void p78_moe_golden(const Params& p, int l, float* lds) { PHASE_IDS;
    const int lane = tidx & 63, wave = tidx >> 6;
    float* hrow = lds + wave * 1536; float* arow = hrow + 1024;
    const bf16_t* HB = (const bf16_t*)(p.ws + WS_HB);
    const f32x4* ROUTE = (const f32x4*)(p.ws + WS_ROUTE);
    bf16_t* Y = (bf16_t*)(p.ws + WS_Y);
    const int nrows = l == 0 ? NTOK : NL;
    for (int it = GW; it < nrows * 2; it += NGW) {
        const int r = it >> 1, slot = it & 1;
        const f32x4 rt = ROUTE[r];
        const int e = __float_as_int(rt[slot]); const float wgt = rt[2 + slot];
        for (int k = lane; k < D; k += 64) hrow[k] = bf2f(HB[(size_t)r * D + k]);
        __builtin_amdgcn_s_waitcnt(0);
        const float* Wg = p.w_eg + ((size_t)(l * NEXP + e) * D) * DEXP; const float* Wu = p.w_eu + ((size_t)(l * NEXP + e) * D) * DEXP; const float* Wd = p.w_ed + ((size_t)(l * NEXP + e) * DEXP) * D;
        float ag[8], au[8];
#pragma unroll
        for (int i = 0; i < 8; ++i) { ag[i] = 0.f; au[i] = 0.f; }
        for (int k = 0; k < D; ++k) { const float hv = hrow[k]; const float* g = Wg + (size_t)k * DEXP + lane; const float* u = Wu + (size_t)k * DEXP + lane;
#pragma unroll
            for (int i = 0; i < 8; ++i) { ag[i] = fmaf(hv, g[64 * i], ag[i]); au[i] = fmaf(hv, u[64 * i], au[i]); } }
#pragma unroll
        for (int i = 0; i < 8; ++i) arow[64 * i + lane] = siluf(ag[i]) * au[i];
        __builtin_amdgcn_s_waitcnt(0);
        float acc[16];
#pragma unroll
        for (int i = 0; i < 16; ++i) acc[i] = 0.f;
        for (int j = 0; j < DEXP; ++j) { const float a = arow[j]; const float* wr = Wd + (size_t)j * D + lane;
#pragma unroll
            for (int i = 0; i < 16; ++i) acc[i] = fmaf(a, wr[64 * i], acc[i]); }
#pragma unroll
        for (int i = 0; i < 16; ++i) Y[(size_t)it * D + 64 * i + lane] = f2bf(wgt * acc[i]);
        __builtin_amdgcn_s_waitcnt(0);
    }
}

__device__ __forceinline__ void p9_final(const Params& p) { PHASE_IDS;
    const int lane = tidx & 63;
    const float* MOD = (const float*)(p.ws + WS_MOD);
    const bf16_t* Y = (const bf16_t*)(p.ws + WS_Y);
    for (int r = GW; r < NL; r += NGW) {
        const RowInfo ri = row_info(r);
        float* xr = p.out + (size_t)r * D;
        f32x4 v[4]; float ss = 0.f;
#pragma unroll
        for (int j = 0; j < 4; ++j) {
            const int col = 4 * lane + 256 * j;
            v[j] = *(const f32x4*)(xr + col);
            const f32x4 g2 = *(const f32x4*)(MOD + ((size_t)(DEPTH - 1) * 9 + ri.bidx) * 6144 + 5 * D + col);
            const bf16_t* y0 = Y + (size_t)(2 * r) * D + col; const bf16_t* y1 = y0 + D;
#pragma unroll
            for (int e = 0; e < 4; ++e) v[j][e] += g2[e] * (bf2f(y0[e]) + bf2f(y1[e]));
            ss += v[j][0] * v[j][0] + v[j][1] * v[j][1] + v[j][2] * v[j][2] + v[j][3] * v[j][3];
        }
        const float rstd = rsqrtf(wave_sum(ss) * (1.f / D) + EPS);
#pragma unroll
        for (int j = 0; j < 4; ++j) { const int col = 4 * lane + 256 * j; const f32x4 nw = *(const f32x4*)(p.final_norm + col); f32x4 o;
#pragma unroll
            for (int e = 0; e < 4; ++e) o[e] = v[j][e] * rstd * nw[e];
            *(f32x4*)(xr + col) = o; }
    }
}

namespace pg8 {
#define PG8_LAS __attribute__((address_space(3)))
typedef short bf16x8 __attribute__((ext_vector_type(8)));
typedef unsigned u32x4 __attribute__((ext_vector_type(4)));
typedef unsigned u32x2 __attribute__((ext_vector_type(2)));
constexpr int BM = 256, BK = 64, HALF = 128, HTB = HALF * BK * 2, STAGE_BYTES = 8 * HTB;
__host__ __device__ __forceinline__ int lds_byte(int r, int c) { const int st = (r >> 4) * 2 + (c >> 5), rr = r & 15, cc = c & 31, ob = rr * 64 + cc * 2; return st * 1024 + (ob ^ (((ob >> 9) & 1) << 5)); }
__host__ __device__ __forceinline__ void stage_rc(int b, int& R, int& C) { const int st = b / 1024, sb = b % 1024, swz = sb ^ (((sb >> 9) & 1) << 5); R = (st >> 1) * 16 + swz / 64; C = (st & 1) * 32 + (swz % 64) / 2; }
__host__ __device__ __forceinline__ int perm32(int rho) { const int n = rho >> 4, i = rho & 15; return 8 * (i >> 2) + 4 * n + (i & 3); }
__device__ __forceinline__ unsigned cvt_pk_bf16(float lo, float hi) { unsigned r; asm volatile("v_cvt_pk_bf16_f32 %0, %1, %2" : "=v"(r) : "v"(lo), "v"(hi)); return r; }

struct Unit { int pm, pn; unsigned a_off, b_off; int e, cnt; };

template <class Epi, class Sched>
__device__ __forceinline__ void gemm_phase(PG8_LAS unsigned char* lds, const bf16_t* A, const bf16_t* Bt, const int K, const Sched& S, const Epi& E) {
    const int tid = otid(), wid = __builtin_amdgcn_readfirstlane(tid >> 6), lane = tid & 63, wr = wid >> 2, wc = wid & 3, fr = lane & 15, fq = lane >> 4;
    const int nt = K / BK;
    int Ra[2]; unsigned Ca2[2], voffB[2];
#pragma unroll
    for (int i = 0; i < 2; ++i) { int R, C; stage_rc(tid * 16 + i * 8192, R, C); const int Rb = (R & ~31) + perm32(R & 31); Ra[i] = R; Ca2[i] = (unsigned)C * 2u; voffB[i] = (unsigned)(Rb * K + C) * 2u; }
    const size_t kstep = (size_t)(BK * 2);
    const size_t hstep = (size_t)HALF * K * 2;
    const unsigned ldsw = (unsigned)wid * 1024u;
    const int aoff = lds_byte(wr * 64 + fr, fq * 8), boff = lds_byte(wc * 32 + fr, fq * 8);
#define PG8_SA(b, h) (((b) * 2 + (h)) * HTB)
#define PG8_SB(b, h) ((4 + (b) * 2 + (h)) * HTB)
#define PG8_STAGE_B(bufoff, gbase) do { _Pragma("unroll") for (int _i = 0; _i < 2; ++_i) \
        __builtin_amdgcn_global_load_lds((const unsigned*)((const char*)(gbase) + voffB[_i]), (PG8_LAS unsigned*)(lds + (bufoff) + ldsw + _i * 8192), 16, 0, 0); } while (0)
#define PG8_STAGE_A(bufoff, kbyte, offs) do { _Pragma("unroll") for (int _i = 0; _i < 2; ++_i) \
        __builtin_amdgcn_global_load_lds((const unsigned*)(Ab + (size_t)(offs)[_i] + (size_t)(kbyte)), (PG8_LAS unsigned*)(lds + (bufoff) + ldsw + _i * 8192), 16, 0, 0); } while (0)
#define PG8_LDA(dst, b, h) do { _Pragma("unroll") for (int m = 0; m < 4; ++m) _Pragma("unroll") for (int k = 0; k < 2; ++k) dst[m][k] = *(const PG8_LAS bf16x8*)(lds + PG8_SA(b, h) + aoff + m * 2048 + k * 1024); } while (0)
#define PG8_LDB(dst, b, h) do { _Pragma("unroll") for (int n = 0; n < 2; ++n) _Pragma("unroll") for (int k = 0; k < 2; ++k) dst[n][k] = *(const PG8_LAS bf16x8*)(lds + PG8_SB(b, h) + boff + n * 2048 + k * 1024); } while (0)
#define PG8_MMA(ai, bj, At, Bt_) do { __builtin_amdgcn_s_setprio(1); _Pragma("unroll") for (int m = 0; m < 4; ++m) _Pragma("unroll") for (int n = 0; n < 2; ++n) _Pragma("unroll") for (int k = 0; k < 2; ++k) \
        acc[ai][bj][m][n] = __builtin_amdgcn_mfma_f32_16x16x32_bf16(Bt_[n][k], At[m][k], acc[ai][bj][m][n], 0, 0, 0); __builtin_amdgcn_s_setprio(0); } while (0)
#define PG8_WAIT_V(n) asm volatile("s_waitcnt vmcnt(" #n ")" ::: "memory")
#define PG8_WAIT_L(n) asm volatile("s_waitcnt lgkmcnt(" #n ")" ::: "memory")
#define PG8_BAR __builtin_amdgcn_s_barrier()
#define PG8_SCHED __builtin_amdgcn_sched_barrier(0)
    Unit cur, nxt; int ui = 0;
    if (!S.next(0, cur)) return;
    f32x4 acc[2][2][4][2];
#pragma unroll
    for (int a = 0; a < 2; ++a)
#pragma unroll
        for (int b = 0; b < 2; ++b)
#pragma unroll
            for (int m = 0; m < 4; ++m)
#pragma unroll
                for (int n = 0; n < 2; ++n) acc[a][b][m][n] = (f32x4){0.f, 0.f, 0.f, 0.f};
    bf16x8 At[4][2], B0[2][2], B1[2][2];
    const char* Ab = (const char*)A;
    unsigned ga0[2], ga1[2], gn0[2], gn1[2];
#pragma unroll
    for (int i = 0; i < 2; ++i) { ga0[i] = S.a_row_off(cur, Ra[i], K) + Ca2[i]; ga1[i] = S.a_row_off(cur, HALF + Ra[i], K) + Ca2[i]; }
    const char* cB = (const char*)Bt + cur.b_off;
    PG8_STAGE_B(PG8_SB(0, 0), cB); PG8_STAGE_B(PG8_SB(0, 1), cB + hstep); PG8_STAGE_A(PG8_SA(0, 0), 0, ga0); PG8_STAGE_A(PG8_SA(0, 1), 0, ga1);
    if (wr == 1) PG8_BAR;
    PG8_WAIT_V(2); PG8_BAR;
    PG8_STAGE_B(PG8_SB(1, 0), cB + kstep); PG8_STAGE_A(PG8_SA(1, 0), kstep, ga0); PG8_STAGE_B(PG8_SB(1, 1), cB + hstep + kstep);
    PG8_WAIT_V(6); PG8_BAR;
    for (;;) {
        const bool has_next = S.next(ui + 1, nxt);
        if (has_next) {
#pragma unroll
            for (int i = 0; i < 2; ++i) { gn0[i] = S.a_row_off(nxt, Ra[i], K) + Ca2[i]; gn1[i] = S.a_row_off(nxt, HALF + Ra[i], K) + Ca2[i]; }
        } else {
#pragma unroll
            for (int i = 0; i < 2; ++i) { gn0[i] = ga0[i]; gn1[i] = ga1[i]; }
        }
        const char* nB = has_next ? (const char*)Bt + nxt.b_off : cB;
        for (int t = 0; t < nt; t += 2) {
            const bool last = (t == nt - 2);
            const size_t k1 = (size_t)(t + 1) * kstep;
            unsigned o20[2], o21[2];
#pragma unroll
            for (int i = 0; i < 2; ++i) { o20[i] = last ? gn0[i] : ga0[i]; o21[i] = last ? gn1[i] : ga1[i]; }
            const size_t k2 = last ? 0 : (size_t)(t + 2) * kstep, k3 = k2 + kstep;
            const char* b2 = last ? nB : cB + (size_t)(t + 2) * kstep; const char* b3 = b2 + kstep;
            PG8_LDB(B0, 0, 0); PG8_LDB(B1, 0, 1); PG8_SCHED; PG8_LDA(At, 0, 0); PG8_STAGE_A(PG8_SA(1, 1), k1, ga1);
            PG8_WAIT_V(8); PG8_WAIT_L(0); PG8_BAR; PG8_MMA(0, 0, At, B0); PG8_MMA(0, 1, At, B1); PG8_BAR; PG8_SCHED;
            PG8_LDA(At, 0, 1); PG8_STAGE_B(PG8_SB(0, 0), b2); PG8_STAGE_B(PG8_SB(0, 1), b2 + hstep); PG8_STAGE_A(PG8_SA(0, 0), k2, o20);
            PG8_WAIT_V(8); PG8_WAIT_L(0); PG8_BAR; PG8_MMA(1, 0, At, B0); PG8_MMA(1, 1, At, B1); PG8_BAR; PG8_SCHED;
            PG8_LDB(B0, 1, 0); PG8_LDB(B1, 1, 1); PG8_SCHED; PG8_LDA(At, 1, 0); PG8_STAGE_A(PG8_SA(0, 1), k2, o21);
            PG8_WAIT_V(8); PG8_WAIT_L(0); PG8_BAR; PG8_MMA(0, 0, At, B0); PG8_MMA(0, 1, At, B1); PG8_BAR; PG8_SCHED;
            PG8_LDA(At, 1, 1); PG8_STAGE_B(PG8_SB(1, 0), b3); PG8_STAGE_B(PG8_SB(1, 1), b3 + hstep); PG8_STAGE_A(PG8_SA(1, 0), k3, o20);
            PG8_WAIT_V(8); PG8_WAIT_L(0); PG8_BAR; PG8_MMA(1, 0, At, B0); PG8_MMA(1, 1, At, B1); PG8_BAR; PG8_SCHED;
        }
        if (wr == 0) PG8_BAR;
        E(acc, cur, wr, wc, fr, fq);
        if (!has_next) break;
#pragma unroll
        for (int a = 0; a < 2; ++a)
#pragma unroll
            for (int b = 0; b < 2; ++b)
#pragma unroll
                for (int m = 0; m < 4; ++m)
#pragma unroll
                    for (int n = 0; n < 2; ++n) acc[a][b][m][n] = (f32x4){0.f, 0.f, 0.f, 0.f};
        cur = nxt; cB = nB; ++ui;
#pragma unroll
        for (int i = 0; i < 2; ++i) { ga0[i] = gn0[i]; ga1[i] = gn1[i]; }
        if (wr == 1) PG8_BAR;
    }
    PG8_WAIT_V(0);
    PG8_BAR;
#undef PG8_SA
#undef PG8_SB
#undef PG8_STAGE_A
#undef PG8_STAGE_B
#undef PG8_LDA
#undef PG8_LDB
#undef PG8_MMA
#undef PG8_WAIT_V
#undef PG8_WAIT_L
#undef PG8_BAR
#undef PG8_SCHED
}

struct PlainOrder {
    int nM, nN, nwg, G, c;
    __device__ void init(int M, int N, int G_, int c_) { nM = M / BM; nN = N / BM; nwg = nM * nN; G = G_; c = c_; }
    __device__ __forceinline__ bool next(int i, Unit& u) const {
        const int L = i * G + c; if (L >= nwg) return false;
        int wgid = L; { const int q = nwg / 8, r = nwg % 8, xcd = wgid % 8, off = wgid / 8; wgid = (xcd < r ? xcd * (q + 1) : r * (q + 1) + (xcd - r) * q) + off; }
        const int nig = 8 * nN, gid = wgid / nig, fm = gid * 8, gsz = (nM - fm) < 8 ? (nM - fm) : 8;
        u.pm = fm + ((wgid % nig) % gsz); u.pn = (wgid % nig) / gsz; u.a_off = 0; u.b_off = 0; u.e = 0; u.cnt = 256; return true;
    }
    __device__ __forceinline__ unsigned a_row_off(const Unit& u, int rl, int K) const { return (unsigned)((u.pm * BM + rl) * K) * 2u; }
};
}
struct PlainSched {
    pg8::PlainOrder o; int K;
    __device__ __forceinline__ bool next(int i, pg8::Unit& u) const { if (!o.next(i, u)) return false; u.b_off = (unsigned)(u.pn * 256 * K) * 2u; return true; }
    __device__ __forceinline__ unsigned a_row_off(const pg8::Unit& u, int rl, int K_) const { return o.a_row_off(u, rl, K_); }
};

struct EpiOutProj {
    const float* xs_lat; const float* xs_ctx; float* xd_lat; float* xd_ctx; const float* g1;
    __device__ __forceinline__ void operator()(const f32x4 (&acc)[2][2][4][2], const pg8::Unit& u, int wr, int wc, int fr, int fq) const {
        const int row0 = u.pm * 256 + wr * 64 + fr, col0 = u.pn * 256 + wc * 32 + 8 * fq;
        const bool isctx = u.pm >= 64; const int bidx = isctx ? 8 : (u.pm >> 3);
        const float* xs = isctx ? xs_ctx - (size_t)NL * D : xs_lat; float* xd = isctx ? xd_ctx - (size_t)NL * D : xd_lat;
        f32x4 g[2][2];
#pragma unroll
        for (int bj = 0; bj < 2; ++bj)
#pragma unroll
            for (int n = 0; n < 2; ++n) g[bj][n] = *(const f32x4*)(g1 + (size_t)bidx * 6144 + col0 + bj * 128 + 4 * n);
#pragma unroll
        for (int ai = 0; ai < 2; ++ai)
#pragma unroll
            for (int m = 0; m < 4; ++m) {
                const size_t ro = (size_t)(row0 + ai * 128 + m * 16) * D + col0;
#pragma unroll
                for (int bj = 0; bj < 2; ++bj)
#pragma unroll
                    for (int n = 0; n < 2; ++n) { const f32x4 xv = *(const f32x4*)(xs + ro + bj * 128 + 4 * n); *(f32x4*)(xd + ro + bj * 128 + 4 * n) = xv + g[bj][n] * acc[ai][bj][m][n]; }
            }
    }
};
__device__ __forceinline__ void p5_outproj_fast(const Params& p, int l, unsigned char* lds_raw) { PHASE_IDS;
    PlainSched S; S.K = D; S.o.init(l == 0 ? NTOK : NL, D, gridDim.x, bidx_);
    EpiOutProj E{l == 0 ? p.x : p.out, l == 0 ? p.ctx : (const float*)(p.ws + WS_XC), p.out, (float*)(p.ws + WS_XC), (const float*)(p.ws + WS_MOD) + (size_t)l * 9 * 6144 + 2 * D};
    pg8::gemm_phase((PG8_LAS unsigned char*)lds_raw, (const bf16_t*)(p.ws + WS_HB), (const bf16_t*)(p.ws + WS_WOUT) + (size_t)l * D * D, D, S, E);
}

#define PIN_ACC(acc) do { _Pragma("unroll") for (int a_ = 0; a_ < 2; ++a_) _Pragma("unroll") for (int b_ = 0; b_ < 2; ++b_) _Pragma("unroll") for (int m_ = 0; m_ < 4; ++m_) \
    asm volatile("" : "+v"(acc[a_][b_][m_][0]), "+v"(acc[a_][b_][m_][1])); } while (0)
struct EpiInProj {
    struct { unsigned char* ws; const float* q_norm; const float* k_norm; } p; int l;
    __device__ __forceinline__ void operator()(f32x4 (&acc)[2][2][4][2], const pg8::Unit& u, int wr, int wc, int fr, int fq) const {
        const int T = u.pn;
        const bool isctx = u.pm >= 64; const int b = isctx ? u.pm - 64 : (u.pm >> 3); const int t0 = (isctx ? 0 : (u.pm & 7) * 256) + wr * 64 + fr;
        const int row0 = u.pm * 256 + wr * 64 + fr;
        if (T <= 1) {
            bf16_t* dst; int ld;
            if (!isctx) { dst = (bf16_t*)(p.ws + WS_YFTL) + ((size_t)b * 256 * 2 + T) * SEQ; ld = SEQ; } else { dst = (bf16_t*)(p.ws + WS_YFTC) + ((size_t)b * 256 * 2 + T) * CTXL; ld = CTXL; }
            unsigned eo = (unsigned)((64 * wc + 8 * fq) * 2 * ld + t0);
#pragma unroll
            for (int bj = 0; bj < 2; ++bj)
#pragma unroll
                for (int n = 0; n < 2; ++n)
#pragma unroll
                    for (int e = 0; e < 4; ++e) { bf16_t* cp = dst + eo;
#pragma unroll
                        for (int ai = 0; ai < 2; ++ai)
#pragma unroll
                            for (int m = 0; m < 4; ++m) cp[ai * 128 + m * 16] = f2bf(acc[ai][bj][m][n][e]);
                        eo += (unsigned)(((n == 1 && e == 3) ? 25 : 1) * 2 * ld); asm volatile("" : "+v"(eo) :: "memory"); }
        } else if (T <= 4 || T == 8) {
            bf16_t* dst; int ld; float sc = 1.f;
            if (T == 2) { dst = (bf16_t*)(p.ws + WS_GQK); ld = 256; if (wc < 2) sc = 0.17677669529663687f; }
            else if (T == 3) { dst = (bf16_t*)(p.ws + WS_GV); ld = 256; } else if (T == 4) { dst = (bf16_t*)(p.ws + WS_GG); ld = 256; } else { dst = (bf16_t*)(p.ws + WS_GD); ld = 32; }
            if (T != 8 || wc == 0) {
#pragma unroll
                for (int ai = 0; ai < 2; ++ai)
#pragma unroll
                    for (int m = 0; m < 4; ++m) { const size_t r = row0 + ai * 128 + m * 16;
#pragma unroll
                        for (int bj = 0; bj < 2; ++bj) { if (T == 8 && bj == 1) continue;
                            const f32x4 v0 = acc[ai][bj][m][0] * sc, v1 = acc[ai][bj][m][1] * sc;
                            pg8::u32x4 w; w.x = pg8::cvt_pk_bf16(v0[0], v0[1]); w.y = pg8::cvt_pk_bf16(v0[2], v0[3]); w.z = pg8::cvt_pk_bf16(v1[0], v1[1]); w.w = pg8::cvt_pk_bf16(v1[2], v1[3]);
                            *(pg8::u32x4*)(dst + r * ld + 64 * wc + 32 * bj + 8 * fq) = w; } }
            }
        } else if (T == 7 && wc >= 2) {
            bf16_t* dst = (bf16_t*)(p.ws + WS_AVT) + ((size_t)(b * 2 + (wc - 2)) * 64) * KEYS + (isctx ? 0 : CTXL);
            unsigned eo = (unsigned)(8 * fq * KEYS + t0);
#pragma unroll
            for (int bj = 0; bj < 2; ++bj)
#pragma unroll
                for (int n = 0; n < 2; ++n)
#pragma unroll
                    for (int e = 0; e < 4; ++e) { bf16_t* cp = dst + eo;
#pragma unroll
                        for (int ai = 0; ai < 2; ++ai)
#pragma unroll
                            for (int m = 0; m < 4; ++m) cp[ai * 128 + m * 16] = f2bf(acc[ai][bj][m][n][e]);
                        eo += (unsigned)(((n == 1 && e == 3) ? 25 : 1) * KEYS); asm volatile("" : "+v"(eo) :: "memory"); }
        } else {
            const bool isq = T != 7;
            const float* nw = isq ? p.q_norm : p.k_norm;
            f32x4 w4[2][2];
#pragma unroll
            for (int bj = 0; bj < 2; ++bj)
#pragma unroll
                for (int n = 0; n < 2; ++n) w4[bj][n] = *(const f32x4*)(nw + 32 * bj + 8 * fq + 4 * n);
            const float osc = isq ? QSCALE : 1.f;
            const float* ROPE = (const float*)(p.ws + WS_TAB) + 2048;
            const int half = fq >> 1;
            const int rbase = row0 - t0;
            int t = t0;
#pragma unroll
            for (int ai = 0; ai < 2; ++ai)
#pragma unroll
                for (int m = 0; m < 4; ++m) {
                    float ss = 0.f;
#pragma unroll
                    for (int bj = 0; bj < 2; ++bj)
#pragma unroll
                        for (int n = 0; n < 2; ++n) { const f32x4 v = acc[ai][bj][m][n]; ss += v[0] * v[0] + v[1] * v[1] + v[2] * v[2] + v[3] * v[3]; }
                    ss += __shfl_xor(ss, 16); ss += __shfl_xor(ss, 32);
                    const float rs = rsqrtf(ss * (1.f / 64.f) + EPS);
                    bf16_t* dst = isq ? (bf16_t*)(p.ws + WS_AQ) + (size_t)(rbase + t) * 512 + ((T - 5) * 4 + wc) * 64
                                      : (bf16_t*)(p.ws + WS_AK) + ((size_t)b * KEYS + (isctx ? 0 : CTXL) + t) * 128 + wc * 64;
#pragma unroll
                    for (int bj = 0; bj < 2; ++bj) {
                        f32x4 o[2];
#pragma unroll
                        for (int n = 0; n < 2; ++n) {
                            const f32x4 xv = acc[ai][bj][m][n] * rs * w4[bj][n];
                            if (!isctx) {
                                const int pos = bj == 0 ? (t >> 6) : (t & 63);
                                const f32x4* rp = (const f32x4*)(ROPE + 2 * (pos * 16 + 8 * (fq & 1) + 4 * n));
                                const f32x4 cs01 = rp[0], cs23 = rp[1];
                                f32x4 xp;
#pragma unroll
                                for (int e = 0; e < 4; ++e) xp[e] = __shfl_xor(xv[e], 32);
                                const float sg = half == 0 ? -1.f : 1.f;
                                o[n][0] = xv[0] * cs01[0] + sg * xp[0] * cs01[1]; o[n][1] = xv[1] * cs01[2] + sg * xp[1] * cs01[3];
                                o[n][2] = xv[2] * cs23[0] + sg * xp[2] * cs23[1]; o[n][3] = xv[3] * cs23[2] + sg * xp[3] * cs23[3];
                            } else o[n] = xv;
                            o[n] = o[n] * osc;
                        }
                        pg8::u32x4 w; w.x = pg8::cvt_pk_bf16(o[0][0], o[0][1]); w.y = pg8::cvt_pk_bf16(o[0][2], o[0][3]); w.z = pg8::cvt_pk_bf16(o[1][0], o[1][1]); w.w = pg8::cvt_pk_bf16(o[1][2], o[1][3]);
                        *(pg8::u32x4*)(dst + 32 * bj + 8 * fq) = w;
                    }
                    t += (m == 3) ? 80 : 16; asm volatile("" : "+v"(t) :: "memory");
                }
        }
    }
};
__device__ __forceinline__ void p2_inproj_fast(const Params& p, int l, unsigned char* lds_raw) { PHASE_IDS;
    PlainSched S; S.K = D; S.o.init(NTOK, NIN, gridDim.x, bidx_);
    EpiInProj E{{p.ws, p.q_norm + l * 64, p.k_norm + l * 64}, l};
    pg8::gemm_phase((PG8_LAS unsigned char*)lds_raw, (const bf16_t*)(p.ws + WS_HB), (const bf16_t*)(p.ws + WS_WIN) + (size_t)l * NIN * D, D, S, E);
}

struct MoeSched {
    const int* list; const int* tab;
    int G, c, total; bool down;
    __device__ __forceinline__ bool next(int i, pg8::Unit& u) const {
        const int L = i * G + c; if (L >= total) return false;
        int e = 0;
#pragma unroll
        for (int q = 1; q < NEXP; ++q) if (L >= tab[q]) e = q;
        e = __builtin_amdgcn_readfirstlane(e);
        const int us = tab[e], sg = tab[17 + e], cn = tab[33 + e];
        const int rem = L - us, mtile = rem >> 2, pn = rem & 3;
        u.pm = mtile; u.pn = pn; u.e = e; u.cnt = __builtin_amdgcn_readfirstlane(cn - mtile * 256); u.a_off = (unsigned)__builtin_amdgcn_readfirstlane(sg + mtile * 256);
        u.b_off = down ? (unsigned)((e * 1024 + pn * 256) * DEXP) * 2u : (unsigned)((e * 1024 + pn * 256) * D) * 2u;
        return true;
    }
    __device__ __forceinline__ unsigned a_row_off(const pg8::Unit& u, int rl, int K) const {
        if (down) return (unsigned)((u.a_off + rl) * K) * 2u;
        const int idx = u.pm * 256 + (rl < u.cnt ? rl : u.cnt - 1);
        const int pair = list[u.e * NTOK + idx];
        return (unsigned)((pair >> 1) * K) * 2u;
    }
};
__device__ __forceinline__ int moe_tables(const unsigned* ctl, int l, int* tab, int tidx) {
    if (tidx == 0) { int u = 0, sgm = 0;
        for (int e = 0; e < NEXP; ++e) { const int n = (int)__hip_atomic_load(ctl + CW_CNT + (l * NEXP + e) * 64, __ATOMIC_RELAXED, __HIP_MEMORY_SCOPE_AGENT); const int mt = (n + 255) >> 8; tab[e] = u; tab[17 + e] = sgm; tab[33 + e] = n; u += mt * 4; sgm += mt * 256; }
        tab[16] = u; }
    __syncthreads();
    return __builtin_amdgcn_readfirstlane(tab[16]);
}
struct EpiGateUp {
    bf16_t* act;
    __device__ __forceinline__ void operator()(f32x4 (&acc)[2][2][4][2], const pg8::Unit& u, int wr, int wc, int fr, int fq) const {
        bf16_t* base = act + (size_t)(u.a_off + wr * 64 + fr) * DEXP + u.pn * 128 + wc * 32 + 8 * fq;
#pragma unroll
        for (int ai = 0; ai < 2; ++ai)
#pragma unroll
            for (int m = 0; m < 4; ++m) {
                f32x4 o[2];
#pragma unroll
                for (int n = 0; n < 2; ++n)
#pragma unroll
                    for (int e = 0; e < 4; ++e) { const float g = acc[ai][0][m][n][e]; o[n][e] = g * __builtin_amdgcn_rcpf(1.f + __expf(-g)) * acc[ai][1][m][n][e]; }
                pg8::u32x4 w; w.x = pg8::cvt_pk_bf16(o[0][0], o[0][1]); w.y = pg8::cvt_pk_bf16(o[0][2], o[0][3]); w.z = pg8::cvt_pk_bf16(o[1][0], o[1][1]); w.w = pg8::cvt_pk_bf16(o[1][2], o[1][3]);
                *(pg8::u32x4*)(base + (size_t)(ai * 128 + m * 16) * DEXP) = w;
            }
    }
};
struct EpiDown {
    bf16_t* Y; const int* list; const f32x4* route;
    __device__ __forceinline__ void operator()(f32x4 (&acc)[2][2][4][2], const pg8::Unit& u, int wr, int wc, int fr, int fq) const {
        int rl = wr * 64 + fr;
        const int col = u.pn * 256 + wc * 32 + 8 * fq;
#pragma unroll
        for (int ai = 0; ai < 2; ++ai)
#pragma unroll
            for (int m = 0; m < 4; ++m) {
                if (rl < u.cnt) {
                    const int pair = list[u.e * NTOK + u.pm * 256 + rl];
                    const float w = ((const float*)(route + (pair >> 1)))[2 + (pair & 1)];
                    bf16_t* dst = Y + (size_t)pair * D + col;
#pragma unroll
                    for (int bj = 0; bj < 2; ++bj) { const f32x4 v0 = acc[ai][bj][m][0] * w, v1 = acc[ai][bj][m][1] * w;
                        pg8::u32x4 o; o.x = pg8::cvt_pk_bf16(v0[0], v0[1]); o.y = pg8::cvt_pk_bf16(v0[2], v0[3]); o.z = pg8::cvt_pk_bf16(v1[0], v1[1]); o.w = pg8::cvt_pk_bf16(v1[2], v1[3]);
                        *(pg8::u32x4*)(dst + bj * 128) = o; }
                }
                rl += (m == 3) ? 80 : 16; asm volatile("" : "+v"(rl) :: "memory");
            }
    }
};
__device__ __forceinline__ void p7_gateup_fast(const Params& p, int l, unsigned char* lds_raw) { PHASE_IDS;
    int* tab = (int*)(lds_raw + pg8::STAGE_BYTES + 1024);
    MoeSched S; S.list = (const int*)(p.ws + WS_LIST) + (size_t)l * NEXP * NTOK; S.tab = tab; S.G = gridDim.x; S.c = bidx_; S.down = false; S.total = moe_tables((const unsigned*)(p.ws + WS_CTL), l, tab, tidx);
    EpiGateUp E{(bf16_t*)(p.ws + WS_ACT)};
    pg8::gemm_phase((PG8_LAS unsigned char*)lds_raw, (const bf16_t*)(p.ws + WS_HB), (const bf16_t*)(p.ws + WS_WGU), D, S, E);
}
__device__ __forceinline__ void p8_down_fast(const Params& p, int l, unsigned char* lds_raw) { PHASE_IDS;
    int* tab = (int*)(lds_raw + pg8::STAGE_BYTES + 1024);
    MoeSched S; S.list = (const int*)(p.ws + WS_LIST) + (size_t)l * NEXP * NTOK; S.tab = tab; S.G = gridDim.x; S.c = bidx_; S.down = true; S.total = moe_tables((const unsigned*)(p.ws + WS_CTL), l, tab, tidx);
    EpiDown E{(bf16_t*)(p.ws + WS_Y), (const int*)(p.ws + WS_LIST) + (size_t)l * NEXP * NTOK, (const f32x4*)(p.ws + WS_ROUTE)};
    pg8::gemm_phase((PG8_LAS unsigned char*)lds_raw, (const bf16_t*)(p.ws + WS_ACT), (const bf16_t*)(p.ws + WS_WD), DEXP, S, E);
}

struct FnetSched {
    int mtiles, nunits, G, c;
    __device__ __forceinline__ bool next(int i, pg8::Unit& u) const {
        const int L = i * G + c; if (L >= nunits) return false;
        u.e = L / mtiles; u.pm = L % mtiles; u.pn = 0; u.cnt = 256; u.a_off = 0; u.b_off = 0; return true;
    }
    __device__ __forceinline__ unsigned a_row_off(const pg8::Unit& u, int rl, int K) const { return (unsigned)((u.pm * 256 + rl) * K) * 2u; }
};
struct FnetSchedK { FnetSched s; int K;
    __device__ __forceinline__ bool next(int i, pg8::Unit& u) const { if (!s.next(i, u)) return false; u.b_off = (unsigned)(u.e * 256 * K) * 2u; return true; }
    __device__ __forceinline__ unsigned a_row_off(const pg8::Unit& u, int rl, int K_) const { return s.a_row_off(u, rl, K_); }
};
struct EpiFnet {
    bf16_t* mix; int row0, rows_per_b; float scale;
    __device__ __forceinline__ void operator()(f32x4 (&acc)[2][2][4][2], const pg8::Unit& u, int wr, int wc, int fr, int fq) const {
        bf16_t* base = mix + (size_t)(row0 + u.e * rows_per_b + u.pm * 256 + wr * 64 + fr) * D + wc * 32 + 8 * fq;
#pragma unroll
        for (int ai = 0; ai < 2; ++ai)
#pragma unroll
            for (int m = 0; m < 4; ++m)
#pragma unroll
                for (int bj = 0; bj < 2; ++bj) { const f32x4 v0 = acc[ai][bj][m][0] * scale, v1 = acc[ai][bj][m][1] * scale;
                    pg8::u32x4 o; o.x = pg8::cvt_pk_bf16(v0[0], v0[1]); o.y = pg8::cvt_pk_bf16(v0[2], v0[3]); o.z = pg8::cvt_pk_bf16(v1[0], v1[1]); o.w = pg8::cvt_pk_bf16(v1[2], v1[3]);
                    *(pg8::u32x4*)(base + (size_t)(ai * 128 + m * 16) * D + bj * 128) = o; }
    }
};
__device__ __forceinline__ void p3_fnet_fast(const Params& p, int l, unsigned char* lds_raw) { PHASE_IDS;
    {
        FnetSchedK S; S.s.mtiles = 8; S.s.nunits = 64; S.s.G = gridDim.x; S.s.c = bidx_; S.K = 4096;
        EpiFnet E{(bf16_t*)(p.ws + WS_HB), 0, SEQ, 0.0027621358640099515f};
        pg8::gemm_phase((PG8_LAS unsigned char*)lds_raw, (const bf16_t*)(p.ws + WS_DMAT), (const bf16_t*)(p.ws + WS_YFTL), 4096, S, E);
    }
    if (l == 0) {
        FnetSchedK S; S.s.mtiles = 1; S.s.nunits = 8; S.s.G = gridDim.x; S.s.c = (bidx_ + (int)gridDim.x - 64) % (int)gridDim.x; S.K = 512;
        EpiFnet E{(bf16_t*)(p.ws + WS_HB), NL, CTXL, 0.0078125f};
        pg8::gemm_phase((PG8_LAS unsigned char*)lds_raw, (const bf16_t*)(p.ws + WS_DMATC), (const bf16_t*)(p.ws + WS_YFTC), 512, S, E);
    }
}

typedef float f32x16 __attribute__((ext_vector_type(16)));
typedef short s16x4 __attribute__((ext_vector_type(4)));
__device__ __forceinline__ void attn_unit(unsigned char* ws, unsigned char* lds_raw, int b, int h, int qrow0, int nkt, int tid) {
    typedef pg8::bf16x8 bf16x8;
    const int lane = tid & 63, wid = tid >> 6, r32 = lane & 31, hi = lane >> 5, kvh = h >> 2;
    const bf16_t* AQ = (const bf16_t*)(ws + WS_AQ); const bf16_t* AK = (const bf16_t*)(ws + WS_AK); const bf16_t* AVT = (const bf16_t*)(ws + WS_AVT);
    bf16_t* MIX = (bf16_t*)(ws + WS_HB);
    const int srow = tid >> 3, sch = tid & 7;
    const bf16_t* kg = AK + ((size_t)b * KEYS + srow) * 128 + kvh * 64 + sch * 8;
    const bf16_t* vg = AVT + ((size_t)(b * 2 + kvh) * 64 + srow) * KEYS + sch * 8;
    const int kst = srow * 128 + ((sch ^ ((srow >> 1) & 7)) << 4);
    const int vst = srow * 128 + ((sch ^ ((srow >> 2) & 7)) << 4);
    const bool vswap = (srow >> 1) & 1;
    unsigned char* Kb = lds_raw; unsigned char* Vb = lds_raw + 16384;
    const int kx = (r32 >> 1) & 7, vx = (r32 >> 1) & 15;
    const int krd = r32 * 128;
    const int vrd = r32 * 128;
    bf16x8 qf[4];
    { const bf16_t* qp = AQ + (size_t)(qrow0 + wid * 32 + r32) * 512 + h * 64 + hi * 8;
#pragma unroll
      for (int s = 0; s < 4; ++s) qf[s] = *(const bf16x8*)(qp + s * 16); }
    f32x16 o0 = {}, o1 = {};
    float mrow = -1e30f, lrow = 0.f;
    pg8::u32x4 kreg = *(const pg8::u32x4*)kg, vreg = *(const pg8::u32x4*)vg;
    __syncthreads();
    *(pg8::u32x4*)(Kb + kst) = kreg; *(pg8::u32x4*)(Vb + vst) = vswap ? (pg8::u32x4){vreg.z, vreg.w, vreg.x, vreg.y} : vreg;
    __syncthreads();
    for (int t = 0; t < nkt; ++t) {
        const int cur = (t & 1) * 8192;
        if (t + 1 < nkt) { kreg = *(const pg8::u32x4*)(kg + (size_t)(t + 1) * 64 * 128); vreg = *(const pg8::u32x4*)(vg + (t + 1) * 64); }
        f32x16 p0 = {}, p1 = {};
#pragma unroll
        for (int s = 0; s < 4; ++s) {
            const bf16x8 k0 = *(const bf16x8*)(Kb + cur + krd + (((2 * s + hi) ^ kx) << 4));
            const bf16x8 k1 = *(const bf16x8*)(Kb + cur + 4096 + krd + (((2 * s + hi) ^ kx) << 4));
            p0 = __builtin_amdgcn_mfma_f32_32x32x16_bf16(k0, qf[s], p0, 0, 0, 0);
            p1 = __builtin_amdgcn_mfma_f32_32x32x16_bf16(k1, qf[s], p1, 0, 0, 0);
        }
        float mx = p0[0];
#pragma unroll
        for (int r = 1; r < 16; ++r) mx = fmaxf(mx, p0[r]);
#pragma unroll
        for (int r = 0; r < 16; ++r) mx = fmaxf(mx, p1[r]);
        { auto rr = __builtin_amdgcn_permlane32_swap(__float_as_uint(mx), __float_as_uint(mx), false, false); mx = fmaxf(__uint_as_float(rr[0]), __uint_as_float(rr[1])); }
        const float mn = fmaxf(mrow, mx), alpha = __builtin_amdgcn_exp2f(mrow - mn);
        mrow = mn;
        float sum = 0.f;
#pragma unroll
        for (int r = 0; r < 16; ++r) { p0[r] = __builtin_amdgcn_exp2f(p0[r] - mn); sum += p0[r]; }
#pragma unroll
        for (int r = 0; r < 16; ++r) { p1[r] = __builtin_amdgcn_exp2f(p1[r] - mn); sum += p1[r]; }
        lrow = lrow * alpha + sum;
#pragma unroll
        for (int r = 0; r < 16; ++r) { o0[r] *= alpha; o1[r] *= alpha; }
        bf16x8 pf[4];
#pragma unroll
        for (int s = 0; s < 2; ++s) {
            pg8::u32x4 w0, w1;
            w0.x = pg8::cvt_pk_bf16(p0[8 * s + 0], p0[8 * s + 1]); w0.y = pg8::cvt_pk_bf16(p0[8 * s + 2], p0[8 * s + 3]); w0.z = pg8::cvt_pk_bf16(p0[8 * s + 4], p0[8 * s + 5]); w0.w = pg8::cvt_pk_bf16(p0[8 * s + 6], p0[8 * s + 7]);
            w1.x = pg8::cvt_pk_bf16(p1[8 * s + 0], p1[8 * s + 1]); w1.y = pg8::cvt_pk_bf16(p1[8 * s + 2], p1[8 * s + 3]); w1.z = pg8::cvt_pk_bf16(p1[8 * s + 4], p1[8 * s + 5]); w1.w = pg8::cvt_pk_bf16(p1[8 * s + 6], p1[8 * s + 7]);
            pf[s] = __builtin_bit_cast(bf16x8, w0); pf[2 + s] = __builtin_bit_cast(bf16x8, w1);
        }
#pragma unroll
        for (int ks = 0; ks < 4; ++ks) {
            const s16x4 a0 = *(const s16x4*)(Vb + cur + vrd + (((4 * ks + hi) ^ vx) << 3));
            const s16x4 a1 = *(const s16x4*)(Vb + cur + vrd + (((4 * ks + 2 + hi) ^ vx) << 3));
            const s16x4 c0 = *(const s16x4*)(Vb + cur + 4096 + vrd + (((4 * ks + hi) ^ vx) << 3));
            const s16x4 c1 = *(const s16x4*)(Vb + cur + 4096 + vrd + (((4 * ks + 2 + hi) ^ vx) << 3));
            const bf16x8 va = {a0[0], a0[1], a0[2], a0[3], a1[0], a1[1], a1[2], a1[3]};
            const bf16x8 vc = {c0[0], c0[1], c0[2], c0[3], c1[0], c1[1], c1[2], c1[3]};
            o0 = __builtin_amdgcn_mfma_f32_32x32x16_bf16(va, pf[ks], o0, 0, 0, 0);
            o1 = __builtin_amdgcn_mfma_f32_32x32x16_bf16(vc, pf[ks], o1, 0, 0, 0);
        }
        if (t + 1 < nkt) { const int nx = 8192 - cur; *(pg8::u32x4*)(Kb + nx + kst) = kreg; *(pg8::u32x4*)(Vb + nx + vst) = vswap ? (pg8::u32x4){vreg.z, vreg.w, vreg.x, vreg.y} : vreg; }
        __syncthreads();
    }
    { auto rr = __builtin_amdgcn_permlane32_swap(__float_as_uint(lrow), __float_as_uint(lrow), false, false); lrow = __uint_as_float(rr[0]) + __uint_as_float(rr[1]); }
    const float inv = 1.f / lrow;
    bf16_t* op = MIX + (size_t)(qrow0 + wid * 32 + r32) * D + 512 + h * 64 + 4 * hi;
#pragma unroll
    for (int g = 0; g < 4; ++g) {
        pg8::u32x2 w0, w1;
        w0.x = pg8::cvt_pk_bf16(o0[4 * g] * inv, o0[4 * g + 1] * inv); w0.y = pg8::cvt_pk_bf16(o0[4 * g + 2] * inv, o0[4 * g + 3] * inv);
        w1.x = pg8::cvt_pk_bf16(o1[4 * g] * inv, o1[4 * g + 1] * inv); w1.y = pg8::cvt_pk_bf16(o1[4 * g + 2] * inv, o1[4 * g + 3] * inv);
        *(pg8::u32x2*)(op + 8 * g) = w0; *(pg8::u32x2*)(op + 32 + 8 * g) = w1;
    }
}
__device__ __forceinline__ void p3_attn_fast(const Params& p, int l, unsigned char* lds_raw) { PHASE_IDS;
    const int G = gridDim.x;
    const int skip = G >= 128 ? 64 : 0, Ga = G - skip;
    if (bidx_ >= skip)
        for (int u = bidx_ - skip; u < BATCH * 8 * 8; u += Ga) { const int qb = u & 7, h = (u >> 3) & 7, b = u >> 6; attn_unit(p.ws, lds_raw, b, h, b * SEQ + qb * 256, KEYS / 64, tidx); }
    if (l == 0) for (int u = bidx_; u < BATCH * 8; u += G) { const int h = u & 7, b = u >> 3; attn_unit(p.ws, lds_raw, b, h, NL + b * CTXL, CTXL / 64, tidx); }
}

struct GlaPrep { float cum[16], tot[16], q[16], k[16]; };
__device__ __forceinline__ void gla_prep(GlaPrep& g, const Params& p, int l, int row0, int h, int w4, int lane) {
    const int dir = w4 >> 1, kh = w4 & 1, row = row0 + lane;
    const bf16_t* GD = (const bf16_t*)(p.ws + WS_GD); const bf16_t* GQK = (const bf16_t*)(p.ws + WS_GQK);
    float gd[16];
    { const pg8::u32x4 a = *(const pg8::u32x4*)(GD + (size_t)row * 32 + dir * 16), c = *(const pg8::u32x4*)(GD + (size_t)row * 32 + dir * 16 + 8);
      const unsigned w[8] = {a.x, a.y, a.z, a.w, c.x, c.y, c.z, c.w};
#pragma unroll
      for (int i = 0; i < 8; ++i) { gd[2 * i] = __uint_as_float(w[i] << 16); gd[2 * i + 1] = __uint_as_float(w[i] & 0xffff0000u); } }
    const float* wu = p.w_gup + ((size_t)(l * 2 + dir) * 16) * 128 + h * 32 + kh * 16;
    const float* bu = p.b_gg + (l * 2 + dir) * 128 + h * 32 + kh * 16;
#pragma unroll
    for (int kk = 0; kk < 16; ++kk) g.cum[kk] = bu[kk];
#pragma unroll
    for (int r = 0; r < 16; ++r) {
#pragma unroll
        for (int kk = 0; kk < 16; ++kk) g.cum[kk] = fmaf(gd[r], wu[r * 128 + kk], g.cum[kk]);
        asm volatile("" ::: "memory");
    }
#pragma unroll
    for (int kk = 0; kk < 16; ++kk) { const float z = g.cum[kk]; g.cum[kk] = (fminf(z, 0.f) - __logf(1.f + __expf(-fabsf(z)))) * (1.f / 16.f); }
#pragma unroll
    for (int off = 1; off < 64; off <<= 1) {
        const int src = dir == 0 ? lane - off : lane + off; const bool ok = (unsigned)src < 64u;
#pragma unroll
        for (int kk = 0; kk < 16; ++kk) {
            const float y = __shfl(g.cum[kk], src & 63);
            g.cum[kk] += ok ? y : 0.f;
        }
    }
#pragma unroll
    for (int kk = 0; kk < 16; ++kk) g.tot[kk] = __shfl(g.cum[kk], dir == 0 ? 63 : 0);
    { const bf16_t* qp = GQK + (size_t)row * 256 + h * 32 + kh * 16;
      const pg8::u32x4 a = *(const pg8::u32x4*)qp, c = *(const pg8::u32x4*)(qp + 8), e = *(const pg8::u32x4*)(qp + 128), f = *(const pg8::u32x4*)(qp + 136);
      const unsigned wq[8] = {a.x, a.y, a.z, a.w, c.x, c.y, c.z, c.w}, wk[8] = {e.x, e.y, e.z, e.w, f.x, f.y, f.z, f.w};
#pragma unroll
      for (int i = 0; i < 8; ++i) { g.q[2 * i] = __uint_as_float(wq[i] << 16); g.q[2 * i + 1] = __uint_as_float(wq[i] & 0xffff0000u); g.k[2 * i] = __uint_as_float(wk[i] << 16); g.k[2 * i + 1] = __uint_as_float(wk[i] & 0xffff0000u); } }
}
__device__ __forceinline__ void gla_stage_vt(bf16_t* VT, const unsigned char* ws, int row0, int h, int tg) {
    const bf16_t* GV = (const bf16_t*)(ws + WS_GV);
    const int t = tg >> 2, c = tg & 3;
    const pg8::u32x4 a = *(const pg8::u32x4*)(GV + (size_t)(row0 + t) * 256 + h * 64 + 16 * c), b2 = *(const pg8::u32x4*)(GV + (size_t)(row0 + t) * 256 + h * 64 + 16 * c + 8);
    const unsigned w[8] = {a.x, a.y, a.z, a.w, b2.x, b2.y, b2.z, b2.w};
#pragma unroll
    for (int i = 0; i < 8; ++i) { VT[(16 * c + 2 * i) * 72 + t] = (bf16_t)(w[i] & 0xffffu); VT[(16 * c + 2 * i + 1) * 72 + t] = (bf16_t)(w[i] >> 16); }
}
__device__ __forceinline__ int gla_row0(int b, int cs) { return cs < 4 ? NL + b * CTXL + cs * 64 : b * SEQ + (cs - 4) * 64; }

__device__ __forceinline__ void p3_gla_local_fast(const Params& p, int l, unsigned char* lds_raw) { PHASE_IDS;
    typedef pg8::bf16x8 bf16x8;
    const int grp = __builtin_amdgcn_readfirstlane(tidx >> 8), tg = tidx & 255, w4 = __builtin_amdgcn_readfirstlane((tidx >> 6) & 3), lane = tidx & 63;
    bf16_t* KT = (bf16_t*)(lds_raw + grp * 32768);
    bf16_t* VT = KT + 2 * 32 * 72;
    float* AST = (float*)(p.ws + WS_AST); float* DEC = (float*)(p.ws + WS_DEC);
    const int nitems = BATCH * NCHK * 4;
    for (int pi = bidx_; pi * 2 < nitems; pi += gridDim.x) {
        const int it = pi * 2 + grp; const bool valid = it < nitems;
        const int h = it & 3, cs = (it >> 2) % NCHK, b = it / (4 * NCHK);
        const int dir = w4 >> 1, kh = w4 & 1;
        __syncthreads();
        if (valid) {
            const int row0 = gla_row0(b, cs);
            GlaPrep g; gla_prep(g, p, l, row0, h, w4, lane);
#pragma unroll
            for (int kk = 0; kk < 16; ++kk) KT[(dir * 32 + kh * 16 + kk) * 72 + lane] = f2bf(g.k[kk] * __expf(g.tot[kk] - g.cum[kk]));
            if (lane == 0) {
#pragma unroll
                for (int kk = 0; kk < 16; ++kk) DEC[((size_t)it * 2 + dir) * 32 + kh * 16 + kk] = __expf(g.tot[kk]);
            }
            gla_stage_vt(VT, p.ws, row0, h, tg);
        }
        __syncthreads();
        if (valid) {
            const int r = lane & 15, q4 = lane >> 4, kt = kh;
            float* dst = AST + ((size_t)it * 2 + dir) * 2048;
#pragma unroll
            for (int vt = 0; vt < 4; ++vt) {
                f32x4 acc = {0.f, 0.f, 0.f, 0.f};
#pragma unroll
                for (int ks = 0; ks < 2; ++ks) {
                    const bf16x8 a = *(const bf16x8*)(KT + (dir * 32 + kt * 16 + r) * 72 + ks * 32 + q4 * 8);
                    const bf16x8 bb = *(const bf16x8*)(VT + (vt * 16 + r) * 72 + ks * 32 + q4 * 8);
                    acc = __builtin_amdgcn_mfma_f32_16x16x32_bf16(a, bb, acc, 0, 0, 0);
                }
                *(f32x4*)(dst + (vt * 16 + r) * 32 + kt * 16 + q4 * 4) = acc;
            }
        }
    }
}
__device__ __forceinline__ void p3_gla_scan_fast(const Params& p) { PHASE_IDS;
    const float* AST = (const float*)(p.ws + WS_AST); const float* DEC = (const float*)(p.ws + WS_DEC);
    bf16_t* ST = (bf16_t*)(p.ws + WS_ST);
    for (int i = GT; i < BATCH * 4 * 2 * 2048; i += NGT) {
        const int e = i & 2047, dir = (i >> 11) & 1, h = (i >> 12) & 3, b = i >> 14, k = e & 31;
        float s = 0.f;
        if (dir == 0) {
#pragma unroll 4
            for (int cs = 0; cs < NCHK; ++cs) { const size_t id = (((size_t)b * NCHK + cs) * 4 + h) * 2; ST[id * 2048 + e] = f2bf(s); s = DEC[id * 32 + k] * s + AST[id * 2048 + e]; }
        } else {
#pragma unroll 4
            for (int q = 0; q < NCHK; ++q) { const int cs = q < 4 ? 3 - q : NCHK + 3 - q; const size_t id = (((size_t)b * NCHK + cs) * 4 + h) * 2 + 1; ST[id * 2048 + e] = f2bf(s); s = DEC[id * 32 + k] * s + AST[id * 2048 + e]; }
        }
    }
}
__device__ __forceinline__ void p4_gla_out_fast(const Params& p, int l, unsigned char* lds_raw) { PHASE_IDS;
    typedef pg8::bf16x8 bf16x8;
    const int grp = __builtin_amdgcn_readfirstlane(tidx >> 8), tg = tidx & 255, w4 = __builtin_amdgcn_readfirstlane((tidx >> 6) & 3), lane = tidx & 63;
    bf16_t* QT = (bf16_t*)(lds_raw + grp * 65536);
    bf16_t* KL = QT + 2 * 64 * 40;
    bf16_t* SL = KL + 2 * 64 * 40;
    bf16_t* VT = SL + 2 * 64 * 40;
    bf16_t* ATT = VT + 64 * 72;
    const bf16_t* ST = (const bf16_t*)(p.ws + WS_ST); const bf16_t* GG = (const bf16_t*)(p.ws + WS_GG);
    bf16_t* MIX = (bf16_t*)(p.ws + WS_HB);
    const int cs0 = l == 1 ? 4 : 0, ncs = NCHK - cs0, nitems = BATCH * ncs * 4;
    for (int pi = bidx_; pi * 2 < nitems; pi += gridDim.x) {
        const int itl = pi * 2 + grp; const bool valid = itl < nitems;
        const int h = itl & 3, cs = cs0 + (itl >> 2) % ncs, b = itl / (4 * ncs);
        const int it = (b * NCHK + cs) * 4 + h;
        const int dir = w4 >> 1, kh = w4 & 1;
        const int row0 = gla_row0(b, cs);
        __syncthreads();
        if (valid) {
            GlaPrep g; gla_prep(g, p, l, row0, h, w4, lane);
            pg8::u32x4 wq[2], wk[2];
#pragma unroll
            for (int i = 0; i < 8; ++i) {
                const float e0 = __expf(g.cum[2 * i]), e1 = __expf(g.cum[2 * i + 1]);
                ((unsigned*)wq)[i] = pg8::cvt_pk_bf16(g.q[2 * i] * e0, g.q[2 * i + 1] * e1);
                ((unsigned*)wk)[i] = pg8::cvt_pk_bf16(g.k[2 * i] * __builtin_amdgcn_rcpf(e0), g.k[2 * i + 1] * __builtin_amdgcn_rcpf(e1));
            }
            *(pg8::u32x4*)(QT + (dir * 64 + lane) * 40 + kh * 16) = wq[0]; *(pg8::u32x4*)(QT + (dir * 64 + lane) * 40 + kh * 16 + 8) = wq[1];
            *(pg8::u32x4*)(KL + (dir * 64 + lane) * 40 + kh * 16) = wk[0]; *(pg8::u32x4*)(KL + (dir * 64 + lane) * 40 + kh * 16 + 8) = wk[1];
            gla_stage_vt(VT, p.ws, row0, h, tg);
#pragma unroll
            for (int j = 0; j < 2; ++j) { const int pc = tg + 256 * j, d2 = pc >> 8, v = (pc >> 2) & 63, c = pc & 3;
                *(pg8::u32x4*)(SL + (d2 * 64 + v) * 40 + c * 8) = *(const pg8::u32x4*)(ST + ((size_t)it * 2 + d2) * 2048 + v * 32 + c * 8); }
        }
        __syncthreads();
        if (valid) {
            const int r = lane & 15, q4 = lane >> 4, i0 = 16 * w4;
            const bf16x8 aF = *(const bf16x8*)(QT + (0 * 64 + i0 + r) * 40 + q4 * 8), aB = *(const bf16x8*)(QT + (1 * 64 + i0 + r) * 40 + q4 * 8);
#pragma unroll
            for (int jt = 0; jt < 4; ++jt) {
                const bf16x8 bF = *(const bf16x8*)(KL + (0 * 64 + jt * 16 + r) * 40 + q4 * 8), bB = *(const bf16x8*)(KL + (1 * 64 + jt * 16 + r) * 40 + q4 * 8);
                const f32x4 z = {0.f, 0.f, 0.f, 0.f};
                const f32x4 F = __builtin_amdgcn_mfma_f32_16x16x32_bf16(aF, bF, z, 0, 0, 0), Bv = __builtin_amdgcn_mfma_f32_16x16x32_bf16(aB, bB, z, 0, 0, 0);
                const int j = jt * 16 + r;
#pragma unroll
                for (int e = 0; e < 4; ++e) { const int i = i0 + 4 * q4 + e; const float v = (j <= i ? F[e] : 0.f) + (j >= i ? Bv[e] : 0.f); ATT[i * 72 + j] = f2bf(v); }
            }
            __builtin_amdgcn_s_waitcnt(0);
            f32x4 o[4];
#pragma unroll
            for (int vt = 0; vt < 4; ++vt) {
                f32x4 acc = {0.f, 0.f, 0.f, 0.f};
#pragma unroll
                for (int ks = 0; ks < 2; ++ks) {
                    const bf16x8 a = *(const bf16x8*)(ATT + (i0 + r) * 72 + ks * 32 + q4 * 8);
                    const bf16x8 bb = *(const bf16x8*)(VT + (vt * 16 + r) * 72 + ks * 32 + q4 * 8);
                    acc = __builtin_amdgcn_mfma_f32_16x16x32_bf16(a, bb, acc, 0, 0, 0);
                }
                const bf16x8 sF = *(const bf16x8*)(SL + (0 * 64 + vt * 16 + r) * 40 + q4 * 8), sB = *(const bf16x8*)(SL + (1 * 64 + vt * 16 + r) * 40 + q4 * 8);
                acc = __builtin_amdgcn_mfma_f32_16x16x32_bf16(aF, sF, acc, 0, 0, 0);
                acc = __builtin_amdgcn_mfma_f32_16x16x32_bf16(aB, sB, acc, 0, 0, 0);
                o[vt] = acc;
            }
            float gn[4];
#pragma unroll
            for (int vt = 0; vt < 4; ++vt) gn[vt] = p.gla_norm[l * 64 + vt * 16 + r];
#pragma unroll
            for (int e = 0; e < 4; ++e) {
                float ss = o[0][e] * o[0][e] + o[1][e] * o[1][e] + o[2][e] * o[2][e] + o[3][e] * o[3][e];
                ss += __shfl_xor(ss, 1); ss += __shfl_xor(ss, 2); ss += __shfl_xor(ss, 4); ss += __shfl_xor(ss, 8);
                const float rs = rsqrtf(ss * (1.f / 64.f) + EPS);
                const size_t row = row0 + i0 + 4 * q4 + e;
#pragma unroll
                for (int vt = 0; vt < 4; ++vt) {
                    const float gt = bf2f(GG[row * 256 + h * 64 + vt * 16 + r]);
                    MIX[row * D + 256 + h * 64 + vt * 16 + r] = f2bf(o[vt][e] * rs * gn[vt] * gt * __builtin_amdgcn_rcpf(1.f + __expf(-gt)));
                }
            }
        }
    }
}

#define LAS __attribute__((address_space(3)))
__device__ __forceinline__ void transpose_item(const float* W, int ldw, int k0, int n0, bf16_t* wt_row0, int ldt, float* scr, int lane) {
#pragma unroll 8
    for (int i = 0; i < 32; ++i) { const int kk = 2 * i + (lane >> 5); scr[kk * 33 + (lane & 31)] = W[(size_t)(k0 + kk) * ldw + n0 + (lane & 31)]; }
    __builtin_amdgcn_s_waitcnt(0); asm volatile("" ::: "memory");
    const int c = lane & 7;
#pragma unroll
    for (int j = 0; j < 4; ++j) { const int n = (lane >> 3) + 8 * j; const float* s = scr + (8 * c) * 33 + n;
        pg8::u32x4 o; o.x = pg8::cvt_pk_bf16(s[0 * 33], s[1 * 33]); o.y = pg8::cvt_pk_bf16(s[2 * 33], s[3 * 33]); o.z = pg8::cvt_pk_bf16(s[4 * 33], s[5 * 33]); o.w = pg8::cvt_pk_bf16(s[6 * 33], s[7 * 33]);
        *(pg8::u32x4*)(wt_row0 + (size_t)n * ldt + k0 + 8 * c) = o; }
    __builtin_amdgcn_s_waitcnt(0); asm volatile("" ::: "memory");
}
__host__ __device__ __forceinline__ int tile_pos(int lc) { return 128 * ((lc >> 5) & 1) + 32 * (lc >> 6) + (lc & 31); }
__device__ __forceinline__ int inproj_dest(int c) {
    int T, lc;
    if (c < C_GV) { T = 2; lc = c - C_GQ; } else if (c < C_GG) { T = 3; lc = c - C_GV; } else if (c < C_GDF) { T = 4; lc = c - C_GG; }
    else if (c < C_AQ) { T = 8; lc = c - C_GDF; } else if (c < C_AQ + 256) { T = 5; lc = c - C_AQ; } else if (c < C_AK) { T = 6; lc = c - C_AQ - 256; } else { T = 7; lc = c - C_AK; }
    return T * 256 + tile_pos(lc);
}
__device__ __forceinline__ void convert_experts(const Params& p, int l, float* lds) { PHASE_IDS;
    const int lane = tidx & 63, wave = tidx >> 6;
    float* scr = lds + wave * 2112;
    bf16_t* WGU = (bf16_t*)(p.ws + WS_WGU); bf16_t* WD = (bf16_t*)(p.ws + WS_WD);
    for (int it = GW; it < 2 * NEXP * 16 * 16; it += NGW) {
        const int nb = it & 15, kb = (it >> 4) & 15, e = (it >> 8) & 15, part = it >> 12, n0 = nb * 32;
        const float* W = (part == 0 ? p.w_eg : p.w_eu) + (size_t)(l * NEXP + e) * D * DEXP;
        transpose_item(W, DEXP, kb * 64, n0, WGU + ((size_t)e * 1024 + (n0 >> 7) * 256 + part * 128 + (n0 & 127)) * D, D, scr, lane);
    }
    for (int it = GW; it < NEXP * 8 * 32; it += NGW) {
        const int nb = it & 31, kb = (it >> 5) & 7, e = it >> 8;
        transpose_item(p.w_ed + (size_t)(l * NEXP + e) * DEXP * D, D, kb * 64, nb * 32, WD + ((size_t)e * 1024 + nb * 32) * DEXP, DEXP, scr, lane);
    }
}
__device__ __forceinline__ void p0a_fast(const Params& p, float* lds) { PHASE_IDS;
    const int lane = tidx & 63, wave = tidx >> 6;
    float* scr = lds + wave * 2112;
    bf16_t* WIN = (bf16_t*)(p.ws + WS_WIN); bf16_t* WOUT = (bf16_t*)(p.ws + WS_WOUT);
    for (int it = GW; it < 2 * 16 * 49; it += NGW) {
        const int nb = it % 49, kb = (it / 49) & 15, l = it / (49 * 16), n0 = 256 + nb * 32;
        transpose_item(p.w_in + (size_t)l * D * DIN, DIN, kb * 64, n0, WIN + ((size_t)l * NIN + inproj_dest(n0)) * D, D, scr, lane);
    }
    for (int it = GW; it < 2 * 16 * 32; it += NGW) {
        const int nb = it & 31, kb = (it >> 5) & 15, l = it >> 9;
        transpose_item(p.w_out + (size_t)l * D * D, D, kb * 64, nb * 32, WOUT + ((size_t)l * D + nb * 32) * D, D, scr, lane);
    }
    for (int it = GW; it < 2 * 16 * 4 * 4; it += NGW) {
        const int jq = it & 3, g = (it >> 2) & 3, kb = (it >> 4) & 15, l = it >> 8;
        const float* W = p.w_in + (size_t)l * D * DIN;
        float yr[16], ys[16];
#pragma unroll
        for (int jj = 0; jj < 16; ++jj) { yr[jj] = 0.f; ys[jj] = 0.f; }
        for (int half = 0; half < 2; ++half) {
            __builtin_amdgcn_s_waitcnt(0); asm volatile("" ::: "memory");
            for (int i = 0; i < 32; ++i) { const int kk = 2 * i + (lane >> 5); scr[kk * 33 + (lane & 31)] = W[(size_t)(kb * 64 + kk) * DIN + g * 64 + half * 32 + (lane & 31)]; }
            __builtin_amdgcn_s_waitcnt(0); asm volatile("" ::: "memory");
            for (int cc = 0; cc < 32; ++cc) {
                const float u = scr[lane * 33 + cc]; const int c = half * 32 + cc;
#pragma unroll
                for (int jj = 0; jj < 16; ++jj) { const int j = jq * 16 + jj; const int m = (j * c) & 63; float sn, cs; sincos_r((float)m * 0.09817477042468103f, sn, cs); yr[jj] = fmaf(u, cs, yr[jj]); ys[jj] = fmaf(u, sn, ys[jj]); }
            }
        }
#pragma unroll
        for (int jj = 0; jj < 16; ++jj) { const int j = jq * 16 + jj; const size_t row = (size_t)l * NIN + tile_pos(g * 64 + j);
            WIN[(row) * D + kb * 64 + lane] = f2bf(yr[jj]); WIN[(row + 256) * D + kb * 64 + lane] = f2bf(ys[jj]); }
    }
    for (int i = GT; i < 2 * 224 * (D / 8); i += NGT) {
        const int k8 = i & 127, lc = 32 + (i >> 7) % 224, l = i / (224 * 128);
        *(pg8::u32x4*)(WIN + ((size_t)l * NIN + 8 * 256 + tile_pos(lc)) * D + k8 * 8) = (pg8::u32x4){0u, 0u, 0u, 0u};
    }
    {
        bf16_t* DM = (bf16_t*)(p.ws + WS_DMAT);
        for (int i = GT; i < 2048 * 4096 / 8; i += NGT) {
            const int t8 = (i & 511) * 8, k = i >> 9; unsigned w[4];
#pragma unroll
            for (int q = 0; q < 4; ++q) { float v[2];
#pragma unroll
                for (int e = 0; e < 2; ++e) { const int tt = t8 + 2 * q + e, t = tt & 2047; const int m = (k * t) & 2047; float sn, cs; sincos_r((float)m * (6.283185307179586f / 2048.f), sn, cs); v[e] = tt < 2048 ? cs : -sn; }
                w[q] = pg8::cvt_pk_bf16(v[0], v[1]); }
            *(pg8::u32x4*)(DM + (size_t)k * 4096 + t8) = (pg8::u32x4){w[0], w[1], w[2], w[3]};
        }
        bf16_t* DC = (bf16_t*)(p.ws + WS_DMATC);
        for (int i = GT; i < 256 * 512 / 8; i += NGT) {
            const int t8 = (i & 63) * 8, k = i >> 6; unsigned w[4];
#pragma unroll
            for (int q = 0; q < 4; ++q) { float v[2];
#pragma unroll
                for (int e = 0; e < 2; ++e) { const int tt = t8 + 2 * q + e, t = tt & 255; const int m = (k * t) & 255; float sn, cs; sincos_r((float)m * (6.283185307179586f / 256.f), sn, cs); v[e] = tt < 256 ? cs : -sn; }
                w[q] = pg8::cvt_pk_bf16(v[0], v[1]); }
            *(pg8::u32x4*)(DC + (size_t)k * 512 + t8) = (pg8::u32x4){w[0], w[1], w[2], w[3]};
        }
    }
    convert_experts(p, 0, lds);
}

#define XB_TMO      128
#define XB_XCNT(j)  (256  + 64 * (j))
#define XB_XSUB(j)  (1280 + 64 * (j))
#define XB_XGEN(j)  (2304 + 64 * (j))
#define XB_TOP      3328
#define XB_TOPGEN   3392
#define XCD_BAR_WORDS 3456
#define XB_SPIN_CAP (1u << 18)
__device__ __forceinline__ unsigned xb_ld(unsigned* p)              { return __hip_atomic_load(p, __ATOMIC_RELAXED, __HIP_MEMORY_SCOPE_AGENT); }
__device__ __forceinline__ unsigned xb_add(unsigned* p, unsigned v) { return __hip_atomic_fetch_add(p, v, __ATOMIC_RELAXED, __HIP_MEMORY_SCOPE_AGENT); }
__device__ __forceinline__ unsigned xb_xcc_id() { return (unsigned)__builtin_amdgcn_s_getreg((3 << 11) | 20) & 0xFu; }
#define XB_SPIN(cond, bar) do { unsigned _sp = 0; while (cond) { __builtin_amdgcn_s_sleep(1); \
    if ((++_sp & 255u) == 0u) { if (xb_ld(&(bar)[XB_TMO])) break; if (_sp > XB_SPIN_CAP) { atomicAdd(&(bar)[XB_TMO], 1u); break; } } } } while (0)
struct XcdBarrier { unsigned* bar; unsigned x; volatile __attribute__((address_space(3))) unsigned* st; };
__device__ __forceinline__ XcdBarrier xcd_barrier_post(unsigned* bar, volatile __attribute__((address_space(3))) unsigned* st) {
    XcdBarrier b; b.bar = bar; b.x = xb_xcc_id(); b.st = st;
    if (threadIdx.x == 0) (void)xb_add(&bar[XB_XCNT(b.x)], 1u);
    return b;
}
__device__ __forceinline__ void xcd_barrier_complete(unsigned* bar, unsigned x, unsigned& nloc, unsigned& nx) {
    const unsigned G = gridDim.x * gridDim.y * gridDim.z;
    unsigned sum, cnt, mine, sp = 0u;
    for (;;) {
        sum = 0u; cnt = 0u; mine = 0u;
#pragma unroll
        for (unsigned j = 0; j < 16; ++j) { const unsigned c = xb_ld(&bar[XB_XCNT(j)]); sum += c; cnt += (c > 0u) ? 1u : 0u; mine = (j == x) ? c : mine; }
        if (sum == G) break;
        __builtin_amdgcn_s_sleep(1);
        if ((++sp & 255u) == 0u) { if (xb_ld(&bar[XB_TMO])) break; if (sp > XB_SPIN_CAP) { atomicAdd(&bar[XB_TMO], 1u); break; } }
    }
    nloc = mine > 0u ? mine : 1u; nx = cnt > 0u ? cnt : 1u;
}
__device__ __forceinline__ void xcd_barrier(const XcdBarrier& b) {
    asm volatile("s_waitcnt vmcnt(0)" ::: "memory");
    __syncthreads();
    if (threadIdx.x == 0) {
        unsigned* bar = b.bar;
        __builtin_amdgcn_s_waitcnt(0);
        unsigned nloc = b.st[0], nx = b.st[1];
        if (nloc == 0u) { xcd_barrier_complete(bar, b.x, nloc, nx); b.st[0] = nloc; b.st[1] = nx; }
        const unsigned old = xb_add(&bar[XB_XSUB(b.x)], 1u);
        const unsigned gen = old / nloc;
        if (old + 1u == (gen + 1u) * nloc) {
            __builtin_amdgcn_fence(__ATOMIC_RELEASE, "agent");
            asm volatile("s_waitcnt vmcnt(0)" ::: "memory");
            const unsigned og = xb_add(&bar[XB_TOP], 1u);
            const unsigned tg = og / nx;
            if (og + 1u == (tg + 1u) * nx) xb_add(&bar[XB_TOPGEN], 1u);
            else XB_SPIN(xb_ld(&bar[XB_TOPGEN]) == tg, bar);
            __builtin_amdgcn_fence(__ATOMIC_ACQUIRE, "agent");
            xb_add(&bar[XB_XGEN(b.x)], 1u);
            asm volatile("s_waitcnt vmcnt(0)" ::: "memory");
        } else {
            XB_SPIN(xb_ld(&bar[XB_XGEN(b.x)]) == gen, bar);
            __builtin_amdgcn_fence(__ATOMIC_ACQUIRE, "agent");
            asm volatile("s_waitcnt vmcnt(0)" ::: "memory");
        }
    }
    __syncthreads();
}

__global__ void __launch_bounds__(NTHREADS) mega(Params p) {
    extern __shared__ __attribute__((aligned(16))) unsigned char lds_raw[];
    float* lds = (float*)lds_raw;
    cg::grid_group grid = cg::this_grid();
    volatile __attribute__((address_space(3))) unsigned* bst = (volatile __attribute__((address_space(3))) unsigned*)((__attribute__((address_space(3))) unsigned char*)lds_raw + pg8::STAGE_BYTES + 512);
    if (threadIdx.x < 2) bst[threadIdx.x] = 0u;
    __syncthreads();
    const XcdBarrier bar = xcd_barrier_post((unsigned*)(p.ws + WS_CTL), bst);
#define GSYNC() xcd_barrier(bar)
    p0a(p); p0a_fast(p, lds); grid.sync();
    p0b(p); GSYNC();
#define LAYER(l) do { p1_norm1(p, l); if (l == 1) convert_experts(p, 1, lds); GSYNC(); p2_inproj_fast(p, l, lds_raw); GSYNC(); \
        p3_fnet_fast(p, l, lds_raw); __syncthreads(); p3_gla_local_fast(p, l, lds_raw); __syncthreads(); p3_attn_fast(p, l, lds_raw); GSYNC(); p3_gla_scan_fast(p); GSYNC(); p4_gla_out_fast(p, l, lds_raw); GSYNC(); \
        p5_outproj_fast(p, l, lds_raw); GSYNC(); p6_norm2_router(p, l, lds); GSYNC(); p7_gateup_fast(p, l, lds_raw); GSYNC(); p8_down_fast(p, l, lds_raw); GSYNC(); } while (0)
    LAYER(0);
    LAYER(1);
#undef LAYER
    p9_final(p);
}

extern "C" void kernel_launch(void* const* d_in, const int* in_sizes, int n_in, void* d_out, int out_size, void* d_ws, size_t ws_size, hipStream_t stream) {
    static int grid_blocks = 0;
    if (!grid_blocks) {
        int dev = 0, cus = 0, per_cu = 0;
        hipGetDevice(&dev);
        hipDeviceGetAttribute(&cus, hipDeviceAttributeMultiprocessorCount, dev);
        hipFuncSetAttribute((const void*)mega, hipFuncAttributeMaxDynamicSharedMemorySize, LDS_BYTES);
        hipOccupancyMaxActiveBlocksPerMultiprocessor(&per_cu, (const void*)mega, NTHREADS, LDS_BYTES);
        if (per_cu < 1) { fprintf(stderr, "occupancy query says %d blocks/CU\n", per_cu); per_cu = 1; }
        grid_blocks = cus;
        if (n_in != 21 || ws_size < WS_END) fprintf(stderr, "unexpected n_in %d / ws_size %zu\n", n_in, ws_size);
    }
    hipMemsetAsync((char*)d_ws + WS_CTL, 0, 1 * MiB, stream);
    Params p{};
    const float** f = (const float**)&p;
    for (int i = 0; i < 21; ++i) f[i] = (const float*)d_in[i];
    p.out = (float*)d_out; p.ws = (unsigned char*)d_ws;
    void* args[] = {&p};
    hipError_t e = hipLaunchCooperativeKernel((const void*)mega, dim3(grid_blocks), dim3(NTHREADS), args, LDS_BYTES, stream);
    if (e != hipSuccess) fprintf(stderr, "cooperative launch failed: %s (grid %d)\n", hipGetErrorString(e), grid_blocks);
}
```

```cpp
#include <hip/hip_runtime.h>
#include <hip/hip_cooperative_groups.h>
#include <cstdio>
#include <cstdint>
namespace cg = cooperative_groups;

typedef unsigned short bf16_t;
typedef float f32x4 __attribute__((ext_vector_type(4)));

constexpr int D = 1024, BATCH = 8, SEQ = 2048, CTXL = 256, DEPTH = 2;
constexpr int NL = BATCH * SEQ, NC = BATCH * CTXL, NTOK = NL + NC;
constexpr int DIN = 1824;
constexpr int C_FN = 0, C_GQ = 256, C_GK = 384, C_GV = 512, C_GG = 768, C_GDF = 1024, C_GDB = 1040, C_AQ = 1056, C_AK = 1568, C_AV = 1696;
constexpr int KEYS = CTXL + SEQ;
constexpr int NCHK = 36;
constexpr int NEXP = 16, DEXP = 512;
constexpr float EPS = 1e-6f;
constexpr float QSCALE = 0.125f * 1.4426950408889634f;
constexpr int NWAVES = 8, NTHREADS = 512;
#ifndef DUP
#define DUP 0
#endif
#define DUPN(id) ((DUP == (id)) ? 2 : 1)
#define GOLDEN_FNET 0
#define GOLDEN_ATTN 0
#define GOLDEN_GLA 0
constexpr int LDS_BYTES = 147456;

constexpr size_t MiB = 1u << 20;
constexpr size_t WS_CTL = 0;
constexpr size_t WS_MODP = 151 * MiB;
constexpr size_t WS_MOD = 9 * MiB;
constexpr size_t WS_TAB = 10 * MiB;
constexpr size_t WS_XC = 11 * MiB;
constexpr size_t WS_HB = 19 * MiB;
constexpr size_t WS_YFTL = 55 * MiB;
constexpr size_t WS_YFTC = 71 * MiB;
constexpr size_t WS_GQK = 73 * MiB;
constexpr size_t WS_GV = 82 * MiB;
constexpr size_t WS_GG = 91 * MiB;
constexpr size_t WS_GD = 100 * MiB;
constexpr size_t WS_AQ = 102 * MiB;
constexpr size_t WS_AK = 120 * MiB;
constexpr size_t WS_AVT = 125 * MiB;
constexpr size_t WS_AST = 130 * MiB;
constexpr size_t WS_DEC = 149 * MiB;
constexpr size_t WS_ROUTE = 150 * MiB;
constexpr size_t WS_Y = 151 * MiB;
constexpr size_t WS_WIN = 223 * MiB;
constexpr size_t WS_WOUT = 232 * MiB;
constexpr size_t WS_WGU = 236 * MiB;
constexpr size_t WS_WD = 268 * MiB;
constexpr size_t WS_DMAT = 284 * MiB;
constexpr size_t WS_DMATC = 300 * MiB;
constexpr size_t WS_LIST = 301 * MiB;
constexpr size_t WS_ST = 304 * MiB;
constexpr size_t WS_END = 314 * MiB;
constexpr size_t WS_ACT = WS_YFTL;
constexpr int CW_CNT = 8192;
constexpr int NIN = 2304;

struct Params {
    const float *x, *c, *ctx, *c_ctx, *w_ada, *b_ada, *norm_mix, *norm_ffn, *w_in, *w_gup, *b_gg, *gla_norm, *q_norm, *k_norm, *w_out, *w_router, *b_router, *w_eg, *w_eu, *w_ed, *final_norm;
    float* out;
    unsigned char* ws;
};

namespace pg8 {
typedef unsigned u32x4 __attribute__((ext_vector_type(4)));
typedef unsigned u32x2 __attribute__((ext_vector_type(2)));
__device__ __forceinline__ unsigned cvt_pk_bf16(float lo, float hi) { unsigned r; asm volatile("v_cvt_pk_bf16_f32 %0, %1, %2" : "=v"(r) : "v"(lo), "v"(hi)); return r; }
}
__device__ __forceinline__ float bf2f(bf16_t v) { return __uint_as_float((unsigned)v << 16); }
__device__ __forceinline__ bf16_t f2bf(float f) { unsigned u = __float_as_uint(f); return (bf16_t)((u + 0x7fffu + ((u >> 16) & 1u)) >> 16); }
__device__ __forceinline__ float wave_sum(float v) {
#pragma unroll
    for (int o = 1; o < 64; o <<= 1) v += __shfl_xor(v, o);
    return v;
}
__device__ __forceinline__ float siluf(float v) { return v / (1.f + expf(-v)); }
__device__ __forceinline__ float sigmoidf(float v) { return 1.f / (1.f + expf(-v)); }
__device__ __forceinline__ float logsigmoidf(float z) { return fminf(z, 0.f) - log1pf(expf(-fabsf(z))); }
__device__ __forceinline__ void sincos_r(float x, float& s, float& c) {
    const float k = rintf(x * 0.63661977236758134f);
    float r = fmaf(k, -1.57079625129699707031f, x); r = fmaf(k, -7.54978995489188216e-8f, r);
    const int q = ((int)k) & 3;
    const float r2 = r * r;
    float sp = fmaf(r2, 2.7557314297e-6f, -1.9841270114e-4f); sp = fmaf(sp, r2, 8.3333337680e-3f); sp = fmaf(sp, r2, -1.6666667163e-1f); sp = fmaf(sp * r2, r, r);
    float cp = fmaf(r2, 2.4801587642e-5f, -1.3888889225e-3f); cp = fmaf(cp, r2, 4.1666667908e-2f); cp = fmaf(cp, r2, -0.5f); cp = fmaf(cp, r2, 1.f);
    const float ss = (q & 1) ? cp : sp, cc = (q & 1) ? sp : cp;
    s = (q & 2) ? -ss : ss; c = ((q + 1) & 2) ? -cc : cc;
}
struct RowInfo { int b, t, bidx, isctx; };
__device__ __forceinline__ RowInfo row_info(int r) { RowInfo ri; if (r < NL) { ri.b = r >> 11; ri.t = r & 2047; ri.bidx = ri.b; ri.isctx = 0; } else { const int q = r - NL; ri.b = q >> 8; ri.t = q & 255; ri.bidx = 8; ri.isctx = 1; } return ri; }

__device__ __forceinline__ int otid() { int t = threadIdx.x; asm volatile("" : "+v"(t)); return t; }
__device__ __forceinline__ int obid() { int b = blockIdx.x; asm volatile("" : "+s"(b)); return b; }
#define PHASE_IDS const int tidx = otid(); const int bidx_ = obid(); (void)tidx; (void)bidx_
#define GW (bidx_ * NWAVES + (tidx >> 6))
#define NGW (gridDim.x * NWAVES)
#define GT (bidx_ * NTHREADS + tidx)
#define NGT (gridDim.x * NTHREADS)

__device__ __forceinline__ void p0a(const Params& p, float* lds) { PHASE_IDS;
    const int lane = tidx & 63;
    float* MODP = (float*)(p.ws + WS_MODP);
    float* sl = lds + 20000;
    for (int i = tidx; i < 9 * D; i += NTHREADS) { const int j = i >> 10, k = i & 1023; const float cv = j < 8 ? p.c[j * D + k] : p.c_ctx[k]; sl[k * 12 + j] = siluf(cv); }
    __syncthreads();
    for (int it = GW; it < 2 * 16 * 96; it += NGW) {
        const int l = it / (16 * 96), kc = (it / 96) % 16, cb = it % 96, col = cb * 64 + lane;
        float w[64];
        const float* wp = p.w_ada + ((size_t)l * D + kc * 64) * 6144 + col;
#pragma unroll
        for (int kk = 0; kk < 64; ++kk) w[kk] = wp[(size_t)kk * 6144];
        float acc[9];
#pragma unroll
        for (int j = 0; j < 9; ++j) acc[j] = 0.f;
#pragma unroll
        for (int kk = 0; kk < 64; ++kk) {
            const f32x4* sp = (const f32x4*)(sl + (kc * 64 + kk) * 12); const f32x4 s0 = sp[0], s1 = sp[1], s2 = sp[2];
            acc[0] = fmaf(s0[0], w[kk], acc[0]); acc[1] = fmaf(s0[1], w[kk], acc[1]); acc[2] = fmaf(s0[2], w[kk], acc[2]); acc[3] = fmaf(s0[3], w[kk], acc[3]);
            acc[4] = fmaf(s1[0], w[kk], acc[4]); acc[5] = fmaf(s1[1], w[kk], acc[5]); acc[6] = fmaf(s1[2], w[kk], acc[6]); acc[7] = fmaf(s1[3], w[kk], acc[7]);
            acc[8] = fmaf(s2[0], w[kk], acc[8]);
        }
#pragma unroll
        for (int j = 0; j < 9; ++j) MODP[((size_t)(l * 16 + kc) * 9 + j) * 6144 + col] = acc[j];
    }
    float* TAB = (float*)(p.ws + WS_TAB);
    for (int i = GT; i < 2048 + 1024; i += NGT) {
        if (i < 2048) { float s, c; sincos_r((float)i * (6.283185307179586f / 2048.f), s, c); TAB[i] = c; }
        else { const int q = i - 2048, pos = q >> 4, f = q & 15; const float inv = exp2f(-(float)f * (13.287712379549449f / 16.f)); float s, c; sincos_r((float)pos * inv, s, c); TAB[2048 + 2 * q] = c; TAB[2048 + 2 * q + 1] = s; }
    }
}
__device__ __forceinline__ void p0b(const Params& p) { PHASE_IDS;
    const float* MODP = (const float*)(p.ws + WS_MODP);
    float* MOD = (float*)(p.ws + WS_MOD);
    for (int i = GT; i < 2 * 9 * 6144; i += NGT) {
        const int l = i / (9 * 6144), j = (i / 6144) % 9, col = i % 6144;
        float s = p.b_ada[l * 6144 + col];
        for (int kc = 0; kc < 16; ++kc) s += MODP[((size_t)(l * 16 + kc) * 9 + j) * 6144 + col];
        MOD[i] = s;
    }
}

__device__ __forceinline__ float* xrow_ptr(const Params& p, int r) { return r < NL ? p.out + (size_t)r * D : (float*)(p.ws + WS_XC) + (size_t)(r - NL) * D; }
__device__ __forceinline__ const float* xin_ptr(const Params& p, int r) { return r < NL ? p.x + (size_t)r * D : p.ctx + (size_t)(r - NL) * D; }

constexpr int RPW = 3;
__device__ __forceinline__ f32x4 bf4_to_f4(pg8::u32x2 w) { f32x4 r; r[0] = __uint_as_float(w.x << 16); r[1] = __uint_as_float(w.x & 0xffff0000u); r[2] = __uint_as_float(w.y << 16); r[3] = __uint_as_float(w.y & 0xffff0000u); return r; }
__device__ __forceinline__ void p1_norm1(const Params& p, int l) { PHASE_IDS;
    const int lane = tidx & 63;
    const float* MOD = (const float*)(p.ws + WS_MOD);
    bf16_t* HB = (bf16_t*)(p.ws + WS_HB);
    const bf16_t* Y = (const bf16_t*)(p.ws + WS_Y);
    for (int r0 = GW * RPW; r0 < NTOK; r0 += NGW * RPW) {
        f32x4 v[RPW][4]; pg8::u32x2 y0[RPW][4], y1[RPW][4];
#pragma unroll
        for (int q = 0; q < RPW; ++q) { const int r = (r0 + q < NTOK) ? r0 + q : NTOK - 1;
#pragma unroll
            for (int j = 0; j < 4; ++j) { const int col = 4 * lane + 256 * j;
                if (l == 0) v[q][j] = *(const f32x4*)(xin_ptr(p, r) + col);
                else { v[q][j] = *(const f32x4*)(xrow_ptr(p, r) + col); y0[q][j] = *(const pg8::u32x2*)(Y + (size_t)(2 * r) * D + col); y1[q][j] = *(const pg8::u32x2*)(Y + (size_t)(2 * r + 1) * D + col); } } }
#pragma unroll
        for (int q = 0; q < RPW; ++q) { const int r = r0 + q; if (r >= NTOK) break;
            const RowInfo ri = row_info(r);
            float ss = 0.f;
#pragma unroll
            for (int j = 0; j < 4; ++j) { const int col = 4 * lane + 256 * j;
                if (l != 0) { const f32x4 g2 = *(const f32x4*)(MOD + ((size_t)(l - 1) * 9 + ri.bidx) * 6144 + 5 * D + col);
                    v[q][j] += g2 * (bf4_to_f4(y0[q][j]) + bf4_to_f4(y1[q][j])); *(f32x4*)(xrow_ptr(p, r) + col) = v[q][j]; }
                ss += v[q][j][0] * v[q][j][0] + v[q][j][1] * v[q][j][1] + v[q][j][2] * v[q][j][2] + v[q][j][3] * v[q][j][3]; }
            const float rstd = rsqrtf(wave_sum(ss) * (1.f / D) + EPS);
            const float* mod = MOD + ((size_t)l * 9 + ri.bidx) * 6144;
#pragma unroll
            for (int j = 0; j < 4; ++j) { const int col = 4 * lane + 256 * j;
                const f32x4 nw = *(const f32x4*)(p.norm_mix + l * D + col), sh = *(const f32x4*)(mod + col), sc = *(const f32x4*)(mod + D + col);
                const f32x4 hv = v[q][j] * rstd * nw * (sc + 1.f) + sh;
                pg8::u32x2 o; o.x = pg8::cvt_pk_bf16(hv[0], hv[1]); o.y = pg8::cvt_pk_bf16(hv[2], hv[3]);
                *(pg8::u32x2*)(HB + (size_t)r * D + col) = o; }
        }
    }
}

__device__ __forceinline__ void p2_inproj_golden(const Params& p, int l, float* lds) { PHASE_IDS;
    const int lane = tidx & 63, wave = tidx >> 6;
    float* hrow = lds + wave * 2880;
    float* orow = hrow + 1024;
    const bf16_t* HB = (const bf16_t*)(p.ws + WS_HB);
    const float* TAB = (const float*)(p.ws + WS_TAB);
    bf16_t* YFTL = (bf16_t*)(p.ws + WS_YFTL); bf16_t* YFTC = (bf16_t*)(p.ws + WS_YFTC);
    bf16_t* GQK = (bf16_t*)(p.ws + WS_GQK); bf16_t* GV = (bf16_t*)(p.ws + WS_GV); bf16_t* GG = (bf16_t*)(p.ws + WS_GG); bf16_t* GD = (bf16_t*)(p.ws + WS_GD);
    bf16_t* AQ = (bf16_t*)(p.ws + WS_AQ); bf16_t* AK = (bf16_t*)(p.ws + WS_AK); bf16_t* AVT = (bf16_t*)(p.ws + WS_AVT);
    const float* W = p.w_in + (size_t)l * D * DIN;
    for (int r = GW; r < NTOK; r += NGW) {
        const RowInfo ri = row_info(r);
        for (int k = lane; k < D; k += 64) hrow[k] = bf2f(HB[(size_t)r * D + k]);
        __builtin_amdgcn_s_waitcnt(0);
        float acc[29];
#pragma unroll
        for (int i = 0; i < 29; ++i) acc[i] = 0.f;
#pragma unroll 1
        for (int k = 0; k < D; ++k) {
            const float h = hrow[k]; const float* wr = W + (size_t)k * DIN + lane;
#pragma unroll
            for (int i = 0; i < 28; ++i) acc[i] = fmaf(h, wr[64 * i], acc[i]);
            if (lane < 32) acc[28] = fmaf(h, wr[64 * 28], acc[28]);
        }
#pragma unroll
        for (int i = 0; i < 28; ++i) orow[64 * i + lane] = acc[i];
        if (lane < 32) orow[64 * 28 + lane] = acc[28];
        __builtin_amdgcn_s_waitcnt(0);
        {
            const int j = lane;
#pragma unroll 1
            for (int g = 0; g < 4; ++g) {
                float yr = 0.f, ys = 0.f;
#pragma unroll 4
                for (int c = 0; c < 64; ++c) { const int m = ((j * c) & 63) * 32; const float u = orow[C_FN + g * 64 + c]; yr = fmaf(u, TAB[m], yr); ys = fmaf(u, TAB[(m - 512) & 2047], ys); }
                if (!ri.isctx) { bf16_t* o = YFTL + (((size_t)ri.b * 256 + g * 64 + j) * 2) * SEQ + ri.t; o[0] = f2bf(yr); o[SEQ] = f2bf(ys); }
                else { bf16_t* o = YFTC + (((size_t)ri.b * 256 + g * 64 + j) * 2) * CTXL + ri.t; o[0] = f2bf(yr); o[CTXL] = f2bf(ys); }
            }
        }
        for (int i = lane; i < 128; i += 64) { GQK[(size_t)r * 256 + i] = f2bf(orow[C_GQ + i] * 0.17677669529663687f); GQK[(size_t)r * 256 + 128 + i] = f2bf(orow[C_GK + i]); }
        for (int i = lane; i < 256; i += 64) { GV[(size_t)r * 256 + i] = f2bf(orow[C_GV + i]); GG[(size_t)r * 256 + i] = f2bf(orow[C_GG + i]); }
        if (lane < 32) GD[(size_t)r * 32 + lane] = f2bf(orow[C_GDF + lane]);
        {
            const int d = lane, axis = d >> 5, half = (d >> 4) & 1, f = d & 15;
            const int pos = axis == 0 ? (ri.t >> 6) : (ri.t & 63);
            const float cs = TAB[2048 + 2 * (pos * 16 + f)], sn = TAB[2048 + 2 * (pos * 16 + f) + 1];
#pragma unroll 1
            for (int h = 0; h < 10; ++h) {
                const int base = h < 8 ? C_AQ + h * 64 : C_AK + (h - 8) * 64;
                const float* nw = h < 8 ? p.q_norm + l * 64 : p.k_norm + l * 64;
                const float v = orow[base + d], vp = orow[base + (d ^ 16)];
                const float rs = rsqrtf(wave_sum(v * v) * (1.f / 64.f) + EPS);
                float xv = v * rs * nw[d], xp = vp * rs * nw[d ^ 16], o = xv;
                if (!ri.isctx) o = half == 0 ? xv * cs - xp * sn : xv * cs + xp * sn;
                if (h < 8) AQ[(size_t)r * 512 + h * 64 + d] = f2bf(o * QSCALE);
                else AK[((size_t)ri.b * KEYS + (ri.isctx ? ri.t : CTXL + ri.t)) * 128 + (h - 8) * 64 + d] = f2bf(o);
            }
            for (int kvh = 0; kvh < 2; ++kvh) AVT[(((size_t)ri.b * 2 + kvh) * 64 + d) * KEYS + (ri.isctx ? ri.t : CTXL + ri.t)] = f2bf(orow[C_AV + kvh * 64 + d]);
        }
        __builtin_amdgcn_s_waitcnt(0);
    }
}

__device__ __forceinline__ void attn_golden_wave(const Params& p, int b, int h, int qrow, int nkeys) { PHASE_IDS;
    const bf16_t* AQ = (const bf16_t*)(p.ws + WS_AQ); const bf16_t* AK = (const bf16_t*)(p.ws + WS_AK); const bf16_t* AVT = (const bf16_t*)(p.ws + WS_AVT);
    bf16_t* MIX = (bf16_t*)(p.ws + WS_HB);
    const int kvh = h >> 2, d = tidx & 63;
    const float q = bf2f(AQ[(size_t)qrow * 512 + h * 64 + d]);
    float o = 0.f, m = -1e30f, lsum = 0.f;
    const bf16_t* kb = AK + (size_t)b * KEYS * 128 + kvh * 64 + d;
    const bf16_t* vb = AVT + (((size_t)b * 2 + kvh) * 64 + d) * KEYS;
#pragma unroll 4
    for (int key = 0; key < nkeys; ++key) {
        const float s = wave_sum(q * bf2f(kb[(size_t)key * 128]));
        const float mn = fmaxf(m, s), a = exp2f(m - mn), pe = exp2f(s - mn);
        lsum = lsum * a + pe; m = mn;
        o = fmaf(o, a, pe * bf2f(vb[key]));
    }
    MIX[(size_t)qrow * D + 512 + h * 64 + d] = f2bf(o / lsum);
}

__device__ __forceinline__ void gla_stage(const Params& p, int l, int b, int cs, int h, float* cumF, float* cumB, float* sq, float* sk, float* sv) { PHASE_IDS;
    const int tid = tidx;
    const bf16_t* GQK = (const bf16_t*)(p.ws + WS_GQK); const bf16_t* GV = (const bf16_t*)(p.ws + WS_GV); const bf16_t* GD = (const bf16_t*)(p.ws + WS_GD);
    const int row0 = cs < 4 ? NL + b * CTXL + cs * 64 : b * SEQ + (cs - 4) * 64;
    for (int i = tid; i < 64 * 32 * 2; i += NTHREADS) {
        const int dir = i >> 11, tok = (i >> 5) & 63, k = i & 31;
        const float* wu = p.w_gup + ((size_t)(l * 2 + dir) * 16) * 128 + h * 32 + k;
        float z = p.b_gg[(l * 2 + dir) * 128 + h * 32 + k];
#pragma unroll
        for (int rr = 0; rr < 16; ++rr) z = fmaf(bf2f(GD[(size_t)(row0 + tok) * 32 + dir * 16 + rr]), wu[rr * 128], z);
        (dir == 0 ? cumF : cumB)[tok * 32 + k] = logsigmoidf(z) * (1.f / 16.f);
    }
    for (int i = tid; i < 64 * 32; i += NTHREADS) { const int tok = i >> 5, k = i & 31; sq[i] = bf2f(GQK[(size_t)(row0 + tok) * 256 + h * 32 + k]); sk[i] = bf2f(GQK[(size_t)(row0 + tok) * 256 + 128 + h * 32 + k]); }
    for (int i = tid; i < 64 * 64; i += NTHREADS) { const int tok = i >> 6, v = i & 63; sv[i] = bf2f(GV[(size_t)(row0 + tok) * 256 + h * 64 + v]); }
    __syncthreads();
    if (tid < 32) { float a = 0.f; for (int t = 0; t < 64; ++t) { a += cumF[t * 32 + tid]; cumF[t * 32 + tid] = a; } }
    else if (tid < 64) { const int k = tid - 32; float a = 0.f; for (int t = 63; t >= 0; --t) { a += cumB[t * 32 + k]; cumB[t * 32 + k] = a; } }
    __syncthreads();
}

__device__ __forceinline__ void p3_mixers_golden(const Params& p, int l, float* lds) { PHASE_IDS;
    const float* TAB = (const float*)(p.ws + WS_TAB);
    bf16_t* MIX = (bf16_t*)(p.ws + WS_HB);
    if (GOLDEN_ATTN) for (int i = GW; i < BATCH * 8 * SEQ; i += NGW) { const int q = i & 2047, h = (i >> 11) & 7, b = i >> 14; attn_golden_wave(p, b, h, b * SEQ + q, KEYS); }
    if (GOLDEN_ATTN && l == 0) for (int i = GW; i < BATCH * 8 * CTXL; i += NGW) { const int q = i & 255, h = (i >> 8) & 7, b = i >> 11; attn_golden_wave(p, b, h, NL + b * CTXL + q, CTXL); }
    if (GOLDEN_FNET) {
        const bf16_t* YFTL = (const bf16_t*)(p.ws + WS_YFTL);
        const float scale = 1.f / sqrtf(64.f * SEQ);
        for (int i = GT; i < BATCH * 256 * SEQ; i += NGT) {
            const int k = i & 2047, j = (i >> 11) & 255, b = i >> 19;
            const bf16_t* yr = YFTL + (((size_t)b * 256 + j) * 2) * SEQ; const bf16_t* ys = yr + SEQ;
            float acc = 0.f;
            for (int t = 0; t < SEQ; ++t) { const int m = (k * t) & 2047; acc = fmaf(TAB[m], bf2f(yr[t]), acc); acc = fmaf(-TAB[(m - 512) & 2047], bf2f(ys[t]), acc); }
            MIX[(size_t)(b * SEQ + k) * D + j] = f2bf(acc * scale);
        }
    }
    if (GOLDEN_FNET && l == 0) {
        const bf16_t* YFTC = (const bf16_t*)(p.ws + WS_YFTC);
        const float scale = 1.f / sqrtf(64.f * CTXL);
        for (int i = GT; i < BATCH * 256 * CTXL; i += NGT) {
            const int k = i & 255, j = (i >> 8) & 255, b = i >> 16;
            const bf16_t* yr = YFTC + (((size_t)b * 256 + j) * 2) * CTXL; const bf16_t* ys = yr + CTXL;
            float acc = 0.f;
            for (int t = 0; t < CTXL; ++t) { const int m = ((k * t) & 255) * 8; acc = fmaf(TAB[m], bf2f(yr[t]), acc); acc = fmaf(-TAB[(m - 512) & 2047], bf2f(ys[t]), acc); }
            MIX[(size_t)(NL + b * CTXL + k) * D + j] = f2bf(acc * scale);
        }
    }
    if (GOLDEN_GLA) {
        float* cumF = lds; float* cumB = cumF + 2048; float* sq = cumB + 2048; float* sk = sq + 2048; float* sv = sk + 2048;
        float* AST = (float*)(p.ws + WS_AST); float* DEC = (float*)(p.ws + WS_DEC);
        for (int it = bidx_; it < BATCH * NCHK * 4; it += gridDim.x) {
            const int h = it & 3, cs = (it >> 2) % NCHK, b = it / (4 * NCHK);
            __syncthreads();
            gla_stage(p, l, b, cs, h, cumF, cumB, sq, sk, sv);
            for (int i = tidx; i < 2 * 2048; i += NTHREADS) {
                const int dir = i >> 11, k = (i >> 6) & 31, v = i & 63;
                const float* cum = dir == 0 ? cumF : cumB; const float last = dir == 0 ? cum[63 * 32 + k] : cum[k];
                float a = 0.f;
                for (int t = 0; t < 64; ++t) a = fmaf(sk[t * 32 + k] * expf(last - cum[t * 32 + k]), sv[t * 64 + v], a);
                AST[((((size_t)b * NCHK + cs) * 4 + h) * 2 + dir) * 2048 + k * 64 + v] = a;
                if (v == 0) DEC[((((size_t)b * NCHK + cs) * 4 + h) * 2 + dir) * 32 + k] = expf(last);
            }
        }
    }
}

__device__ __forceinline__ void p4_gla_out_golden(const Params& p, int l, float* lds) { PHASE_IDS;
    float* cumF = lds; float* cumB = cumF + 2048; float* sq = cumB + 2048; float* sk = sq + 2048; float* sv = sk + 2048;
    float* Sf = sv + 4096; float* Sb = Sf + 2048; float* att = Sb + 2048; float* ob = att + 4096;
    const float* AST = (const float*)(p.ws + WS_AST); const float* DEC = (const float*)(p.ws + WS_DEC);
    const bf16_t* GG = (const bf16_t*)(p.ws + WS_GG);
    bf16_t* MIX = (bf16_t*)(p.ws + WS_HB);
    const int tid = tidx;
    for (int it = bidx_; it < BATCH * NCHK * 4; it += gridDim.x) {
        const int h = it & 3, cs = (it >> 2) % NCHK, b = it / (4 * NCHK);
        if (l == 1 && cs < 4) continue;
        __syncthreads();
        gla_stage(p, l, b, cs, h, cumF, cumB, sq, sk, sv);
        for (int i = tid; i < 2048; i += NTHREADS) {
            const int k = i >> 6;
            float s = 0.f;
            for (int c = 0; c < cs; ++c) { const size_t id = (((size_t)b * NCHK + c) * 4 + h) * 2 + 0; s = DEC[id * 32 + k] * s + AST[id * 2048 + i]; }
            Sf[i] = s;
            s = 0.f;
            if (cs < 4) { for (int c = 3; c > cs; --c) { const size_t id = (((size_t)b * NCHK + c) * 4 + h) * 2 + 1; s = DEC[id * 32 + k] * s + AST[id * 2048 + i]; } }
            else { for (int c = 3; c >= 0; --c) { const size_t id = (((size_t)b * NCHK + c) * 4 + h) * 2 + 1; s = DEC[id * 32 + k] * s + AST[id * 2048 + i]; }
                   for (int c = NCHK - 1; c > cs; --c) { const size_t id = (((size_t)b * NCHK + c) * 4 + h) * 2 + 1; s = DEC[id * 32 + k] * s + AST[id * 2048 + i]; } }
            Sb[i] = s;
        }
        for (int i = tid; i < 4096; i += NTHREADS) {
            const int ti = i >> 6, tj = i & 63;
            float a = 0.f;
            if (tj <= ti) for (int k = 0; k < 32; ++k) a = fmaf(sq[ti * 32 + k] * sk[tj * 32 + k], expf(cumF[ti * 32 + k] - cumF[tj * 32 + k]), a);
            if (tj >= ti) for (int k = 0; k < 32; ++k) a = fmaf(sq[ti * 32 + k] * sk[tj * 32 + k], expf(cumB[ti * 32 + k] - cumB[tj * 32 + k]), a);
            att[i] = a;
        }
        __syncthreads();
        for (int i = tid; i < 4096; i += NTHREADS) {
            const int ti = i >> 6, v = i & 63;
            float a = 0.f;
            for (int tj = 0; tj < 64; ++tj) a = fmaf(att[ti * 64 + tj], sv[tj * 64 + v], a);
            for (int k = 0; k < 32; ++k) a = fmaf(sq[ti * 32 + k], expf(cumF[ti * 32 + k]) * Sf[k * 64 + v] + expf(cumB[ti * 32 + k]) * Sb[k * 64 + v], a);
            ob[i] = a;
        }
        __syncthreads();
        const int row0 = cs < 4 ? NL + b * CTXL + cs * 64 : b * SEQ + (cs - 4) * 64;
        for (int i = tid; i < 4096; i += NTHREADS) {
            const int ti = i >> 6, v = i & 63;
            float ss = 0.f;
            for (int vv = 0; vv < 64; ++vv) ss = fmaf(ob[ti * 64 + vv], ob[ti * 64 + vv], ss);
            const float rs = rsqrtf(ss * (1.f / 64.f) + EPS);
            const float g = bf2f(GG[(size_t)(row0 + ti) * 256 + h * 64 + v]);
            MIX[(size_t)(row0 + ti) * D + 256 + h * 64 + v] = f2bf(ob[i] * rs * p.gla_norm[l * 64 + v] * siluf(g));
        }
    }
}

__device__ __forceinline__ void p5_outproj_golden(const Params& p, int l, float* lds) { PHASE_IDS;
    const int lane = tidx & 63, wave = tidx >> 6;
    float* mrow = lds + wave * 1024;
    const bf16_t* MIX = (const bf16_t*)(p.ws + WS_HB);
    const float* MOD = (const float*)(p.ws + WS_MOD);
    const float* W = p.w_out + (size_t)l * D * D;
    const int nrows = l == 0 ? NTOK : NL;
    for (int r = GW; r < nrows; r += NGW) {
        const RowInfo ri = row_info(r);
        for (int k = lane; k < D; k += 64) mrow[k] = bf2f(MIX[(size_t)r * D + k]);
        __builtin_amdgcn_s_waitcnt(0);
        float acc[16];
#pragma unroll
        for (int i = 0; i < 16; ++i) acc[i] = 0.f;
        for (int k = 0; k < D; ++k) { const float m = mrow[k]; const float* wr = W + (size_t)k * D + lane;
#pragma unroll
            for (int i = 0; i < 16; ++i) acc[i] = fmaf(m, wr[64 * i], acc[i]); }
        const float* g1 = MOD + ((size_t)l * 9 + ri.bidx) * 6144 + 2 * D;
        const float* xs = l == 0 ? xin_ptr(p, r) : xrow_ptr(p, r);
        float* xd = xrow_ptr(p, r);
#pragma unroll
        for (int i = 0; i < 16; ++i) { const int col = 64 * i + lane; xd[col] = xs[col] + g1[col] * acc[i]; }
        __builtin_amdgcn_s_waitcnt(0);
    }
}

__device__ __forceinline__ void p6_norm2_router(const Params& p, int l, float* lds) { PHASE_IDS;
    const int lane = tidx & 63, wave = tidx >> 6;
    const float* MOD = (const float*)(p.ws + WS_MOD);
    bf16_t* HB = (bf16_t*)(p.ws + WS_HB);
    f32x4* ROUTE = (f32x4*)(p.ws + WS_ROUTE);
    const int nrows = l == 0 ? NTOK : NL;
    const int rpb = (nrows + (int)gridDim.x - 1) / (int)gridDim.x, rbeg = bidx_ * rpb, rend = (rbeg + rpb < nrows) ? rbeg + rpb : nrows;
    const int rpw = (rpb + NWAVES - 1) / NWAVES;
    int* lcnt = (int*)lds; int* lbase = lcnt + 16; int* rroute = lbase + 16;
    if (tidx < 16) lcnt[tidx] = 0;
    float* wl = lds + 256;
    for (int i = tidx; i < D * NEXP; i += NTHREADS) { const int k = i >> 4; wl[(((k >> 8) * 4 + (k & 3)) * 64 + ((k >> 2) & 63)) * 20 + (i & 15)] = p.w_router[i]; }
    __syncthreads();
    const int wbeg = rbeg + wave * rpw, wend = (wbeg + rpw < rend) ? wbeg + rpw : rend;
    for (int r0 = wbeg; r0 < wend; r0 += RPW) {
        f32x4 v[RPW][4];
#pragma unroll
        for (int q = 0; q < RPW; ++q) { const int r = (r0 + q < wend) ? r0 + q : wend - 1;
#pragma unroll
            for (int j = 0; j < 4; ++j) v[q][j] = *(const f32x4*)(xrow_ptr(p, r) + 4 * lane + 256 * j); }
#pragma unroll
        for (int q = 0; q < RPW; ++q) { const int r = r0 + q; if (r >= wend) break;
            const RowInfo ri = row_info(r);
            float ss = 0.f;
#pragma unroll
            for (int j = 0; j < 4; ++j) ss += v[q][j][0] * v[q][j][0] + v[q][j][1] * v[q][j][1] + v[q][j][2] * v[q][j][2] + v[q][j][3] * v[q][j][3];
            const float rstd = rsqrtf(wave_sum(ss) * (1.f / D) + EPS);
            const float* mod = MOD + ((size_t)l * 9 + ri.bidx) * 6144;
            float lg[16];
#pragma unroll
            for (int e = 0; e < 16; ++e) lg[e] = 0.f;
#pragma unroll
            for (int j = 0; j < 4; ++j) {
                const int col = 4 * lane + 256 * j;
                const f32x4 nw = *(const f32x4*)(p.norm_ffn + l * D + col), sh = *(const f32x4*)(mod + 3 * D + col), sc = *(const f32x4*)(mod + 4 * D + col);
                const f32x4 hv4 = v[q][j] * rstd * nw * (sc + 1.f) + sh;
                pg8::u32x2 o; o.x = pg8::cvt_pk_bf16(hv4[0], hv4[1]); o.y = pg8::cvt_pk_bf16(hv4[2], hv4[3]);
                *(pg8::u32x2*)(HB + (size_t)r * D + col) = o;
#pragma unroll
                for (int e = 0; e < 4; ++e) {
                    const float hv = hv4[e];
                    const f32x4* wr = (const f32x4*)(wl + ((j * 4 + e) * 64 + lane) * 20);
#pragma unroll
                    for (int qq = 0; qq < 4; ++qq) { const f32x4 w4 = wr[qq]; lg[4 * qq] = fmaf(hv, w4[0], lg[4 * qq]); lg[4 * qq + 1] = fmaf(hv, w4[1], lg[4 * qq + 1]); lg[4 * qq + 2] = fmaf(hv, w4[2], lg[4 * qq + 2]); lg[4 * qq + 3] = fmaf(hv, w4[3], lg[4 * qq + 3]); }
                }
            }
            float t8[8], t4[4], t2[2], t1;
            { const bool up = lane & 32;
#pragma unroll
              for (int e = 0; e < 8; ++e) { const float keep = up ? lg[8 + e] : lg[e], give = up ? lg[e] : lg[8 + e]; t8[e] = keep + __shfl_xor(give, 32); } }
            { const bool up = lane & 16;
#pragma unroll
              for (int e = 0; e < 4; ++e) { const float keep = up ? t8[4 + e] : t8[e], give = up ? t8[e] : t8[4 + e]; t4[e] = keep + __shfl_xor(give, 16); } }
            { const bool up = lane & 8;
#pragma unroll
              for (int e = 0; e < 2; ++e) { const float keep = up ? t4[2 + e] : t4[e], give = up ? t4[e] : t4[2 + e]; t2[e] = keep + __shfl_xor(give, 8); } }
            { const bool up = lane & 4; const float keep = up ? t2[1] : t2[0], give = up ? t2[0] : t2[1]; t1 = keep + __shfl_xor(give, 4); }
            t1 += __shfl_xor(t1, 2); t1 += __shfl_xor(t1, 1);
            float s[16], sel[16];
#pragma unroll
            for (int e = 0; e < 16; ++e) { const int src = ((e >> 3) & 1) * 32 + ((e >> 2) & 1) * 16 + ((e >> 1) & 1) * 8 + (e & 1) * 4; s[e] = sigmoidf(__shfl(t1, src)); sel[e] = s[e] + p.b_router[e]; }
            int bestg = 0; float bestscore = -1e30f;
#pragma unroll
            for (int g = 0; g < 4; ++g) {
                float m1 = -1e30f, m2 = -1e30f;
#pragma unroll
                for (int i = 0; i < 4; ++i) { const float vsel = sel[4 * g + i]; if (vsel > m1) { m2 = m1; m1 = vsel; } else if (vsel > m2) m2 = vsel; }
                const float gs = m1 + m2;
                if (gs > bestscore) { bestscore = gs; bestg = g; }
            }
            int i1 = 0, i2 = 0; float m1 = -1e30f, m2 = -1e30f, s1 = 0.f, s2 = 0.f;
#pragma unroll
            for (int g = 0; g < 4; ++g) if (g == bestg) {
#pragma unroll
                for (int i = 0; i < 4; ++i) { const float vsel = sel[4 * g + i]; if (vsel > m1) { m1 = vsel; i1 = i; s1 = s[4 * g + i]; } }
#pragma unroll
                for (int i = 0; i < 4; ++i) { const float vsel = sel[4 * g + i]; if (i != i1 && vsel > m2) { m2 = vsel; i2 = i; s2 = s[4 * g + i]; } }
            }
            if (lane == 0) { const int e1 = bestg * 4 + i1, e2 = bestg * 4 + i2; f32x4 rt; rt[0] = __int_as_float(e1); rt[1] = __int_as_float(e2); rt[2] = s1 / (s1 + s2); rt[3] = s2 / (s1 + s2); ROUTE[r] = rt;
                rroute[r - rbeg] = e1 | (e2 << 8); atomicAdd(&lcnt[e1], 1); atomicAdd(&lcnt[e2], 1); }
        }
    }
    __syncthreads();
    unsigned* ctl = (unsigned*)(p.ws + WS_CTL);
    if (tidx < 16) { lbase[tidx] = (int)__hip_atomic_fetch_add(ctl + CW_CNT + (l * NEXP + tidx) * 64, (unsigned)lcnt[tidx], __ATOMIC_RELAXED, __HIP_MEMORY_SCOPE_AGENT); lcnt[tidx] = 0; }
    __syncthreads();
    int* LIST = (int*)(p.ws + WS_LIST) + (size_t)l * NEXP * NTOK;
    if (tidx < rend - rbeg) {
        const int rr = rroute[tidx], r = rbeg + tidx;
#pragma unroll
        for (int slot = 0; slot < 2; ++slot) { const int e = (rr >> (8 * slot)) & 255; const int pos = lbase[e] + atomicAdd(&lcnt[e], 1); LIST[e * NTOK + pos] = 2 * r + slot; }
    }
    __syncthreads();
}

__device__ __forceinline__ void p78_moe_golden(const Params& p, int l, float* lds) { PHASE_IDS;
    const int lane = tidx & 63, wave = tidx >> 6;
    float* hrow = lds + wave * 1536; float* arow = hrow + 1024;
    const bf16_t* HB = (const bf16_t*)(p.ws + WS_HB);
    const f32x4* ROUTE = (const f32x4*)(p.ws + WS_ROUTE);
    bf16_t* Y = (bf16_t*)(p.ws + WS_Y);
    const int nrows = l == 0 ? NTOK : NL;
    for (int it = GW; it < nrows * 2; it += NGW) {
        const int r = it >> 1, slot = it & 1;
        const f32x4 rt = ROUTE[r];
        const int e = __float_as_int(rt[slot]); const float wgt = rt[2 + slot];
        for (int k = lane; k < D; k += 64) hrow[k] = bf2f(HB[(size_t)r * D + k]);
        __builtin_amdgcn_s_waitcnt(0);
        const float* Wg = p.w_eg + ((size_t)(l * NEXP + e) * D) * DEXP; const float* Wu = p.w_eu + ((size_t)(l * NEXP + e) * D) * DEXP; const float* Wd = p.w_ed + ((size_t)(l * NEXP + e) * DEXP) * D;
        float ag[8], au[8];
#pragma unroll
        for (int i = 0; i < 8; ++i) { ag[i] = 0.f; au[i] = 0.f; }
        for (int k = 0; k < D; ++k) { const float hv = hrow[k]; const float* g = Wg + (size_t)k * DEXP + lane; const float* u = Wu + (size_t)k * DEXP + lane;
#pragma unroll
            for (int i = 0; i < 8; ++i) { ag[i] = fmaf(hv, g[64 * i], ag[i]); au[i] = fmaf(hv, u[64 * i], au[i]); } }
#pragma unroll
        for (int i = 0; i < 8; ++i) arow[64 * i + lane] = siluf(ag[i]) * au[i];
        __builtin_amdgcn_s_waitcnt(0);
        float acc[16];
#pragma unroll
        for (int i = 0; i < 16; ++i) acc[i] = 0.f;
        for (int j = 0; j < DEXP; ++j) { const float a = arow[j]; const float* wr = Wd + (size_t)j * D + lane;
#pragma unroll
            for (int i = 0; i < 16; ++i) acc[i] = fmaf(a, wr[64 * i], acc[i]); }
#pragma unroll
        for (int i = 0; i < 16; ++i) Y[(size_t)it * D + 64 * i + lane] = f2bf(wgt * acc[i]);
        __builtin_amdgcn_s_waitcnt(0);
    }
}

__device__ __forceinline__ void p9_final(const Params& p) { PHASE_IDS;
    const int lane = tidx & 63;
    const float* MOD = (const float*)(p.ws + WS_MOD);
    const bf16_t* Y = (const bf16_t*)(p.ws + WS_Y);
    for (int r0 = GW * RPW; r0 < NL; r0 += NGW * RPW) {
        f32x4 v[RPW][4]; pg8::u32x2 y0[RPW][4], y1[RPW][4];
#pragma unroll
        for (int q = 0; q < RPW; ++q) { const int r = (r0 + q < NL) ? r0 + q : NL - 1;
#pragma unroll
            for (int j = 0; j < 4; ++j) { const int col = 4 * lane + 256 * j;
                v[q][j] = *(const f32x4*)(p.out + (size_t)r * D + col); y0[q][j] = *(const pg8::u32x2*)(Y + (size_t)(2 * r) * D + col); y1[q][j] = *(const pg8::u32x2*)(Y + (size_t)(2 * r + 1) * D + col); } }
#pragma unroll
        for (int q = 0; q < RPW; ++q) { const int r = r0 + q; if (r >= NL) break;
            const int bidx = r >> 11;
            float ss = 0.f;
#pragma unroll
            for (int j = 0; j < 4; ++j) { const int col = 4 * lane + 256 * j;
                const f32x4 g2 = *(const f32x4*)(MOD + ((size_t)(DEPTH - 1) * 9 + bidx) * 6144 + 5 * D + col);
                v[q][j] += g2 * (bf4_to_f4(y0[q][j]) + bf4_to_f4(y1[q][j]));
                ss += v[q][j][0] * v[q][j][0] + v[q][j][1] * v[q][j][1] + v[q][j][2] * v[q][j][2] + v[q][j][3] * v[q][j][3]; }
            const float rstd = rsqrtf(wave_sum(ss) * (1.f / D) + EPS);
#pragma unroll
            for (int j = 0; j < 4; ++j) { const int col = 4 * lane + 256 * j; const f32x4 nw = *(const f32x4*)(p.final_norm + col); *(f32x4*)(p.out + (size_t)r * D + col) = v[q][j] * rstd * nw; }
        }
    }
}

namespace pg8 {
#define PG8_LAS __attribute__((address_space(3)))
typedef short bf16x8 __attribute__((ext_vector_type(8)));
typedef unsigned u32x4 __attribute__((ext_vector_type(4)));
typedef unsigned u32x2 __attribute__((ext_vector_type(2)));
constexpr int BM = 256, BK = 64, HALF = 128, HTB = HALF * BK * 2, STAGE_BYTES = 8 * HTB;
__host__ __device__ __forceinline__ int lds_byte(int r, int c) { const int st = (r >> 4) * 2 + (c >> 5), rr = r & 15, cc = c & 31, ob = rr * 64 + cc * 2; return st * 1024 + (ob ^ (((ob >> 9) & 1) << 5)); }
__host__ __device__ __forceinline__ void stage_rc(int b, int& R, int& C) { const int st = b / 1024, sb = b % 1024, swz = sb ^ (((sb >> 9) & 1) << 5); R = (st >> 1) * 16 + swz / 64; C = (st & 1) * 32 + (swz % 64) / 2; }
__host__ __device__ __forceinline__ int perm32(int rho) { const int n = rho >> 4, i = rho & 15; return 8 * (i >> 2) + 4 * n + (i & 3); }
struct Unit { int pm, pn; unsigned a_off, b_off; int e, cnt; };

template <class Epi, class Sched>
__device__ __forceinline__ void gemm_phase(PG8_LAS unsigned char* lds, const bf16_t* A, const bf16_t* Bt, const int K, const Sched& S, const Epi& E) {
    const int tid = otid(), wid = __builtin_amdgcn_readfirstlane(tid >> 6), lane = tid & 63, wr = wid >> 2, wc = wid & 3, fr = lane & 15, fq = lane >> 4;
    const int nt = K / BK;
    int Ra[2]; unsigned Ca2[2], voffB[2];
#pragma unroll
    for (int i = 0; i < 2; ++i) { int R, C; stage_rc(tid * 16 + i * 8192, R, C); const int Rb = (R & ~31) + perm32(R & 31); Ra[i] = R; Ca2[i] = (unsigned)C * 2u; voffB[i] = (unsigned)(Rb * K + C) * 2u; }
    const size_t kstep = (size_t)(BK * 2);
    const size_t hstep = (size_t)HALF * K * 2;
    const unsigned ldsw = (unsigned)wid * 1024u;
    const int aoff = lds_byte(wr * 64 + fr, fq * 8), boff = lds_byte(wc * 32 + fr, fq * 8);
#define PG8_SA(b, h) (((b) * 2 + (h)) * HTB)
#define PG8_SB(b, h) ((4 + (b) * 2 + (h)) * HTB)
#define PG8_STAGE_B(bufoff, gbase) do { _Pragma("unroll") for (int _i = 0; _i < 2; ++_i) \
        __builtin_amdgcn_global_load_lds((const unsigned*)((const char*)(gbase) + voffB[_i]), (PG8_LAS unsigned*)(lds + (bufoff) + ldsw + _i * 8192), 16, 0, 0); } while (0)
#define PG8_STAGE_A(bufoff, kbyte, offs) do { _Pragma("unroll") for (int _i = 0; _i < 2; ++_i) \
        __builtin_amdgcn_global_load_lds((const unsigned*)(Ab + (size_t)(offs)[_i] + (size_t)(kbyte)), (PG8_LAS unsigned*)(lds + (bufoff) + ldsw + _i * 8192), 16, 0, 0); } while (0)
#define PG8_LDA(dst, b, h) do { _Pragma("unroll") for (int m = 0; m < 4; ++m) _Pragma("unroll") for (int k = 0; k < 2; ++k) dst[m][k] = *(const PG8_LAS bf16x8*)(lds + PG8_SA(b, h) + aoff + m * 2048 + k * 1024); } while (0)
#define PG8_LDB(dst, b, h) do { _Pragma("unroll") for (int n = 0; n < 2; ++n) _Pragma("unroll") for (int k = 0; k < 2; ++k) dst[n][k] = *(const PG8_LAS bf16x8*)(lds + PG8_SB(b, h) + boff + n * 2048 + k * 1024); } while (0)
#define PG8_MMA(ai, bj, At, Bt_) do { __builtin_amdgcn_s_setprio(1); _Pragma("unroll") for (int m = 0; m < 4; ++m) _Pragma("unroll") for (int n = 0; n < 2; ++n) _Pragma("unroll") for (int k = 0; k < 2; ++k) \
        acc[ai][bj][m][n] = __builtin_amdgcn_mfma_f32_16x16x32_bf16(Bt_[n][k], At[m][k], acc[ai][bj][m][n], 0, 0, 0); __builtin_amdgcn_s_setprio(0); } while (0)
#define PG8_WAIT_V(n) asm volatile("s_waitcnt vmcnt(" #n ")" ::: "memory")
#define PG8_WAIT_L(n) asm volatile("s_waitcnt lgkmcnt(" #n ")" ::: "memory")
#define PG8_BAR __builtin_amdgcn_s_barrier()
#define PG8_SCHED __builtin_amdgcn_sched_barrier(0)
    Unit cur, nxt; int ui = 0;
    if (!S.next(0, cur)) return;
    f32x4 acc[2][2][4][2];
#pragma unroll
    for (int a = 0; a < 2; ++a)
#pragma unroll
        for (int b = 0; b < 2; ++b)
#pragma unroll
            for (int m = 0; m < 4; ++m)
#pragma unroll
                for (int n = 0; n < 2; ++n) acc[a][b][m][n] = (f32x4){0.f, 0.f, 0.f, 0.f};
    bf16x8 At[4][2], B0[2][2], B1[2][2];
    const char* Ab = (const char*)A;
    unsigned ga0[2], ga1[2], gn0[2], gn1[2];
#pragma unroll
    for (int i = 0; i < 2; ++i) { ga0[i] = S.a_row_off(cur, Ra[i], K) + Ca2[i]; ga1[i] = S.a_row_off(cur, HALF + Ra[i], K) + Ca2[i]; }
    const char* cB = (const char*)Bt + cur.b_off;
    PG8_STAGE_B(PG8_SB(0, 0), cB); PG8_STAGE_B(PG8_SB(0, 1), cB + hstep); PG8_STAGE_A(PG8_SA(0, 0), 0, ga0); PG8_STAGE_A(PG8_SA(0, 1), 0, ga1);
    if (wr == 1) PG8_BAR;
    PG8_WAIT_V(2); PG8_BAR;
    PG8_STAGE_B(PG8_SB(1, 0), cB + kstep); PG8_STAGE_A(PG8_SA(1, 0), kstep, ga0); PG8_STAGE_B(PG8_SB(1, 1), cB + hstep + kstep);
    PG8_WAIT_V(6); PG8_BAR;
    for (;;) {
        const bool has_next = S.next(ui + 1, nxt);
        if (has_next) {
#pragma unroll
            for (int i = 0; i < 2; ++i) { gn0[i] = S.a_row_off(nxt, Ra[i], K) + Ca2[i]; gn1[i] = S.a_row_off(nxt, HALF + Ra[i], K) + Ca2[i]; }
        } else {
#pragma unroll
            for (int i = 0; i < 2; ++i) { gn0[i] = ga0[i]; gn1[i] = ga1[i]; }
        }
        const char* nB = has_next ? (const char*)Bt + nxt.b_off : cB;
        for (int t = 0; t < nt; t += 2) {
            const bool last = (t == nt - 2);
            const size_t k1 = (size_t)(t + 1) * kstep;
            unsigned o20[2], o21[2];
#pragma unroll
            for (int i = 0; i < 2; ++i) { o20[i] = last ? gn0[i] : ga0[i]; o21[i] = last ? gn1[i] : ga1[i]; }
            const size_t k2 = last ? 0 : (size_t)(t + 2) * kstep, k3 = k2 + kstep;
            const char* b2 = last ? nB : cB + (size_t)(t + 2) * kstep; const char* b3 = b2 + kstep;
            PG8_LDB(B0, 0, 0); PG8_LDB(B1, 0, 1); PG8_SCHED; PG8_LDA(At, 0, 0); PG8_STAGE_A(PG8_SA(1, 1), k1, ga1);
            PG8_WAIT_V(8); PG8_WAIT_L(0); PG8_BAR; PG8_MMA(0, 0, At, B0); PG8_MMA(0, 1, At, B1); PG8_BAR; PG8_SCHED;
            PG8_LDA(At, 0, 1); PG8_STAGE_B(PG8_SB(0, 0), b2); PG8_STAGE_B(PG8_SB(0, 1), b2 + hstep); PG8_STAGE_A(PG8_SA(0, 0), k2, o20);
            PG8_WAIT_V(8); PG8_WAIT_L(0); PG8_BAR; PG8_MMA(1, 0, At, B0); PG8_MMA(1, 1, At, B1); PG8_BAR; PG8_SCHED;
            PG8_LDB(B0, 1, 0); PG8_LDB(B1, 1, 1); PG8_SCHED; PG8_LDA(At, 1, 0); PG8_STAGE_A(PG8_SA(0, 1), k2, o21);
            PG8_WAIT_V(8); PG8_WAIT_L(0); PG8_BAR; PG8_MMA(0, 0, At, B0); PG8_MMA(0, 1, At, B1); PG8_BAR; PG8_SCHED;
            PG8_LDA(At, 1, 1); PG8_STAGE_B(PG8_SB(1, 0), b3); PG8_STAGE_B(PG8_SB(1, 1), b3 + hstep); PG8_STAGE_A(PG8_SA(1, 0), k3, o20);
            PG8_WAIT_V(8); PG8_WAIT_L(0); PG8_BAR; PG8_MMA(1, 0, At, B0); PG8_MMA(1, 1, At, B1); PG8_BAR; PG8_SCHED;
        }
        if (wr == 0) PG8_BAR;
        E(acc, cur, wr, wc, fr, fq);
        if (!has_next) break;
#pragma unroll
        for (int a = 0; a < 2; ++a)
#pragma unroll
            for (int b = 0; b < 2; ++b)
#pragma unroll
                for (int m = 0; m < 4; ++m)
#pragma unroll
                    for (int n = 0; n < 2; ++n) acc[a][b][m][n] = (f32x4){0.f, 0.f, 0.f, 0.f};
        cur = nxt; cB = nB; ++ui;
#pragma unroll
        for (int i = 0; i < 2; ++i) { ga0[i] = gn0[i]; ga1[i] = gn1[i]; }
        if (wr == 1) PG8_BAR;
    }
    PG8_WAIT_V(0);
    PG8_BAR;
#undef PG8_SA
#undef PG8_SB
#undef PG8_STAGE_A
#undef PG8_STAGE_B
#undef PG8_LDA
#undef PG8_LDB
#undef PG8_MMA
#undef PG8_WAIT_V
#undef PG8_WAIT_L
#undef PG8_BAR
#undef PG8_SCHED
}

struct PlainOrder {
    int nM, nN, nwg, G, c;
    __device__ void init(int M, int N, int G_, int c_) { nM = M / BM; nN = N / BM; nwg = nM * nN; G = G_; c = c_; }
    __device__ __forceinline__ bool next(int i, Unit& u, int dup = 1) const {
        int L = i * G + c; if (L >= nwg * dup) return false; if (L >= nwg) L -= nwg;
        int wgid = L; { const int q = nwg / 8, r = nwg % 8, xcd = wgid % 8, off = wgid / 8; wgid = (xcd < r ? xcd * (q + 1) : r * (q + 1) + (xcd - r) * q) + off; }
        const int nig = 8 * nN, gid = wgid / nig, fm = gid * 8, gsz = (nM - fm) < 8 ? (nM - fm) : 8;
        u.pm = fm + ((wgid % nig) % gsz); u.pn = (wgid % nig) / gsz; u.a_off = 0; u.b_off = 0; u.e = 0; u.cnt = 256; return true;
    }
    __device__ __forceinline__ unsigned a_row_off(const Unit& u, int rl, int K) const { return (unsigned)((u.pm * BM + rl) * K) * 2u; }
};
}
struct PlainSched {
    pg8::PlainOrder o; int K; int dup;
    __device__ __forceinline__ bool next(int i, pg8::Unit& u) const { if (!o.next(i, u, dup)) return false; u.b_off = (unsigned)(u.pn * 256 * K) * 2u; return true; }
    __device__ __forceinline__ unsigned a_row_off(const pg8::Unit& u, int rl, int K_) const { return o.a_row_off(u, rl, K_); }
};

struct EpiOutProj {
    const float* xs_lat; const float* xs_ctx; float* xd_lat; float* xd_ctx; const float* g1;
    __device__ __forceinline__ void operator()(const f32x4 (&acc)[2][2][4][2], const pg8::Unit& u, int wr, int wc, int fr, int fq) const {
        const int row0 = u.pm * 256 + wr * 64 + fr, col0 = u.pn * 256 + wc * 32 + 8 * fq;
        const bool isctx = u.pm >= 64; const int bidx = isctx ? 8 : (u.pm >> 3);
        const float* xs = isctx ? xs_ctx - (size_t)NL * D : xs_lat; float* xd = isctx ? xd_ctx - (size_t)NL * D : xd_lat;
        f32x4 g[2][2];
#pragma unroll
        for (int bj = 0; bj < 2; ++bj)
#pragma unroll
            for (int n = 0; n < 2; ++n) g[bj][n] = *(const f32x4*)(g1 + (size_t)bidx * 6144 + col0 + bj * 128 + 4 * n);
#pragma unroll
        for (int ai = 0; ai < 2; ++ai)
#pragma unroll
            for (int m = 0; m < 4; ++m) {
                const size_t ro = (size_t)(row0 + ai * 128 + m * 16) * D + col0;
#pragma unroll
                for (int bj = 0; bj < 2; ++bj)
#pragma unroll
                    for (int n = 0; n < 2; ++n) { const f32x4 xv = *(const f32x4*)(xs + ro + bj * 128 + 4 * n); *(f32x4*)(xd + ro + bj * 128 + 4 * n) = xv + g[bj][n] * acc[ai][bj][m][n]; }
            }
    }
};
__device__ __forceinline__ void p5_outproj_fast(const Params& p, int l, unsigned char* lds_raw) { PHASE_IDS;
    PlainSched S; S.K = D; S.dup = (l == 0 ? DUPN(8) : 1); S.o.init(l == 0 ? NTOK : NL, D, gridDim.x, bidx_);
    EpiOutProj E{l == 0 ? p.x : p.out, l == 0 ? p.ctx : (const float*)(p.ws + WS_XC), p.out, (float*)(p.ws + WS_XC), (const float*)(p.ws + WS_MOD) + (size_t)l * 9 * 6144 + 2 * D};
    pg8::gemm_phase((PG8_LAS unsigned char*)lds_raw, (const bf16_t*)(p.ws + WS_HB), (const bf16_t*)(p.ws + WS_WOUT) + (size_t)l * D * D, D, S, E);
}

#define PIN_ACC(acc) do { _Pragma("unroll") for (int a_ = 0; a_ < 2; ++a_) _Pragma("unroll") for (int b_ = 0; b_ < 2; ++b_) _Pragma("unroll") for (int m_ = 0; m_ < 4; ++m_) \
    asm volatile("" : "+v"(acc[a_][b_][m_][0]), "+v"(acc[a_][b_][m_][1])); } while (0)
struct EpiInProj {
    struct { unsigned char* ws; const float* q_norm; const float* k_norm; } p; int l;
    __device__ __forceinline__ void operator()(f32x4 (&acc)[2][2][4][2], const pg8::Unit& u, int wr, int wc, int fr, int fq) const {
        const int T = u.pn;
        const bool isctx = u.pm >= 64; const int b = isctx ? u.pm - 64 : (u.pm >> 3); const int t0 = (isctx ? 0 : (u.pm & 7) * 256) + wr * 64 + fr;
        const int row0 = u.pm * 256 + wr * 64 + fr;
        if (T <= 1) {
            bf16_t* dst; int ld;
            if (!isctx) { dst = (bf16_t*)(p.ws + WS_YFTL) + ((size_t)b * 256 * 2 + T) * SEQ; ld = SEQ; } else { dst = (bf16_t*)(p.ws + WS_YFTC) + ((size_t)b * 256 * 2 + T) * CTXL; ld = CTXL; }
            unsigned eo = (unsigned)((64 * wc + 8 * fq) * 2 * ld + t0);
#pragma unroll
            for (int bj = 0; bj < 2; ++bj)
#pragma unroll
                for (int n = 0; n < 2; ++n)
#pragma unroll
                    for (int e = 0; e < 4; ++e) { bf16_t* cp = dst + eo;
#pragma unroll
                        for (int ai = 0; ai < 2; ++ai)
#pragma unroll
                            for (int m = 0; m < 4; ++m) cp[ai * 128 + m * 16] = f2bf(acc[ai][bj][m][n][e]);
                        eo += (unsigned)(((n == 1 && e == 3) ? 25 : 1) * 2 * ld); asm volatile("" : "+v"(eo) :: "memory"); }
        } else if (T <= 4 || T == 8) {
            bf16_t* dst; int ld; float sc = 1.f;
            if (T == 2) { dst = (bf16_t*)(p.ws + WS_GQK); ld = 256; if (wc < 2) sc = 0.17677669529663687f; }
            else if (T == 3) { dst = (bf16_t*)(p.ws + WS_GV); ld = 256; } else if (T == 4) { dst = (bf16_t*)(p.ws + WS_GG); ld = 256; } else { dst = (bf16_t*)(p.ws + WS_GD); ld = 32; }
            if (T != 8 || wc == 0) {
#pragma unroll
                for (int ai = 0; ai < 2; ++ai)
#pragma unroll
                    for (int m = 0; m < 4; ++m) { const size_t r = row0 + ai * 128 + m * 16;
#pragma unroll
                        for (int bj = 0; bj < 2; ++bj) { if (T == 8 && bj == 1) continue;
                            const f32x4 v0 = acc[ai][bj][m][0] * sc, v1 = acc[ai][bj][m][1] * sc;
                            pg8::u32x4 w; w.x = pg8::cvt_pk_bf16(v0[0], v0[1]); w.y = pg8::cvt_pk_bf16(v0[2], v0[3]); w.z = pg8::cvt_pk_bf16(v1[0], v1[1]); w.w = pg8::cvt_pk_bf16(v1[2], v1[3]);
                            *(pg8::u32x4*)(dst + r * ld + 64 * wc + 32 * bj + 8 * fq) = w; } }
            }
        } else if (T == 7 && wc >= 2) {
            bf16_t* dst = (bf16_t*)(p.ws + WS_AVT) + ((size_t)(b * 2 + (wc - 2)) * 64) * KEYS + (isctx ? 0 : CTXL);
            unsigned eo = (unsigned)(8 * fq * KEYS + t0);
#pragma unroll
            for (int bj = 0; bj < 2; ++bj)
#pragma unroll
                for (int n = 0; n < 2; ++n)
#pragma unroll
                    for (int e = 0; e < 4; ++e) { bf16_t* cp = dst + eo;
#pragma unroll
                        for (int ai = 0; ai < 2; ++ai)
#pragma unroll
                            for (int m = 0; m < 4; ++m) cp[ai * 128 + m * 16] = f2bf(acc[ai][bj][m][n][e]);
                        eo += (unsigned)(((n == 1 && e == 3) ? 25 : 1) * KEYS); asm volatile("" : "+v"(eo) :: "memory"); }
        } else {
            const bool isq = T != 7;
            const float* nw = isq ? p.q_norm : p.k_norm;
            f32x4 w4[2][2];
#pragma unroll
            for (int bj = 0; bj < 2; ++bj)
#pragma unroll
                for (int n = 0; n < 2; ++n) w4[bj][n] = *(const f32x4*)(nw + 32 * bj + 8 * fq + 4 * n);
            const float osc = isq ? QSCALE : 1.f;
            const float* ROPE = (const float*)(p.ws + WS_TAB) + 2048;
            const int half = fq >> 1;
            const int rbase = row0 - t0;
            int t = t0;
#pragma unroll
            for (int ai = 0; ai < 2; ++ai)
#pragma unroll
                for (int m = 0; m < 4; ++m) {
                    float ss = 0.f;
#pragma unroll
                    for (int bj = 0; bj < 2; ++bj)
#pragma unroll
                        for (int n = 0; n < 2; ++n) { const f32x4 v = acc[ai][bj][m][n]; ss += v[0] * v[0] + v[1] * v[1] + v[2] * v[2] + v[3] * v[3]; }
                    ss += __shfl_xor(ss, 16); ss += __shfl_xor(ss, 32);
                    const float rs = rsqrtf(ss * (1.f / 64.f) + EPS);
                    bf16_t* dst = isq ? (bf16_t*)(p.ws + WS_AQ) + (size_t)(rbase + t) * 512 + ((T - 5) * 4 + wc) * 64
                                      : (bf16_t*)(p.ws + WS_AK) + ((size_t)b * KEYS + (isctx ? 0 : CTXL) + t) * 128 + wc * 64;
#pragma unroll
                    for (int bj = 0; bj < 2; ++bj) {
                        f32x4 o[2];
#pragma unroll
                        for (int n = 0; n < 2; ++n) {
                            const f32x4 xv = acc[ai][bj][m][n] * rs * w4[bj][n];
                            if (!isctx) {
                                const int pos = bj == 0 ? (t >> 6) : (t & 63);
                                const f32x4* rp = (const f32x4*)(ROPE + 2 * (pos * 16 + 8 * (fq & 1) + 4 * n));
                                const f32x4 cs01 = rp[0], cs23 = rp[1];
                                f32x4 xp;
#pragma unroll
                                for (int e = 0; e < 4; ++e) xp[e] = __shfl_xor(xv[e], 32);
                                const float sg = half == 0 ? -1.f : 1.f;
                                o[n][0] = xv[0] * cs01[0] + sg * xp[0] * cs01[1]; o[n][1] = xv[1] * cs01[2] + sg * xp[1] * cs01[3];
                                o[n][2] = xv[2] * cs23[0] + sg * xp[2] * cs23[1]; o[n][3] = xv[3] * cs23[2] + sg * xp[3] * cs23[3];
                            } else o[n] = xv;
                            o[n] = o[n] * osc;
                        }
                        pg8::u32x4 w; w.x = pg8::cvt_pk_bf16(o[0][0], o[0][1]); w.y = pg8::cvt_pk_bf16(o[0][2], o[0][3]); w.z = pg8::cvt_pk_bf16(o[1][0], o[1][1]); w.w = pg8::cvt_pk_bf16(o[1][2], o[1][3]);
                        *(pg8::u32x4*)(dst + 32 * bj + 8 * fq) = w;
                    }
                    t += (m == 3) ? 80 : 16; asm volatile("" : "+v"(t) :: "memory");
                }
        }
    }
};
__device__ __forceinline__ void p2_inproj_fast(const Params& p, int l, unsigned char* lds_raw) { PHASE_IDS;
    PlainSched S; S.K = D; S.dup = DUPN(3); S.o.init(NTOK, NIN, gridDim.x, bidx_);
    EpiInProj E{{p.ws, p.q_norm + l * 64, p.k_norm + l * 64}, l};
    pg8::gemm_phase((PG8_LAS unsigned char*)lds_raw, (const bf16_t*)(p.ws + WS_HB), (const bf16_t*)(p.ws + WS_WIN) + (size_t)l * NIN * D, D, S, E);
}

struct MoeSched {
    const int* list; const int* tab;
    int G, c, total, dup; bool down;
    __device__ __forceinline__ bool next(int i, pg8::Unit& u) const {
        int L = i * G + c; if (L >= total * dup) return false; if (L >= total) L -= total;
        int e = 0;
#pragma unroll
        for (int q = 1; q < NEXP; ++q) if (L >= tab[q]) e = q;
        e = __builtin_amdgcn_readfirstlane(e);
        const int us = tab[e], sg = tab[17 + e], cn = tab[33 + e];
        const int rem = L - us, mtile = rem >> 2, pn = rem & 3;
        u.pm = mtile; u.pn = pn; u.e = e; u.cnt = __builtin_amdgcn_readfirstlane(cn - mtile * 256); u.a_off = (unsigned)__builtin_amdgcn_readfirstlane(sg + mtile * 256);
        u.b_off = down ? (unsigned)((e * 1024 + pn * 256) * DEXP) * 2u : (unsigned)((e * 1024 + pn * 256) * D) * 2u;
        return true;
    }
    __device__ __forceinline__ unsigned a_row_off(const pg8::Unit& u, int rl, int K) const {
        if (down) return (unsigned)((u.a_off + rl) * K) * 2u;
        const int idx = u.pm * 256 + (rl < u.cnt ? rl : u.cnt - 1);
        const int pair = list[u.e * NTOK + idx];
        return (unsigned)((pair >> 1) * K) * 2u;
    }
};
__device__ __forceinline__ int moe_tables(const unsigned* ctl, int l, int* tab, int tidx) {
    if (tidx == 0) { int u = 0, sgm = 0;
        for (int e = 0; e < NEXP; ++e) { const int n = (int)__hip_atomic_load(ctl + CW_CNT + (l * NEXP + e) * 64, __ATOMIC_RELAXED, __HIP_MEMORY_SCOPE_AGENT); const int mt = (n + 255) >> 8; tab[e] = u; tab[17 + e] = sgm; tab[33 + e] = n; u += mt * 4; sgm += mt * 256; }
        tab[16] = u; }
    __syncthreads();
    return __builtin_amdgcn_readfirstlane(tab[16]);
}
struct EpiGateUp {
    bf16_t* act;
    __device__ __forceinline__ void operator()(f32x4 (&acc)[2][2][4][2], const pg8::Unit& u, int wr, int wc, int fr, int fq) const {
        bf16_t* base = act + (size_t)(u.a_off + wr * 64 + fr) * DEXP + u.pn * 128 + wc * 32 + 8 * fq;
#pragma unroll
        for (int ai = 0; ai < 2; ++ai)
#pragma unroll
            for (int m = 0; m < 4; ++m) {
                f32x4 o[2];
#pragma unroll
                for (int n = 0; n < 2; ++n)
#pragma unroll
                    for (int e = 0; e < 4; ++e) { const float g = acc[ai][0][m][n][e]; o[n][e] = g * __builtin_amdgcn_rcpf(1.f + __expf(-g)) * acc[ai][1][m][n][e]; }
                pg8::u32x4 w; w.x = pg8::cvt_pk_bf16(o[0][0], o[0][1]); w.y = pg8::cvt_pk_bf16(o[0][2], o[0][3]); w.z = pg8::cvt_pk_bf16(o[1][0], o[1][1]); w.w = pg8::cvt_pk_bf16(o[1][2], o[1][3]);
                *(pg8::u32x4*)(base + (size_t)(ai * 128 + m * 16) * DEXP) = w;
            }
    }
};
struct EpiDown {
    bf16_t* Y; const int* list; const f32x4* route;
    __device__ __forceinline__ void operator()(f32x4 (&acc)[2][2][4][2], const pg8::Unit& u, int wr, int wc, int fr, int fq) const {
        int rl = wr * 64 + fr;
        const int col = u.pn * 256 + wc * 32 + 8 * fq;
#pragma unroll
        for (int ai = 0; ai < 2; ++ai)
#pragma unroll
            for (int m = 0; m < 4; ++m) {
                if (rl < u.cnt) {
                    const int pair = list[u.e * NTOK + u.pm * 256 + rl];
                    const float w = ((const float*)(route + (pair >> 1)))[2 + (pair & 1)];
                    bf16_t* dst = Y + (size_t)pair * D + col;
#pragma unroll
                    for (int bj = 0; bj < 2; ++bj) { const f32x4 v0 = acc[ai][bj][m][0] * w, v1 = acc[ai][bj][m][1] * w;
                        pg8::u32x4 o; o.x = pg8::cvt_pk_bf16(v0[0], v0[1]); o.y = pg8::cvt_pk_bf16(v0[2], v0[3]); o.z = pg8::cvt_pk_bf16(v1[0], v1[1]); o.w = pg8::cvt_pk_bf16(v1[2], v1[3]);
                        *(pg8::u32x4*)(dst + bj * 128) = o; }
                }
                rl += (m == 3) ? 80 : 16; asm volatile("" : "+v"(rl) :: "memory");
            }
    }
};
__device__ __forceinline__ void p7_gateup_fast(const Params& p, int l, unsigned char* lds_raw) { PHASE_IDS;
    int* tab = (int*)(lds_raw + LDS_BYTES - 768);
    MoeSched S; S.list = (const int*)(p.ws + WS_LIST) + (size_t)l * NEXP * NTOK; S.tab = tab; S.G = gridDim.x; S.c = bidx_; S.down = false; S.dup = DUPN(9); S.total = moe_tables((const unsigned*)(p.ws + WS_CTL), l, tab, tidx);
    EpiGateUp E{(bf16_t*)(p.ws + WS_ACT)};
    pg8::gemm_phase((PG8_LAS unsigned char*)lds_raw, (const bf16_t*)(p.ws + WS_HB), (const bf16_t*)(p.ws + WS_WGU), D, S, E);
}
__device__ __forceinline__ void p8_down_fast(const Params& p, int l, unsigned char* lds_raw) { PHASE_IDS;
    int* tab = (int*)(lds_raw + LDS_BYTES - 768);
    MoeSched S; S.list = (const int*)(p.ws + WS_LIST) + (size_t)l * NEXP * NTOK; S.tab = tab; S.G = gridDim.x; S.c = bidx_; S.down = true; S.dup = DUPN(10); S.total = moe_tables((const unsigned*)(p.ws + WS_CTL), l, tab, tidx);
    EpiDown E{(bf16_t*)(p.ws + WS_Y), (const int*)(p.ws + WS_LIST) + (size_t)l * NEXP * NTOK, (const f32x4*)(p.ws + WS_ROUTE)};
    pg8::gemm_phase((PG8_LAS unsigned char*)lds_raw, (const bf16_t*)(p.ws + WS_ACT), (const bf16_t*)(p.ws + WS_WD), DEXP, S, E);
}

struct FnetSched {
    int mtiles, nunits, G, c, dup;
    __device__ __forceinline__ bool next(int i, pg8::Unit& u) const {
        int L = i * G + c; if (L >= nunits * dup) return false; if (L >= nunits) L -= nunits;
        u.e = L / mtiles; u.pm = L % mtiles; u.pn = 0; u.cnt = 256; u.a_off = 0; u.b_off = 0; return true;
    }
    __device__ __forceinline__ unsigned a_row_off(const pg8::Unit& u, int rl, int K) const { return (unsigned)((u.pm * 256 + rl) * K) * 2u; }
};
struct FnetSchedK { FnetSched s; int K;
    __device__ __forceinline__ bool next(int i, pg8::Unit& u) const { if (!s.next(i, u)) return false; u.b_off = (unsigned)(u.e * 256 * K) * 2u; return true; }
    __device__ __forceinline__ unsigned a_row_off(const pg8::Unit& u, int rl, int K_) const { return s.a_row_off(u, rl, K_); }
};
struct EpiFnet {
    bf16_t* mix; int row0, rows_per_b; float scale;
    __device__ __forceinline__ void operator()(f32x4 (&acc)[2][2][4][2], const pg8::Unit& u, int wr, int wc, int fr, int fq) const {
        bf16_t* base = mix + (size_t)(row0 + u.e * rows_per_b + u.pm * 256 + wr * 64 + fr) * D + wc * 32 + 8 * fq;
#pragma unroll
        for (int ai = 0; ai < 2; ++ai)
#pragma unroll
            for (int m = 0; m < 4; ++m)
#pragma unroll
                for (int bj = 0; bj < 2; ++bj) { const f32x4 v0 = acc[ai][bj][m][0] * scale, v1 = acc[ai][bj][m][1] * scale;
                    pg8::u32x4 o; o.x = pg8::cvt_pk_bf16(v0[0], v0[1]); o.y = pg8::cvt_pk_bf16(v0[2], v0[3]); o.z = pg8::cvt_pk_bf16(v1[0], v1[1]); o.w = pg8::cvt_pk_bf16(v1[2], v1[3]);
                    *(pg8::u32x4*)(base + (size_t)(ai * 128 + m * 16) * D + bj * 128) = o; }
    }
};
__device__ __forceinline__ void p3_fnet_fast(const Params& p, int l, unsigned char* lds_raw) { PHASE_IDS;
    {
        FnetSchedK S; S.s.dup = DUPN(4); S.s.mtiles = 8; S.s.nunits = 64; S.s.G = gridDim.x; S.s.c = bidx_; S.K = 4096;
        EpiFnet E{(bf16_t*)(p.ws + WS_HB), 0, SEQ, 0.0027621358640099515f};
        pg8::gemm_phase((PG8_LAS unsigned char*)lds_raw, (const bf16_t*)(p.ws + WS_DMAT), (const bf16_t*)(p.ws + WS_YFTL), 4096, S, E);
    }
    if (l == 0) {
        FnetSchedK S; S.s.dup = 1; S.s.mtiles = 1; S.s.nunits = 8; S.s.G = gridDim.x; S.s.c = (bidx_ + (int)gridDim.x - 64) % (int)gridDim.x; S.K = 512;
        EpiFnet E{(bf16_t*)(p.ws + WS_HB), NL, CTXL, 0.0078125f};
        pg8::gemm_phase((PG8_LAS unsigned char*)lds_raw, (const bf16_t*)(p.ws + WS_DMATC), (const bf16_t*)(p.ws + WS_YFTC), 512, S, E);
    }
}

typedef float f32x16 __attribute__((ext_vector_type(16)));
typedef short s16x4 __attribute__((ext_vector_type(4)));
__device__ __forceinline__ void attn_unit(unsigned char* ws, unsigned char* lds_raw, int b, int h, int qrow0, int nkt, int tid) {
    typedef pg8::bf16x8 bf16x8;
    const int lane = tid & 63, wid = tid >> 6, r32 = lane & 31, hi = lane >> 5, kvh = h >> 2;
    const bf16_t* AQ = (const bf16_t*)(ws + WS_AQ); const bf16_t* AK = (const bf16_t*)(ws + WS_AK); const bf16_t* AVT = (const bf16_t*)(ws + WS_AVT);
    bf16_t* MIX = (bf16_t*)(ws + WS_HB);
    const int srow = tid >> 3, sch = tid & 7;
    const bf16_t* kg = AK + ((size_t)b * KEYS + srow) * 128 + kvh * 64 + sch * 8;
    const bf16_t* vg = AVT + ((size_t)(b * 2 + kvh) * 64 + srow) * KEYS + sch * 8;
    const int kst = srow * 128 + ((sch ^ ((srow >> 1) & 7)) << 4);
    const int vst = srow * 128 + ((sch ^ ((srow >> 2) & 7)) << 4);
    const bool vswap = (srow >> 1) & 1;
    unsigned char* Kb = lds_raw; unsigned char* Vb = lds_raw + 16384;
    const int kx = (r32 >> 1) & 7, vx = (r32 >> 1) & 15;
    const int krd = r32 * 128;
    const int vrd = r32 * 128;
    bf16x8 qf[4];
    { const bf16_t* qp = AQ + (size_t)(qrow0 + wid * 32 + r32) * 512 + h * 64 + hi * 8;
#pragma unroll
      for (int s = 0; s < 4; ++s) qf[s] = *(const bf16x8*)(qp + s * 16); }
    f32x16 o0 = {}, o1 = {};
    float mrow = -1e30f, lrow = 0.f;
    pg8::u32x4 kreg = *(const pg8::u32x4*)kg, vreg = *(const pg8::u32x4*)vg;
    __syncthreads();
    *(pg8::u32x4*)(Kb + kst) = kreg; *(pg8::u32x4*)(Vb + vst) = vswap ? (pg8::u32x4){vreg.z, vreg.w, vreg.x, vreg.y} : vreg;
    __syncthreads();
    for (int t = 0; t < nkt; ++t) {
        const int cur = (t & 1) * 8192;
        if (t + 1 < nkt) { kreg = *(const pg8::u32x4*)(kg + (size_t)(t + 1) * 64 * 128); vreg = *(const pg8::u32x4*)(vg + (t + 1) * 64); }
        f32x16 p0 = {}, p1 = {};
#pragma unroll
        for (int s = 0; s < 4; ++s) {
            const bf16x8 k0 = *(const bf16x8*)(Kb + cur + krd + (((2 * s + hi) ^ kx) << 4));
            const bf16x8 k1 = *(const bf16x8*)(Kb + cur + 4096 + krd + (((2 * s + hi) ^ kx) << 4));
            p0 = __builtin_amdgcn_mfma_f32_32x32x16_bf16(k0, qf[s], p0, 0, 0, 0);
            p1 = __builtin_amdgcn_mfma_f32_32x32x16_bf16(k1, qf[s], p1, 0, 0, 0);
        }
        float mx = p0[0];
#pragma unroll
        for (int r = 1; r < 16; ++r) mx = fmaxf(mx, p0[r]);
#pragma unroll
        for (int r = 0; r < 16; ++r) mx = fmaxf(mx, p1[r]);
        { auto rr = __builtin_amdgcn_permlane32_swap(__float_as_uint(mx), __float_as_uint(mx), false, false); mx = fmaxf(__uint_as_float(rr[0]), __uint_as_float(rr[1])); }
        const float mn = fmaxf(mrow, mx), alpha = __builtin_amdgcn_exp2f(mrow - mn);
        mrow = mn;
        float sum = 0.f;
#pragma unroll
        for (int r = 0; r < 16; ++r) { p0[r] = __builtin_amdgcn_exp2f(p0[r] - mn); sum += p0[r]; }
#pragma unroll
        for (int r = 0; r < 16; ++r) { p1[r] = __builtin_amdgcn_exp2f(p1[r] - mn); sum += p1[r]; }
        lrow = lrow * alpha + sum;
#pragma unroll
        for (int r = 0; r < 16; ++r) { o0[r] *= alpha; o1[r] *= alpha; }
        bf16x8 pf[4];
#pragma unroll
        for (int s = 0; s < 2; ++s) {
            pg8::u32x4 w0, w1;
            w0.x = pg8::cvt_pk_bf16(p0[8 * s + 0], p0[8 * s + 1]); w0.y = pg8::cvt_pk_bf16(p0[8 * s + 2], p0[8 * s + 3]); w0.z = pg8::cvt_pk_bf16(p0[8 * s + 4], p0[8 * s + 5]); w0.w = pg8::cvt_pk_bf16(p0[8 * s + 6], p0[8 * s + 7]);
            w1.x = pg8::cvt_pk_bf16(p1[8 * s + 0], p1[8 * s + 1]); w1.y = pg8::cvt_pk_bf16(p1[8 * s + 2], p1[8 * s + 3]); w1.z = pg8::cvt_pk_bf16(p1[8 * s + 4], p1[8 * s + 5]); w1.w = pg8::cvt_pk_bf16(p1[8 * s + 6], p1[8 * s + 7]);
            pf[s] = __builtin_bit_cast(bf16x8, w0); pf[2 + s] = __builtin_bit_cast(bf16x8, w1);
        }
#pragma unroll
        for (int ks = 0; ks < 4; ++ks) {
            const s16x4 a0 = *(const s16x4*)(Vb + cur + vrd + (((4 * ks + hi) ^ vx) << 3));
            const s16x4 a1 = *(const s16x4*)(Vb + cur + vrd + (((4 * ks + 2 + hi) ^ vx) << 3));
            const s16x4 c0 = *(const s16x4*)(Vb + cur + 4096 + vrd + (((4 * ks + hi) ^ vx) << 3));
            const s16x4 c1 = *(const s16x4*)(Vb + cur + 4096 + vrd + (((4 * ks + 2 + hi) ^ vx) << 3));
            const bf16x8 va = {a0[0], a0[1], a0[2], a0[3], a1[0], a1[1], a1[2], a1[3]};
            const bf16x8 vc = {c0[0], c0[1], c0[2], c0[3], c1[0], c1[1], c1[2], c1[3]};
            o0 = __builtin_amdgcn_mfma_f32_32x32x16_bf16(va, pf[ks], o0, 0, 0, 0);
            o1 = __builtin_amdgcn_mfma_f32_32x32x16_bf16(vc, pf[ks], o1, 0, 0, 0);
        }
        if (t + 1 < nkt) { const int nx = 8192 - cur; *(pg8::u32x4*)(Kb + nx + kst) = kreg; *(pg8::u32x4*)(Vb + nx + vst) = vswap ? (pg8::u32x4){vreg.z, vreg.w, vreg.x, vreg.y} : vreg; }
        __syncthreads();
    }
    { auto rr = __builtin_amdgcn_permlane32_swap(__float_as_uint(lrow), __float_as_uint(lrow), false, false); lrow = __uint_as_float(rr[0]) + __uint_as_float(rr[1]); }
    const float inv = 1.f / lrow;
    bf16_t* op = MIX + (size_t)(qrow0 + wid * 32 + r32) * D + 512 + h * 64 + 4 * hi;
#pragma unroll
    for (int g = 0; g < 4; ++g) {
        pg8::u32x2 w0, w1;
        w0.x = pg8::cvt_pk_bf16(o0[4 * g] * inv, o0[4 * g + 1] * inv); w0.y = pg8::cvt_pk_bf16(o0[4 * g + 2] * inv, o0[4 * g + 3] * inv);
        w1.x = pg8::cvt_pk_bf16(o1[4 * g] * inv, o1[4 * g + 1] * inv); w1.y = pg8::cvt_pk_bf16(o1[4 * g + 2] * inv, o1[4 * g + 3] * inv);
        *(pg8::u32x2*)(op + 8 * g) = w0; *(pg8::u32x2*)(op + 32 + 8 * g) = w1;
    }
}
__device__ __forceinline__ void p3_attn_fast(const Params& p, int l, unsigned char* lds_raw) { PHASE_IDS;
    const int G = gridDim.x;
    const int skip = G >= 128 ? 64 : 0, Ga = G - skip;
    if (bidx_ >= skip)
        for (int u = bidx_ - skip; u < BATCH * 8 * 8; u += Ga) { const int qb = u & 7, h = (u >> 3) & 7, b = u >> 6; attn_unit(p.ws, lds_raw, b, h, b * SEQ + qb * 256, KEYS / 64, tidx); }
    if (l == 0) for (int u = bidx_; u < BATCH * 8; u += G) { const int h = u & 7, b = u >> 3; attn_unit(p.ws, lds_raw, b, h, NL + b * CTXL, CTXL / 64, tidx); }
}

struct GlaPrep { float cum[16], tot[16], q[16], k[16]; };
struct GlaIn { pg8::u32x4 gd[2], qk[4], gv[2]; };
__device__ __forceinline__ void gla_load(GlaIn& in, const unsigned char* ws, int row0, int h, int w4, int lane, int tg) {
    const int dir = w4 >> 1, kh = w4 & 1, row = row0 + lane;
    const bf16_t* GD = (const bf16_t*)(ws + WS_GD); const bf16_t* GQK = (const bf16_t*)(ws + WS_GQK); const bf16_t* GV = (const bf16_t*)(ws + WS_GV);
    in.gd[0] = *(const pg8::u32x4*)(GD + (size_t)row * 32 + dir * 16); in.gd[1] = *(const pg8::u32x4*)(GD + (size_t)row * 32 + dir * 16 + 8);
    const bf16_t* qp = GQK + (size_t)row * 256 + h * 32 + kh * 16;
    in.qk[0] = *(const pg8::u32x4*)qp; in.qk[1] = *(const pg8::u32x4*)(qp + 8); in.qk[2] = *(const pg8::u32x4*)(qp + 128); in.qk[3] = *(const pg8::u32x4*)(qp + 136);
    const int t = tg >> 2, c = tg & 3;
    in.gv[0] = *(const pg8::u32x4*)(GV + (size_t)(row0 + t) * 256 + h * 64 + 16 * c); in.gv[1] = *(const pg8::u32x4*)(GV + (size_t)(row0 + t) * 256 + h * 64 + 16 * c + 8);
}
__device__ __forceinline__ void gla_prep(GlaPrep& g, const GlaIn& in, const float* wlds, int h, int w4, int lane) {
    const int dir = w4 >> 1, kh = w4 & 1;
    float gd[16];
    { const unsigned w[8] = {in.gd[0].x, in.gd[0].y, in.gd[0].z, in.gd[0].w, in.gd[1].x, in.gd[1].y, in.gd[1].z, in.gd[1].w};
#pragma unroll
      for (int i = 0; i < 8; ++i) { gd[2 * i] = __uint_as_float(w[i] << 16); gd[2 * i + 1] = __uint_as_float(w[i] & 0xffff0000u); } }
    const float* wu = wlds + dir * 2048 + h * 32 + kh * 16;
    const float* bu = wlds + 4096 + dir * 128 + h * 32 + kh * 16;
#pragma unroll
    for (int kk = 0; kk < 16; ++kk) g.cum[kk] = bu[kk];
#pragma unroll
    for (int r = 0; r < 16; ++r) {
#pragma unroll
        for (int kk = 0; kk < 16; ++kk) g.cum[kk] = fmaf(gd[r], wu[r * 128 + kk], g.cum[kk]);
    }
#pragma unroll
    for (int kk = 0; kk < 16; ++kk) { const float z = g.cum[kk]; g.cum[kk] = (fminf(z, 0.f) - __logf(1.f + __expf(-fabsf(z)))) * (1.f / 16.f); }
#pragma unroll
    for (int off = 1; off < 64; off <<= 1) {
        const int src = dir == 0 ? lane - off : lane + off; const bool ok = (unsigned)src < 64u;
#pragma unroll
        for (int kk = 0; kk < 16; ++kk) {
            const float y = __shfl(g.cum[kk], src & 63);
            g.cum[kk] += ok ? y : 0.f;
        }
    }
#pragma unroll
    for (int kk = 0; kk < 16; ++kk) g.tot[kk] = __shfl(g.cum[kk], dir == 0 ? 63 : 0);
    { const unsigned wq[8] = {in.qk[0].x, in.qk[0].y, in.qk[0].z, in.qk[0].w, in.qk[1].x, in.qk[1].y, in.qk[1].z, in.qk[1].w}, wk[8] = {in.qk[2].x, in.qk[2].y, in.qk[2].z, in.qk[2].w, in.qk[3].x, in.qk[3].y, in.qk[3].z, in.qk[3].w};
#pragma unroll
      for (int i = 0; i < 8; ++i) { g.q[2 * i] = __uint_as_float(wq[i] << 16); g.q[2 * i + 1] = __uint_as_float(wq[i] & 0xffff0000u); g.k[2 * i] = __uint_as_float(wk[i] << 16); g.k[2 * i + 1] = __uint_as_float(wk[i] & 0xffff0000u); } }
}
__device__ __forceinline__ void gla_stage_w(float* wlds, const Params& p, int l, int tidx) {
    for (int i = tidx; i < 4096; i += NTHREADS) wlds[i] = p.w_gup[(size_t)l * 4096 + i];
    if (tidx < 256) wlds[4096 + tidx] = p.b_gg[l * 256 + tidx];
    __syncthreads();
}
__device__ __forceinline__ void gla_write_vt(bf16_t* VT, const GlaIn& in, int tg) {
    const int t = tg >> 2, c = tg & 3;
    const unsigned w[8] = {in.gv[0].x, in.gv[0].y, in.gv[0].z, in.gv[0].w, in.gv[1].x, in.gv[1].y, in.gv[1].z, in.gv[1].w};
#pragma unroll
    for (int i = 0; i < 8; ++i) { VT[(16 * c + 2 * i) * 72 + t] = (bf16_t)(w[i] & 0xffffu); VT[(16 * c + 2 * i + 1) * 72 + t] = (bf16_t)(w[i] >> 16); }
}
__device__ __forceinline__ int gla_row0(int b, int cs) { return cs < 4 ? NL + b * CTXL + cs * 64 : b * SEQ + (cs - 4) * 64; }

__device__ __forceinline__ void p3_gla_local_fast(const Params& p, int l, unsigned char* lds_raw) { PHASE_IDS;
    typedef pg8::bf16x8 bf16x8;
    const int grp = __builtin_amdgcn_readfirstlane(tidx >> 8), tg = tidx & 255, w4 = __builtin_amdgcn_readfirstlane((tidx >> 6) & 3), lane = tidx & 63;
    bf16_t* KT = (bf16_t*)(lds_raw + grp * 32768);
    bf16_t* VT = KT + 2 * 32 * 72;
    float* AST = (float*)(p.ws + WS_AST); float* DEC = (float*)(p.ws + WS_DEC);
    float* wlds = (float*)(lds_raw + 65536); gla_stage_w(wlds, p, l, tidx);
    const int nitems = BATCH * NCHK * 4;
    for (int pi = bidx_; pi * 2 < nitems; pi += gridDim.x) {
        const int it = pi * 2 + grp; const bool valid = it < nitems;
        const int h = it & 3, cs = (it >> 2) % NCHK, b = it / (4 * NCHK);
        const int dir = w4 >> 1, kh = w4 & 1;
        GlaIn in;
        if (valid) gla_load(in, p.ws, gla_row0(b, cs), h, w4, lane, tg);
        __syncthreads();
        if (valid) {
            GlaPrep g; gla_prep(g, in, wlds, h, w4, lane);
#pragma unroll
            for (int kk = 0; kk < 16; ++kk) KT[(dir * 32 + kh * 16 + kk) * 72 + lane] = f2bf(g.k[kk] * __expf(g.tot[kk] - g.cum[kk]));
            if (lane == 0) {
#pragma unroll
                for (int kk = 0; kk < 16; ++kk) DEC[((size_t)it * 2 + dir) * 32 + kh * 16 + kk] = __expf(g.tot[kk]);
            }
            gla_write_vt(VT, in, tg);
        }
        __syncthreads();
        if (valid) {
            const int r = lane & 15, q4 = lane >> 4, kt = kh;
            float* dst = AST + ((size_t)it * 2 + dir) * 2048;
#pragma unroll
            for (int vt = 0; vt < 4; ++vt) {
                f32x4 acc = {0.f, 0.f, 0.f, 0.f};
#pragma unroll
                for (int ks = 0; ks < 2; ++ks) {
                    const bf16x8 a = *(const bf16x8*)(KT + (dir * 32 + kt * 16 + r) * 72 + ks * 32 + q4 * 8);
                    const bf16x8 bb = *(const bf16x8*)(VT + (vt * 16 + r) * 72 + ks * 32 + q4 * 8);
                    acc = __builtin_amdgcn_mfma_f32_16x16x32_bf16(a, bb, acc, 0, 0, 0);
                }
                *(f32x4*)(dst + (vt * 16 + r) * 32 + kt * 16 + q4 * 4) = acc;
            }
        }
    }
}
__device__ __forceinline__ void p3_gla_scan_fast(const Params& p) { PHASE_IDS;
    const float* AST = (const float*)(p.ws + WS_AST); const float* DEC = (const float*)(p.ws + WS_DEC);
    bf16_t* ST = (bf16_t*)(p.ws + WS_ST);
    for (int i = GT; i < BATCH * 4 * 2 * 2048; i += NGT) {
        const int e = i & 2047, dir = (i >> 11) & 1, h = (i >> 12) & 3, b = i >> 14, k = e & 31;
        float a[NCHK], d[NCHK];
#pragma unroll
        for (int q = 0; q < NCHK; ++q) { const int cs = dir == 0 ? q : (q < 4 ? 3 - q : NCHK + 3 - q); const size_t id = (((size_t)b * NCHK + cs) * 4 + h) * 2 + dir; a[q] = AST[id * 2048 + e]; d[q] = DEC[id * 32 + k]; }
        float s = 0.f;
#pragma unroll
        for (int q = 0; q < NCHK; ++q) { const int cs = dir == 0 ? q : (q < 4 ? 3 - q : NCHK + 3 - q); const size_t id = (((size_t)b * NCHK + cs) * 4 + h) * 2 + dir; ST[id * 2048 + e] = f2bf(s); s = d[q] * s + a[q]; }
    }
}
__device__ __forceinline__ void p4_gla_out_fast(const Params& p, int l, unsigned char* lds_raw) { PHASE_IDS;
    typedef pg8::bf16x8 bf16x8;
    const int grp = __builtin_amdgcn_readfirstlane(tidx >> 8), tg = tidx & 255, w4 = __builtin_amdgcn_readfirstlane((tidx >> 6) & 3), lane = tidx & 63;
    bf16_t* QT = (bf16_t*)(lds_raw + grp * 58368);
    bf16_t* KL = QT + 2 * 64 * 40;
    bf16_t* SL = KL + 2 * 64 * 40;
    bf16_t* VT = SL + 2 * 64 * 40;
    bf16_t* ATT = VT + 64 * 72;
    bf16_t* GL = ATT + 64 * 72;
    const bf16_t* ST = (const bf16_t*)(p.ws + WS_ST); const bf16_t* GG = (const bf16_t*)(p.ws + WS_GG);
    bf16_t* MIX = (bf16_t*)(p.ws + WS_HB);
    float* wlds = (float*)(lds_raw + 116736); gla_stage_w(wlds, p, l, tidx);
    const int cs0 = l == 1 ? 4 : 0, ncs = NCHK - cs0, nitems = BATCH * ncs * 4;
    for (int pi = bidx_; pi * 2 < nitems; pi += gridDim.x) {
        const int itl = pi * 2 + grp; const bool valid = itl < nitems;
        const int h = itl & 3, cs = cs0 + (itl >> 2) % ncs, b = itl / (4 * ncs);
        const int it = (b * NCHK + cs) * 4 + h;
        const int dir = w4 >> 1, kh = w4 & 1;
        const int row0 = gla_row0(b, cs);
        GlaIn in; pg8::u32x4 st[2], gg[2];
        const int gr = tg >> 2, gc = tg & 3;
        if (valid) {
            gla_load(in, p.ws, row0, h, w4, lane, tg);
#pragma unroll
            for (int j = 0; j < 2; ++j) { const int pc = tg + 256 * j, d2 = pc >> 8, v = (pc >> 2) & 63, c = pc & 3; st[j] = *(const pg8::u32x4*)(ST + ((size_t)it * 2 + d2) * 2048 + v * 32 + c * 8); }
            gg[0] = *(const pg8::u32x4*)(GG + (size_t)(row0 + gr) * 256 + h * 64 + 16 * gc); gg[1] = *(const pg8::u32x4*)(GG + (size_t)(row0 + gr) * 256 + h * 64 + 16 * gc + 8);
        }
        __syncthreads();
        if (valid) {
            GlaPrep g; gla_prep(g, in, wlds, h, w4, lane);
            pg8::u32x4 wq[2], wk[2];
#pragma unroll
            for (int i = 0; i < 8; ++i) {
                const float e0 = __expf(g.cum[2 * i]), e1 = __expf(g.cum[2 * i + 1]);
                ((unsigned*)wq)[i] = pg8::cvt_pk_bf16(g.q[2 * i] * e0, g.q[2 * i + 1] * e1);
                ((unsigned*)wk)[i] = pg8::cvt_pk_bf16(g.k[2 * i] * __builtin_amdgcn_rcpf(e0), g.k[2 * i + 1] * __builtin_amdgcn_rcpf(e1));
            }
            *(pg8::u32x4*)(QT + (dir * 64 + lane) * 40 + kh * 16) = wq[0]; *(pg8::u32x4*)(QT + (dir * 64 + lane) * 40 + kh * 16 + 8) = wq[1];
            *(pg8::u32x4*)(KL + (dir * 64 + lane) * 40 + kh * 16) = wk[0]; *(pg8::u32x4*)(KL + (dir * 64 + lane) * 40 + kh * 16 + 8) = wk[1];
            gla_write_vt(VT, in, tg);
#pragma unroll
            for (int j = 0; j < 2; ++j) { const int pc = tg + 256 * j, d2 = pc >> 8, v = (pc >> 2) & 63, c = pc & 3; *(pg8::u32x4*)(SL + (d2 * 64 + v) * 40 + c * 8) = st[j]; }
            *(pg8::u32x4*)(GL + gr * 72 + 16 * gc) = gg[0]; *(pg8::u32x4*)(GL + gr * 72 + 16 * gc + 8) = gg[1];
        }
        __syncthreads();
        if (valid) {
            const int r = lane & 15, q4 = lane >> 4, i0 = 16 * w4;
            const bf16x8 aF = *(const bf16x8*)(QT + (0 * 64 + i0 + r) * 40 + q4 * 8), aB = *(const bf16x8*)(QT + (1 * 64 + i0 + r) * 40 + q4 * 8);
#pragma unroll
            for (int jt = 0; jt < 4; ++jt) {
                const bf16x8 bF = *(const bf16x8*)(KL + (0 * 64 + jt * 16 + r) * 40 + q4 * 8), bB = *(const bf16x8*)(KL + (1 * 64 + jt * 16 + r) * 40 + q4 * 8);
                const f32x4 z = {0.f, 0.f, 0.f, 0.f};
                const f32x4 F = __builtin_amdgcn_mfma_f32_16x16x32_bf16(aF, bF, z, 0, 0, 0), Bv = __builtin_amdgcn_mfma_f32_16x16x32_bf16(aB, bB, z, 0, 0, 0);
                const int j = jt * 16 + r;
#pragma unroll
                for (int e = 0; e < 4; ++e) { const int i = i0 + 4 * q4 + e; const float v = (j <= i ? F[e] : 0.f) + (j >= i ? Bv[e] : 0.f); ATT[i * 72 + j] = f2bf(v); }
            }
            __builtin_amdgcn_s_waitcnt(0);
            f32x4 o[4];
#pragma unroll
            for (int vt = 0; vt < 4; ++vt) {
                f32x4 acc = {0.f, 0.f, 0.f, 0.f};
#pragma unroll
                for (int ks = 0; ks < 2; ++ks) {
                    const bf16x8 a = *(const bf16x8*)(ATT + (i0 + r) * 72 + ks * 32 + q4 * 8);
                    const bf16x8 bb = *(const bf16x8*)(VT + (vt * 16 + r) * 72 + ks * 32 + q4 * 8);
                    acc = __builtin_amdgcn_mfma_f32_16x16x32_bf16(a, bb, acc, 0, 0, 0);
                }
                const bf16x8 sF = *(const bf16x8*)(SL + (0 * 64 + vt * 16 + r) * 40 + q4 * 8), sB = *(const bf16x8*)(SL + (1 * 64 + vt * 16 + r) * 40 + q4 * 8);
                acc = __builtin_amdgcn_mfma_f32_16x16x32_bf16(aF, sF, acc, 0, 0, 0);
                acc = __builtin_amdgcn_mfma_f32_16x16x32_bf16(aB, sB, acc, 0, 0, 0);
                o[vt] = acc;
            }
            float gn[4];
#pragma unroll
            for (int vt = 0; vt < 4; ++vt) gn[vt] = p.gla_norm[l * 64 + vt * 16 + r];
#pragma unroll
            for (int e = 0; e < 4; ++e) {
                float ss = o[0][e] * o[0][e] + o[1][e] * o[1][e] + o[2][e] * o[2][e] + o[3][e] * o[3][e];
                ss += __shfl_xor(ss, 1); ss += __shfl_xor(ss, 2); ss += __shfl_xor(ss, 4); ss += __shfl_xor(ss, 8);
                const float rs = rsqrtf(ss * (1.f / 64.f) + EPS);
                bf16_t* gl = GL + (i0 + 4 * q4 + e) * 72 + r;
#pragma unroll
                for (int vt = 0; vt < 4; ++vt) { const float gt = bf2f(gl[vt * 16]); gl[vt * 16] = f2bf(o[vt][e] * rs * gn[vt] * gt * __builtin_amdgcn_rcpf(1.f + __expf(-gt))); }
            }
        }
        __syncthreads();
        if (valid) { *(pg8::u32x4*)(MIX + (size_t)(row0 + gr) * D + 256 + h * 64 + 16 * gc) = *(const pg8::u32x4*)(GL + gr * 72 + 16 * gc); *(pg8::u32x4*)(MIX + (size_t)(row0 + gr) * D + 256 + h * 64 + 16 * gc + 8) = *(const pg8::u32x4*)(GL + gr * 72 + 16 * gc + 8); }
    }
}

#define LAS __attribute__((address_space(3)))
__device__ __forceinline__ void conv_item(const float* W, int ldw, int k0, int n, bool valid, bf16_t* dst_row  ) {
    float v[64];
    const float* src = W + (size_t)k0 * ldw + (valid ? n : 0);
#pragma unroll
    for (int i = 0; i < 64; ++i) v[i] = src[(size_t)i * ldw];
    if (valid) {
#pragma unroll
        for (int g = 0; g < 8; ++g) { pg8::u32x4 o; o.x = pg8::cvt_pk_bf16(v[8 * g], v[8 * g + 1]); o.y = pg8::cvt_pk_bf16(v[8 * g + 2], v[8 * g + 3]); o.z = pg8::cvt_pk_bf16(v[8 * g + 4], v[8 * g + 5]); o.w = pg8::cvt_pk_bf16(v[8 * g + 6], v[8 * g + 7]);
            *(pg8::u32x4*)(dst_row + 8 * g) = o; }
    }
}
__host__ __device__ __forceinline__ int tile_pos(int lc) { return 128 * ((lc >> 5) & 1) + 32 * (lc >> 6) + (lc & 31); }
__device__ __forceinline__ int inproj_dest(int c) {
    int T, lc;
    if (c < C_GV) { T = 2; lc = c - C_GQ; } else if (c < C_GG) { T = 3; lc = c - C_GV; } else if (c < C_GDF) { T = 4; lc = c - C_GG; }
    else if (c < C_AQ) { T = 8; lc = c - C_GDF; } else if (c < C_AQ + 256) { T = 5; lc = c - C_AQ; } else if (c < C_AK) { T = 6; lc = c - C_AQ - 256; } else { T = 7; lc = c - C_AK; }
    return T * 256 + tile_pos(lc);
}
__device__ __forceinline__ void convert_experts(const Params& p, int l, float* lds) { PHASE_IDS;
    const int lane = tidx & 63;
    bf16_t* WGU = (bf16_t*)(p.ws + WS_WGU); bf16_t* WD = (bf16_t*)(p.ws + WS_WD);
    for (int it = GW; it < 2 * NEXP * 16 * 8; it += NGW) {
        const int nb = it & 7, kb = (it >> 3) & 15, e = (it >> 7) & 15, part = it >> 11, n = nb * 64 + lane;
        const float* W = (part == 0 ? p.w_eg : p.w_eu) + (size_t)(l * NEXP + e) * D * DEXP;
        conv_item(W, DEXP, kb * 64, n, true, WGU + ((size_t)e * 1024 + (n >> 7) * 256 + part * 128 + (n & 127)) * D + kb * 64);
    }
    for (int it = GW; it < NEXP * 8 * 16; it += NGW) {
        const int nb = it & 15, kb = (it >> 4) & 7, e = it >> 7, n = nb * 64 + lane;
        conv_item(p.w_ed + (size_t)(l * NEXP + e) * DEXP * D, D, kb * 64, n, true, WD + ((size_t)e * 1024 + n) * DEXP + kb * 64);
    }
}
__device__ __forceinline__ void p0a_fast(const Params& p, float* lds) { PHASE_IDS;
    const int lane = tidx & 63, wave = tidx >> 6;
    float* scr = lds + wave * 2304;
    bf16_t* WIN = (bf16_t*)(p.ws + WS_WIN); bf16_t* WOUT = (bf16_t*)(p.ws + WS_WOUT);
    for (int it = GW; it < 2 * 16 * 25; it += NGW) {
        const int nb = it % 25, kb = (it / 25) & 15, l = it / (25 * 16), n = 256 + nb * 64 + lane; const bool valid = n < DIN;
        conv_item(p.w_in + (size_t)l * D * DIN, DIN, kb * 64, n, valid, WIN + ((size_t)l * NIN + inproj_dest(valid ? n : 256)) * D + kb * 64);
    }
    for (int it = GW; it < 2 * 16 * 16; it += NGW) {
        const int nb = it & 15, kb = (it >> 4) & 15, l = it >> 8, n = nb * 64 + lane;
        conv_item(p.w_out + (size_t)l * D * D, D, kb * 64, n, true, WOUT + ((size_t)l * D + n) * D + kb * 64);
    }
    { float sn, cs; sincos_r((float)lane * 0.09817477042468103f, sn, cs); scr[2 * lane] = cs; scr[2 * lane + 1] = sn; }
    float* tile = scr + 128;
    for (int it = GW; it < 2 * 16 * 4 * 4; it += NGW) {
        const int jq = it & 3, g = (it >> 2) & 3, kb = (it >> 4) & 15, l = it >> 8;
        const float* W = p.w_in + (size_t)l * D * DIN;
        float yr[16], ys[16];
#pragma unroll
        for (int jj = 0; jj < 16; ++jj) { yr[jj] = 0.f; ys[jj] = 0.f; }
        for (int half = 0; half < 2; ++half) {
            __builtin_amdgcn_s_waitcnt(0); asm volatile("" ::: "memory");
#pragma unroll 8
            for (int i = 0; i < 32; ++i) { const int kk = 2 * i + (lane >> 5); tile[kk * 33 + (lane & 31)] = W[(size_t)(kb * 64 + kk) * DIN + g * 64 + half * 32 + (lane & 31)]; }
            __builtin_amdgcn_s_waitcnt(0); asm volatile("" ::: "memory");
            for (int cc = 0; cc < 32; ++cc) {
                const float u = tile[lane * 33 + cc]; const int c = half * 32 + cc;
#pragma unroll
                for (int jj = 0; jj < 16; ++jj) { const int m = ((jq * 16 + jj) * c) & 63; yr[jj] = fmaf(u, scr[2 * m], yr[jj]); ys[jj] = fmaf(u, scr[2 * m + 1], ys[jj]); }
            }
        }
#pragma unroll
        for (int jj = 0; jj < 16; ++jj) { const int j = jq * 16 + jj; const size_t row = (size_t)l * NIN + tile_pos(g * 64 + j);
            WIN[(row) * D + kb * 64 + lane] = f2bf(yr[jj]); WIN[(row + 256) * D + kb * 64 + lane] = f2bf(ys[jj]); }
    }
    for (int i = GT; i < 2 * 224 * (D / 8); i += NGT) {
        const int k8 = i & 127, lc = 32 + (i >> 7) % 224, l = i / (224 * 128);
        *(pg8::u32x4*)(WIN + ((size_t)l * NIN + 8 * 256 + tile_pos(lc)) * D + k8 * 8) = (pg8::u32x4){0u, 0u, 0u, 0u};
    }
    {
        bf16_t* DM = (bf16_t*)(p.ws + WS_DMAT);
        for (int i = GT; i < 2048 * 4096 / 8; i += NGT) {
            const int t8 = (i & 511) * 8, k = i >> 9; unsigned w[4];
#pragma unroll
            for (int q = 0; q < 4; ++q) { float v[2];
#pragma unroll
                for (int e = 0; e < 2; ++e) { const int tt = t8 + 2 * q + e, t = tt & 2047; const int m = (k * t) & 2047; float sn, cs; sincos_r((float)m * (6.283185307179586f / 2048.f), sn, cs); v[e] = tt < 2048 ? cs : -sn; }
                w[q] = pg8::cvt_pk_bf16(v[0], v[1]); }
            *(pg8::u32x4*)(DM + (size_t)k * 4096 + t8) = (pg8::u32x4){w[0], w[1], w[2], w[3]};
        }
        bf16_t* DC = (bf16_t*)(p.ws + WS_DMATC);
        for (int i = GT; i < 256 * 512 / 8; i += NGT) {
            const int t8 = (i & 63) * 8, k = i >> 6; unsigned w[4];
#pragma unroll
            for (int q = 0; q < 4; ++q) { float v[2];
#pragma unroll
                for (int e = 0; e < 2; ++e) { const int tt = t8 + 2 * q + e, t = tt & 255; const int m = (k * t) & 255; float sn, cs; sincos_r((float)m * (6.283185307179586f / 256.f), sn, cs); v[e] = tt < 256 ? cs : -sn; }
                w[q] = pg8::cvt_pk_bf16(v[0], v[1]); }
            *(pg8::u32x4*)(DC + (size_t)k * 512 + t8) = (pg8::u32x4){w[0], w[1], w[2], w[3]};
        }
    }
    convert_experts(p, 0, lds);
}

#define XB_TMO      128
#define XB_XCNT(j)  (256  + 64 * (j))
#define XB_XSUB(j)  (1280 + 64 * (j))
#define XB_XGEN(j)  (2304 + 64 * (j))
#define XB_TOP      3328
#define XB_TOPGEN   3392
#define XCD_BAR_WORDS 3456
#define XB_SPIN_CAP (1u << 18)
__device__ __forceinline__ unsigned xb_ld(unsigned* p)              { return __hip_atomic_load(p, __ATOMIC_RELAXED, __HIP_MEMORY_SCOPE_AGENT); }
__device__ __forceinline__ unsigned xb_add(unsigned* p, unsigned v) { return __hip_atomic_fetch_add(p, v, __ATOMIC_RELAXED, __HIP_MEMORY_SCOPE_AGENT); }
__device__ __forceinline__ unsigned xb_xcc_id() { return (unsigned)__builtin_amdgcn_s_getreg((3 << 11) | 20) & 0xFu; }
#define XB_SPIN(cond, bar) do { unsigned _sp = 0; while (cond) { __builtin_amdgcn_s_sleep(1); \
    if ((++_sp & 255u) == 0u) { if (xb_ld(&(bar)[XB_TMO])) break; if (_sp > XB_SPIN_CAP) { atomicAdd(&(bar)[XB_TMO], 1u); break; } } } } while (0)
struct XcdBarrier { unsigned* bar; unsigned x; volatile __attribute__((address_space(3))) unsigned* st; };
__device__ __forceinline__ XcdBarrier xcd_barrier_post(unsigned* bar, volatile __attribute__((address_space(3))) unsigned* st) {
    XcdBarrier b; b.bar = bar; b.x = xb_xcc_id(); b.st = st;
    if (threadIdx.x == 0) (void)xb_add(&bar[XB_XCNT(b.x)], 1u);
    return b;
}
__device__ __forceinline__ void xcd_barrier_complete(unsigned* bar, unsigned x, unsigned& nloc, unsigned& nx) {
    const unsigned G = gridDim.x * gridDim.y * gridDim.z;
    unsigned sum, cnt, mine, sp = 0u;
    for (;;) {
        sum = 0u; cnt = 0u; mine = 0u;
#pragma unroll
        for (unsigned j = 0; j < 16; ++j) { const unsigned c = xb_ld(&bar[XB_XCNT(j)]); sum += c; cnt += (c > 0u) ? 1u : 0u; mine = (j == x) ? c : mine; }
        if (sum == G) break;
        __builtin_amdgcn_s_sleep(1);
        if ((++sp & 255u) == 0u) { if (xb_ld(&bar[XB_TMO])) break; if (sp > XB_SPIN_CAP) { atomicAdd(&bar[XB_TMO], 1u); break; } }
    }
    nloc = mine > 0u ? mine : 1u; nx = cnt > 0u ? cnt : 1u;
}
__device__ __forceinline__ void xcd_barrier(const XcdBarrier& b) {
    asm volatile("s_waitcnt vmcnt(0)" ::: "memory");
    __syncthreads();
    if (threadIdx.x == 0) {
        unsigned* bar = b.bar;
        __builtin_amdgcn_s_waitcnt(0);
        unsigned nloc = b.st[0], nx = b.st[1];
        if (nloc == 0u) { xcd_barrier_complete(bar, b.x, nloc, nx); b.st[0] = nloc; b.st[1] = nx; }
        const unsigned old = xb_add(&bar[XB_XSUB(b.x)], 1u);
        const unsigned gen = old / nloc;
        if (old + 1u == (gen + 1u) * nloc) {
            __builtin_amdgcn_fence(__ATOMIC_RELEASE, "agent");
            asm volatile("s_waitcnt vmcnt(0)" ::: "memory");
            const unsigned og = xb_add(&bar[XB_TOP], 1u);
            const unsigned tg = og / nx;
            if (og + 1u == (tg + 1u) * nx) xb_add(&bar[XB_TOPGEN], 1u);
            else XB_SPIN(xb_ld(&bar[XB_TOPGEN]) == tg, bar);
            __builtin_amdgcn_fence(__ATOMIC_ACQUIRE, "agent");
            xb_add(&bar[XB_XGEN(b.x)], 1u);
            asm volatile("s_waitcnt vmcnt(0)" ::: "memory");
        } else {
            XB_SPIN(xb_ld(&bar[XB_XGEN(b.x)]) == gen, bar);
            __builtin_amdgcn_fence(__ATOMIC_ACQUIRE, "agent");
            asm volatile("s_waitcnt vmcnt(0)" ::: "memory");
        }
    }
    __syncthreads();
}

__global__ void __launch_bounds__(NTHREADS) mega(Params p) {
    extern __shared__ __attribute__((aligned(16))) unsigned char lds_raw[];
    float* lds = (float*)lds_raw;
    cg::grid_group grid = cg::this_grid();
    volatile __attribute__((address_space(3))) unsigned* bst = (volatile __attribute__((address_space(3))) unsigned*)((__attribute__((address_space(3))) unsigned char*)lds_raw + LDS_BYTES - 1024);
    if (threadIdx.x < 2) bst[threadIdx.x] = 0u;
    __syncthreads();
    const XcdBarrier bar = xcd_barrier_post((unsigned*)(p.ws + WS_CTL), bst);
#define GSYNC() xcd_barrier(bar)
    p0a(p, lds); __syncthreads(); p0a_fast(p, lds); grid.sync();
    p0b(p); GSYNC();
#define LAYER(l) do { for (int d_ = 0; d_ < ((l) == 0 ? DUPN(2) : 1); ++d_) p1_norm1(p, l); if (l == 1) convert_experts(p, 1, lds); GSYNC(); \
        p2_inproj_fast(p, l, lds_raw); GSYNC(); \
        p3_fnet_fast(p, l, lds_raw); __syncthreads(); for (int d_ = 0; d_ < DUPN(5); ++d_) p3_gla_local_fast(p, l, lds_raw); __syncthreads(); \
        for (int d_ = 0; d_ < DUPN(6); ++d_) p3_attn_fast(p, l, lds_raw); GSYNC(); p3_gla_scan_fast(p); GSYNC(); for (int d_ = 0; d_ < DUPN(7); ++d_) p4_gla_out_fast(p, l, lds_raw); GSYNC(); \
        p5_outproj_fast(p, l, lds_raw); GSYNC(); p6_norm2_router(p, l, lds); GSYNC(); \
        p7_gateup_fast(p, l, lds_raw); GSYNC(); p8_down_fast(p, l, lds_raw); GSYNC(); } while (0)
    LAYER(0);
    LAYER(1);
#undef LAYER
    p9_final(p);
}

extern "C" void kernel_launch(void* const* d_in, const int* in_sizes, int n_in, void* d_out, int out_size, void* d_ws, size_t ws_size, hipStream_t stream) {
    static int grid_blocks = 0;
    if (!grid_blocks) {
        int dev = 0, cus = 0, per_cu = 0;
        hipGetDevice(&dev);
        hipDeviceGetAttribute(&cus, hipDeviceAttributeMultiprocessorCount, dev);
        hipFuncSetAttribute((const void*)mega, hipFuncAttributeMaxDynamicSharedMemorySize, LDS_BYTES);
        hipOccupancyMaxActiveBlocksPerMultiprocessor(&per_cu, (const void*)mega, NTHREADS, LDS_BYTES);
        if (per_cu < 1) { fprintf(stderr, "occupancy query says %d blocks/CU\n", per_cu); per_cu = 1; }
        grid_blocks = cus;
        if (n_in != 21 || ws_size < WS_END) fprintf(stderr, "unexpected n_in %d / ws_size %zu\n", n_in, ws_size);
    }
    hipMemsetAsync((char*)d_ws + WS_CTL, 0, 1 * MiB, stream);
    Params p{};
    const float** f = (const float**)&p;
    for (int i = 0; i < 21; ++i) f[i] = (const float*)d_in[i];
    p.out = (float*)d_out; p.ws = (unsigned char*)d_ws;
    void* args[] = {&p};
    hipError_t e = hipLaunchCooperativeKernel((const void*)mega, dim3(grid_blocks), dim3(NTHREADS), args, LDS_BYTES, stream);
    if (e != hipSuccess) fprintf(stderr, "cooperative launch failed: %s (grid %d)\n", hipGetErrorString(e), grid_blocks);
}
```

```cpp
#include <hip/hip_runtime.h>
#include <hip/hip_cooperative_groups.h>
#include <cstdio>
#include <cstdint>
namespace cg = cooperative_groups;

typedef unsigned short bf16_t;
typedef float f32x4 __attribute__((ext_vector_type(4)));

constexpr int D = 1024, BATCH = 8, SEQ = 2048, CTXL = 256, DEPTH = 2;
constexpr int NL = BATCH * SEQ, NC = BATCH * CTXL, NTOK = NL + NC;
constexpr int DIN = 1824;
constexpr int C_FN = 0, C_GQ = 256, C_GK = 384, C_GV = 512, C_GG = 768, C_GDF = 1024, C_GDB = 1040, C_AQ = 1056, C_AK = 1568, C_AV = 1696;
constexpr int KEYS = CTXL + SEQ;
constexpr int NCHK = 36;
constexpr int NEXP = 16, DEXP = 512;
constexpr float EPS = 1e-6f;
constexpr float QSCALE = 0.125f * 1.4426950408889634f;
constexpr int NWAVES = 8, NTHREADS = 512;
#ifndef DUP
#define DUP 0
#endif
#ifndef PROBE_A
#define PROBE_A -1
#endif
#ifndef PROBE_B
#define PROBE_B -1
#endif
#define PROBE_K 8
#define DUPN(id) ((DUP == (id)) ? 2 : 1)
#define GOLDEN_FNET 0
#define GOLDEN_ATTN 0
#define GOLDEN_GLA 0
constexpr int LDS_BYTES = 147456;

constexpr size_t MiB = 1u << 20;
constexpr size_t WS_CTL = 0;
constexpr size_t WS_MODP = 151 * MiB;
constexpr size_t WS_MOD = 9 * MiB;
constexpr size_t WS_TAB = 10 * MiB;
constexpr size_t WS_XC = 11 * MiB;
constexpr size_t WS_HB = 19 * MiB;
constexpr size_t WS_YFTL = 55 * MiB;
constexpr size_t WS_YFTC = 71 * MiB;
constexpr size_t WS_GQK = 73 * MiB;
constexpr size_t WS_GV = 82 * MiB;
constexpr size_t WS_GG = 91 * MiB;
constexpr size_t WS_GD = 100 * MiB;
constexpr size_t WS_AQ = 102 * MiB;
constexpr size_t WS_AK = 120 * MiB;
constexpr size_t WS_AVT = 125 * MiB;
constexpr size_t WS_AST = 130 * MiB;
constexpr size_t WS_DEC = 149 * MiB;
constexpr size_t WS_ROUTE = 150 * MiB;
constexpr size_t WS_Y = 151 * MiB;
constexpr size_t WS_WIN = 314 * MiB;
constexpr size_t WS_WOUT = 232 * MiB;
constexpr size_t WS_WGU = 236 * MiB;
constexpr size_t WS_WD = 268 * MiB;
constexpr size_t WS_WD1 = 284 * MiB;
constexpr size_t WS_DMATC = 300 * MiB;
constexpr size_t WS_LIST = 301 * MiB;
constexpr size_t WS_ST = 304 * MiB;
constexpr size_t WS_END = 324 * MiB;
constexpr size_t WS_ACT = WS_YFTL;
constexpr int CW_CNT = 8192;
constexpr int NIN = 2560;

struct Params {
    const float *x, *c, *ctx, *c_ctx, *w_ada, *b_ada, *norm_mix, *norm_ffn, *w_in, *w_gup, *b_gg, *gla_norm, *q_norm, *k_norm, *w_out, *w_router, *b_router, *w_eg, *w_eu, *w_ed, *final_norm;
    float* out;
    unsigned char* ws;
};

#define LDSP(T) __attribute__((address_space(3))) T*
namespace pg8 {
typedef short bf16x8 __attribute__((ext_vector_type(8)));
typedef unsigned u32x4 __attribute__((ext_vector_type(4)));
typedef unsigned u32x2 __attribute__((ext_vector_type(2)));
__device__ __forceinline__ unsigned cvt_pk_bf16(float lo, float hi) { unsigned r; asm volatile("v_cvt_pk_bf16_f32 %0, %1, %2" : "=v"(r) : "v"(lo), "v"(hi)); return r; }
typedef __bf16 bf16x2_c __attribute__((ext_vector_type(2)));
typedef float f32x2_c __attribute__((ext_vector_type(2)));
__device__ __forceinline__ unsigned cvt_pk_bf16_c(float lo, float hi) { f32x2_c v = {lo, hi}; return __builtin_bit_cast(unsigned, __builtin_convertvector(v, bf16x2_c)); }
}
__device__ __forceinline__ float bf2f(bf16_t v) { return __uint_as_float((unsigned)v << 16); }
__device__ __forceinline__ bf16_t f2bf(float f) { unsigned u = __float_as_uint(f); return (bf16_t)((u + 0x7fffu + ((u >> 16) & 1u)) >> 16); }
__device__ __forceinline__ float wave_sum(float v) {
#pragma unroll
    for (int o = 1; o < 64; o <<= 1) v += __shfl_xor(v, o);
    return v;
}
__device__ __forceinline__ float siluf(float v) { return v / (1.f + expf(-v)); }
__device__ __forceinline__ float sigmoidf(float v) { return 1.f / (1.f + expf(-v)); }
__device__ __forceinline__ float logsigmoidf(float z) { return fminf(z, 0.f) - log1pf(expf(-fabsf(z))); }
__device__ __forceinline__ void sincos_r(float x, float& s, float& c) {
    const float k = rintf(x * 0.63661977236758134f);
    float r = fmaf(k, -1.57079625129699707031f, x); r = fmaf(k, -7.54978995489188216e-8f, r);
    const int q = ((int)k) & 3;
    const float r2 = r * r;
    float sp = fmaf(r2, 2.7557314297e-6f, -1.9841270114e-4f); sp = fmaf(sp, r2, 8.3333337680e-3f); sp = fmaf(sp, r2, -1.6666667163e-1f); sp = fmaf(sp * r2, r, r);
    float cp = fmaf(r2, 2.4801587642e-5f, -1.3888889225e-3f); cp = fmaf(cp, r2, 4.1666667908e-2f); cp = fmaf(cp, r2, -0.5f); cp = fmaf(cp, r2, 1.f);
    const float ss = (q & 1) ? cp : sp, cc = (q & 1) ? sp : cp;
    s = (q & 2) ? -ss : ss; c = ((q + 1) & 2) ? -cc : cc;
}
struct RowInfo { int b, t, bidx, isctx; };
__device__ __forceinline__ RowInfo row_info(int r) { RowInfo ri; if (r < NL) { ri.b = r >> 11; ri.t = r & 2047; ri.bidx = ri.b; ri.isctx = 0; } else { const int q = r - NL; ri.b = q >> 8; ri.t = q & 255; ri.bidx = 8; ri.isctx = 1; } return ri; }

#define WTAB_OFF (LDS_BYTES - 256)
extern __shared__ __attribute__((aligned(16))) unsigned char lds_raw[];
__device__ __forceinline__ int hw_wave_slot() { return (int)__builtin_amdgcn_s_getreg((5 << 11) | 4) & 63; }
__device__ __forceinline__ int otid() {
    int l; asm volatile("v_mbcnt_lo_u32_b32 %0, -1, 0\n\tv_mbcnt_hi_u32_b32 %0, -1, %0" : "=v"(l));
    const int w = __builtin_amdgcn_readfirstlane(((volatile __attribute__((address_space(3))) int*)((__attribute__((address_space(3))) unsigned char*)lds_raw + WTAB_OFF))[hw_wave_slot()]);
    return w * 64 + l; }
__device__ __forceinline__ int obid() { int b = blockIdx.x; asm volatile("" : "+s"(b)); return b; }
#define PHASE_IDS const int tidx = otid(); const int bidx_ = obid(); (void)tidx; (void)bidx_
#define GW (bidx_ * NWAVES + (tidx >> 6))
#define NGW (gridDim.x * NWAVES)
#define GT (bidx_ * NTHREADS + tidx)
#define NGT (gridDim.x * NTHREADS)

__device__ __forceinline__ void p0a(const Params& p, float* lds) { PHASE_IDS;
    const int lane = tidx & 63;
    float* MODP = (float*)(p.ws + WS_MODP);
    float* sl = lds + 20000;
    { float cv[18];
#pragma unroll
      for (int q = 0; q < 18; ++q) { const int i = tidx + NTHREADS * q, j = i >> 10, k = i & 1023; cv[q] = j < 8 ? p.c[j * D + k] : p.c_ctx[k]; }
#pragma unroll
      for (int q = 0; q < 18; ++q) { const int i = tidx + NTHREADS * q, j = i >> 10, k = i & 1023; sl[k * 12 + j] = siluf(cv[q]); } }
    __syncthreads();
    for (int it = GW; it < 2 * 32 * 24; it += NGW) {
        const int l = it / (32 * 24), kc = (it / 24) % 32, cb = it % 24, col = cb * 256 + 4 * lane;
        f32x4 w[32];
        const float* wp = p.w_ada + ((size_t)l * D + kc * 32) * 6144 + col;
#pragma unroll
        for (int kk = 0; kk < 32; ++kk) w[kk] = *(const f32x4*)(wp + (size_t)kk * 6144);
        f32x4 acc[9];
#pragma unroll
        for (int j = 0; j < 9; ++j) acc[j] = (f32x4){0.f, 0.f, 0.f, 0.f};
#pragma unroll
        for (int kk = 0; kk < 32; ++kk) {
            const f32x4* sp = (const f32x4*)(sl + (kc * 32 + kk) * 12); const f32x4 s0 = sp[0], s1 = sp[1], s2 = sp[2];
            acc[0] += w[kk] * s0[0]; acc[1] += w[kk] * s0[1]; acc[2] += w[kk] * s0[2]; acc[3] += w[kk] * s0[3];
            acc[4] += w[kk] * s1[0]; acc[5] += w[kk] * s1[1]; acc[6] += w[kk] * s1[2]; acc[7] += w[kk] * s1[3];
            acc[8] += w[kk] * s2[0];
        }
#pragma unroll
        for (int j = 0; j < 9; ++j) *(f32x4*)(MODP + ((size_t)(l * 32 + kc) * 9 + j) * 6144 + col) = acc[j];
    }
    {
        bf16_t* M1 = (bf16_t*)(p.ws + WS_TAB + 16384); bf16_t* M2 = (bf16_t*)(p.ws + WS_TAB + 24576); bf16_t* EC = (bf16_t*)(p.ws + WS_TAB + 40960);
        for (int i = GT; i < 64 * 64 + 64 * 128 + 2 * 64 * 64; i += NGT) {
            if (i < 4096) { const int m = i >> 6, k = i & 63, rp = m >> 5, k1 = m & 31, part = k >> 5, sl = k & 31, r = ((sl >> 2) & 1) * 16 + 4 * (sl >> 3) + (sl & 3); float sn, cs; sincos_r((float)((k1 * r) & 31) * (6.283185307179586f / 32.f), sn, cs);
                M1[i] = f2bf(rp == 0 ? (part == 0 ? cs : -sn) : (part == 0 ? -sn : -cs)); }
            else if (i < 4096 + 8192) { const int q = i - 4096, k2 = q >> 7, kk = q & 127, ri = kk >> 6, c = kk & 63; float sn, cs; sincos_r((float)((k2 * c) & 63) * (6.283185307179586f / 64.f), sn, cs); M2[q] = f2bf(ri == 0 ? cs : sn); }
            else { const int q = i - 12288, part = q >> 12, jl = (q >> 6) & 63, ch = q & 63; float sn, cs; sincos_r((float)((jl * ch) & 63) * (6.283185307179586f / 64.f), sn, cs); EC[q] = f2bf(part == 0 ? cs : sn); }
        }
    }
    float* TAB = (float*)(p.ws + WS_TAB);
    for (int i = GT; i < 2048 + 1024; i += NGT) {
        if (i < 2048) { float s, c; sincos_r((float)i * (6.283185307179586f / 2048.f), s, c); TAB[i] = c; }
        else { const int q = i - 2048, pos = q >> 4, f = q & 15; const float inv = exp2f(-(float)f * (13.287712379549449f / 16.f)); float s, c; sincos_r((float)pos * inv, s, c); TAB[2048 + 2 * q] = c; TAB[2048 + 2 * q + 1] = s; }
    }
}
__device__ __forceinline__ void p0b(const Params& p) { PHASE_IDS;
    const float* MODP = (const float*)(p.ws + WS_MODP);
    float* MOD = (float*)(p.ws + WS_MOD);
    for (int i = GT; i < 2 * 9 * 6144; i += NGT) {
        const int l = i / (9 * 6144), j = (i / 6144) % 9, col = i % 6144;
        float s = p.b_ada[l * 6144 + col];
#pragma unroll
        for (int kc = 0; kc < 32; ++kc) s += MODP[((size_t)(l * 32 + kc) * 9 + j) * 6144 + col];
        MOD[i] = s;
    }
}

__device__ __forceinline__ float* xrow_ptr(const Params& p, int r) { return r < NL ? p.out + (size_t)r * D : (float*)(p.ws + WS_XC) + (size_t)(r - NL) * D; }
__device__ __forceinline__ const float* xin_ptr(const Params& p, int r) { return r < NL ? p.x + (size_t)r * D : p.ctx + (size_t)(r - NL) * D; }

constexpr int RPW = 3;
__device__ __forceinline__ f32x4 bf4_to_f4(pg8::u32x2 w) { f32x4 r; r[0] = __uint_as_float(w.x << 16); r[1] = __uint_as_float(w.x & 0xffff0000u); r[2] = __uint_as_float(w.y << 16); r[3] = __uint_as_float(w.y & 0xffff0000u); return r; }
__device__ __forceinline__ void p1_norm1(const Params& p, int l) { PHASE_IDS;
    const int lane = tidx & 63;
    const float* MOD = (const float*)(p.ws + WS_MOD);
    bf16_t* HB = (bf16_t*)(p.ws + WS_HB);
    const bf16_t* Y = (const bf16_t*)(p.ws + WS_Y);
    f32x4 nwv[4];
#pragma unroll
    for (int j = 0; j < 4; ++j) nwv[j] = *(const f32x4*)(p.norm_mix + l * D + 4 * lane + 256 * j);
    for (int r0 = GW * RPW; r0 < NTOK; r0 += NGW * RPW) {
        f32x4 v[RPW][4], gsc[4], gsh[4], gg2[4]; pg8::u32x2 y0[RPW][4], y1[RPW][4];
        const int gb = row_info(r0).bidx;
        { const float* mod0 = MOD + ((size_t)l * 9 + gb) * 6144;
#pragma unroll
          for (int j = 0; j < 4; ++j) { const int col = 4 * lane + 256 * j; gsc[j] = *(const f32x4*)(mod0 + D + col); gsh[j] = *(const f32x4*)(mod0 + col);
              if (l != 0) gg2[j] = *(const f32x4*)(MOD + ((size_t)(l - 1) * 9 + gb) * 6144 + 5 * D + col); } }
#pragma unroll
        for (int q = 0; q < RPW; ++q) { const int r = (r0 + q < NTOK) ? r0 + q : NTOK - 1;
#pragma unroll
            for (int j = 0; j < 4; ++j) { const int col = 4 * lane + 256 * j;
                if (l == 0) v[q][j] = *(const f32x4*)(xin_ptr(p, r) + col);
                else { v[q][j] = *(const f32x4*)(xrow_ptr(p, r) + col); y0[q][j] = *(const pg8::u32x2*)(Y + (size_t)(2 * r) * D + col); y1[q][j] = *(const pg8::u32x2*)(Y + (size_t)(2 * r + 1) * D + col); } } }
#pragma unroll
        for (int q = 0; q < RPW; ++q) { const int r = r0 + q; if (r >= NTOK) break;
            const RowInfo ri = row_info(r);
            f32x4 rsc[4], rsh[4], rg2[4];
#pragma unroll
            for (int j = 0; j < 4; ++j) { rsc[j] = gsc[j]; rsh[j] = gsh[j]; rg2[j] = gg2[j]; }
            if (ri.bidx != gb) {
                const float* mod = MOD + ((size_t)l * 9 + ri.bidx) * 6144;
#pragma unroll
                for (int j = 0; j < 4; ++j) { const int col = 4 * lane + 256 * j; rsc[j] = *(const f32x4*)(mod + D + col); rsh[j] = *(const f32x4*)(mod + col);
                    if (l != 0) rg2[j] = *(const f32x4*)(MOD + ((size_t)(l - 1) * 9 + ri.bidx) * 6144 + 5 * D + col); }
            }
            float ss = 0.f;
#pragma unroll
            for (int j = 0; j < 4; ++j) { const int col = 4 * lane + 256 * j;
                if (l != 0) { v[q][j] += rg2[j] * (bf4_to_f4(y0[q][j]) + bf4_to_f4(y1[q][j])); *(f32x4*)(xrow_ptr(p, r) + col) = v[q][j]; }
                ss += v[q][j][0] * v[q][j][0] + v[q][j][1] * v[q][j][1] + v[q][j][2] * v[q][j][2] + v[q][j][3] * v[q][j][3]; }
            const float rstd = rsqrtf(wave_sum(ss) * (1.f / D) + EPS);
#pragma unroll
            for (int j = 0; j < 4; ++j) { const int col = 4 * lane + 256 * j;
                const f32x4 nw = nwv[j];
                const f32x4 hv = v[q][j] * rstd * nw * (rsc[j] + 1.f) + rsh[j];
                pg8::u32x2 o; o.x = pg8::cvt_pk_bf16(hv[0], hv[1]); o.y = pg8::cvt_pk_bf16(hv[2], hv[3]);
                *(pg8::u32x2*)(HB + (size_t)r * D + col) = o; }
        }
    }
}

__device__ __forceinline__ void p6_norm2_router(const Params& p, int l, float* lds_unused) { PHASE_IDS;
    typedef pg8::bf16x8 bf16x8;
    typedef __attribute__((address_space(3))) unsigned char lds_u8;
    const int lane = tidx & 63, wave = __builtin_amdgcn_readfirstlane(tidx >> 6);
    const float* MOD = (const float*)(p.ws + WS_MOD);
    bf16_t* HB = (bf16_t*)(p.ws + WS_HB);
    f32x4* ROUTE = (f32x4*)(p.ws + WS_ROUTE);
    const int nrows = l == 0 ? NTOK : NL;
    const int rpb = (nrows + (int)gridDim.x - 1) / (int)gridDim.x, rbeg = bidx_ * rpb, rend = (rbeg + rpb < nrows) ? rbeg + rpb : nrows;
    constexpr int RS = 1032;
    lds_u8* L = (lds_u8*)lds_raw;
    LDSP(bf16_t) AH = (LDSP(bf16_t))(L); LDSP(bf16_t) AL = AH + 16 * RS; LDSP(bf16_t) WH = AL + 16 * RS; LDSP(bf16_t) WL = WH + 16 * RS;
    LDSP(float) PART = (LDSP(float))(L + 132096);
    LDSP(int) lcnt = (LDSP(int))(L + 140288); LDSP(int) lbase = lcnt + 16; LDSP(int) rroute = lbase + 16;
    if (tidx < 16) lcnt[tidx] = 0;
    {
        f32x4 wv[8];
#pragma unroll
        for (int j = 0; j < 8; ++j) wv[j] = ((const f32x4*)p.w_router)[tidx + NTHREADS * j];
#pragma unroll
        for (int j = 0; j < 8; ++j) { const int i4 = tidx + NTHREADS * j, k = i4 >> 2, e0 = (i4 & 3) * 4;
#pragma unroll
            for (int c = 0; c < 4; ++c) { const bf16_t hb = f2bf(wv[j][c]); WH[(e0 + c) * RS + k] = hb; WL[(e0 + c) * RS + k] = f2bf(wv[j][c] - bf2f(hb)); } }
    }
    const int nbatch = (rend - rbeg + 15) >> 4;
    f32x4 vn[2][4];
#pragma unroll
    for (int q = 0; q < 2; ++q) { const int r = (rbeg + wave * 2 + q < rend) ? rbeg + wave * 2 + q : rend - 1;
#pragma unroll
        for (int j = 0; j < 4; ++j) vn[q][j] = *(const f32x4*)(xrow_ptr(p, r) + 4 * lane + 256 * j); }
    f32x4 nwv[4];
#pragma unroll
    for (int j = 0; j < 4; ++j) nwv[j] = *(const f32x4*)(p.norm_ffn + l * D + 4 * lane + 256 * j);
    for (int bt = 0; bt < nbatch; ++bt) {
        const int r0 = rbeg + bt * 16 + wave * 2;
        f32x4 v[2][4], gsc[4], gsh[4];
        const int rl0 = r0 < rend ? r0 : rend - 1, gb = row_info(rl0).bidx;
        { const float* mod0 = MOD + ((size_t)l * 9 + gb) * 6144;
#pragma unroll
          for (int j = 0; j < 4; ++j) { const int col = 4 * lane + 256 * j; gsc[j] = *(const f32x4*)(mod0 + 4 * D + col); gsh[j] = *(const f32x4*)(mod0 + 3 * D + col); } }
#pragma unroll
        for (int q = 0; q < 2; ++q)
#pragma unroll
            for (int j = 0; j < 4; ++j) v[q][j] = vn[q][j];
        if (bt + 1 < nbatch) {
#pragma unroll
            for (int q = 0; q < 2; ++q) { const int r = (r0 + 16 + q < rend) ? r0 + 16 + q : rend - 1;
#pragma unroll
                for (int j = 0; j < 4; ++j) vn[q][j] = *(const f32x4*)(xrow_ptr(p, r) + 4 * lane + 256 * j); }
        }
#pragma unroll
        for (int j = 0; j < 4; ++j) gsc[j] = (gsc[j] + 1.f) * nwv[j];
#pragma unroll
        for (int q = 0; q < 2; ++q) { const int r = r0 + q;
            if (r < rend) {
                const RowInfo ri = row_info(r);
                float ss = 0.f;
#pragma unroll
                for (int j = 0; j < 4; ++j) ss += v[q][j][0] * v[q][j][0] + v[q][j][1] * v[q][j][1] + v[q][j][2] * v[q][j][2] + v[q][j][3] * v[q][j][3];
                const float rstd = rsqrtf(wave_sum(ss) * (1.f / D) + EPS);
                f32x4 rsc[4], rsh[4];
#pragma unroll
                for (int j = 0; j < 4; ++j) { rsc[j] = gsc[j]; rsh[j] = gsh[j]; }
                if (ri.bidx != gb) {
                    const float* mod = MOD + ((size_t)l * 9 + ri.bidx) * 6144;
#pragma unroll
                    for (int j = 0; j < 4; ++j) { const int col = 4 * lane + 256 * j; rsc[j] = (*(const f32x4*)(mod + 4 * D + col) + 1.f) * *(const f32x4*)(p.norm_ffn + l * D + col); rsh[j] = *(const f32x4*)(mod + 3 * D + col); }
                }
#pragma unroll
                for (int j = 0; j < 4; ++j) {
                    const int col = 4 * lane + 256 * j;
                    const f32x4 hv = v[q][j] * rstd * rsc[j] + rsh[j];
                    pg8::u32x2 hi; hi.x = pg8::cvt_pk_bf16(hv[0], hv[1]); hi.y = pg8::cvt_pk_bf16(hv[2], hv[3]);
                    *(pg8::u32x2*)(HB + (size_t)r * D + col) = hi;
                    pg8::u32x2 lo;
                    lo.x = pg8::cvt_pk_bf16(hv[0] - __uint_as_float(hi.x << 16), hv[1] - __uint_as_float(hi.x & 0xffff0000u));
                    lo.y = pg8::cvt_pk_bf16(hv[2] - __uint_as_float(hi.y << 16), hv[3] - __uint_as_float(hi.y & 0xffff0000u));
                    *(LDSP(pg8::u32x2))(AH + (wave * 2 + q) * RS + col) = hi; *(LDSP(pg8::u32x2))(AL + (wave * 2 + q) * RS + col) = lo;
                }
            }
        }
        __syncthreads();
        {
            const int rr = lane & 15, q4 = lane >> 4;
            f32x4 acc = {0.f, 0.f, 0.f, 0.f};
#pragma unroll
            for (int s4 = 0; s4 < 4; ++s4) { const int ko = (wave * 4 + s4) * 32 + 8 * q4;
                const bf16x8 ah = *(LDSP(const bf16x8))(AH + rr * RS + ko), al = *(LDSP(const bf16x8))(AL + rr * RS + ko);
                const bf16x8 wh = *(LDSP(const bf16x8))(WH + rr * RS + ko), wlo = *(LDSP(const bf16x8))(WL + rr * RS + ko);
                acc = __builtin_amdgcn_mfma_f32_16x16x32_bf16(ah, wh, acc, 0, 0, 0);
                acc = __builtin_amdgcn_mfma_f32_16x16x32_bf16(ah, wlo, acc, 0, 0, 0);
                acc = __builtin_amdgcn_mfma_f32_16x16x32_bf16(al, wh, acc, 0, 0, 0); }
#pragma unroll
            for (int e = 0; e < 4; ++e) PART[wave * 256 + (4 * q4 + e) * 16 + rr] = acc[e];
        }
        __syncthreads();
        if (wave == 0 && lane < 16) {
            const int r = rbeg + bt * 16 + lane;
            if (r < rend) {
                float s[16], sel[16];
#pragma unroll
                for (int e = 0; e < 16; ++e) { float lgt = 0.f;
#pragma unroll
                    for (int w8 = 0; w8 < 8; ++w8) lgt += PART[w8 * 256 + lane * 16 + e];
                    s[e] = __builtin_amdgcn_rcpf(1.f + __expf(-lgt)); sel[e] = s[e] + p.b_router[e]; }
                int bestg = 0; float bestscore = -1e30f;
#pragma unroll
                for (int g = 0; g < 4; ++g) {
                    const float a0 = sel[4 * g], a1 = sel[4 * g + 1], a2 = sel[4 * g + 2], a3 = sel[4 * g + 3];
                    const float t1x = fmaxf(a0, a1), t2x = fminf(a0, a1), t3x = fmaxf(a2, a3), t4x = fminf(a2, a3);
                    const float gs = fmaxf(t1x, t3x) + fmaxf(fmaxf(fminf(t1x, t3x), t2x), t4x);
                    if (gs > bestscore) { bestscore = gs; bestg = g; }
                }
                float c0 = sel[0], c1 = sel[1], c2 = sel[2], c3 = sel[3], u0 = s[0], u1 = s[1], u2 = s[2], u3 = s[3];
#pragma unroll
                for (int g = 1; g < 4; ++g) { const bool pick = bestg == g; c0 = pick ? sel[4 * g] : c0; c1 = pick ? sel[4 * g + 1] : c1; c2 = pick ? sel[4 * g + 2] : c2; c3 = pick ? sel[4 * g + 3] : c3;
                    u0 = pick ? s[4 * g] : u0; u1 = pick ? s[4 * g + 1] : u1; u2 = pick ? s[4 * g + 2] : u2; u3 = pick ? s[4 * g + 3] : u3; }
                int i1 = 0; float m1 = c0, s1 = u0;
                if (c1 > m1) { m1 = c1; i1 = 1; s1 = u1; }
                if (c2 > m1) { m1 = c2; i1 = 2; s1 = u2; }
                if (c3 > m1) { m1 = c3; i1 = 3; s1 = u3; }
                int i2 = -1; float m2 = -1e30f, s2 = 0.f;
                if (i1 != 0) { m2 = c0; i2 = 0; s2 = u0; }
                if (i1 != 1 && (i2 < 0 || c1 > m2)) { m2 = c1; i2 = 1; s2 = u1; }
                if (i1 != 2 && (i2 < 0 || c2 > m2)) { m2 = c2; i2 = 2; s2 = u2; }
                if (i1 != 3 && (i2 < 0 || c3 > m2)) { m2 = c3; i2 = 3; s2 = u3; }
                const int e1 = bestg * 4 + i1, e2 = bestg * 4 + i2; const float rw = __builtin_amdgcn_rcpf(s1 + s2);
                f32x4 rt; rt[0] = __int_as_float(e1); rt[1] = __int_as_float(e2); rt[2] = s1 * rw; rt[3] = s2 * rw; ROUTE[r] = rt;
                rroute[r - rbeg] = e1 | (e2 << 8); atomicAdd((int*)&lcnt[e1], 1); atomicAdd((int*)&lcnt[e2], 1);
            }
        }
    }
    __syncthreads();
    unsigned* ctl = (unsigned*)(p.ws + WS_CTL);
    if (tidx < 16) { lbase[tidx] = (int)__hip_atomic_fetch_add(ctl + CW_CNT + (l * NEXP + tidx) * 64, (unsigned)lcnt[tidx], __ATOMIC_RELAXED, __HIP_MEMORY_SCOPE_AGENT); lcnt[tidx] = 0; }
    __syncthreads();
    int* LIST = (int*)(p.ws + WS_LIST) + (size_t)l * NEXP * NTOK;
    if (tidx < rend - rbeg) {
        const int rr = rroute[tidx], r = rbeg + tidx;
#pragma unroll
        for (int slot = 0; slot < 2; ++slot) { const int e = (rr >> (8 * slot)) & 255; const int pos = lbase[e] + atomicAdd((int*)&lcnt[e], 1); LIST[e * NTOK + pos] = 2 * r + slot; }
    }
    __syncthreads();
}

__device__ __forceinline__ void p9_final(const Params& p) { PHASE_IDS;
    const int lane = tidx & 63;
    const float* MOD = (const float*)(p.ws + WS_MOD);
    const bf16_t* Y = (const bf16_t*)(p.ws + WS_Y);
    f32x4 nwv[4];
#pragma unroll
    for (int j = 0; j < 4; ++j) nwv[j] = *(const f32x4*)(p.final_norm + 4 * lane + 256 * j);
    for (int r0 = GW * RPW; r0 < NL; r0 += NGW * RPW) {
        f32x4 v[RPW][4], gg2[4]; pg8::u32x2 y0[RPW][4], y1[RPW][4];
        const int gb = r0 >> 11;
#pragma unroll
        for (int j = 0; j < 4; ++j) gg2[j] = *(const f32x4*)(MOD + ((size_t)(DEPTH - 1) * 9 + gb) * 6144 + 5 * D + 4 * lane + 256 * j);
#pragma unroll
        for (int q = 0; q < RPW; ++q) { const int r = (r0 + q < NL) ? r0 + q : NL - 1;
#pragma unroll
            for (int j = 0; j < 4; ++j) { const int col = 4 * lane + 256 * j;
                v[q][j] = *(const f32x4*)(p.out + (size_t)r * D + col); y0[q][j] = *(const pg8::u32x2*)(Y + (size_t)(2 * r) * D + col); y1[q][j] = *(const pg8::u32x2*)(Y + (size_t)(2 * r + 1) * D + col); } }
#pragma unroll
        for (int q = 0; q < RPW; ++q) { const int r = r0 + q; if (r >= NL) break;
            const int bidx = r >> 11;
            float ss = 0.f;
#pragma unroll
            for (int j = 0; j < 4; ++j) { const int col = 4 * lane + 256 * j;
                const f32x4 g2 = bidx == gb ? gg2[j] : *(const f32x4*)(MOD + ((size_t)(DEPTH - 1) * 9 + bidx) * 6144 + 5 * D + col);
                v[q][j] += g2 * (bf4_to_f4(y0[q][j]) + bf4_to_f4(y1[q][j]));
                ss += v[q][j][0] * v[q][j][0] + v[q][j][1] * v[q][j][1] + v[q][j][2] * v[q][j][2] + v[q][j][3] * v[q][j][3]; }
            const float rstd = rsqrtf(wave_sum(ss) * (1.f / D) + EPS);
#pragma unroll
            for (int j = 0; j < 4; ++j) { const int col = 4 * lane + 256 * j; *(f32x4*)(p.out + (size_t)r * D + col) = v[q][j] * rstd * nwv[j]; }
        }
    }
}

namespace pg8 {
#define PG8_LAS __attribute__((address_space(3)))
typedef short bf16x8 __attribute__((ext_vector_type(8)));
typedef unsigned u32x4 __attribute__((ext_vector_type(4)));
typedef unsigned u32x2 __attribute__((ext_vector_type(2)));
constexpr int BM = 256, BK = 64, HALF = 128, HTB = HALF * BK * 2, STAGE_BYTES = 8 * HTB;
__host__ __device__ __forceinline__ int lds_byte(int r, int c) { const int st = (r >> 4) * 2 + (c >> 5), rr = r & 15, cc = c & 31, ob = rr * 64 + cc * 2; return st * 1024 + (ob ^ (((ob >> 9) & 1) << 5)); }
__host__ __device__ __forceinline__ void stage_rc(int b, int& R, int& C) { const int st = b / 1024, sb = b % 1024, swz = sb ^ (((sb >> 9) & 1) << 5); R = (st >> 1) * 16 + swz / 64; C = (st & 1) * 32 + (swz % 64) / 2; }
__host__ __device__ __forceinline__ int perm32(int rho) { const int n = rho >> 4, i = rho & 15; return 8 * (i >> 2) + 4 * n + (i & 3); }
struct Unit { int pm, pn; unsigned a_off, b_off; int e, cnt; };

template <class Epi, class Sched>
__device__ __forceinline__ void gemm_phase(PG8_LAS unsigned char* lds, const bf16_t* A, const bf16_t* Bt, const int K, const Sched& S, const Epi& E) {
    const int tid = otid(), wid = __builtin_amdgcn_readfirstlane(tid >> 6), lane = tid & 63, wr = wid >> 2, wc = wid & 3, fr = lane & 15, fq = lane >> 4;
    const int nt = K / BK;
    int Ra[2]; unsigned Ca2[2], voffB[2];
#pragma unroll
    for (int i = 0; i < 2; ++i) { int R, C; stage_rc(tid * 16 + i * 8192, R, C); const int Rb = (R & ~31) + perm32(R & 31); Ra[i] = R; Ca2[i] = (unsigned)C * 2u; voffB[i] = (unsigned)(Rb * K + C) * 2u; }
    const size_t kstep = (size_t)(BK * 2);
    const size_t hstep = (size_t)HALF * K * 2;
    const unsigned ldsw = (unsigned)wid * 1024u;
    const int aoff = lds_byte(wr * 64 + fr, fq * 8), boff = lds_byte(wc * 32 + fr, fq * 8);
#define PG8_SA(b, h) (((b) * 2 + (h)) * HTB)
#define PG8_SB(b, h) ((4 + (b) * 2 + (h)) * HTB)
#define PG8_STAGE_B(bufoff, gbase) do { _Pragma("unroll") for (int _i = 0; _i < 2; ++_i) \
        __builtin_amdgcn_global_load_lds((const unsigned*)((const char*)(gbase) + voffB[_i]), (PG8_LAS unsigned*)(lds + (bufoff) + ldsw + _i * 8192), 16, 0, 0); } while (0)
#define PG8_STAGE_A(bufoff, kbyte, offs) do { _Pragma("unroll") for (int _i = 0; _i < 2; ++_i) \
        __builtin_amdgcn_global_load_lds((const unsigned*)(Ab + (size_t)(offs)[_i] + (size_t)(kbyte)), (PG8_LAS unsigned*)(lds + (bufoff) + ldsw + _i * 8192), 16, 0, 0); } while (0)
#define PG8_LDA(dst, b, h) do { _Pragma("unroll") for (int m = 0; m < 4; ++m) _Pragma("unroll") for (int k = 0; k < 2; ++k) dst[m][k] = *(const PG8_LAS bf16x8*)(lds + PG8_SA(b, h) + aoff + m * 2048 + k * 1024); } while (0)
#define PG8_LDB(dst, b, h) do { _Pragma("unroll") for (int n = 0; n < 2; ++n) _Pragma("unroll") for (int k = 0; k < 2; ++k) dst[n][k] = *(const PG8_LAS bf16x8*)(lds + PG8_SB(b, h) + boff + n * 2048 + k * 1024); } while (0)
#define PG8_MMA(ai, bj, At, Bt_) do { __builtin_amdgcn_s_setprio(1); _Pragma("unroll") for (int m = 0; m < 4; ++m) _Pragma("unroll") for (int n = 0; n < 2; ++n) _Pragma("unroll") for (int k = 0; k < 2; ++k) \
        acc[ai][bj][m][n] = __builtin_amdgcn_mfma_f32_16x16x32_bf16(Bt_[n][k], At[m][k], acc[ai][bj][m][n], 0, 0, 0); __builtin_amdgcn_s_setprio(0); } while (0)
#define PG8_WAIT_V(n) asm volatile("s_waitcnt vmcnt(" #n ")" ::: "memory")
#define PG8_WAIT_L(n) asm volatile("s_waitcnt lgkmcnt(" #n ")" ::: "memory")
#define PG8_BAR __builtin_amdgcn_s_barrier()
#define PG8_SCHED __builtin_amdgcn_sched_barrier(0)
    Unit cur, nxt; int ui = 0;
    if (!S.next(0, cur)) return;
    f32x4 acc[2][2][4][2];
#pragma unroll
    for (int a = 0; a < 2; ++a)
#pragma unroll
        for (int b = 0; b < 2; ++b)
#pragma unroll
            for (int m = 0; m < 4; ++m)
#pragma unroll
                for (int n = 0; n < 2; ++n) acc[a][b][m][n] = (f32x4){0.f, 0.f, 0.f, 0.f};
    bf16x8 At[4][2], B0[2][2], B1[2][2];
    const char* Ab = (const char*)A;
    unsigned ga0[2], ga1[2], gn0[2], gn1[2];
#pragma unroll
    for (int i = 0; i < 2; ++i) { ga0[i] = S.a_row_off(cur, Ra[i], K) + Ca2[i]; ga1[i] = S.a_row_off(cur, HALF + Ra[i], K) + Ca2[i]; }
    const char* cB = (const char*)Bt + cur.b_off;
    PG8_STAGE_B(PG8_SB(0, 0), cB); PG8_STAGE_B(PG8_SB(0, 1), cB + hstep); PG8_STAGE_A(PG8_SA(0, 0), 0, ga0); PG8_STAGE_A(PG8_SA(0, 1), 0, ga1);
    if (wr == 1) PG8_BAR;
    PG8_WAIT_V(2); PG8_BAR;
    PG8_STAGE_B(PG8_SB(1, 0), cB + kstep); PG8_STAGE_A(PG8_SA(1, 0), kstep, ga0); PG8_STAGE_B(PG8_SB(1, 1), cB + hstep + kstep);
    PG8_WAIT_V(6); PG8_BAR;
    for (;;) {
        const bool has_next = S.next(ui + 1, nxt);
        if (has_next) {
#pragma unroll
            for (int i = 0; i < 2; ++i) { gn0[i] = S.a_row_off(nxt, Ra[i], K) + Ca2[i]; gn1[i] = S.a_row_off(nxt, HALF + Ra[i], K) + Ca2[i]; }
        } else {
#pragma unroll
            for (int i = 0; i < 2; ++i) { gn0[i] = ga0[i]; gn1[i] = ga1[i]; }
        }
        const char* nB = has_next ? (const char*)Bt + nxt.b_off : cB;
        for (int t = 0; t < nt; t += 2) {
            const bool last = (t == nt - 2);
            const size_t k1 = (size_t)(t + 1) * kstep;
            unsigned o20[2], o21[2];
#pragma unroll
            for (int i = 0; i < 2; ++i) { o20[i] = last ? gn0[i] : ga0[i]; o21[i] = last ? gn1[i] : ga1[i]; }
            const size_t k2 = last ? 0 : (size_t)(t + 2) * kstep, k3 = k2 + kstep;
            const char* b2 = last ? nB : cB + (size_t)(t + 2) * kstep; const char* b3 = b2 + kstep;
            PG8_LDB(B0, 0, 0); PG8_LDB(B1, 0, 1); PG8_SCHED; PG8_LDA(At, 0, 0); PG8_STAGE_A(PG8_SA(1, 1), k1, ga1);
            PG8_WAIT_V(8); PG8_WAIT_L(0); PG8_BAR; PG8_MMA(0, 0, At, B0); PG8_MMA(0, 1, At, B1); PG8_BAR; PG8_SCHED;
            PG8_LDA(At, 0, 1); PG8_STAGE_B(PG8_SB(0, 0), b2); PG8_STAGE_B(PG8_SB(0, 1), b2 + hstep); PG8_STAGE_A(PG8_SA(0, 0), k2, o20);
            PG8_WAIT_V(8); PG8_WAIT_L(0); PG8_BAR; PG8_MMA(1, 0, At, B0); PG8_MMA(1, 1, At, B1); PG8_BAR; PG8_SCHED;
            PG8_LDB(B0, 1, 0); PG8_LDB(B1, 1, 1); PG8_SCHED; PG8_LDA(At, 1, 0); PG8_STAGE_A(PG8_SA(0, 1), k2, o21);
            PG8_WAIT_V(8); PG8_WAIT_L(0); PG8_BAR; PG8_MMA(0, 0, At, B0); PG8_MMA(0, 1, At, B1); PG8_BAR; PG8_SCHED;
            PG8_LDA(At, 1, 1); PG8_STAGE_B(PG8_SB(1, 0), b3); PG8_STAGE_B(PG8_SB(1, 1), b3 + hstep); PG8_STAGE_A(PG8_SA(1, 0), k3, o20);
            PG8_WAIT_V(8); PG8_WAIT_L(0); PG8_BAR; PG8_MMA(1, 0, At, B0); PG8_MMA(1, 1, At, B1); PG8_BAR; PG8_SCHED;
        }
        if (wr == 0) PG8_BAR;
        E(acc, cur, wr, wc, fr, fq);
        if (!has_next) break;
#pragma unroll
        for (int a = 0; a < 2; ++a)
#pragma unroll
            for (int b = 0; b < 2; ++b)
#pragma unroll
                for (int m = 0; m < 4; ++m)
#pragma unroll
                    for (int n = 0; n < 2; ++n) acc[a][b][m][n] = (f32x4){0.f, 0.f, 0.f, 0.f};
        cur = nxt; cB = nB; ++ui;
#pragma unroll
        for (int i = 0; i < 2; ++i) { ga0[i] = gn0[i]; ga1[i] = gn1[i]; }
        if (wr == 1) PG8_BAR;
    }
    PG8_WAIT_V(0);
    PG8_BAR;
#undef PG8_SA
#undef PG8_SB
#undef PG8_STAGE_A
#undef PG8_STAGE_B
#undef PG8_LDA
#undef PG8_LDB
#undef PG8_MMA
#undef PG8_WAIT_V
#undef PG8_WAIT_L
#undef PG8_BAR
#undef PG8_SCHED
}

struct PlainOrder {
    int nM, nN, nwg, G, c;
    __device__ void init(int M, int N, int G_, int c_) { nM = M / BM; nN = N / BM; nwg = nM * nN; G = G_; c = c_; }
    __device__ __forceinline__ bool next(int i, Unit& u, int dup = 1) const {
        int L = i * G + c; if (L >= nwg * dup) return false; if (L >= nwg) L -= nwg;
        int wgid = L; { const int q = nwg / 8, r = nwg % 8, xcd = wgid % 8, off = wgid / 8; wgid = (xcd < r ? xcd * (q + 1) : r * (q + 1) + (xcd - r) * q) + off; }
        const int nig = 8 * nN, gid = wgid / nig, fm = gid * 8, gsz = (nM - fm) < 8 ? (nM - fm) : 8;
        u.pm = fm + ((wgid % nig) % gsz); u.pn = (wgid % nig) / gsz; u.a_off = 0; u.b_off = 0; u.e = 0; u.cnt = 256; return true;
    }
    __device__ __forceinline__ unsigned a_row_off(const Unit& u, int rl, int K) const { return (unsigned)((u.pm * BM + rl) * K) * 2u; }
};
}
struct PlainSched {
    pg8::PlainOrder o; int K; int dup; bool fperm;
    __device__ __forceinline__ bool next(int i, pg8::Unit& u) const { if (!o.next(i, u, dup)) return false; u.b_off = (unsigned)(u.pn * 256 * K) * 2u; return true; }
    __device__ __forceinline__ unsigned a_row_off(const pg8::Unit& u, int rl, int K_) const {
        if (fperm && u.pn <= 1) rl = u.pm < 64 ? (((rl >> 4) & 3) << 6 | (rl >> 7) << 5 | ((rl >> 6) & 1) << 4 | (rl & 15)) : ((rl & 0xc0) | (rl & 15) << 2 | ((rl >> 4) & 3));
        return o.a_row_off(u, rl, K_); }
};

__device__ __forceinline__ void conv_item4(const float* W, int ldw, int k0, int n, bool valid, bf16_t* dst_row0  , int ldt) {
    f32x4 v[16];
    const float* src = W + (size_t)k0 * ldw + (valid ? n : 0);
#pragma unroll
    for (int i = 0; i < 16; ++i) v[i] = *(const f32x4*)(src + (size_t)i * ldw);
    if (valid) {
#pragma unroll
        for (int c = 0; c < 4; ++c) {
            pg8::u32x4 o0, o1;
            o0.x = pg8::cvt_pk_bf16(v[0][c], v[1][c]); o0.y = pg8::cvt_pk_bf16(v[2][c], v[3][c]); o0.z = pg8::cvt_pk_bf16(v[4][c], v[5][c]); o0.w = pg8::cvt_pk_bf16(v[6][c], v[7][c]);
            o1.x = pg8::cvt_pk_bf16(v[8][c], v[9][c]); o1.y = pg8::cvt_pk_bf16(v[10][c], v[11][c]); o1.z = pg8::cvt_pk_bf16(v[12][c], v[13][c]); o1.w = pg8::cvt_pk_bf16(v[14][c], v[15][c]);
            *(pg8::u32x4*)(dst_row0 + (size_t)c * ldt) = o0; *(pg8::u32x4*)(dst_row0 + (size_t)c * ldt + 8) = o1;
        }
    }
}
__device__ __forceinline__ void conv_tile64(const float* src  , int ldw, bf16_t* dst  ) {
    float v[64];
#pragma unroll
    for (int i = 0; i < 64; ++i) v[i] = src[(size_t)i * ldw];
#pragma unroll
    for (int q = 0; q < 8; ++q) {
        pg8::u32x4 o; o.x = pg8::cvt_pk_bf16(v[8 * q], v[8 * q + 1]); o.y = pg8::cvt_pk_bf16(v[8 * q + 2], v[8 * q + 3]); o.z = pg8::cvt_pk_bf16(v[8 * q + 4], v[8 * q + 5]); o.w = pg8::cvt_pk_bf16(v[8 * q + 6], v[8 * q + 7]);
        *(pg8::u32x4*)(dst + 8 * q) = o;
    }
}
constexpr int CB_RS = 272;
constexpr int CB_BUF = 256 * CB_RS;
__device__ __forceinline__ void cb_load(f32x4 (&v)[16], const float* src, int ldw) {
#pragma unroll
    for (int i = 0; i < 16; ++i) v[i] = *(const f32x4*)(src + (size_t)i * ldw);
}
__device__ __forceinline__ void cb_to_lds(const f32x4 (&v)[16], unsigned char* buf, int w, int lane) {
#pragma unroll
    for (int c = 0; c < 4; ++c) {
        pg8::u32x4 o0, o1;
        o0.x = pg8::cvt_pk_bf16(v[0][c], v[1][c]); o0.y = pg8::cvt_pk_bf16(v[2][c], v[3][c]); o0.z = pg8::cvt_pk_bf16(v[4][c], v[5][c]); o0.w = pg8::cvt_pk_bf16(v[6][c], v[7][c]);
        o1.x = pg8::cvt_pk_bf16(v[8][c], v[9][c]); o1.y = pg8::cvt_pk_bf16(v[10][c], v[11][c]); o1.z = pg8::cvt_pk_bf16(v[12][c], v[13][c]); o1.w = pg8::cvt_pk_bf16(v[14][c], v[15][c]);
        LDSP(pg8::u32x4) q = (LDSP(pg8::u32x4))(buf + (4 * lane + c) * CB_RS + 32 * w);
        q[0] = o0; q[1] = o1;
    }
}
struct CbTile { const float* src; bf16_t* dst; int ldw, ldd, rsplit; };
__device__ __forceinline__ CbTile cb_expert_tile(const Params& p, int l, bf16_t* WGU, bf16_t* WD, int t, int w, int lane) {
    CbTile c;
    if (t < 512) { const int nt = t & 1, kt = (t >> 1) & 7, e = (t >> 4) & 15, part = t >> 8;
        c.src = (part == 0 ? p.w_eg : p.w_eu) + ((size_t)(l * NEXP + e) * D + kt * 128 + 16 * w) * DEXP + nt * 256 + 4 * lane; c.ldw = DEXP;
        c.dst = WGU + ((size_t)e * 1024 + nt * 512 + part * 128) * D + kt * 128; c.ldd = D; c.rsplit = 128; }
    else { const int q = t - 512, nt = q & 3, kt = (q >> 2) & 3, e = (q >> 4) & 15;
        c.src = p.w_ed + ((size_t)(l * NEXP + e) * DEXP + kt * 128 + 16 * w) * D + nt * 256 + 4 * lane; c.ldw = D;
        c.dst = WD + ((size_t)e * 1024 + nt * 256) * DEXP + kt * 128; c.ldd = DEXP; c.rsplit = 0; }
    return c;
}
__device__ __forceinline__ void convert_experts_b(const Params& p, int l, bf16_t* WGU, bf16_t* WD, int t0, int t1, int blk, int nblk, int tidx, unsigned char* lds_raw) {
    const int lane = tidx & 63, w = tidx >> 6, j = tidx & 15, r0 = tidx >> 4;
    int par = 0, t = t0 + blk;
    if (t >= t1) return;
    CbTile cur = cb_expert_tile(p, l, WGU, WD, t, w, lane);
    f32x4 v[16];
    cb_load(v, cur.src, cur.ldw);
    for (;;) {
        const int tn = t + nblk; const bool more = tn < t1;
        const CbTile nx = cb_expert_tile(p, l, WGU, WD, more ? tn : t, w, lane);
        f32x4 vn[16];
        if (more) cb_load(vn, nx.src, nx.ldw);
        unsigned char* buf = lds_raw + par * CB_BUF; par ^= 1;
        cb_to_lds(v, buf, w, lane);
        __syncthreads();
#pragma unroll
        for (int i = 0; i < 8; ++i) { const int r = r0 + 32 * i;
            const pg8::u32x4 x = *(LDSP(pg8::u32x4))(buf + r * CB_RS + 16 * j);
            *(pg8::u32x4*)(cur.dst + (size_t)(r + (r & cur.rsplit)) * cur.ldd + 8 * j) = x; }
        if (!more) break;
#pragma unroll
        for (int i = 0; i < 16; ++i) v[i] = vn[i];
        cur = nx; t = tn;
    }
}
constexpr int CW_DYN = 12000;
__device__ __forceinline__ void convert_experts_dyn(const Params& p, int l, bf16_t* WGU, bf16_t* WD, int t0, int t1, int tidx, unsigned char* lds_raw) {
    const int lane = tidx & 63, w = tidx >> 6, j = tidx & 15, r0 = tidx >> 4;
    unsigned* ctr = (unsigned*)(p.ws + WS_CTL) + CW_DYN;
    volatile int* slot = (volatile int*)(lds_raw + LDS_BYTES - 480);
    int par = 0;
    for (;;) {
        if (tidx == 0) *slot = t0 + (int)atomicAdd(ctr, 1u);
        __syncthreads();
        const int t = *slot;
        if (t >= t1) break;
        const CbTile cur = cb_expert_tile(p, l, WGU, WD, t, w, lane);
        f32x4 v[16];
        cb_load(v, cur.src, cur.ldw);
        unsigned char* buf = lds_raw + par * CB_BUF; par ^= 1;
        cb_to_lds(v, buf, w, lane);
        __syncthreads();
#pragma unroll
        for (int i = 0; i < 8; ++i) { const int r = r0 + 32 * i;
            const pg8::u32x4 x = *(LDSP(pg8::u32x4))(buf + r * CB_RS + 16 * j);
            *(pg8::u32x4*)(cur.dst + (size_t)(r + (r & cur.rsplit)) * cur.ldd + 8 * j) = x; }
    }
}
__device__ __forceinline__ void convert_gateup(const Params& p, int l, bf16_t* WGU, int gw0, int ngw, int lane) {
    for (int it = gw0; it < 2 * NEXP * 16 * 8; it += ngw) {
        const int nb = it & 7, kb = (it >> 3) & 15, e = (it >> 7) & 15, part = it >> 11, n = nb * 64 + lane;
        const float* W = (part == 0 ? p.w_eg : p.w_eu) + (size_t)(l * NEXP + e) * D * DEXP;
        conv_tile64(W + (size_t)(kb * 64) * DEXP + n, DEXP, WGU + ((size_t)e * 1024 + (n >> 7) * 256 + part * 128 + (n & 127)) * D + kb * 64);
    }
}
__device__ __forceinline__ void convert_down(const Params& p, int l, bf16_t* WD, int gw0, int ngw, int lane) {
    for (int it = gw0; it < NEXP * 8 * 16; it += ngw) {
        const int nb = it & 15, kb = (it >> 4) & 7, e = it >> 7, n = nb * 64 + lane;
        conv_tile64(p.w_ed + ((size_t)(l * NEXP + e) * DEXP + kb * 64) * D + n, D, WD + ((size_t)e * 1024 + n) * DEXP + kb * 64);
    }
}
struct EpiOutProj {
    const float* xs_lat; const float* xs_ctx; float* xd_lat; float* xd_ctx; const float* g1;
    __device__ __forceinline__ void operator()(const f32x4 (&acc)[2][2][4][2], const pg8::Unit& u, int wr, int wc, int fr, int fq) const {
        const int row0 = u.pm * 256 + wr * 64 + fr, col0 = u.pn * 256 + wc * 32 + 8 * fq;
        const bool isctx = u.pm >= 64; const int bidx = isctx ? 8 : (u.pm >> 3);
        const float* xs = isctx ? xs_ctx - (size_t)NL * D : xs_lat; float* xd = isctx ? xd_ctx - (size_t)NL * D : xd_lat;
        f32x4 g[2][2];
#pragma unroll
        for (int bj = 0; bj < 2; ++bj)
#pragma unroll
            for (int n = 0; n < 2; ++n) g[bj][n] = *(const f32x4*)(g1 + (size_t)bidx * 6144 + col0 + bj * 128 + 4 * n);
#pragma unroll
        for (int ai = 0; ai < 2; ++ai)
#pragma unroll
            for (int m = 0; m < 4; ++m) {
                const size_t ro = (size_t)(row0 + ai * 128 + m * 16) * D + col0;
#pragma unroll
                for (int bj = 0; bj < 2; ++bj)
#pragma unroll
                    for (int n = 0; n < 2; ++n) { const f32x4 xv = *(const f32x4*)(xs + ro + bj * 128 + 4 * n); *(f32x4*)(xd + ro + bj * 128 + 4 * n) = xv + g[bj][n] * acc[ai][bj][m][n]; }
            }
    }
};
__device__ __forceinline__ void p5_outproj_fast(const Params& p, int l, unsigned char* lds_raw) { PHASE_IDS;
    PlainSched S; S.K = D; S.fperm = false; S.dup = (l == 0 ? DUPN(8) : 1); S.o.init(l == 0 ? NTOK : NL, D, gridDim.x, bidx_);
    EpiOutProj E{l == 0 ? p.x : p.out, l == 0 ? p.ctx : (const float*)(p.ws + WS_XC), p.out, (float*)(p.ws + WS_XC), (const float*)(p.ws + WS_MOD) + (size_t)l * 9 * 6144 + 2 * D};
    pg8::gemm_phase((PG8_LAS unsigned char*)lds_raw, (const bf16_t*)(p.ws + WS_HB), (const bf16_t*)(p.ws + WS_WOUT) + (size_t)l * D * D, D, S, E);
    if (l == 0) {
        const int G = gridDim.x, rem = S.o.nwg % G, first = rem == 0 ? 0 : rem, nb = G - first;
        if (bidx_ >= first) { const int gw0 = (bidx_ - first) * NWAVES + (tidx >> 6), ngw = nb * NWAVES, lane = tidx & 63;
            (void)gw0; (void)ngw; (void)lane; convert_experts_b(p, 0, (bf16_t*)(p.ws + WS_WGU), (bf16_t*)(p.ws + WS_WD), 384, 768, bidx_ - first, nb, tidx, lds_raw); }
    }
}

#define PIN_ACC(acc) do { _Pragma("unroll") for (int a_ = 0; a_ < 2; ++a_) _Pragma("unroll") for (int b_ = 0; b_ < 2; ++b_) _Pragma("unroll") for (int m_ = 0; m_ < 4; ++m_) \
    asm volatile("" : "+v"(acc[a_][b_][m_][0]), "+v"(acc[a_][b_][m_][1])); } while (0)
struct EpiInProj {
    struct { unsigned char* ws; const float* q_norm; const float* k_norm; } p; int l;
    __device__ __forceinline__ void operator()(f32x4 (&acc)[2][2][4][2], const pg8::Unit& u, int wr, int wc, int fr, int fq) const {
        asm volatile("" : "+v"(fr), "+v"(fq));
        const int T = u.pn;
        const bool isctx = u.pm >= 64; const int b = isctx ? u.pm - 64 : (u.pm >> 3); const int t0 = (isctx ? 0 : (u.pm & 7) * 256) + wr * 64 + fr;
        const int row0 = u.pm * 256 + wr * 64 + fr;
        if (T <= 1) {
            bf16_t* dst = isctx ? (bf16_t*)(p.ws + WS_YFTC) + ((size_t)b * 256 * 2 + T) * CTXL + 64 * wr + 4 * fr
                                : (bf16_t*)(p.ws + WS_YFTL) + ((size_t)b * 256 * 2 + T) * SEQ + (16 * wr + fr) * 32 + 4 * (u.pm & 7);
            const int ld = isctx ? CTXL : SEQ, oa = isctx ? 128 : 1024;
            unsigned eo = (unsigned)((64 * wc + 8 * fq) * 2 * ld);
#pragma unroll
            for (int bj = 0; bj < 2; ++bj)
#pragma unroll
                for (int n = 0; n < 2; ++n)
#pragma unroll
                    for (int e = 0; e < 4; ++e) { bf16_t* cp = dst + eo;
#pragma unroll
                        for (int ai = 0; ai < 2; ++ai) { pg8::u32x2 w; w.x = pg8::cvt_pk_bf16(acc[ai][bj][0][n][e], acc[ai][bj][1][n][e]); w.y = pg8::cvt_pk_bf16(acc[ai][bj][2][n][e], acc[ai][bj][3][n][e]); *(pg8::u32x2*)(cp + ai * oa) = w; }
                        eo += (unsigned)(((n == 1 && e == 3) ? 25 : 1) * 2 * ld); asm volatile("" : "+v"(eo) :: "memory"); }
        } else if (T <= 4 || T >= 8) {
            bf16_t* dst; int ld; float sc = 1.f;
            if (T == 9) { dst = (bf16_t*)(p.ws + WS_YFTL); ld = 256; }
            else if (T == 2) { dst = (bf16_t*)(p.ws + WS_GQK); ld = 256; if (wc < 2) sc = 0.17677669529663687f; }
            else if (T == 3) { dst = (bf16_t*)(p.ws + WS_GV); ld = 256; } else if (T == 4) { dst = (bf16_t*)(p.ws + WS_GG); ld = 256; } else { dst = (bf16_t*)(p.ws + WS_GD); ld = 32; }
            if (T != 8 || wc == 0) {
#pragma unroll
                for (int ai = 0; ai < 2; ++ai)
#pragma unroll
                    for (int m = 0; m < 4; ++m) { const size_t r = row0 + ai * 128 + m * 16;
#pragma unroll
                        for (int bj = 0; bj < 2; ++bj) { if (T == 8 && bj == 1) continue;
                            const f32x4 v0 = acc[ai][bj][m][0] * sc, v1 = acc[ai][bj][m][1] * sc;
                            pg8::u32x4 w; w.x = pg8::cvt_pk_bf16(v0[0], v0[1]); w.y = pg8::cvt_pk_bf16(v0[2], v0[3]); w.z = pg8::cvt_pk_bf16(v1[0], v1[1]); w.w = pg8::cvt_pk_bf16(v1[2], v1[3]);
                            *(pg8::u32x4*)(dst + r * ld + 64 * wc + 32 * bj + 8 * fq) = w; } }
            }
        } else if (T == 7 && wc >= 2) {
            bf16_t* dst = (bf16_t*)(p.ws + WS_AVT) + ((size_t)(b * 2 + (wc - 2)) * 64) * KEYS + (isctx ? 0 : CTXL);
            unsigned eo = (unsigned)(8 * fq * KEYS + t0);
#pragma unroll
            for (int bj = 0; bj < 2; ++bj)
#pragma unroll
                for (int n = 0; n < 2; ++n)
#pragma unroll
                    for (int e = 0; e < 4; ++e) { bf16_t* cp = dst + eo;
#pragma unroll
                        for (int ai = 0; ai < 2; ++ai)
#pragma unroll
                            for (int m = 0; m < 4; ++m) cp[ai * 128 + m * 16] = f2bf(acc[ai][bj][m][n][e]);
                        eo += (unsigned)(((n == 1 && e == 3) ? 25 : 1) * KEYS); asm volatile("" : "+v"(eo) :: "memory"); }
        } else {
            const bool isq = T != 7;
            const float* nw = isq ? p.q_norm : p.k_norm;
            f32x4 w4[2][2];
#pragma unroll
            for (int bj = 0; bj < 2; ++bj)
#pragma unroll
                for (int n = 0; n < 2; ++n) w4[bj][n] = *(const f32x4*)(nw + 32 * bj + 8 * fq + 4 * n);
            const float osc = isq ? QSCALE : 1.f;
            const float* ROPE = (const float*)(p.ws + WS_TAB) + 2048;
            const int half = fq >> 1;
            const int rbase = row0 - t0;
            int t = t0;
#pragma unroll
            for (int ai = 0; ai < 2; ++ai)
#pragma unroll
                for (int m = 0; m < 4; ++m) {
                    float ss = 0.f;
#pragma unroll
                    for (int bj = 0; bj < 2; ++bj)
#pragma unroll
                        for (int n = 0; n < 2; ++n) { const f32x4 v = acc[ai][bj][m][n]; ss += v[0] * v[0] + v[1] * v[1] + v[2] * v[2] + v[3] * v[3]; }
                    ss += __shfl_xor(ss, 16); ss += __shfl_xor(ss, 32);
                    const float rs = rsqrtf(ss * (1.f / 64.f) + EPS);
                    bf16_t* dst = isq ? (bf16_t*)(p.ws + WS_AQ) + (size_t)(rbase + t) * 512 + ((T - 5) * 4 + wc) * 64
                                      : (bf16_t*)(p.ws + WS_AK) + ((size_t)b * KEYS + (isctx ? 0 : CTXL) + t) * 128 + wc * 64;
#pragma unroll
                    for (int bj = 0; bj < 2; ++bj) {
                        f32x4 o[2];
#pragma unroll
                        for (int n = 0; n < 2; ++n) {
                            const f32x4 xv = acc[ai][bj][m][n] * rs * w4[bj][n];
                            if (!isctx) {
                                const int pos = bj == 0 ? (t >> 6) : (t & 63);
                                const f32x4* rp = (const f32x4*)(ROPE + 2 * (pos * 16 + 8 * (fq & 1) + 4 * n));
                                const f32x4 cs01 = rp[0], cs23 = rp[1];
                                f32x4 xp;
#pragma unroll
                                for (int e = 0; e < 4; ++e) xp[e] = __shfl_xor(xv[e], 32);
                                const float sg = half == 0 ? -1.f : 1.f;
                                o[n][0] = xv[0] * cs01[0] + sg * xp[0] * cs01[1]; o[n][1] = xv[1] * cs01[2] + sg * xp[1] * cs01[3];
                                o[n][2] = xv[2] * cs23[0] + sg * xp[2] * cs23[1]; o[n][3] = xv[3] * cs23[2] + sg * xp[3] * cs23[3];
                            } else o[n] = xv;
                            o[n] = o[n] * osc;
                        }
                        pg8::u32x4 w; w.x = pg8::cvt_pk_bf16(o[0][0], o[0][1]); w.y = pg8::cvt_pk_bf16(o[0][2], o[0][3]); w.z = pg8::cvt_pk_bf16(o[1][0], o[1][1]); w.w = pg8::cvt_pk_bf16(o[1][2], o[1][3]);
                        *(pg8::u32x4*)(dst + 32 * bj + 8 * fq) = w;
                    }
                    t += (m == 3) ? 80 : 16; asm volatile("" : "+v"(t) :: "memory");
                }
        }
    }
};
struct InProjSched {
    pg8::PlainOrder o; int K, l, ntl, ntc, nlat, total, G, c;
    __device__ __forceinline__ void init(int l_, int G_, int c_) { l = l_; G = G_; c = c_; K = D; ntl = 8; ntc = l_ == 0 ? 9 : 4; nlat = 64 * ntl; total = nlat + 8 * ntc; o.init(64 * 256, ntl * 256, G_, c_); }
    __device__ __forceinline__ bool next(int i, pg8::Unit& u) const {
        const int L = i * G + c; if (L >= total) return false;
        int tile;
        if (L < nlat) { o.next(i, u); tile = u.pn == 0 ? 9 : u.pn + 1; }
        else { const int idx = L - nlat, k = idx % ntc; u.pm = 64 + idx / ntc; tile = l == 0 ? k : (k < 2 ? 2 + k : (k == 2 ? 7 : 8)); u.a_off = 0; u.e = 0; u.cnt = 256; }
        u.pn = tile; u.b_off = (unsigned)(tile * 256 * K) * 2u; return true;
    }
    __device__ __forceinline__ void a_ready(const pg8::Unit&) const {}
    __device__ __forceinline__ unsigned a_row_off(const pg8::Unit& u, int rl, int K_) const {
        if (u.pn <= 1) rl = (rl & 0xc0) | (rl & 15) << 2 | ((rl >> 4) & 3);
        return o.a_row_off(u, rl, K_); }
};
__device__ __forceinline__ void p2_inproj_fast(const Params& p, int l, unsigned char* lds_raw) { PHASE_IDS;
    InProjSched S; S.init(l, gridDim.x, bidx_);
    EpiInProj E{{p.ws, p.q_norm + l * 64, p.k_norm + l * 64}, l};
    pg8::gemm_phase((PG8_LAS unsigned char*)lds_raw, (const bf16_t*)(p.ws + WS_HB), (const bf16_t*)(p.ws + WS_WIN) + (size_t)l * NIN * D, D, S, E);
    {
        const int G = gridDim.x, rem = S.total % G, first = rem == 0 ? 0 : rem, nb = G - first;
        if (bidx_ >= first) { const int gw0 = (bidx_ - first) * NWAVES + (tidx >> 6), ngw = nb * NWAVES, lane = tidx & 63;
            (void)gw0; (void)ngw; (void)lane; if (l == 0) convert_experts_b(p, 0, (bf16_t*)(p.ws + WS_WGU), (bf16_t*)(p.ws + WS_WD), 0, 384, bidx_ - first, nb, tidx, lds_raw); else convert_experts_b(p, 1, (bf16_t*)(p.ws + WS_Y), (bf16_t*)(p.ws + WS_WD1), 0, 512, bidx_ - first, nb, tidx, lds_raw); }
    }
}

struct MoeSched {
    const int* list; const int* tab;
    int G, c, total, dup; bool down;
    __device__ __forceinline__ bool next(int i, pg8::Unit& u) const {
        int e, rem;
        if (G == 256) {
            const int x = c & 7, ul = i * 32 + (c >> 3);
            const int n0 = tab[x + 1] - tab[x], n1 = tab[x + 9] - tab[x + 8];
            if (ul < n0) { e = x; rem = ul; } else if (ul < n0 + n1) { e = x + 8; rem = ul - n0; } else return false;
        } else {
            const int L = i * G + c; if (L >= total) return false;
            e = 0;
#pragma unroll
            for (int q = 1; q < NEXP; ++q) if (L >= tab[q]) e = q;
            rem = L - tab[e];
        }
        e = __builtin_amdgcn_readfirstlane(e); rem = __builtin_amdgcn_readfirstlane(rem);
        const int sg = tab[17 + e], cn = tab[33 + e];
        const int mtile = rem >> 2, pn = rem & 3;
        u.pm = mtile; u.pn = pn; u.e = e; u.cnt = __builtin_amdgcn_readfirstlane(cn - mtile * 256); u.a_off = (unsigned)__builtin_amdgcn_readfirstlane(sg + mtile * 256);
        u.b_off = down ? (unsigned)((e * 1024 + pn * 256) * DEXP) * 2u : (unsigned)((e * 1024 + pn * 256) * D) * 2u;
        return true;
    }
    __device__ __forceinline__ unsigned a_row_off(const pg8::Unit& u, int rl, int K) const {
        if (down) return (unsigned)((u.a_off + rl) * K) * 2u;
        const int idx = u.pm * 256 + (rl < u.cnt ? rl : u.cnt - 1);
        const int pair = list[u.e * NTOK + idx];
        return (unsigned)((pair >> 1) * K) * 2u;
    }
};
__device__ __forceinline__ int moe_tables(const unsigned* ctl, int l, int* tab, int tidx) {
    if (tidx == 0) { int u = 0, sgm = 0;
        for (int e = 0; e < NEXP; ++e) { const int n = (int)__hip_atomic_load(ctl + CW_CNT + (l * NEXP + e) * 64, __ATOMIC_RELAXED, __HIP_MEMORY_SCOPE_AGENT); const int mt = (n + 255) >> 8; tab[e] = u; tab[17 + e] = sgm; tab[33 + e] = n; u += mt * 4; sgm += mt * 256; }
        tab[16] = u; }
    __syncthreads();
    return __builtin_amdgcn_readfirstlane(tab[16]);
}
struct EpiGateUp {
    bf16_t* act;
    __device__ __forceinline__ void operator()(f32x4 (&acc)[2][2][4][2], const pg8::Unit& u, int wr, int wc, int fr, int fq) const {
        bf16_t* base = act + (size_t)(u.a_off + wr * 64 + fr) * DEXP + u.pn * 128 + wc * 32 + 8 * fq;
#pragma unroll
        for (int ai = 0; ai < 2; ++ai)
#pragma unroll
            for (int m = 0; m < 4; ++m) {
                f32x4 o[2];
#pragma unroll
                for (int n = 0; n < 2; ++n)
#pragma unroll
                    for (int e = 0; e < 4; ++e) { const float g = acc[ai][0][m][n][e]; o[n][e] = g * __builtin_amdgcn_rcpf(1.f + __expf(-g)) * acc[ai][1][m][n][e]; }
                pg8::u32x4 w; w.x = pg8::cvt_pk_bf16(o[0][0], o[0][1]); w.y = pg8::cvt_pk_bf16(o[0][2], o[0][3]); w.z = pg8::cvt_pk_bf16(o[1][0], o[1][1]); w.w = pg8::cvt_pk_bf16(o[1][2], o[1][3]);
                *(pg8::u32x4*)(base + (size_t)(ai * 128 + m * 16) * DEXP) = w;
            }
    }
};
struct EpiDown {
    bf16_t* Y; const int* list; const f32x4* route;
    __device__ __forceinline__ void operator()(f32x4 (&acc)[2][2][4][2], const pg8::Unit& u, int wr, int wc, int fr, int fq) const {
        asm volatile("" : "+v"(fr), "+v"(fq));
        const int rl0 = wr * 64 + fr;
        const int col = u.pn * 256 + wc * 32 + 8 * fq;
        int pair[8]; float w[8];
#pragma unroll
        for (int i = 0; i < 8; ++i) { const int rl = rl0 + (i >> 2) * 128 + (i & 3) * 16; pair[i] = rl < u.cnt ? list[u.e * NTOK + u.pm * 256 + rl] : -1; }
#pragma unroll
        for (int i = 0; i < 8; ++i) w[i] = pair[i] >= 0 ? ((const float*)(route + (pair[i] >> 1)))[2 + (pair[i] & 1)] : 0.f;
#pragma unroll
        for (int i = 0; i < 8; ++i) {
            if (pair[i] >= 0) {
                bf16_t* dst = Y + (size_t)pair[i] * D + col;
#pragma unroll
                for (int bj = 0; bj < 2; ++bj) { const f32x4 v0 = acc[i >> 2][bj][i & 3][0] * w[i], v1 = acc[i >> 2][bj][i & 3][1] * w[i];
                    pg8::u32x4 o; o.x = pg8::cvt_pk_bf16(v0[0], v0[1]); o.y = pg8::cvt_pk_bf16(v0[2], v0[3]); o.z = pg8::cvt_pk_bf16(v1[0], v1[1]); o.w = pg8::cvt_pk_bf16(v1[2], v1[3]);
                    *(pg8::u32x4*)(dst + bj * 128) = o; }
            }
        }
    }
};
__device__ __forceinline__ void p7_gateup_fast(const Params& p, int l, unsigned char* lds_raw) { PHASE_IDS;
    int* tab = (int*)(lds_raw + LDS_BYTES - 768);
    MoeSched S; S.list = (const int*)(p.ws + WS_LIST) + (size_t)l * NEXP * NTOK; S.tab = tab; S.G = gridDim.x; S.c = bidx_; S.down = false; S.dup = DUPN(9); S.total = moe_tables((const unsigned*)(p.ws + WS_CTL), l, tab, tidx);
    EpiGateUp E{(bf16_t*)(p.ws + WS_ACT)};
    pg8::gemm_phase((PG8_LAS unsigned char*)lds_raw, (const bf16_t*)(p.ws + WS_HB), (const bf16_t*)(p.ws + (l == 0 ? WS_WGU : WS_Y)), D, S, E);
    if (l == 0) convert_experts_dyn(p, 1, (bf16_t*)(p.ws + WS_Y), (bf16_t*)(p.ws + WS_WD1), 512, 768, tidx, lds_raw);
}
__device__ __forceinline__ void p8_down_fast(const Params& p, int l, unsigned char* lds_raw) { PHASE_IDS;
    int* tab = (int*)(lds_raw + LDS_BYTES - 768);
    MoeSched S; S.list = (const int*)(p.ws + WS_LIST) + (size_t)l * NEXP * NTOK; S.tab = tab; S.G = gridDim.x; S.c = bidx_; S.down = true; S.dup = DUPN(10); S.total = moe_tables((const unsigned*)(p.ws + WS_CTL), l, tab, tidx);
    EpiDown E{(bf16_t*)(p.ws + WS_Y), (const int*)(p.ws + WS_LIST) + (size_t)l * NEXP * NTOK, (const f32x4*)(p.ws + WS_ROUTE)};
    pg8::gemm_phase((PG8_LAS unsigned char*)lds_raw, (const bf16_t*)(p.ws + WS_ACT), (const bf16_t*)(p.ws + (l == 0 ? WS_WD : WS_WD1)), DEXP, S, E);
}

struct FnetSched {
    int mtiles, nunits, G, c, dup;
    __device__ __forceinline__ bool next(int i, pg8::Unit& u) const {
        int L = i * G + c; if (L >= nunits * dup) return false; if (L >= nunits) L -= nunits;
        u.e = L / mtiles; u.pm = L % mtiles; u.pn = 0; u.cnt = 256; u.a_off = 0; u.b_off = 0; return true;
    }
    __device__ __forceinline__ unsigned a_row_off(const pg8::Unit& u, int rl, int K) const { return (unsigned)((u.pm * 256 + rl) * K) * 2u; }
};
struct FnetSchedK { FnetSched s; int K;
    __device__ __forceinline__ bool next(int i, pg8::Unit& u) const { if (!s.next(i, u)) return false; u.b_off = (unsigned)(u.e * 256 * K) * 2u; return true; }
    __device__ __forceinline__ unsigned a_row_off(const pg8::Unit& u, int rl, int K_) const { return s.a_row_off(u, rl, K_); }
};
struct EpiFnet {
    bf16_t* mix; int row0, rows_per_b; float scale;
    __device__ __forceinline__ void operator()(f32x4 (&acc)[2][2][4][2], const pg8::Unit& u, int wr, int wc, int fr, int fq) const {
        bf16_t* base = mix + (size_t)(row0 + u.e * rows_per_b + u.pm * 256 + wr * 64 + fr) * D + wc * 32 + 8 * fq;
#pragma unroll
        for (int ai = 0; ai < 2; ++ai)
#pragma unroll
            for (int m = 0; m < 4; ++m)
#pragma unroll
                for (int bj = 0; bj < 2; ++bj) { const f32x4 v0 = acc[ai][bj][m][0] * scale, v1 = acc[ai][bj][m][1] * scale;
                    pg8::u32x4 o; o.x = pg8::cvt_pk_bf16(v0[0], v0[1]); o.y = pg8::cvt_pk_bf16(v0[2], v0[3]); o.z = pg8::cvt_pk_bf16(v1[0], v1[1]); o.w = pg8::cvt_pk_bf16(v1[2], v1[3]);
                    *(pg8::u32x4*)(base + (size_t)(ai * 128 + m * 16) * D + bj * 128) = o; }
    }
};
__device__ __forceinline__ void p3_fnet_fast(const Params& p, int l, unsigned char* lds_raw) { PHASE_IDS;
    if (l == 0) {
        FnetSchedK S; S.s.dup = 1; S.s.mtiles = 1; S.s.nunits = 8; S.s.G = gridDim.x; S.s.c = ((int)gridDim.x - 1 - bidx_); S.K = 512;
        EpiFnet E{(bf16_t*)(p.ws + WS_HB), NL, CTXL, 0.0078125f};
        pg8::gemm_phase((PG8_LAS unsigned char*)lds_raw, (const bf16_t*)(p.ws + WS_DMATC), (const bf16_t*)(p.ws + WS_YFTC), 512, S, E);
    }
}
typedef float f32x16 __attribute__((ext_vector_type(16)));
typedef short s16x4 __attribute__((ext_vector_type(4)));
#define ATTN_THR 8.0f
__device__ __forceinline__ void attn_softmax(f32x16& p0, f32x16& p1, f32x16& o0, f32x16& o1, float& mref, float& lrow, pg8::u32x4 (&pf)[4], bool first) {
    float mx = p0[0];
#pragma unroll
    for (int r = 1; r < 16; ++r) mx = fmaxf(mx, p0[r]);
#pragma unroll
    for (int r = 0; r < 16; ++r) mx = fmaxf(mx, p1[r]);
    { auto rr = __builtin_amdgcn_permlane32_swap(__float_as_uint(mx), __float_as_uint(mx), false, false); mx = fmaxf(__uint_as_float(rr[0]), __uint_as_float(rr[1])); }
    if (first || __any(mx > ATTN_THR)) {
        const float delta = first ? mx : fmaxf(mx, 0.f), alpha = __builtin_amdgcn_exp2f(-delta);
        mref += delta; lrow *= alpha;
#pragma unroll
        for (int r = 0; r < 16; ++r) { p0[r] -= delta; p1[r] -= delta; o0[r] *= alpha; o1[r] *= alpha; }
    }
    float sum = 0.f;
#pragma unroll
    for (int r = 0; r < 16; ++r) { p0[r] = __builtin_amdgcn_exp2f(p0[r]); sum += p0[r]; }
#pragma unroll
    for (int r = 0; r < 16; ++r) { p1[r] = __builtin_amdgcn_exp2f(p1[r]); sum += p1[r]; }
    lrow += sum;
#pragma unroll
    for (int s = 0; s < 2; ++s) {
        pf[s].x = pg8::cvt_pk_bf16(p0[8 * s + 0], p0[8 * s + 1]); pf[s].y = pg8::cvt_pk_bf16(p0[8 * s + 2], p0[8 * s + 3]); pf[s].z = pg8::cvt_pk_bf16(p0[8 * s + 4], p0[8 * s + 5]); pf[s].w = pg8::cvt_pk_bf16(p0[8 * s + 6], p0[8 * s + 7]);
        pf[2 + s].x = pg8::cvt_pk_bf16(p1[8 * s + 0], p1[8 * s + 1]); pf[2 + s].y = pg8::cvt_pk_bf16(p1[8 * s + 2], p1[8 * s + 3]); pf[2 + s].z = pg8::cvt_pk_bf16(p1[8 * s + 4], p1[8 * s + 5]); pf[2 + s].w = pg8::cvt_pk_bf16(p1[8 * s + 6], p1[8 * s + 7]);
    }
}
__device__ __forceinline__ void attn_store(bf16_t* op, const f32x16& o0, const f32x16& o1, float lrow) {
    { auto rr = __builtin_amdgcn_permlane32_swap(__float_as_uint(lrow), __float_as_uint(lrow), false, false); lrow = __uint_as_float(rr[0]) + __uint_as_float(rr[1]); }
    const float inv = 1.f / lrow;
#pragma unroll
    for (int g = 0; g < 4; ++g) {
        pg8::u32x2 w0, w1;
        w0.x = pg8::cvt_pk_bf16(o0[4 * g] * inv, o0[4 * g + 1] * inv); w0.y = pg8::cvt_pk_bf16(o0[4 * g + 2] * inv, o0[4 * g + 3] * inv);
        w1.x = pg8::cvt_pk_bf16(o1[4 * g] * inv, o1[4 * g + 1] * inv); w1.y = pg8::cvt_pk_bf16(o1[4 * g + 2] * inv, o1[4 * g + 3] * inv);
        *(pg8::u32x2*)(op + 8 * g) = w0; *(pg8::u32x2*)(op + 32 + 8 * g) = w1;
    }
}
__device__ __forceinline__ void attn_unit(unsigned char* ws, unsigned char* lds_raw, int b, int kvh, int qrow0, int nkt, int tid) {
    typedef pg8::bf16x8 bf16x8;
    const int lane = tid & 63, wid = __builtin_amdgcn_readfirstlane(tid >> 6), r32 = lane & 31, hi = lane >> 5, h = kvh * 4 + (wid >> 1);
    const bf16_t* AQ = (const bf16_t*)(ws + WS_AQ); const bf16_t* AK = (const bf16_t*)(ws + WS_AK); const bf16_t* AVT = (const bf16_t*)(ws + WS_AVT);
    const int srow = wid * 8 + (lane >> 3), sx = (srow >> 1) & 7, sch = (lane & 7) ^ sx;
    const bf16_t* kg = AK + ((size_t)b * KEYS + srow) * 128 + kvh * 64 + sch * 8;
    const bf16_t* vg = AVT + ((size_t)(b * 2 + kvh) * 64 + srow) * KEYS + sch * 8;
    typedef __attribute__((address_space(3))) unsigned char lds_u8;
    lds_u8* Kb = (lds_u8*)lds_raw; lds_u8* Vb = Kb + 24576;
    const int kx = (r32 >> 1) & 7;
    const int krd = r32 * 128, vrd = r32 * 128 + hi * 8;
    const int qr = qrow0 + (wid & 1) * 64 + r32;
    lds_u8* Ql = Kb + 40960 + wid * 8192 + lane * 16;
    { const bf16_t* qp = AQ + (size_t)qr * 512 + h * 64 + hi * 8;
      bf16x8 qa[4], qb[4];
#pragma unroll
      for (int s = 0; s < 4; ++s) { qa[s] = *(const bf16x8*)(qp + s * 16); qb[s] = *(const bf16x8*)(qp + 32 * 512 + s * 16); }
      __syncthreads();
#pragma unroll
      for (int s = 0; s < 4; ++s) { *(LDSP(bf16x8))(Ql + s * 2048) = qa[s]; *(LDSP(bf16x8))(Ql + s * 2048 + 1024) = qb[s]; } }
    f32x16 oA0 = {}, oA1 = {}, oB0 = {}, oB1 = {};
    float mA = 0.f, lA = 0.f, mB = 0.f, lB = 0.f;
#define ATTN_DMA_K(t, koff) __builtin_amdgcn_global_load_lds((const unsigned*)(kg + (size_t)(t) * 64 * 128), (LDSP(unsigned))(Kb + (koff) + wid * 1024), 16, 0, 0)
#define ATTN_DMA_V(t, voff) __builtin_amdgcn_global_load_lds((const unsigned*)(vg + (t) * 64), (LDSP(unsigned))(Vb + (voff) + wid * 1024), 16, 0, 0)
    ATTN_DMA_K(0, 0); ATTN_DMA_V(0, 0); if (nkt > 1) ATTN_DMA_K(1, 8192);
    __syncthreads();
#define ATTN_QK2(koff) do { asm volatile("" : "+v"(Ql));     \
        { const float nA_ = -mA, nB_ = -mB; _Pragma("unroll") for (int r_ = 0; r_ < 16; ++r_) { pA0[r_] = nA_; pA1[r_] = nA_; pB0[r_] = nB_; pB1[r_] = nB_; } } \
        _Pragma("unroll") for (int s = 0; s < 4; ++s) { \
            const bf16x8 k0 = *(LDSP(const bf16x8))(Kb + (koff) + krd + (((2 * s + hi) ^ kx) << 4)); \
            const bf16x8 k1 = *(LDSP(const bf16x8))(Kb + (koff) + 4096 + krd + (((2 * s + hi) ^ kx) << 4)); \
            const bf16x8 qA = *(LDSP(const bf16x8))(Ql + s * 2048), qB = *(LDSP(const bf16x8))(Ql + s * 2048 + 1024); \
            pA0 = __builtin_amdgcn_mfma_f32_32x32x16_bf16(k0, qA, pA0, 0, 0, 0); \
            pA1 = __builtin_amdgcn_mfma_f32_32x32x16_bf16(k1, qA, pA1, 0, 0, 0); \
            pB0 = __builtin_amdgcn_mfma_f32_32x32x16_bf16(k0, qB, pB0, 0, 0, 0); \
            pB1 = __builtin_amdgcn_mfma_f32_32x32x16_bf16(k1, qB, pB1, 0, 0, 0); \
            asm volatile("" ::: "memory"); } } while (0)
#define ATTN_PV(vcur) do { _Pragma("unroll") for (int ks = 0; ks < 4; ++ks) { \
            const s16x4 a0 = *(LDSP(const s16x4))(Vb + (vcur) + vrd + (((2 * ks) ^ kx) << 4)); \
            const s16x4 a1 = *(LDSP(const s16x4))(Vb + (vcur) + vrd + (((2 * ks + 1) ^ kx) << 4)); \
            const s16x4 c0 = *(LDSP(const s16x4))(Vb + (vcur) + 4096 + vrd + (((2 * ks) ^ kx) << 4)); \
            const s16x4 c1 = *(LDSP(const s16x4))(Vb + (vcur) + 4096 + vrd + (((2 * ks + 1) ^ kx) << 4)); \
            const bf16x8 va = {a0[0], a0[1], a0[2], a0[3], a1[0], a1[1], a1[2], a1[3]}; \
            const bf16x8 vc = {c0[0], c0[1], c0[2], c0[3], c1[0], c1[1], c1[2], c1[3]}; \
            oA0 = __builtin_amdgcn_mfma_f32_32x32x16_bf16(va, __builtin_bit_cast(bf16x8, pfA[ks]), oA0, 0, 0, 0); \
            oA1 = __builtin_amdgcn_mfma_f32_32x32x16_bf16(vc, __builtin_bit_cast(bf16x8, pfA[ks]), oA1, 0, 0, 0); \
            oB0 = __builtin_amdgcn_mfma_f32_32x32x16_bf16(va, __builtin_bit_cast(bf16x8, pfB[ks]), oB0, 0, 0, 0); \
            oB1 = __builtin_amdgcn_mfma_f32_32x32x16_bf16(vc, __builtin_bit_cast(bf16x8, pfB[ks]), oB1, 0, 0, 0); \
            asm volatile("" ::: "memory"); } } while (0)
    pg8::u32x4 pfA[4], pfB[4];
    f32x16 pA0, pA1, pB0, pB1;
    int kc = 0, kn = 8192, kn2 = 16384, vcur = 0;
    if (wid < 4) {
        for (int t = 0; t < nkt; ++t) {
            if (t + 2 < nkt) ATTN_DMA_K(t + 2, kn2);
            if (t + 1 < nkt) ATTN_DMA_V(t + 1, 8192 - vcur);
            ATTN_QK2(kc);
            attn_softmax(pA0, pA1, oA0, oA1, mA, lA, pfA, t == 0);
            attn_softmax(pB0, pB1, oB0, oB1, mB, lB, pfB, t == 0);
            asm volatile("" ::: "memory");
            ATTN_PV(vcur);
            __syncthreads();
            { const int k0_ = kc; kc = kn; kn = kn2; kn2 = k0_; } vcur = 8192 - vcur;
        }
    } else {
        ATTN_QK2(0);
        for (int t = 0; t < nkt; ++t) {
            if (t + 2 < nkt) ATTN_DMA_K(t + 2, kn2);
            if (t + 1 < nkt) ATTN_DMA_V(t + 1, 8192 - vcur);
            attn_softmax(pA0, pA1, oA0, oA1, mA, lA, pfA, t == 0);
            attn_softmax(pB0, pB1, oB0, oB1, mB, lB, pfB, t == 0);
            asm volatile("" ::: "memory");
            ATTN_PV(vcur);
            if (t + 1 < nkt) ATTN_QK2(kn);
            __syncthreads();
            { const int k0_ = kc; kc = kn; kn = kn2; kn2 = k0_; } vcur = 8192 - vcur;
        }
    }
#undef ATTN_DMA_K
#undef ATTN_DMA_V
#undef ATTN_QK2
#undef ATTN_PV
    {
      const int t2 = otid(), l2 = t2 & 63, w2 = __builtin_amdgcn_readfirstlane(t2 >> 6);
      bf16_t* op = (bf16_t*)(ws + WS_HB) + (size_t)(qrow0 + (w2 & 1) * 64 + (l2 & 31)) * D + 512 + (kvh * 4 + (w2 >> 1)) * 64 + 4 * (l2 >> 5);
      attn_store(op, oA0, oA1, lA);
      attn_store(op + (size_t)32 * D, oB0, oB1, lB); }
}
__device__ __forceinline__ void p3_attn_fast(const Params& p, int l, unsigned char* lds_raw) { PHASE_IDS;
    const int G = gridDim.x;
    for (int u = bidx_; u < BATCH * 2 * 16; u += G) { const int rb = u & 15, kvh = (u >> 4) & 1, b = u >> 5; attn_unit(p.ws, lds_raw, b, kvh, b * SEQ + rb * 128, KEYS / 64, tidx); }
    if (l == 0) for (int u = bidx_; u < BATCH * 2 * 2; u += G) { const int rb = u & 1, kvh = (u >> 1) & 1, b = u >> 2; attn_unit(p.ws, lds_raw, b, kvh, NL + b * CTXL + rb * 128, CTXL / 64, tidx); }
}

struct GlaPrep { float cum[16], tot[16], q[16], k[16]; };
struct GlaIn { pg8::u32x4 gd[2], qk[4], gv[2]; };
__device__ __forceinline__ void gla_load(GlaIn& in, const unsigned char* ws, int row0, int h, int w4, int lane, int tg) {
    const int dir = w4 >> 1, kh = w4 & 1, row = row0 + lane;
    const bf16_t* GD = (const bf16_t*)(ws + WS_GD); const bf16_t* GQK = (const bf16_t*)(ws + WS_GQK); const bf16_t* GV = (const bf16_t*)(ws + WS_GV);
    in.gd[0] = *(const pg8::u32x4*)(GD + (size_t)row * 32 + dir * 16); in.gd[1] = *(const pg8::u32x4*)(GD + (size_t)row * 32 + dir * 16 + 8);
    const bf16_t* qp = GQK + (size_t)row * 256 + h * 32 + kh * 16;
    in.qk[0] = *(const pg8::u32x4*)qp; in.qk[1] = *(const pg8::u32x4*)(qp + 8); in.qk[2] = *(const pg8::u32x4*)(qp + 128); in.qk[3] = *(const pg8::u32x4*)(qp + 136);
    const int t = tg >> 2, c = tg & 3;
    in.gv[0] = *(const pg8::u32x4*)(GV + (size_t)(row0 + t) * 256 + h * 64 + 16 * c); in.gv[1] = *(const pg8::u32x4*)(GV + (size_t)(row0 + t) * 256 + h * 64 + 16 * c + 8);
}
__device__ __forceinline__ void gla_prep(GlaPrep& g, const GlaIn& in, const float* wlds, int h, int w4, int lane) {
    const int dir = w4 >> 1, kh = w4 & 1;
    float gd[16];
    { const unsigned w[8] = {in.gd[0].x, in.gd[0].y, in.gd[0].z, in.gd[0].w, in.gd[1].x, in.gd[1].y, in.gd[1].z, in.gd[1].w};
#pragma unroll
      for (int i = 0; i < 8; ++i) { gd[2 * i] = __uint_as_float(w[i] << 16); gd[2 * i + 1] = __uint_as_float(w[i] & 0xffff0000u); } }
    const float* wu = wlds + dir * 2048 + h * 32 + kh * 16;
    const float* bu = wlds + 4096 + dir * 128 + h * 32 + kh * 16;
#pragma unroll
    for (int kk = 0; kk < 16; ++kk) g.cum[kk] = bu[kk];
#pragma unroll
    for (int r = 0; r < 16; ++r) {
#pragma unroll
        for (int kk = 0; kk < 16; ++kk) g.cum[kk] = fmaf(gd[r], wu[r * 128 + kk], g.cum[kk]);
    }
#pragma unroll
    for (int kk = 0; kk < 16; ++kk) { const float z = g.cum[kk]; g.cum[kk] = (fminf(z, 0.f) - __logf(1.f + __expf(-fabsf(z)))) * (1.f / 16.f); }
#pragma unroll
    for (int off = 1; off < 64; off <<= 1) {
        const int src = dir == 0 ? lane - off : lane + off; const bool ok = (unsigned)src < 64u;
#pragma unroll
        for (int kk = 0; kk < 16; ++kk) {
            const float y = __shfl(g.cum[kk], src & 63);
            g.cum[kk] += ok ? y : 0.f;
        }
    }
#pragma unroll
    for (int kk = 0; kk < 16; ++kk) g.tot[kk] = __shfl(g.cum[kk], dir == 0 ? 63 : 0);
    { const unsigned wq[8] = {in.qk[0].x, in.qk[0].y, in.qk[0].z, in.qk[0].w, in.qk[1].x, in.qk[1].y, in.qk[1].z, in.qk[1].w}, wk[8] = {in.qk[2].x, in.qk[2].y, in.qk[2].z, in.qk[2].w, in.qk[3].x, in.qk[3].y, in.qk[3].z, in.qk[3].w};
#pragma unroll
      for (int i = 0; i < 8; ++i) { g.q[2 * i] = __uint_as_float(wq[i] << 16); g.q[2 * i + 1] = __uint_as_float(wq[i] & 0xffff0000u); g.k[2 * i] = __uint_as_float(wk[i] << 16); g.k[2 * i + 1] = __uint_as_float(wk[i] & 0xffff0000u); } }
}
__device__ __forceinline__ void gla_stage_w(float* wlds, const Params& p, int l, int tidx) {
    { f32x4 wv[2]; float bv = 0.f;
#pragma unroll
      for (int j = 0; j < 2; ++j) wv[j] = ((const f32x4*)(p.w_gup + (size_t)l * 4096))[tidx + NTHREADS * j];
      if (tidx < 256) bv = p.b_gg[l * 256 + tidx];
#pragma unroll
      for (int j = 0; j < 2; ++j) ((f32x4*)wlds)[tidx + NTHREADS * j] = wv[j];
      if (tidx < 256) wlds[4096 + tidx] = bv; }
    __syncthreads();
}
__device__ __forceinline__ void gla_write_vt(bf16_t* VT, const GlaIn& in, int tg) {
    const int t = tg >> 2, c = tg & 3;
    const unsigned w[8] = {in.gv[0].x, in.gv[0].y, in.gv[0].z, in.gv[0].w, in.gv[1].x, in.gv[1].y, in.gv[1].z, in.gv[1].w};
#pragma unroll
    for (int i = 0; i < 8; ++i) { VT[(16 * c + 2 * i) * 72 + t] = (bf16_t)(w[i] & 0xffffu); VT[(16 * c + 2 * i + 1) * 72 + t] = (bf16_t)(w[i] >> 16); }
}
__device__ __forceinline__ int gla_row0(int b, int cs) { return cs < 4 ? NL + b * CTXL + cs * 64 : b * SEQ + (cs - 4) * 64; }

__device__ __forceinline__ void p3_gla_local_fast(const Params& p, int l, unsigned char* lds_raw) { PHASE_IDS;
    typedef pg8::bf16x8 bf16x8;
    const int grp = __builtin_amdgcn_readfirstlane(tidx >> 8), tg = tidx & 255, w4 = __builtin_amdgcn_readfirstlane((tidx >> 6) & 3), lane = tidx & 63;
    bf16_t* KT = (bf16_t*)(lds_raw + grp * 32768);
    bf16_t* VT = KT + 2 * 32 * 72;
    float* AST = (float*)(p.ws + WS_AST); float* DEC = (float*)(p.ws + WS_DEC);
    float* wlds = (float*)(lds_raw + 65536); gla_stage_w(wlds, p, l, tidx);
    const int nitems = BATCH * NCHK * 4;
    const int G = gridDim.x, half = G >> 1, npairs = nitems / 2, nup = (G - half) * 4 < npairs ? (G - half) * 4 : npairs;
    const int myfirst = bidx_ >= half ? (bidx_ - half) : nup + bidx_, mystep = bidx_ >= half ? (G - half) : half, myend = bidx_ >= half ? nup : npairs;
    for (int pi = myfirst; pi < myend; pi += mystep) {
        const int it = pi * 2 + grp; const bool valid = it < nitems;
        const int h = it & 3, cs = (it >> 2) % NCHK, b = it / (4 * NCHK);
        const int dir = w4 >> 1, kh = w4 & 1;
        GlaIn in;
        if (valid) gla_load(in, p.ws, gla_row0(b, cs), h, w4, lane, tg);
        __syncthreads();
        if (valid) {
            GlaPrep g; gla_prep(g, in, wlds, h, w4, lane);
#pragma unroll
            for (int kk = 0; kk < 16; ++kk) KT[(dir * 32 + kh * 16 + kk) * 72 + lane] = f2bf(g.k[kk] * __expf(g.tot[kk] - g.cum[kk]));
            if (lane == 0) {
#pragma unroll
                for (int kk = 0; kk < 16; ++kk) DEC[((size_t)it * 2 + dir) * 32 + kh * 16 + kk] = __expf(g.tot[kk]);
            }
            gla_write_vt(VT, in, tg);
        }
        __syncthreads();
        if (valid) {
            const int r = lane & 15, q4 = lane >> 4, kt = kh;
            float* dst = AST + ((size_t)it * 2 + dir) * 2048;
#pragma unroll
            for (int vt = 0; vt < 4; ++vt) {
                f32x4 acc = {0.f, 0.f, 0.f, 0.f};
#pragma unroll
                for (int ks = 0; ks < 2; ++ks) {
                    const bf16x8 a = *(const bf16x8*)(KT + (dir * 32 + kt * 16 + r) * 72 + ks * 32 + q4 * 8);
                    const bf16x8 bb = *(const bf16x8*)(VT + (vt * 16 + r) * 72 + ks * 32 + q4 * 8);
                    acc = __builtin_amdgcn_mfma_f32_16x16x32_bf16(a, bb, acc, 0, 0, 0);
                }
                *(f32x4*)(dst + (vt * 16 + r) * 32 + kt * 16 + q4 * 4) = acc;
            }
        }
    }
}
__device__ __forceinline__ void p3_gla_scan_fast(const Params& p) { PHASE_IDS;
    const float* AST = (const float*)(p.ws + WS_AST); const float* DEC = (const float*)(p.ws + WS_DEC);
    bf16_t* ST = (bf16_t*)(p.ws + WS_ST);
    for (int i = GT; i < BATCH * 4 * 2 * 2048; i += NGT) {
        const int e = i & 2047, dir = (i >> 11) & 1, h = (i >> 12) & 3, b = i >> 14, k = e & 31;
        float a[NCHK], d[NCHK];
#pragma unroll
        for (int q = 0; q < NCHK; ++q) { const int cs = dir == 0 ? q : (q < 4 ? 3 - q : NCHK + 3 - q); const size_t id = (((size_t)b * NCHK + cs) * 4 + h) * 2 + dir; a[q] = AST[id * 2048 + e]; d[q] = DEC[id * 32 + k]; }
        float s = 0.f;
#pragma unroll
        for (int q = 0; q < NCHK; ++q) { const int cs = dir == 0 ? q : (q < 4 ? 3 - q : NCHK + 3 - q); const size_t id = (((size_t)b * NCHK + cs) * 4 + h) * 2 + dir; ST[id * 2048 + e] = f2bf(s); s = d[q] * s + a[q]; }
    }
}
__device__ __forceinline__ void p4_gla_out_fast(const Params& p, int l, unsigned char* lds_raw) { PHASE_IDS;
    typedef pg8::bf16x8 bf16x8;
    const int grp = __builtin_amdgcn_readfirstlane(tidx >> 8), tg = tidx & 255, w4 = __builtin_amdgcn_readfirstlane((tidx >> 6) & 3), lane = tidx & 63;
    bf16_t* QT = (bf16_t*)(lds_raw + grp * 58368);
    bf16_t* KL = QT + 2 * 64 * 40;
    bf16_t* SL = KL + 2 * 64 * 40;
    bf16_t* VT = SL + 2 * 64 * 40;
    bf16_t* ATT = VT + 64 * 72;
    bf16_t* GL = ATT + 64 * 72;
    const bf16_t* ST = (const bf16_t*)(p.ws + WS_ST); const bf16_t* GG = (const bf16_t*)(p.ws + WS_GG);
    bf16_t* MIX = (bf16_t*)(p.ws + WS_HB);
    float* wlds = (float*)(lds_raw + 116736); gla_stage_w(wlds, p, l, tidx);
    const int cs0 = l == 1 ? 4 : 0, ncs = NCHK - cs0, nitems = BATCH * ncs * 4;
    for (int pi = bidx_; pi * 2 < nitems; pi += gridDim.x) {
        const int itl = pi * 2 + grp; const bool valid = itl < nitems;
        const int h = itl & 3, cs = cs0 + (itl >> 2) % ncs, b = itl / (4 * ncs);
        const int it = (b * NCHK + cs) * 4 + h;
        const int dir = w4 >> 1, kh = w4 & 1;
        const int row0 = gla_row0(b, cs);
        GlaIn in; pg8::u32x4 st[2], gg[2];
        const int gr = tg >> 2, gc = tg & 3;
        if (valid) {
            gla_load(in, p.ws, row0, h, w4, lane, tg);
#pragma unroll
            for (int j = 0; j < 2; ++j) { const int pc = tg + 256 * j, d2 = pc >> 8, v = (pc >> 2) & 63, c = pc & 3; st[j] = *(const pg8::u32x4*)(ST + ((size_t)it * 2 + d2) * 2048 + v * 32 + c * 8); }
            gg[0] = *(const pg8::u32x4*)(GG + (size_t)(row0 + gr) * 256 + h * 64 + 16 * gc); gg[1] = *(const pg8::u32x4*)(GG + (size_t)(row0 + gr) * 256 + h * 64 + 16 * gc + 8);
        }
        __syncthreads();
        if (valid) {
            GlaPrep g; gla_prep(g, in, wlds, h, w4, lane);
            pg8::u32x4 wq[2], wk[2];
#pragma unroll
            for (int i = 0; i < 8; ++i) {
                const float e0 = __expf(g.cum[2 * i]), e1 = __expf(g.cum[2 * i + 1]);
                ((unsigned*)wq)[i] = pg8::cvt_pk_bf16(g.q[2 * i] * e0, g.q[2 * i + 1] * e1);
                ((unsigned*)wk)[i] = pg8::cvt_pk_bf16(g.k[2 * i] * __builtin_amdgcn_rcpf(e0), g.k[2 * i + 1] * __builtin_amdgcn_rcpf(e1));
            }
            *(pg8::u32x4*)(QT + (dir * 64 + lane) * 40 + kh * 16) = wq[0]; *(pg8::u32x4*)(QT + (dir * 64 + lane) * 40 + kh * 16 + 8) = wq[1];
            *(pg8::u32x4*)(KL + (dir * 64 + lane) * 40 + kh * 16) = wk[0]; *(pg8::u32x4*)(KL + (dir * 64 + lane) * 40 + kh * 16 + 8) = wk[1];
            gla_write_vt(VT, in, tg);
#pragma unroll
            for (int j = 0; j < 2; ++j) { const int pc = tg + 256 * j, d2 = pc >> 8, v = (pc >> 2) & 63, c = pc & 3; *(pg8::u32x4*)(SL + (d2 * 64 + v) * 40 + c * 8) = st[j]; }
            *(pg8::u32x4*)(GL + gr * 72 + 16 * gc) = gg[0]; *(pg8::u32x4*)(GL + gr * 72 + 16 * gc + 8) = gg[1];
        }
        __syncthreads();
        if (valid) {
            const int r = lane & 15, q4 = lane >> 4, i0 = 16 * w4;
            const bf16x8 aF = *(const bf16x8*)(QT + (0 * 64 + i0 + r) * 40 + q4 * 8), aB = *(const bf16x8*)(QT + (1 * 64 + i0 + r) * 40 + q4 * 8);
#pragma unroll
            for (int jt = 0; jt < 4; ++jt) {
                const bf16x8 bF = *(const bf16x8*)(KL + (0 * 64 + jt * 16 + r) * 40 + q4 * 8), bB = *(const bf16x8*)(KL + (1 * 64 + jt * 16 + r) * 40 + q4 * 8);
                const f32x4 z = {0.f, 0.f, 0.f, 0.f};
                const f32x4 F = __builtin_amdgcn_mfma_f32_16x16x32_bf16(aF, bF, z, 0, 0, 0), Bv = __builtin_amdgcn_mfma_f32_16x16x32_bf16(aB, bB, z, 0, 0, 0);
                const int j = jt * 16 + r;
#pragma unroll
                for (int e = 0; e < 4; ++e) { const int i = i0 + 4 * q4 + e; const float v = (j <= i ? F[e] : 0.f) + (j >= i ? Bv[e] : 0.f); ATT[i * 72 + j] = f2bf(v); }
            }
            __builtin_amdgcn_s_waitcnt(0);
            f32x4 o[4];
#pragma unroll
            for (int vt = 0; vt < 4; ++vt) {
                f32x4 acc = {0.f, 0.f, 0.f, 0.f};
#pragma unroll
                for (int ks = 0; ks < 2; ++ks) {
                    const bf16x8 a = *(const bf16x8*)(ATT + (i0 + r) * 72 + ks * 32 + q4 * 8);
                    const bf16x8 bb = *(const bf16x8*)(VT + (vt * 16 + r) * 72 + ks * 32 + q4 * 8);
                    acc = __builtin_amdgcn_mfma_f32_16x16x32_bf16(a, bb, acc, 0, 0, 0);
                }
                const bf16x8 sF = *(const bf16x8*)(SL + (0 * 64 + vt * 16 + r) * 40 + q4 * 8), sB = *(const bf16x8*)(SL + (1 * 64 + vt * 16 + r) * 40 + q4 * 8);
                acc = __builtin_amdgcn_mfma_f32_16x16x32_bf16(aF, sF, acc, 0, 0, 0);
                acc = __builtin_amdgcn_mfma_f32_16x16x32_bf16(aB, sB, acc, 0, 0, 0);
                o[vt] = acc;
            }
            float gn[4];
#pragma unroll
            for (int vt = 0; vt < 4; ++vt) gn[vt] = p.gla_norm[l * 64 + vt * 16 + r];
#pragma unroll
            for (int e = 0; e < 4; ++e) {
                float ss = o[0][e] * o[0][e] + o[1][e] * o[1][e] + o[2][e] * o[2][e] + o[3][e] * o[3][e];
                ss += __shfl_xor(ss, 1); ss += __shfl_xor(ss, 2); ss += __shfl_xor(ss, 4); ss += __shfl_xor(ss, 8);
                const float rs = rsqrtf(ss * (1.f / 64.f) + EPS);
                bf16_t* gl = GL + (i0 + 4 * q4 + e) * 72 + r;
#pragma unroll
                for (int vt = 0; vt < 4; ++vt) { const float gt = bf2f(gl[vt * 16]); gl[vt * 16] = f2bf(o[vt][e] * rs * gn[vt] * gt * __builtin_amdgcn_rcpf(1.f + __expf(-gt))); }
            }
        }
        __syncthreads();
        if (valid) { *(pg8::u32x4*)(MIX + (size_t)(row0 + gr) * D + 256 + h * 64 + 16 * gc) = *(const pg8::u32x4*)(GL + gr * 72 + 16 * gc); *(pg8::u32x4*)(MIX + (size_t)(row0 + gr) * D + 256 + h * 64 + 16 * gc + 8) = *(const pg8::u32x4*)(GL + gr * 72 + 16 * gc + 8); }
    }
}

constexpr size_t TAB_M1 = 16384, TAB_M2 = 24576, TAB_EC = 40960;
__device__ __forceinline__ void p3_fnet_fft(const Params& p, unsigned char* lds_raw) { PHASE_IDS;
    typedef pg8::bf16x8 bf16x8;
    const int lane = tidx & 63, w = __builtin_amdgcn_readfirstlane(tidx >> 6), j = lane & 15, q4 = lane >> 4;
    const float* TAB = (const float*)(p.ws + WS_TAB);
    const bf16_t* M1g = (const bf16_t*)(p.ws + WS_TAB + TAB_M1); const bf16_t* M2g = (const bf16_t*)(p.ws + WS_TAB + TAB_M2); const bf16_t* ECg = (const bf16_t*)(p.ws + WS_TAB + TAB_EC);
    const bf16_t* U = (const bf16_t*)(p.ws + WS_YFTL);
    bf16_t* MIX = (bf16_t*)(p.ws + WS_HB);
    const float scale = 0.0027621358640099515f;
    for (int it = bidx_; it < BATCH * 16; it += gridDim.x) {
        const int b = it >> 4, jb = it & 15;
        const bf16_t* M1 = M1g; const bf16_t* M2 = M2g; const bf16_t* EC = ECg; asm volatile("" : "+s"(M1), "+s"(M2), "+s"(EC));
        __syncthreads();
        {
            bf16x8 a1[4][2];
#pragma unroll
            for (int mt = 0; mt < 4; ++mt)
#pragma unroll
                for (int ks = 0; ks < 2; ++ks) a1[mt][ks] = *(const bf16x8*)(M1 + (16 * mt + j) * 64 + ks * 32 + 8 * q4);
            bf16x8 ec[2][2];
#pragma unroll
            for (int part = 0; part < 2; ++part)
#pragma unroll
                for (int ks = 0; ks < 2; ++ks) ec[part][ks] = *(const bf16x8*)(EC + part * 4096 + (16 * (jb & 3) + j) * 64 + ks * 32 + 8 * q4);
            const bf16_t* ub = U + ((size_t)b * SEQ + 64 * j + 8 * w) * 256 + (jb >> 2) * 64 + 8 * q4;
#pragma unroll
            for (int half = 0; half < 2; ++half) {
                bf16x8 ua[4][2][2];
#pragma unroll
                for (int ci = 0; ci < 4; ++ci)
#pragma unroll
                    for (int tl = 0; tl < 2; ++tl)
#pragma unroll
                        for (int ks = 0; ks < 2; ++ks) ua[ci][tl][ks] = *(const bf16x8*)(ub + (size_t)(1024 * tl + 4 * half + ci) * 256 + ks * 32);
                bf16x8 y[4][2];
#pragma unroll
                for (int ci = 0; ci < 4; ++ci)
#pragma unroll
                    for (int part = 0; part < 2; ++part) { f32x4 d[2];
#pragma unroll
                        for (int tl = 0; tl < 2; ++tl) { d[tl] = (f32x4){0.f, 0.f, 0.f, 0.f};
#pragma unroll
                            for (int ks = 0; ks < 2; ++ks) d[tl] = __builtin_amdgcn_mfma_f32_16x16x32_bf16(ua[ci][tl][ks], ec[part][ks], d[tl], 0, 0, 0); }
                        pg8::u32x4 pk; pk.x = pg8::cvt_pk_bf16_c(d[0][0], d[0][1]); pk.y = pg8::cvt_pk_bf16_c(d[0][2], d[0][3]); pk.z = pg8::cvt_pk_bf16_c(d[1][0], d[1][1]); pk.w = pg8::cvt_pk_bf16_c(d[1][2], d[1][3]);
                        y[ci][part] = __builtin_bit_cast(bf16x8, pk); }
                unsigned zp[2][2][4][2];
#pragma unroll
                for (int cp = 0; cp < 2; ++cp) {
                    float zr[2][2][4], zi[2][2][4];
#pragma unroll
                    for (int cq = 0; cq < 2; ++cq) {
                        const int ci = 2 * cp + cq; int c = 8 * w + 4 * half + ci; asm volatile("" : "+s"(c));
                        f32x4 acc[4];
#pragma unroll
                        for (int mt = 0; mt < 4; ++mt) { acc[mt] = (f32x4){0.f, 0.f, 0.f, 0.f};
#pragma unroll
                            for (int ks = 0; ks < 2; ++ks) acc[mt] = __builtin_amdgcn_mfma_f32_16x16x32_bf16(a1[mt][ks], y[ci][ks], acc[mt], 0, 0, 0); }
#pragma unroll
                        for (int m1 = 0; m1 < 2; ++m1)
#pragma unroll
                            for (int e = 0; e < 4; ++e) {
                                const int k1 = 16 * m1 + 4 * q4 + e, idx = k1 * c;
                                const float cs = TAB[idx], sn = TAB[(idx - 512) & 2047];
                                const float re = acc[m1][e], im = acc[2 + m1][e];
                                zr[cq][m1][e] = re * cs + im * sn; zi[cq][m1][e] = im * cs - re * sn;
                            }
                        asm volatile("" ::: "memory");
                    }
#pragma unroll
                    for (int m1 = 0; m1 < 2; ++m1)
#pragma unroll
                        for (int e = 0; e < 4; ++e) { zp[0][m1][e][cp] = pg8::cvt_pk_bf16(zr[0][m1][e], zr[1][m1][e]); zp[1][m1][e][cp] = pg8::cvt_pk_bf16(zi[0][m1][e], zi[1][m1][e]); }
                }
#pragma unroll
                for (int ri = 0; ri < 2; ++ri)
#pragma unroll
                    for (int m1 = 0; m1 < 2; ++m1)
#pragma unroll
                        for (int e = 0; e < 4; ++e) { const int k1 = 16 * m1 + 4 * q4 + e;
                            *(pg8::u32x2*)(lds_raw + ((ri * 32 + k1) * 16 + j) * 128 + ((w ^ ((j >> 1) & 7)) << 4) + half * 8) = (pg8::u32x2){zp[ri][m1][e][0], zp[ri][m1][e][1]}; }
                asm volatile("" ::: "memory");
            }
        }
        __syncthreads();
        {
            bf16x8 a2[4][4];
#pragma unroll
            for (int mt = 0; mt < 4; ++mt)
#pragma unroll
                for (int ks = 0; ks < 4; ++ks) a2[mt][ks] = *(const bf16x8*)(M2 + (16 * mt + j) * 128 + ks * 32 + 8 * q4);
#pragma unroll
            for (int kq = 0; kq < 4; ++kq) {
                const int k1 = 4 * w + kq;
                bf16x8 zb[4];
#pragma unroll
                for (int ks = 0; ks < 4; ++ks) zb[ks] = *(const bf16x8*)(lds_raw + (((ks >> 1) * 32 + k1) * 16 + j) * 128 + (((4 * (ks & 1) + q4) ^ ((j >> 1) & 7)) << 4));
                bf16_t* op = MIX + ((size_t)b * SEQ + k1 + 128 * q4) * D + 16 * jb + j;
#pragma unroll
                for (int mt = 0; mt < 4; ++mt) {
                    f32x4 acc = {0.f, 0.f, 0.f, 0.f};
#pragma unroll
                    for (int ks = 0; ks < 4; ++ks) acc = __builtin_amdgcn_mfma_f32_16x16x32_bf16(a2[mt][ks], zb[ks], acc, 0, 0, 0);
#pragma unroll
                    for (int e = 0; e < 4; ++e) op[(size_t)(32 * e) * D] = f2bf(acc[e] * scale);
                    op += (size_t)512 * D; asm volatile("" : "+v"(op) :: "memory");
                }
            }
        }
    }
}

#define STAMPG(n) do { if ((PROBE_A == (n) || PROBE_B == (n)) && blockIdx.x == 0 && threadIdx.x == 0) ((volatile unsigned long long*)(lds_raw + LDS_BYTES - 512))[PROBE_B == (n) ? 1 : 0] = __builtin_amdgcn_s_memrealtime(); } while (0)
#define LAS __attribute__((address_space(3)))
__host__ __device__ __forceinline__ int tile_pos(int lc) { return 128 * ((lc >> 5) & 1) + 32 * (lc >> 6) + (lc & 31); }
__device__ __forceinline__ int inproj_dest(int c) {
    int T, lc;
    if (c < C_GQ) { T = 9; lc = c; } else if (c < C_GV) { T = 2; lc = c - C_GQ; } else if (c < C_GG) { T = 3; lc = c - C_GV; } else if (c < C_GDF) { T = 4; lc = c - C_GG; }
    else if (c < C_AQ) { T = 8; lc = c - C_GDF; } else if (c < C_AQ + 256) { T = 5; lc = c - C_AQ; } else if (c < C_AK) { T = 6; lc = c - C_AQ - 256; } else { T = 7; lc = c - C_AK; }
    return T * 256 + tile_pos(lc);
}
__device__ __forceinline__ void p0a_fast(const Params& p, float* lds) { PHASE_IDS;
    const int lane = tidx & 63, wave = tidx >> 6;
    float* scr = lds + wave * 2304;
    bf16_t* WIN = (bf16_t*)(p.ws + WS_WIN); bf16_t* WOUT = (bf16_t*)(p.ws + WS_WOUT);
    for (int it = GW; it < 2 * 64 * 8; it += NGW) {
        const int nb = it & 7, kb = (it >> 3) & 63, l = it >> 9, n = nb * 256 + 4 * lane; const bool valid = n < DIN;
        conv_item4(p.w_in + (size_t)l * D * DIN, DIN, kb * 16, n, valid, WIN + ((size_t)l * NIN + inproj_dest(valid ? n : 256)) * D + kb * 16, D);
    }
    STAMPG(41);
    for (int it = GW; it < 2 * 64 * 4; it += NGW) {
        const int nb = it & 3, kb = (it >> 2) & 63, l = it >> 8, n = nb * 256 + 4 * lane;
        conv_item4(p.w_out + (size_t)l * D * D, D, kb * 16, n, true, WOUT + ((size_t)l * D + n) * D + kb * 16, D);
    }
    STAMPG(42);
    { float sn, cs; sincos_r((float)lane * 0.09817477042468103f, sn, cs); scr[2 * lane] = cs; scr[2 * lane + 1] = sn; }
    float* tile = scr + 128;
    for (int it = GW; it < 16 * 4 * 16; it += NGW) {
        const int jq = it & 15, g = (it >> 4) & 3, kb = (it >> 6) & 15, l = 0;
        const float* W = p.w_in + (size_t)l * D * DIN;
        float yr[4], ys[4];
#pragma unroll
        for (int jj = 0; jj < 4; ++jj) { yr[jj] = 0.f; ys[jj] = 0.f; }
        for (int half = 0; half < 2; ++half) {
            __builtin_amdgcn_s_waitcnt(0); asm volatile("" ::: "memory");
            { float tv[32];
#pragma unroll
              for (int i = 0; i < 32; ++i) { const int kk = 2 * i + (lane >> 5); tv[i] = W[(size_t)(kb * 64 + kk) * DIN + g * 64 + half * 32 + (lane & 31)]; }
#pragma unroll
              for (int i = 0; i < 32; ++i) { const int kk = 2 * i + (lane >> 5); tile[kk * 33 + (lane & 31)] = tv[i]; } }
            __builtin_amdgcn_s_waitcnt(0); asm volatile("" ::: "memory");
#pragma unroll 4
            for (int cc = 0; cc < 32; ++cc) {
                const float u = tile[lane * 33 + cc]; const int c = half * 32 + cc;
#pragma unroll
                for (int jj = 0; jj < 4; ++jj) { const int m = ((jq * 4 + jj) * c) & 63; yr[jj] = fmaf(u, scr[2 * m], yr[jj]); ys[jj] = fmaf(u, scr[2 * m + 1], ys[jj]); }
            }
        }
#pragma unroll
        for (int jj = 0; jj < 4; ++jj) { const int j = jq * 4 + jj; const size_t row = (size_t)l * NIN + tile_pos(g * 64 + j);
            WIN[(row) * D + kb * 64 + lane] = f2bf(yr[jj]); WIN[(row + 256) * D + kb * 64 + lane] = f2bf(ys[jj]); }
    }
    STAMPG(43);
    for (int i = GT; i < 2 * 224 * (D / 8); i += NGT) {
        const int k8 = i & 127, lc = 32 + (i >> 7) % 224, l = i / (224 * 128);
        *(pg8::u32x4*)(WIN + ((size_t)l * NIN + 8 * 256 + tile_pos(lc)) * D + k8 * 8) = (pg8::u32x4){0u, 0u, 0u, 0u};
    }
    {
        bf16_t* DC = (bf16_t*)(p.ws + WS_DMATC);
        for (int i = GT; i < 256 * 512 / 8; i += NGT) {
            const int t8 = (i & 63) * 8, k = i >> 6; unsigned w[4];
#pragma unroll
            for (int q = 0; q < 4; ++q) { float v[2];
#pragma unroll
                for (int e = 0; e < 2; ++e) { const int tt = t8 + 2 * q + e, t = tt & 255; const int m = (k * t) & 255; float sn, cs; sincos_r((float)m * (6.283185307179586f / 256.f), sn, cs); v[e] = tt < 256 ? cs : -sn; }
                w[q] = pg8::cvt_pk_bf16(v[0], v[1]); }
            *(pg8::u32x4*)(DC + (size_t)k * 512 + t8) = (pg8::u32x4){w[0], w[1], w[2], w[3]};
        }
    }
    STAMPG(44);
}

#define XB_TMO      128
#define XB_XCNT(j)  (256  + 64 * (j))
#define XB_XSUB(j)  (1280 + 64 * (j))
#define XB_XGEN(j)  (2304 + 64 * (j))
#define XB_TOP      3328
#define XB_TOPGEN   3392
#define XCD_BAR_WORDS 3456
#define XB_SPIN_CAP (1u << 18)
__device__ __forceinline__ unsigned xb_ld(unsigned* p)              { return __hip_atomic_load(p, __ATOMIC_RELAXED, __HIP_MEMORY_SCOPE_AGENT); }
__device__ __forceinline__ unsigned xb_add(unsigned* p, unsigned v) { return __hip_atomic_fetch_add(p, v, __ATOMIC_RELAXED, __HIP_MEMORY_SCOPE_AGENT); }
__device__ __forceinline__ unsigned xb_xcc_id() { return (unsigned)__builtin_amdgcn_s_getreg((3 << 11) | 20) & 0xFu; }
#define XB_SPIN(cond, bar) do { unsigned _sp = 0; while (cond) { __builtin_amdgcn_s_sleep(1); \
    if ((++_sp & 255u) == 0u) { if (xb_ld(&(bar)[XB_TMO])) break; if (_sp > XB_SPIN_CAP) { atomicAdd(&(bar)[XB_TMO], 1u); break; } } } } while (0)
struct XcdBarrier { unsigned* bar; unsigned x; volatile __attribute__((address_space(3))) unsigned* st; };
__device__ __forceinline__ XcdBarrier xcd_barrier_post(unsigned* bar, volatile __attribute__((address_space(3))) unsigned* st) {
    XcdBarrier b; b.bar = bar; b.x = xb_xcc_id(); b.st = st;
    if (otid() == 0) (void)xb_add(&bar[XB_XCNT(b.x)], 1u);
    return b;
}
__device__ __forceinline__ void xcd_barrier_complete(unsigned* bar, unsigned x, unsigned& nloc, unsigned& nx) {
    const unsigned G = gridDim.x * gridDim.y * gridDim.z;
    unsigned sum, cnt, mine, sp = 0u;
    for (;;) {
        sum = 0u; cnt = 0u; mine = 0u;
#pragma unroll
        for (unsigned j = 0; j < 16; ++j) { const unsigned c = xb_ld(&bar[XB_XCNT(j)]); sum += c; cnt += (c > 0u) ? 1u : 0u; mine = (j == x) ? c : mine; }
        if (sum == G) break;
        __builtin_amdgcn_s_sleep(1);
        if ((++sp & 255u) == 0u) { if (xb_ld(&bar[XB_TMO])) break; if (sp > XB_SPIN_CAP) { atomicAdd(&bar[XB_TMO], 1u); break; } }
    }
    nloc = mine > 0u ? mine : 1u; nx = cnt > 0u ? cnt : 1u;
}
__device__ __forceinline__ void xcd_barrier(const XcdBarrier& b) {
    asm volatile("s_waitcnt vmcnt(0)" ::: "memory");
    __syncthreads();
    if (otid() == 0) {
        unsigned* bar = b.bar;
        __builtin_amdgcn_s_waitcnt(0);
        unsigned nloc = b.st[0], nx = b.st[1];
        if (nloc == 0u) { xcd_barrier_complete(bar, b.x, nloc, nx); b.st[0] = nloc; b.st[1] = nx; }
        const unsigned old = xb_add(&bar[XB_XSUB(b.x)], 1u);
        const unsigned gen = old / nloc;
        if (old + 1u == (gen + 1u) * nloc) {
            __builtin_amdgcn_fence(__ATOMIC_RELEASE, "agent");
            asm volatile("s_waitcnt vmcnt(0)" ::: "memory");
            const unsigned og = xb_add(&bar[XB_TOP], 1u);
            const unsigned tg = og / nx;
            if (og + 1u == (tg + 1u) * nx) xb_add(&bar[XB_TOPGEN], 1u);
            else XB_SPIN(xb_ld(&bar[XB_TOPGEN]) == tg, bar);
            __builtin_amdgcn_fence(__ATOMIC_ACQUIRE, "agent");
            xb_add(&bar[XB_XGEN(b.x)], 1u);
            asm volatile("s_waitcnt vmcnt(0)" ::: "memory");
        } else {
            XB_SPIN(xb_ld(&bar[XB_XGEN(b.x)]) == gen, bar);
            __builtin_amdgcn_fence(__ATOMIC_ACQUIRE, "agent");
            asm volatile("s_waitcnt vmcnt(0)" ::: "memory");
        }
    }
    __syncthreads();
}

__global__ void __launch_bounds__(NTHREADS) mega(Params p) {
    if ((threadIdx.x & 63) == 0) ((volatile __attribute__((address_space(3))) int*)((__attribute__((address_space(3))) unsigned char*)lds_raw + WTAB_OFF))[hw_wave_slot()] = threadIdx.x >> 6;
    __syncthreads();
    float* lds = (float*)lds_raw;
    cg::grid_group grid = cg::this_grid();
    volatile __attribute__((address_space(3))) unsigned* bst = (volatile __attribute__((address_space(3))) unsigned*)((__attribute__((address_space(3))) unsigned char*)lds_raw + LDS_BYTES - 1024);
    { const int t0_ = otid(); if (t0_ < 2) bst[t0_] = 0u; }
    __syncthreads();
    const XcdBarrier bar = xcd_barrier_post((unsigned*)(p.ws + WS_CTL), bst);
#define GSYNC() xcd_barrier(bar)
    volatile unsigned long long* tst = (volatile unsigned long long*)(lds_raw + LDS_BYTES - 512);
#define STAMP(n) do { if ((PROBE_A == (n) || PROBE_B == (n)) && blockIdx.x == 0 && threadIdx.x == 0) tst[PROBE_B == (n) ? 1 : 0] = __builtin_amdgcn_s_memrealtime(); } while (0)
    STAMP(0);
    p0a(p, lds); __syncthreads(); STAMP(40); p0a_fast(p, lds); STAMP(45); grid.sync(); STAMP(1);
    p0b(p); GSYNC(); STAMP(2);
#define LAYER(l) do { p1_norm1(p, l); GSYNC(); STAMP(3 + 9 * (l)); \
        p2_inproj_fast(p, l, lds_raw); GSYNC(); STAMP(4 + 9 * (l)); \
        p3_fnet_fft(p, lds_raw); __syncthreads(); STAMP(30 + 3 * (l)); p3_fnet_fast(p, l, lds_raw); __syncthreads(); STAMP(31 + 3 * (l)); p3_gla_local_fast(p, l, lds_raw); __syncthreads(); STAMP(32 + 3 * (l)); p3_attn_fast(p, l, lds_raw); GSYNC(); STAMP(5 + 9 * (l)); \
        p3_gla_scan_fast(p); GSYNC(); STAMP(6 + 9 * (l)); p4_gla_out_fast(p, l, lds_raw); GSYNC(); STAMP(7 + 9 * (l)); \
        p5_outproj_fast(p, l, lds_raw); GSYNC(); STAMP(8 + 9 * (l)); p6_norm2_router(p, l, lds); GSYNC(); STAMP(9 + 9 * (l)); \
        p7_gateup_fast(p, l, lds_raw); GSYNC(); STAMP(10 + 9 * (l)); p8_down_fast(p, l, lds_raw); GSYNC(); STAMP(11 + 9 * (l)); } while (0)
    LAYER(0);
    LAYER(1);
#undef LAYER
    p9_final(p);
    if (PROBE_A >= 0) { __syncthreads(); if (blockIdx.x == 0 && threadIdx.x == 0) { if (PROBE_B == 21) tst[1] = __builtin_amdgcn_s_memrealtime(); const unsigned long long dt = (tst[1] - tst[0]) * PROBE_K, t0 = __builtin_amdgcn_s_memrealtime(); while (__builtin_amdgcn_s_memrealtime() - t0 < dt) __builtin_amdgcn_s_sleep(8); } }
}

extern "C" void kernel_launch(void* const* d_in, const int* in_sizes, int n_in, void* d_out, int out_size, void* d_ws, size_t ws_size, hipStream_t stream) {
    static int grid_blocks = 0;
    if (!grid_blocks) {
        int dev = 0, cus = 0, per_cu = 0;
        hipGetDevice(&dev);
        hipDeviceGetAttribute(&cus, hipDeviceAttributeMultiprocessorCount, dev);
        hipFuncSetAttribute((const void*)mega, hipFuncAttributeMaxDynamicSharedMemorySize, LDS_BYTES);
        hipOccupancyMaxActiveBlocksPerMultiprocessor(&per_cu, (const void*)mega, NTHREADS, LDS_BYTES);
        if (per_cu < 1) { fprintf(stderr, "occupancy query says %d blocks/CU\n", per_cu); per_cu = 1; }
        grid_blocks = cus;
        if (n_in != 21 || ws_size < WS_END) fprintf(stderr, "unexpected n_in %d / ws_size %zu\n", n_in, ws_size);
    }
    hipMemsetAsync((char*)d_ws + WS_CTL, 0, 65536, stream);
    Params p{};
    const float** f = (const float**)&p;
    for (int i = 0; i < 21; ++i) f[i] = (const float*)d_in[i];
    p.out = (float*)d_out; p.ws = (unsigned char*)d_ws;
    void* args[] = {&p};
    hipError_t e = hipLaunchCooperativeKernel((const void*)mega, dim3(grid_blocks), dim3(NTHREADS), args, LDS_BYTES, stream);
    if (e != hipSuccess) fprintf(stderr, "cooperative launch failed: %s (grid %d)\n", hipGetErrorString(e), grid_blocks);
}
```

```cpp
#include <hip/hip_runtime.h>
#include <hip/hip_cooperative_groups.h>
#include <cstdio>
#include <cstdint>
namespace cg = cooperative_groups;

typedef unsigned short bf16_t;
typedef float f32x4 __attribute__((ext_vector_type(4)));

constexpr int D = 1024, BATCH = 8, SEQ = 2048, CTXL = 256, DEPTH = 2;
constexpr int NL = BATCH * SEQ, NC = BATCH * CTXL, NTOK = NL + NC;
constexpr int DIN = 1824;
constexpr int C_FN = 0, C_GQ = 256, C_GK = 384, C_GV = 512, C_GG = 768, C_GDF = 1024, C_GDB = 1040, C_AQ = 1056, C_AK = 1568, C_AV = 1696;
constexpr int KEYS = CTXL + SEQ;
constexpr int NCHK = 36;
constexpr int NEXP = 16, DEXP = 512;
constexpr float EPS = 1e-6f;
constexpr float QSCALE = 0.125f * 1.4426950408889634f;
constexpr int NWAVES = 8, NTHREADS = 512;
#ifndef DUP
#define DUP 0
#endif
#ifndef PROBE_A
#define PROBE_A -1
#endif
#ifndef PROBE_B
#define PROBE_B -1
#endif
#define PROBE_K 8
#define DUPN(id) ((DUP == (id)) ? 2 : 1)
#define GOLDEN_FNET 0
#define GOLDEN_ATTN 0
#define GOLDEN_GLA 0
constexpr int LDS_BYTES = 147456;

constexpr size_t MiB = 1u << 20;
constexpr size_t WS_CTL = 0;
constexpr size_t WS_MODP = 151 * MiB;
constexpr size_t WS_MOD = 9 * MiB;
constexpr size_t WS_TAB = 10 * MiB;
constexpr size_t WS_XC = 11 * MiB;
constexpr size_t WS_HB = 19 * MiB;
constexpr size_t WS_YFTL = 55 * MiB;
constexpr size_t WS_YFTC = 71 * MiB;
constexpr size_t WS_GQK = 73 * MiB;
constexpr size_t WS_GV = 82 * MiB;
constexpr size_t WS_GG = 91 * MiB;
constexpr size_t WS_GD = 100 * MiB;
constexpr size_t WS_AQ = 102 * MiB;
constexpr size_t WS_AK = 120 * MiB;
constexpr size_t WS_AVT = 125 * MiB;
constexpr size_t WS_AST = 130 * MiB;
constexpr size_t WS_DEC = 149 * MiB;
constexpr size_t WS_ROUTE = 150 * MiB;
constexpr size_t WS_Y = 151 * MiB;
constexpr size_t WS_WIN = 314 * MiB;
constexpr size_t WS_WOUT = 232 * MiB;
constexpr size_t WS_WGU = 236 * MiB;
constexpr size_t WS_WD = 268 * MiB;
constexpr size_t WS_WD1 = 284 * MiB;
constexpr size_t WS_DMATC = 300 * MiB;
constexpr size_t WS_LIST = 301 * MiB;
constexpr size_t WS_ST = 304 * MiB;
constexpr size_t WS_END = 324 * MiB;
constexpr size_t WS_ACT = WS_YFTL;
constexpr int CW_CNT = 8192;
constexpr int NIN = 2560;

struct Params {
    const float *x, *c, *ctx, *c_ctx, *w_ada, *b_ada, *norm_mix, *norm_ffn, *w_in, *w_gup, *b_gg, *gla_norm, *q_norm, *k_norm, *w_out, *w_router, *b_router, *w_eg, *w_eu, *w_ed, *final_norm;
    float* out;
    unsigned char* ws;
};

#define LDSP(T) __attribute__((address_space(3))) T*
namespace pg8 {
typedef short bf16x8 __attribute__((ext_vector_type(8)));
typedef unsigned u32x4 __attribute__((ext_vector_type(4)));
typedef unsigned u32x2 __attribute__((ext_vector_type(2)));
__device__ __forceinline__ unsigned cvt_pk_bf16(float lo, float hi) { unsigned r; asm volatile("v_cvt_pk_bf16_f32 %0, %1, %2" : "=v"(r) : "v"(lo), "v"(hi)); return r; }
typedef __bf16 bf16x2_c __attribute__((ext_vector_type(2)));
typedef float f32x2_c __attribute__((ext_vector_type(2)));
__device__ __forceinline__ unsigned cvt_pk_bf16_c(float lo, float hi) { f32x2_c v = {lo, hi}; return __builtin_bit_cast(unsigned, __builtin_convertvector(v, bf16x2_c)); }
}
__device__ __forceinline__ float bf2f(bf16_t v) { return __uint_as_float((unsigned)v << 16); }
__device__ __forceinline__ bf16_t f2bf(float f) { unsigned u = __float_as_uint(f); return (bf16_t)((u + 0x7fffu + ((u >> 16) & 1u)) >> 16); }
__device__ __forceinline__ float wave_sum(float v) {
#pragma unroll
    for (int o = 1; o < 64; o <<= 1) v += __shfl_xor(v, o);
    return v;
}
__device__ __forceinline__ float siluf(float v) { return v / (1.f + expf(-v)); }
__device__ __forceinline__ float sigmoidf(float v) { return 1.f / (1.f + expf(-v)); }
__device__ __forceinline__ float logsigmoidf(float z) { return fminf(z, 0.f) - log1pf(expf(-fabsf(z))); }
__device__ __forceinline__ void sincos_r(float x, float& s, float& c) {
    const float k = rintf(x * 0.63661977236758134f);
    float r = fmaf(k, -1.57079625129699707031f, x); r = fmaf(k, -7.54978995489188216e-8f, r);
    const int q = ((int)k) & 3;
    const float r2 = r * r;
    float sp = fmaf(r2, 2.7557314297e-6f, -1.9841270114e-4f); sp = fmaf(sp, r2, 8.3333337680e-3f); sp = fmaf(sp, r2, -1.6666667163e-1f); sp = fmaf(sp * r2, r, r);
    float cp = fmaf(r2, 2.4801587642e-5f, -1.3888889225e-3f); cp = fmaf(cp, r2, 4.1666667908e-2f); cp = fmaf(cp, r2, -0.5f); cp = fmaf(cp, r2, 1.f);
    const float ss = (q & 1) ? cp : sp, cc = (q & 1) ? sp : cp;
    s = (q & 2) ? -ss : ss; c = ((q + 1) & 2) ? -cc : cc;
}
struct RowInfo { int b, t, bidx, isctx; };
__device__ __forceinline__ RowInfo row_info(int r) { RowInfo ri; if (r < NL) { ri.b = r >> 11; ri.t = r & 2047; ri.bidx = ri.b; ri.isctx = 0; } else { const int q = r - NL; ri.b = q >> 8; ri.t = q & 255; ri.bidx = 8; ri.isctx = 1; } return ri; }

#define WTAB_OFF (LDS_BYTES - 256)
extern __shared__ __attribute__((aligned(16))) unsigned char lds_raw[];
__device__ __forceinline__ int hw_wave_slot() { return (int)__builtin_amdgcn_s_getreg((5 << 11) | 4) & 63; }
__device__ __forceinline__ int otid() {
    int l; asm volatile("v_mbcnt_lo_u32_b32 %0, -1, 0\n\tv_mbcnt_hi_u32_b32 %0, -1, %0" : "=v"(l));
    const int w = __builtin_amdgcn_readfirstlane(((volatile __attribute__((address_space(3))) int*)((__attribute__((address_space(3))) unsigned char*)lds_raw + WTAB_OFF))[hw_wave_slot()]);
    return w * 64 + l; }
__device__ __forceinline__ int obid() { int b = blockIdx.x; asm volatile("" : "+s"(b)); return b; }
#define PHASE_IDS const int tidx = otid(); const int bidx_ = obid(); (void)tidx; (void)bidx_
#define GW (bidx_ * NWAVES + (tidx >> 6))
#define NGW (gridDim.x * NWAVES)
#define GT (bidx_ * NTHREADS + tidx)
#define NGT (gridDim.x * NTHREADS)

__device__ __forceinline__ void p0a(const Params& p, float* lds) { PHASE_IDS;
    const int lane = tidx & 63;
    float* MODP = (float*)(p.ws + WS_MODP);
    float* sl = lds + 20000;
    { float cv[18];
#pragma unroll
      for (int q = 0; q < 18; ++q) { const int i = tidx + NTHREADS * q, j = i >> 10, k = i & 1023; cv[q] = j < 8 ? p.c[j * D + k] : p.c_ctx[k]; }
#pragma unroll
      for (int q = 0; q < 18; ++q) { const int i = tidx + NTHREADS * q, j = i >> 10, k = i & 1023; sl[k * 12 + j] = siluf(cv[q]); } }
    __syncthreads();
    for (int it = GW; it < 2 * 32 * 24; it += NGW) {
        const int l = it / (32 * 24), kc = (it / 24) % 32, cb = it % 24, col = cb * 256 + 4 * lane;
        f32x4 w[32];
        const float* wp = p.w_ada + ((size_t)l * D + kc * 32) * 6144 + col;
#pragma unroll
        for (int kk = 0; kk < 32; ++kk) w[kk] = *(const f32x4*)(wp + (size_t)kk * 6144);
        f32x4 acc[9];
#pragma unroll
        for (int j = 0; j < 9; ++j) acc[j] = (f32x4){0.f, 0.f, 0.f, 0.f};
#pragma unroll
        for (int kk = 0; kk < 32; ++kk) {
            const f32x4* sp = (const f32x4*)(sl + (kc * 32 + kk) * 12); const f32x4 s0 = sp[0], s1 = sp[1], s2 = sp[2];
            acc[0] += w[kk] * s0[0]; acc[1] += w[kk] * s0[1]; acc[2] += w[kk] * s0[2]; acc[3] += w[kk] * s0[3];
            acc[4] += w[kk] * s1[0]; acc[5] += w[kk] * s1[1]; acc[6] += w[kk] * s1[2]; acc[7] += w[kk] * s1[3];
            acc[8] += w[kk] * s2[0];
        }
#pragma unroll
        for (int j = 0; j < 9; ++j) *(f32x4*)(MODP + ((size_t)(l * 32 + kc) * 9 + j) * 6144 + col) = acc[j];
    }
    {
        bf16_t* M1 = (bf16_t*)(p.ws + WS_TAB + 16384); bf16_t* M2 = (bf16_t*)(p.ws + WS_TAB + 24576); bf16_t* EC = (bf16_t*)(p.ws + WS_TAB + 40960);
        for (int i = GT; i < 64 * 64 + 64 * 128 + 2 * 64 * 64; i += NGT) {
            if (i < 4096) { const int m = i >> 6, k = i & 63, rp = m >> 5, k1 = m & 31, part = k >> 5, sl = k & 31, r = ((sl >> 2) & 1) * 16 + 4 * (sl >> 3) + (sl & 3); float sn, cs; sincos_r((float)((k1 * r) & 31) * (6.283185307179586f / 32.f), sn, cs);
                M1[i] = f2bf(rp == 0 ? (part == 0 ? cs : -sn) : (part == 0 ? -sn : -cs)); }
            else if (i < 4096 + 8192) { const int q = i - 4096, k2 = q >> 7, kk = q & 127, ri = kk >> 6, c = kk & 63; float sn, cs; sincos_r((float)((k2 * c) & 63) * (6.283185307179586f / 64.f), sn, cs); M2[q] = f2bf(ri == 0 ? cs : sn); }
            else { const int q = i - 12288, part = q >> 12, jl = (q >> 6) & 63, ch = q & 63; float sn, cs; sincos_r((float)((jl * ch) & 63) * (6.283185307179586f / 64.f), sn, cs); EC[q] = f2bf(part == 0 ? cs : sn); }
        }
    }
    float* TAB = (float*)(p.ws + WS_TAB);
    for (int i = GT; i < 2048 + 1024; i += NGT) {
        if (i < 2048) { float s, c; sincos_r((float)i * (6.283185307179586f / 2048.f), s, c); TAB[i] = c; }
        else { const int q = i - 2048, pos = q >> 4, f = q & 15; const float inv = exp2f(-(float)f * (13.287712379549449f / 16.f)); float s, c; sincos_r((float)pos * inv, s, c); TAB[2048 + 2 * q] = c; TAB[2048 + 2 * q + 1] = s; }
    }
}
__device__ __forceinline__ void p0b(const Params& p) { PHASE_IDS;
    const float* MODP = (const float*)(p.ws + WS_MODP);
    float* MOD = (float*)(p.ws + WS_MOD);
    for (int i = GT; i < 2 * 9 * 6144; i += NGT) {
        const int l = i / (9 * 6144), j = (i / 6144) % 9, col = i % 6144;
        float s = p.b_ada[l * 6144 + col];
#pragma unroll
        for (int kc = 0; kc < 32; ++kc) s += MODP[((size_t)(l * 32 + kc) * 9 + j) * 6144 + col];
        MOD[i] = s;
    }
}

__device__ __forceinline__ float* xrow_ptr(const Params& p, int r) { return r < NL ? p.out + (size_t)r * D : (float*)(p.ws + WS_XC) + (size_t)(r - NL) * D; }
__device__ __forceinline__ const float* xin_ptr(const Params& p, int r) { return r < NL ? p.x + (size_t)r * D : p.ctx + (size_t)(r - NL) * D; }

constexpr int RPW = 3;
__device__ __forceinline__ f32x4 bf4_to_f4(pg8::u32x2 w) { f32x4 r; r[0] = __uint_as_float(w.x << 16); r[1] = __uint_as_float(w.x & 0xffff0000u); r[2] = __uint_as_float(w.y << 16); r[3] = __uint_as_float(w.y & 0xffff0000u); return r; }
__device__ __forceinline__ void p1_norm1(const Params& p, int l) { PHASE_IDS;
    const int lane = tidx & 63;
    const float* MOD = (const float*)(p.ws + WS_MOD);
    bf16_t* HB = (bf16_t*)(p.ws + WS_HB);
    const bf16_t* Y = (const bf16_t*)(p.ws + WS_Y);
    f32x4 nwv[4];
#pragma unroll
    for (int j = 0; j < 4; ++j) nwv[j] = *(const f32x4*)(p.norm_mix + l * D + 4 * lane + 256 * j);
    for (int r0 = GW * RPW; r0 < NTOK; r0 += NGW * RPW) {
        f32x4 v[RPW][4], gsc[4], gsh[4], gg2[4]; pg8::u32x2 y0[RPW][4], y1[RPW][4];
        const int gb = row_info(r0).bidx;
        { const float* mod0 = MOD + ((size_t)l * 9 + gb) * 6144;
#pragma unroll
          for (int j = 0; j < 4; ++j) { const int col = 4 * lane + 256 * j; gsc[j] = *(const f32x4*)(mod0 + D + col); gsh[j] = *(const f32x4*)(mod0 + col);
              if (l != 0) gg2[j] = *(const f32x4*)(MOD + ((size_t)(l - 1) * 9 + gb) * 6144 + 5 * D + col); } }
#pragma unroll
        for (int q = 0; q < RPW; ++q) { const int r = (r0 + q < NTOK) ? r0 + q : NTOK - 1;
#pragma unroll
            for (int j = 0; j < 4; ++j) { const int col = 4 * lane + 256 * j;
                if (l == 0) v[q][j] = *(const f32x4*)(xin_ptr(p, r) + col);
                else { v[q][j] = *(const f32x4*)(xrow_ptr(p, r) + col); y0[q][j] = *(const pg8::u32x2*)(Y + (size_t)(2 * r) * D + col); y1[q][j] = *(const pg8::u32x2*)(Y + (size_t)(2 * r + 1) * D + col); } } }
#pragma unroll
        for (int q = 0; q < RPW; ++q) { const int r = r0 + q; if (r >= NTOK) break;
            const RowInfo ri = row_info(r);
            f32x4 rsc[4], rsh[4], rg2[4];
#pragma unroll
            for (int j = 0; j < 4; ++j) { rsc[j] = gsc[j]; rsh[j] = gsh[j]; rg2[j] = gg2[j]; }
            if (ri.bidx != gb) {
                const float* mod = MOD + ((size_t)l * 9 + ri.bidx) * 6144;
#pragma unroll
                for (int j = 0; j < 4; ++j) { const int col = 4 * lane + 256 * j; rsc[j] = *(const f32x4*)(mod + D + col); rsh[j] = *(const f32x4*)(mod + col);
                    if (l != 0) rg2[j] = *(const f32x4*)(MOD + ((size_t)(l - 1) * 9 + ri.bidx) * 6144 + 5 * D + col); }
            }
            float ss = 0.f;
#pragma unroll
            for (int j = 0; j < 4; ++j) { const int col = 4 * lane + 256 * j;
                if (l != 0) { v[q][j] += rg2[j] * (bf4_to_f4(y0[q][j]) + bf4_to_f4(y1[q][j])); *(f32x4*)(xrow_ptr(p, r) + col) = v[q][j]; }
                ss += v[q][j][0] * v[q][j][0] + v[q][j][1] * v[q][j][1] + v[q][j][2] * v[q][j][2] + v[q][j][3] * v[q][j][3]; }
            const float rstd = rsqrtf(wave_sum(ss) * (1.f / D) + EPS);
#pragma unroll
            for (int j = 0; j < 4; ++j) { const int col = 4 * lane + 256 * j;
                const f32x4 nw = nwv[j];
                const f32x4 hv = v[q][j] * rstd * nw * (rsc[j] + 1.f) + rsh[j];
                pg8::u32x2 o; o.x = pg8::cvt_pk_bf16(hv[0], hv[1]); o.y = pg8::cvt_pk_bf16(hv[2], hv[3]);
                *(pg8::u32x2*)(HB + (size_t)r * D + col) = o; }
        }
    }
}

__device__ __forceinline__ void p6_norm2_router(const Params& p, int l, float* lds_unused) { PHASE_IDS;
    typedef pg8::bf16x8 bf16x8;
    typedef __attribute__((address_space(3))) unsigned char lds_u8;
    const int lane = tidx & 63, wave = __builtin_amdgcn_readfirstlane(tidx >> 6);
    const float* MOD = (const float*)(p.ws + WS_MOD);
    bf16_t* HB = (bf16_t*)(p.ws + WS_HB);
    f32x4* ROUTE = (f32x4*)(p.ws + WS_ROUTE);
    const int nrows = l == 0 ? NTOK : NL;
    const int rpb = (nrows + (int)gridDim.x - 1) / (int)gridDim.x, rbeg = bidx_ * rpb, rend = (rbeg + rpb < nrows) ? rbeg + rpb : nrows;
    constexpr int RS = 1032;
    lds_u8* L = (lds_u8*)lds_raw;
    LDSP(bf16_t) AH = (LDSP(bf16_t))(L); LDSP(bf16_t) AL = AH + 16 * RS; LDSP(bf16_t) WH = AL + 16 * RS; LDSP(bf16_t) WL = WH + 16 * RS;
    LDSP(float) PART = (LDSP(float))(L + 132096);
    LDSP(int) lcnt = (LDSP(int))(L + 140288); LDSP(int) lbase = lcnt + 16; LDSP(int) rroute = lbase + 16;
    if (tidx < 16) lcnt[tidx] = 0;
    {
        f32x4 wv[8];
#pragma unroll
        for (int j = 0; j < 8; ++j) wv[j] = ((const f32x4*)p.w_router)[tidx + NTHREADS * j];
#pragma unroll
        for (int j = 0; j < 8; ++j) { const int i4 = tidx + NTHREADS * j, k = i4 >> 2, e0 = (i4 & 3) * 4;
#pragma unroll
            for (int c = 0; c < 4; ++c) { const bf16_t hb = f2bf(wv[j][c]); WH[(e0 + c) * RS + k] = hb; WL[(e0 + c) * RS + k] = f2bf(wv[j][c] - bf2f(hb)); } }
    }
    const int nbatch = (rend - rbeg + 15) >> 4;
    f32x4 vn[2][4];
#pragma unroll
    for (int q = 0; q < 2; ++q) { const int r = (rbeg + wave * 2 + q < rend) ? rbeg + wave * 2 + q : rend - 1;
#pragma unroll
        for (int j = 0; j < 4; ++j) vn[q][j] = *(const f32x4*)(xrow_ptr(p, r) + 4 * lane + 256 * j); }
    f32x4 nwv[4];
#pragma unroll
    for (int j = 0; j < 4; ++j) nwv[j] = *(const f32x4*)(p.norm_ffn + l * D + 4 * lane + 256 * j);
    for (int bt = 0; bt < nbatch; ++bt) {
        const int r0 = rbeg + bt * 16 + wave * 2;
        f32x4 v[2][4], gsc[4], gsh[4];
        const int rl0 = r0 < rend ? r0 : rend - 1, gb = row_info(rl0).bidx;
        { const float* mod0 = MOD + ((size_t)l * 9 + gb) * 6144;
#pragma unroll
          for (int j = 0; j < 4; ++j) { const int col = 4 * lane + 256 * j; gsc[j] = *(const f32x4*)(mod0 + 4 * D + col); gsh[j] = *(const f32x4*)(mod0 + 3 * D + col); } }
#pragma unroll
        for (int q = 0; q < 2; ++q)
#pragma unroll
            for (int j = 0; j < 4; ++j) v[q][j] = vn[q][j];
        if (bt + 1 < nbatch) {
#pragma unroll
            for (int q = 0; q < 2; ++q) { const int r = (r0 + 16 + q < rend) ? r0 + 16 + q : rend - 1;
#pragma unroll
                for (int j = 0; j < 4; ++j) vn[q][j] = *(const f32x4*)(xrow_ptr(p, r) + 4 * lane + 256 * j); }
        }
#pragma unroll
        for (int j = 0; j < 4; ++j) gsc[j] = (gsc[j] + 1.f) * nwv[j];
#pragma unroll
        for (int q = 0; q < 2; ++q) { const int r = r0 + q;
            if (r < rend) {
                const RowInfo ri = row_info(r);
                float ss = 0.f;
#pragma unroll
                for (int j = 0; j < 4; ++j) ss += v[q][j][0] * v[q][j][0] + v[q][j][1] * v[q][j][1] + v[q][j][2] * v[q][j][2] + v[q][j][3] * v[q][j][3];
                const float rstd = rsqrtf(wave_sum(ss) * (1.f / D) + EPS);
                f32x4 rsc[4], rsh[4];
#pragma unroll
                for (int j = 0; j < 4; ++j) { rsc[j] = gsc[j]; rsh[j] = gsh[j]; }
                if (ri.bidx != gb) {
                    const float* mod = MOD + ((size_t)l * 9 + ri.bidx) * 6144;
#pragma unroll
                    for (int j = 0; j < 4; ++j) { const int col = 4 * lane + 256 * j; rsc[j] = (*(const f32x4*)(mod + 4 * D + col) + 1.f) * *(const f32x4*)(p.norm_ffn + l * D + col); rsh[j] = *(const f32x4*)(mod + 3 * D + col); }
                }
#pragma unroll
                for (int j = 0; j < 4; ++j) {
                    const int col = 4 * lane + 256 * j;
                    const f32x4 hv = v[q][j] * rstd * rsc[j] + rsh[j];
                    pg8::u32x2 hi; hi.x = pg8::cvt_pk_bf16(hv[0], hv[1]); hi.y = pg8::cvt_pk_bf16(hv[2], hv[3]);
                    *(pg8::u32x2*)(HB + (size_t)r * D + col) = hi;
                    pg8::u32x2 lo;
                    lo.x = pg8::cvt_pk_bf16(hv[0] - __uint_as_float(hi.x << 16), hv[1] - __uint_as_float(hi.x & 0xffff0000u));
                    lo.y = pg8::cvt_pk_bf16(hv[2] - __uint_as_float(hi.y << 16), hv[3] - __uint_as_float(hi.y & 0xffff0000u));
                    *(LDSP(pg8::u32x2))(AH + (wave * 2 + q) * RS + col) = hi; *(LDSP(pg8::u32x2))(AL + (wave * 2 + q) * RS + col) = lo;
                }
            }
        }
        __syncthreads();
        {
            const int rr = lane & 15, q4 = lane >> 4;
            f32x4 acc = {0.f, 0.f, 0.f, 0.f};
#pragma unroll
            for (int s4 = 0; s4 < 4; ++s4) { const int ko = (wave * 4 + s4) * 32 + 8 * q4;
                const bf16x8 ah = *(LDSP(const bf16x8))(AH + rr * RS + ko), al = *(LDSP(const bf16x8))(AL + rr * RS + ko);
                const bf16x8 wh = *(LDSP(const bf16x8))(WH + rr * RS + ko), wlo = *(LDSP(const bf16x8))(WL + rr * RS + ko);
                acc = __builtin_amdgcn_mfma_f32_16x16x32_bf16(ah, wh, acc, 0, 0, 0);
                acc = __builtin_amdgcn_mfma_f32_16x16x32_bf16(ah, wlo, acc, 0, 0, 0);
                acc = __builtin_amdgcn_mfma_f32_16x16x32_bf16(al, wh, acc, 0, 0, 0); }
#pragma unroll
            for (int e = 0; e < 4; ++e) PART[wave * 256 + (4 * q4 + e) * 16 + rr] = acc[e];
        }
        __syncthreads();
        if (wave == 0 && lane < 16) {
            const int r = rbeg + bt * 16 + lane;
            if (r < rend) {
                float s[16], sel[16];
#pragma unroll
                for (int e = 0; e < 16; ++e) { float lgt = 0.f;
#pragma unroll
                    for (int w8 = 0; w8 < 8; ++w8) lgt += PART[w8 * 256 + lane * 16 + e];
                    s[e] = __builtin_amdgcn_rcpf(1.f + __expf(-lgt)); sel[e] = s[e] + p.b_router[e]; }
                int bestg = 0; float bestscore = -1e30f;
#pragma unroll
                for (int g = 0; g < 4; ++g) {
                    const float a0 = sel[4 * g], a1 = sel[4 * g + 1], a2 = sel[4 * g + 2], a3 = sel[4 * g + 3];
                    const float t1x = fmaxf(a0, a1), t2x = fminf(a0, a1), t3x = fmaxf(a2, a3), t4x = fminf(a2, a3);
                    const float gs = fmaxf(t1x, t3x) + fmaxf(fmaxf(fminf(t1x, t3x), t2x), t4x);
                    if (gs > bestscore) { bestscore = gs; bestg = g; }
                }
                float c0 = sel[0], c1 = sel[1], c2 = sel[2], c3 = sel[3], u0 = s[0], u1 = s[1], u2 = s[2], u3 = s[3];
#pragma unroll
                for (int g = 1; g < 4; ++g) { const bool pick = bestg == g; c0 = pick ? sel[4 * g] : c0; c1 = pick ? sel[4 * g + 1] : c1; c2 = pick ? sel[4 * g + 2] : c2; c3 = pick ? sel[4 * g + 3] : c3;
                    u0 = pick ? s[4 * g] : u0; u1 = pick ? s[4 * g + 1] : u1; u2 = pick ? s[4 * g + 2] : u2; u3 = pick ? s[4 * g + 3] : u3; }
                int i1 = 0; float m1 = c0, s1 = u0;
                if (c1 > m1) { m1 = c1; i1 = 1; s1 = u1; }
                if (c2 > m1) { m1 = c2; i1 = 2; s1 = u2; }
                if (c3 > m1) { m1 = c3; i1 = 3; s1 = u3; }
                int i2 = -1; float m2 = -1e30f, s2 = 0.f;
                if (i1 != 0) { m2 = c0; i2 = 0; s2 = u0; }
                if (i1 != 1 && (i2 < 0 || c1 > m2)) { m2 = c1; i2 = 1; s2 = u1; }
                if (i1 != 2 && (i2 < 0 || c2 > m2)) { m2 = c2; i2 = 2; s2 = u2; }
                if (i1 != 3 && (i2 < 0 || c3 > m2)) { m2 = c3; i2 = 3; s2 = u3; }
                const int e1 = bestg * 4 + i1, e2 = bestg * 4 + i2; const float rw = __builtin_amdgcn_rcpf(s1 + s2);
                f32x4 rt; rt[0] = __int_as_float(e1); rt[1] = __int_as_float(e2); rt[2] = s1 * rw; rt[3] = s2 * rw; ROUTE[r] = rt;
                rroute[r - rbeg] = e1 | (e2 << 8); atomicAdd((int*)&lcnt[e1], 1); atomicAdd((int*)&lcnt[e2], 1);
            }
        }
    }
    __syncthreads();
    unsigned* ctl = (unsigned*)(p.ws + WS_CTL);
    if (tidx < 16) { lbase[tidx] = (int)__hip_atomic_fetch_add(ctl + CW_CNT + (l * NEXP + tidx) * 64, (unsigned)lcnt[tidx], __ATOMIC_RELAXED, __HIP_MEMORY_SCOPE_AGENT); lcnt[tidx] = 0; }
    __syncthreads();
    int* LIST = (int*)(p.ws + WS_LIST) + (size_t)l * NEXP * NTOK;
    if (tidx < rend - rbeg) {
        const int rr = rroute[tidx], r = rbeg + tidx;
#pragma unroll
        for (int slot = 0; slot < 2; ++slot) { const int e = (rr >> (8 * slot)) & 255; const int pos = lbase[e] + atomicAdd((int*)&lcnt[e], 1); LIST[e * NTOK + pos] = 2 * r + slot; }
    }
    __syncthreads();
}

__device__ __forceinline__ void p9_final(const Params& p) { PHASE_IDS;
    const int lane = tidx & 63;
    const float* MOD = (const float*)(p.ws + WS_MOD);
    const bf16_t* Y = (const bf16_t*)(p.ws + WS_Y);
    f32x4 nwv[4];
#pragma unroll
    for (int j = 0; j < 4; ++j) nwv[j] = *(const f32x4*)(p.final_norm + 4 * lane + 256 * j);
    for (int r0 = GW * RPW; r0 < NL; r0 += NGW * RPW) {
        f32x4 v[RPW][4], gg2[4]; pg8::u32x2 y0[RPW][4], y1[RPW][4];
        const int gb = r0 >> 11;
#pragma unroll
        for (int j = 0; j < 4; ++j) gg2[j] = *(const f32x4*)(MOD + ((size_t)(DEPTH - 1) * 9 + gb) * 6144 + 5 * D + 4 * lane + 256 * j);
#pragma unroll
        for (int q = 0; q < RPW; ++q) { const int r = (r0 + q < NL) ? r0 + q : NL - 1;
#pragma unroll
            for (int j = 0; j < 4; ++j) { const int col = 4 * lane + 256 * j;
                v[q][j] = *(const f32x4*)(p.out + (size_t)r * D + col); y0[q][j] = *(const pg8::u32x2*)(Y + (size_t)(2 * r) * D + col); y1[q][j] = *(const pg8::u32x2*)(Y + (size_t)(2 * r + 1) * D + col); } }
#pragma unroll
        for (int q = 0; q < RPW; ++q) { const int r = r0 + q; if (r >= NL) break;
            const int bidx = r >> 11;
            float ss = 0.f;
#pragma unroll
            for (int j = 0; j < 4; ++j) { const int col = 4 * lane + 256 * j;
                const f32x4 g2 = bidx == gb ? gg2[j] : *(const f32x4*)(MOD + ((size_t)(DEPTH - 1) * 9 + bidx) * 6144 + 5 * D + col);
                v[q][j] += g2 * (bf4_to_f4(y0[q][j]) + bf4_to_f4(y1[q][j]));
                ss += v[q][j][0] * v[q][j][0] + v[q][j][1] * v[q][j][1] + v[q][j][2] * v[q][j][2] + v[q][j][3] * v[q][j][3]; }
            const float rstd = rsqrtf(wave_sum(ss) * (1.f / D) + EPS);
#pragma unroll
            for (int j = 0; j < 4; ++j) { const int col = 4 * lane + 256 * j; *(f32x4*)(p.out + (size_t)r * D + col) = v[q][j] * rstd * nwv[j]; }
        }
    }
}

namespace pg8 {
#define PG8_LAS __attribute__((address_space(3)))
typedef short bf16x8 __attribute__((ext_vector_type(8)));
typedef unsigned u32x4 __attribute__((ext_vector_type(4)));
typedef unsigned u32x2 __attribute__((ext_vector_type(2)));
constexpr int BM = 256, BK = 64, HALF = 128, HTB = HALF * BK * 2, STAGE_BYTES = 8 * HTB;
__host__ __device__ __forceinline__ int lds_byte(int r, int c) { const int st = (r >> 4) * 2 + (c >> 5), rr = r & 15, cc = c & 31, ob = rr * 64 + cc * 2; return st * 1024 + (ob ^ (((ob >> 9) & 1) << 5)); }
__host__ __device__ __forceinline__ void stage_rc(int b, int& R, int& C) { const int st = b / 1024, sb = b % 1024, swz = sb ^ (((sb >> 9) & 1) << 5); R = (st >> 1) * 16 + swz / 64; C = (st & 1) * 32 + (swz % 64) / 2; }
__host__ __device__ __forceinline__ int perm32(int rho) { const int n = rho >> 4, i = rho & 15; return 8 * (i >> 2) + 4 * n + (i & 3); }
struct Unit { int pm, pn; unsigned a_off, b_off; int e, cnt; };

template <class Epi, class Sched>
__device__ __forceinline__ void gemm_phase(PG8_LAS unsigned char* lds, const bf16_t* A, const bf16_t* Bt, const int K, const Sched& S, const Epi& E) {
    const int tid = otid(), wid = __builtin_amdgcn_readfirstlane(tid >> 6), lane = tid & 63, wr = wid >> 2, wc = wid & 3, fr = lane & 15, fq = lane >> 4;
    const int nt = K / BK;
    int Ra[2]; unsigned Ca2[2], voffB[2];
#pragma unroll
    for (int i = 0; i < 2; ++i) { int R, C; stage_rc(tid * 16 + i * 8192, R, C); const int Rb = (R & ~31) + perm32(R & 31); Ra[i] = R; Ca2[i] = (unsigned)C * 2u; voffB[i] = (unsigned)(Rb * K + C) * 2u; }
    const size_t kstep = (size_t)(BK * 2);
    const size_t hstep = (size_t)HALF * K * 2;
    const unsigned ldsw = (unsigned)wid * 1024u;
    const int aoff = lds_byte(wr * 64 + fr, fq * 8), boff = lds_byte(wc * 32 + fr, fq * 8);
#define PG8_SA(b, h) (((b) * 2 + (h)) * HTB)
#define PG8_SB(b, h) ((4 + (b) * 2 + (h)) * HTB)
#define PG8_STAGE_B(bufoff, gbase) do { _Pragma("unroll") for (int _i = 0; _i < 2; ++_i) \
        __builtin_amdgcn_global_load_lds((const unsigned*)((const char*)(gbase) + voffB[_i]), (PG8_LAS unsigned*)(lds + (bufoff) + ldsw + _i * 8192), 16, 0, 0); } while (0)
#define PG8_STAGE_A(bufoff, kbyte, offs) do { _Pragma("unroll") for (int _i = 0; _i < 2; ++_i) \
        __builtin_amdgcn_global_load_lds((const unsigned*)(Ab + (size_t)(offs)[_i] + (size_t)(kbyte)), (PG8_LAS unsigned*)(lds + (bufoff) + ldsw + _i * 8192), 16, 0, 0); } while (0)
#define PG8_LDA(dst, b, h) do { _Pragma("unroll") for (int m = 0; m < 4; ++m) _Pragma("unroll") for (int k = 0; k < 2; ++k) dst[m][k] = *(const PG8_LAS bf16x8*)(lds + PG8_SA(b, h) + aoff + m * 2048 + k * 1024); } while (0)
#define PG8_LDB(dst, b, h) do { _Pragma("unroll") for (int n = 0; n < 2; ++n) _Pragma("unroll") for (int k = 0; k < 2; ++k) dst[n][k] = *(const PG8_LAS bf16x8*)(lds + PG8_SB(b, h) + boff + n * 2048 + k * 1024); } while (0)
#define PG8_MMA(ai, bj, At, Bt_) do { __builtin_amdgcn_s_setprio(1); _Pragma("unroll") for (int m = 0; m < 4; ++m) _Pragma("unroll") for (int n = 0; n < 2; ++n) _Pragma("unroll") for (int k = 0; k < 2; ++k) \
        acc[ai][bj][m][n] = __builtin_amdgcn_mfma_f32_16x16x32_bf16(Bt_[n][k], At[m][k], acc[ai][bj][m][n], 0, 0, 0); __builtin_amdgcn_s_setprio(0); } while (0)
#define PG8_WAIT_V(n) asm volatile("s_waitcnt vmcnt(" #n ")" ::: "memory")
#define PG8_WAIT_L(n) asm volatile("s_waitcnt lgkmcnt(" #n ")" ::: "memory")
#define PG8_BAR __builtin_amdgcn_s_barrier()
#define PG8_SCHED __builtin_amdgcn_sched_barrier(0)
    Unit cur, nxt; int ui = 0;
    if (!S.next(0, cur)) return;
    f32x4 acc[2][2][4][2];
#pragma unroll
    for (int a = 0; a < 2; ++a)
#pragma unroll
        for (int b = 0; b < 2; ++b)
#pragma unroll
            for (int m = 0; m < 4; ++m)
#pragma unroll
                for (int n = 0; n < 2; ++n) acc[a][b][m][n] = (f32x4){0.f, 0.f, 0.f, 0.f};
    bf16x8 At[4][2], B0[2][2], B1[2][2];
    const char* Ab = (const char*)A;
    unsigned ga0[2], ga1[2], gn0[2], gn1[2];
#pragma unroll
    for (int i = 0; i < 2; ++i) { ga0[i] = S.a_row_off(cur, Ra[i], K) + Ca2[i]; ga1[i] = S.a_row_off(cur, HALF + Ra[i], K) + Ca2[i]; }
    const char* cB = (const char*)Bt + cur.b_off;
    PG8_STAGE_B(PG8_SB(0, 0), cB); PG8_STAGE_B(PG8_SB(0, 1), cB + hstep); PG8_STAGE_A(PG8_SA(0, 0), 0, ga0); PG8_STAGE_A(PG8_SA(0, 1), 0, ga1);
    if (wr == 1) PG8_BAR;
    PG8_WAIT_V(2); PG8_BAR;
    PG8_STAGE_B(PG8_SB(1, 0), cB + kstep); PG8_STAGE_A(PG8_SA(1, 0), kstep, ga0); PG8_STAGE_B(PG8_SB(1, 1), cB + hstep + kstep);
    PG8_WAIT_V(6); PG8_BAR;
    for (;;) {
        const bool has_next = S.next(ui + 1, nxt);
        if (has_next) {
#pragma unroll
            for (int i = 0; i < 2; ++i) { gn0[i] = S.a_row_off(nxt, Ra[i], K) + Ca2[i]; gn1[i] = S.a_row_off(nxt, HALF + Ra[i], K) + Ca2[i]; }
        } else {
#pragma unroll
            for (int i = 0; i < 2; ++i) { gn0[i] = ga0[i]; gn1[i] = ga1[i]; }
        }
        const char* nB = has_next ? (const char*)Bt + nxt.b_off : cB;
        for (int t = 0; t < nt; t += 2) {
            const bool last = (t == nt - 2);
            const size_t k1 = (size_t)(t + 1) * kstep;
            unsigned o20[2], o21[2];
#pragma unroll
            for (int i = 0; i < 2; ++i) { o20[i] = last ? gn0[i] : ga0[i]; o21[i] = last ? gn1[i] : ga1[i]; }
            const size_t k2 = last ? 0 : (size_t)(t + 2) * kstep, k3 = k2 + kstep;
            const char* b2 = last ? nB : cB + (size_t)(t + 2) * kstep; const char* b3 = b2 + kstep;
            PG8_LDB(B0, 0, 0); PG8_LDB(B1, 0, 1); PG8_SCHED; PG8_LDA(At, 0, 0); PG8_STAGE_A(PG8_SA(1, 1), k1, ga1);
            PG8_WAIT_V(8); PG8_WAIT_L(0); PG8_BAR; PG8_MMA(0, 0, At, B0); PG8_MMA(0, 1, At, B1); PG8_BAR; PG8_SCHED;
            PG8_LDA(At, 0, 1); PG8_STAGE_B(PG8_SB(0, 0), b2); PG8_STAGE_B(PG8_SB(0, 1), b2 + hstep); PG8_STAGE_A(PG8_SA(0, 0), k2, o20);
            PG8_WAIT_V(8); PG8_WAIT_L(0); PG8_BAR; PG8_MMA(1, 0, At, B0); PG8_MMA(1, 1, At, B1); PG8_BAR; PG8_SCHED;
            PG8_LDB(B0, 1, 0); PG8_LDB(B1, 1, 1); PG8_SCHED; PG8_LDA(At, 1, 0); PG8_STAGE_A(PG8_SA(0, 1), k2, o21);
            PG8_WAIT_V(8); PG8_WAIT_L(0); PG8_BAR; PG8_MMA(0, 0, At, B0); PG8_MMA(0, 1, At, B1); PG8_BAR; PG8_SCHED;
            PG8_LDA(At, 1, 1); PG8_STAGE_B(PG8_SB(1, 0), b3); PG8_STAGE_B(PG8_SB(1, 1), b3 + hstep); PG8_STAGE_A(PG8_SA(1, 0), k3, o20);
            PG8_WAIT_V(8); PG8_WAIT_L(0); PG8_BAR; PG8_MMA(1, 0, At, B0); PG8_MMA(1, 1, At, B1); PG8_BAR; PG8_SCHED;
        }
        if (wr == 0) PG8_BAR;
        E(acc, cur, wr, wc, fr, fq);
        if (!has_next) break;
#pragma unroll
        for (int a = 0; a < 2; ++a)
#pragma unroll
            for (int b = 0; b < 2; ++b)
#pragma unroll
                for (int m = 0; m < 4; ++m)
#pragma unroll
                    for (int n = 0; n < 2; ++n) acc[a][b][m][n] = (f32x4){0.f, 0.f, 0.f, 0.f};
        cur = nxt; cB = nB; ++ui;
#pragma unroll
        for (int i = 0; i < 2; ++i) { ga0[i] = gn0[i]; ga1[i] = gn1[i]; }
        if (wr == 1) PG8_BAR;
    }
    PG8_WAIT_V(0);
    PG8_BAR;
#undef PG8_SA
#undef PG8_SB
#undef PG8_STAGE_A
#undef PG8_STAGE_B
#undef PG8_LDA
#undef PG8_LDB
#undef PG8_MMA
#undef PG8_WAIT_V
#undef PG8_WAIT_L
#undef PG8_BAR
#undef PG8_SCHED
}

struct PlainOrder {
    int nM, nN, nwg, G, c;
    __device__ void init(int M, int N, int G_, int c_) { nM = M / BM; nN = N / BM; nwg = nM * nN; G = G_; c = c_; }
    __device__ __forceinline__ bool next(int i, Unit& u, int dup = 1) const {
        int L = i * G + c; if (L >= nwg * dup) return false; if (L >= nwg) L -= nwg;
        int wgid = L; { const int q = nwg / 8, r = nwg % 8, xcd = wgid % 8, off = wgid / 8; wgid = (xcd < r ? xcd * (q + 1) : r * (q + 1) + (xcd - r) * q) + off; }
        const int nig = 8 * nN, gid = wgid / nig, fm = gid * 8, gsz = (nM - fm) < 8 ? (nM - fm) : 8;
        u.pm = fm + ((wgid % nig) % gsz); u.pn = (wgid % nig) / gsz; u.a_off = 0; u.b_off = 0; u.e = 0; u.cnt = 256; return true;
    }
    __device__ __forceinline__ unsigned a_row_off(const Unit& u, int rl, int K) const { return (unsigned)((u.pm * BM + rl) * K) * 2u; }
};
}
struct PlainSched {
    pg8::PlainOrder o; int K; int dup; bool fperm;
    __device__ __forceinline__ bool next(int i, pg8::Unit& u) const { if (!o.next(i, u, dup)) return false; u.b_off = (unsigned)(u.pn * 256 * K) * 2u; return true; }
    __device__ __forceinline__ unsigned a_row_off(const pg8::Unit& u, int rl, int K_) const {
        if (fperm && u.pn <= 1) rl = u.pm < 64 ? (((rl >> 4) & 3) << 6 | (rl >> 7) << 5 | ((rl >> 6) & 1) << 4 | (rl & 15)) : ((rl & 0xc0) | (rl & 15) << 2 | ((rl >> 4) & 3));
        return o.a_row_off(u, rl, K_); }
};

__device__ __forceinline__ void conv_item4(const float* W, int ldw, int k0, int n, bool valid, bf16_t* dst_row0  , int ldt) {
    f32x4 v[16];
    const float* src = W + (size_t)k0 * ldw + (valid ? n : 0);
#pragma unroll
    for (int i = 0; i < 16; ++i) v[i] = *(const f32x4*)(src + (size_t)i * ldw);
    if (valid) {
#pragma unroll
        for (int c = 0; c < 4; ++c) {
            pg8::u32x4 o0, o1;
            o0.x = pg8::cvt_pk_bf16(v[0][c], v[1][c]); o0.y = pg8::cvt_pk_bf16(v[2][c], v[3][c]); o0.z = pg8::cvt_pk_bf16(v[4][c], v[5][c]); o0.w = pg8::cvt_pk_bf16(v[6][c], v[7][c]);
            o1.x = pg8::cvt_pk_bf16(v[8][c], v[9][c]); o1.y = pg8::cvt_pk_bf16(v[10][c], v[11][c]); o1.z = pg8::cvt_pk_bf16(v[12][c], v[13][c]); o1.w = pg8::cvt_pk_bf16(v[14][c], v[15][c]);
            *(pg8::u32x4*)(dst_row0 + (size_t)c * ldt) = o0; *(pg8::u32x4*)(dst_row0 + (size_t)c * ldt + 8) = o1;
        }
    }
}
__device__ __forceinline__ void conv_tile64(const float* src  , int ldw, bf16_t* dst  ) {
    float v[64];
#pragma unroll
    for (int i = 0; i < 64; ++i) v[i] = src[(size_t)i * ldw];
#pragma unroll
    for (int q = 0; q < 8; ++q) {
        pg8::u32x4 o; o.x = pg8::cvt_pk_bf16(v[8 * q], v[8 * q + 1]); o.y = pg8::cvt_pk_bf16(v[8 * q + 2], v[8 * q + 3]); o.z = pg8::cvt_pk_bf16(v[8 * q + 4], v[8 * q + 5]); o.w = pg8::cvt_pk_bf16(v[8 * q + 6], v[8 * q + 7]);
        *(pg8::u32x4*)(dst + 8 * q) = o;
    }
}
constexpr int CB_RS = 272;
constexpr int CB_BUF = 256 * CB_RS;
__device__ __forceinline__ void cb_load(f32x4 (&v)[16], const float* src, int ldw) {
#pragma unroll
    for (int i = 0; i < 16; ++i) v[i] = *(const f32x4*)(src + (size_t)i * ldw);
}
__device__ __forceinline__ void cb_to_lds(const f32x4 (&v)[16], unsigned char* buf, int w, int lane) {
#pragma unroll
    for (int c = 0; c < 4; ++c) {
        pg8::u32x4 o0, o1;
        o0.x = pg8::cvt_pk_bf16(v[0][c], v[1][c]); o0.y = pg8::cvt_pk_bf16(v[2][c], v[3][c]); o0.z = pg8::cvt_pk_bf16(v[4][c], v[5][c]); o0.w = pg8::cvt_pk_bf16(v[6][c], v[7][c]);
        o1.x = pg8::cvt_pk_bf16(v[8][c], v[9][c]); o1.y = pg8::cvt_pk_bf16(v[10][c], v[11][c]); o1.z = pg8::cvt_pk_bf16(v[12][c], v[13][c]); o1.w = pg8::cvt_pk_bf16(v[14][c], v[15][c]);
        LDSP(pg8::u32x4) q = (LDSP(pg8::u32x4))(buf + (4 * lane + c) * CB_RS + 32 * w);
        q[0] = o0; q[1] = o1;
    }
}
__device__ __forceinline__ void convert_experts_b(const Params& p, int l, bf16_t* WGU, bf16_t* WD, int t0, int t1, int blk, int nblk, int tidx, unsigned char* lds_raw) {
    const int lane = tidx & 63, w = tidx >> 6, j = tidx & 15, r0 = tidx >> 4;
    int par = 0;
    for (int t = t0 + blk; t < t1; t += nblk) {
        const float* src; int ldw; bf16_t* dst; int ldd, rsplit;
        if (t < 512) { const int nt = t & 1, kt = (t >> 1) & 7, e = (t >> 4) & 15, part = t >> 8;
            src = (part == 0 ? p.w_eg : p.w_eu) + ((size_t)(l * NEXP + e) * D + kt * 128 + 16 * w) * DEXP + nt * 256 + 4 * lane; ldw = DEXP;
            dst = WGU + ((size_t)e * 1024 + nt * 512 + part * 128) * D + kt * 128; ldd = D; rsplit = 128; }
        else { const int q = t - 512, nt = q & 3, kt = (q >> 2) & 3, e = q >> 4;
            src = p.w_ed + ((size_t)(l * NEXP + e) * DEXP + kt * 128 + 16 * w) * D + nt * 256 + 4 * lane; ldw = D;
            dst = WD + ((size_t)e * 1024 + nt * 256) * DEXP + kt * 128; ldd = DEXP; rsplit = 0; }
        f32x4 v[16];
        cb_load(v, src, ldw);
        unsigned char* buf = lds_raw + par * CB_BUF; par ^= 1;
        cb_to_lds(v, buf, w, lane);
        __syncthreads();
#pragma unroll
        for (int i = 0; i < 8; ++i) { const int r = r0 + 32 * i;
            const pg8::u32x4 x = *(LDSP(pg8::u32x4))(buf + r * CB_RS + 16 * j);
            *(pg8::u32x4*)(dst + (size_t)(r + (r & rsplit)) * ldd + 8 * j) = x; }
    }
}
__device__ __forceinline__ void convert_gateup(const Params& p, int l, bf16_t* WGU, int gw0, int ngw, int lane) {
    for (int it = gw0; it < 2 * NEXP * 16 * 8; it += ngw) {
        const int nb = it & 7, kb = (it >> 3) & 15, e = (it >> 7) & 15, part = it >> 11, n = nb * 64 + lane;
        const float* W = (part == 0 ? p.w_eg : p.w_eu) + (size_t)(l * NEXP + e) * D * DEXP;
        conv_tile64(W + (size_t)(kb * 64) * DEXP + n, DEXP, WGU + ((size_t)e * 1024 + (n >> 7) * 256 + part * 128 + (n & 127)) * D + kb * 64);
    }
}
__device__ __forceinline__ void convert_down(const Params& p, int l, bf16_t* WD, int gw0, int ngw, int lane) {
    for (int it = gw0; it < NEXP * 8 * 16; it += ngw) {
        const int nb = it & 15, kb = (it >> 4) & 7, e = it >> 7, n = nb * 64 + lane;
        conv_tile64(p.w_ed + ((size_t)(l * NEXP + e) * DEXP + kb * 64) * D + n, D, WD + ((size_t)e * 1024 + n) * DEXP + kb * 64);
    }
}
struct EpiOutProj {
    const float* xs_lat; const float* xs_ctx; float* xd_lat; float* xd_ctx; const float* g1;
    __device__ __forceinline__ void operator()(const f32x4 (&acc)[2][2][4][2], const pg8::Unit& u, int wr, int wc, int fr, int fq) const {
        const int row0 = u.pm * 256 + wr * 64 + fr, col0 = u.pn * 256 + wc * 32 + 8 * fq;
        const bool isctx = u.pm >= 64; const int bidx = isctx ? 8 : (u.pm >> 3);
        const float* xs = isctx ? xs_ctx - (size_t)NL * D : xs_lat; float* xd = isctx ? xd_ctx - (size_t)NL * D : xd_lat;
        f32x4 g[2][2];
#pragma unroll
        for (int bj = 0; bj < 2; ++bj)
#pragma unroll
            for (int n = 0; n < 2; ++n) g[bj][n] = *(const f32x4*)(g1 + (size_t)bidx * 6144 + col0 + bj * 128 + 4 * n);
#pragma unroll
        for (int ai = 0; ai < 2; ++ai)
#pragma unroll
            for (int m = 0; m < 4; ++m) {
                const size_t ro = (size_t)(row0 + ai * 128 + m * 16) * D + col0;
#pragma unroll
                for (int bj = 0; bj < 2; ++bj)
#pragma unroll
                    for (int n = 0; n < 2; ++n) { const f32x4 xv = *(const f32x4*)(xs + ro + bj * 128 + 4 * n); *(f32x4*)(xd + ro + bj * 128 + 4 * n) = xv + g[bj][n] * acc[ai][bj][m][n]; }
            }
    }
};
__device__ __forceinline__ void p5_outproj_fast(const Params& p, int l, unsigned char* lds_raw) { PHASE_IDS;
    PlainSched S; S.K = D; S.fperm = false; S.dup = (l == 0 ? DUPN(8) : 1); S.o.init(l == 0 ? NTOK : NL, D, gridDim.x, bidx_);
    EpiOutProj E{l == 0 ? p.x : p.out, l == 0 ? p.ctx : (const float*)(p.ws + WS_XC), p.out, (float*)(p.ws + WS_XC), (const float*)(p.ws + WS_MOD) + (size_t)l * 9 * 6144 + 2 * D};
    pg8::gemm_phase((PG8_LAS unsigned char*)lds_raw, (const bf16_t*)(p.ws + WS_HB), (const bf16_t*)(p.ws + WS_WOUT) + (size_t)l * D * D, D, S, E);
    if (l == 0) {
        const int G = gridDim.x, rem = S.o.nwg % G, first = rem == 0 ? 0 : rem, nb = G - first;
        if (bidx_ >= first) { const int gw0 = (bidx_ - first) * NWAVES + (tidx >> 6), ngw = nb * NWAVES, lane = tidx & 63;
            (void)gw0; (void)ngw; (void)lane; convert_experts_b(p, 0, (bf16_t*)(p.ws + WS_WGU), (bf16_t*)(p.ws + WS_WD), 0, 768, bidx_ - first, nb, tidx, lds_raw); }
    }
}

#define PIN_ACC(acc) do { _Pragma("unroll") for (int a_ = 0; a_ < 2; ++a_) _Pragma("unroll") for (int b_ = 0; b_ < 2; ++b_) _Pragma("unroll") for (int m_ = 0; m_ < 4; ++m_) \
    asm volatile("" : "+v"(acc[a_][b_][m_][0]), "+v"(acc[a_][b_][m_][1])); } while (0)
struct EpiInProj {
    struct { unsigned char* ws; const float* q_norm; const float* k_norm; } p; int l;
    __device__ __forceinline__ void operator()(f32x4 (&acc)[2][2][4][2], const pg8::Unit& u, int wr, int wc, int fr, int fq) const {
        asm volatile("" : "+v"(fr), "+v"(fq));
        const int T = u.pn;
        const bool isctx = u.pm >= 64; const int b = isctx ? u.pm - 64 : (u.pm >> 3); const int t0 = (isctx ? 0 : (u.pm & 7) * 256) + wr * 64 + fr;
        const int row0 = u.pm * 256 + wr * 64 + fr;
        if (T <= 1) {
            bf16_t* dst = isctx ? (bf16_t*)(p.ws + WS_YFTC) + ((size_t)b * 256 * 2 + T) * CTXL + 64 * wr + 4 * fr
                                : (bf16_t*)(p.ws + WS_YFTL) + ((size_t)b * 256 * 2 + T) * SEQ + (16 * wr + fr) * 32 + 4 * (u.pm & 7);
            const int ld = isctx ? CTXL : SEQ, oa = isctx ? 128 : 1024;
            unsigned eo = (unsigned)((64 * wc + 8 * fq) * 2 * ld);
#pragma unroll
            for (int bj = 0; bj < 2; ++bj)
#pragma unroll
                for (int n = 0; n < 2; ++n)
#pragma unroll
                    for (int e = 0; e < 4; ++e) { bf16_t* cp = dst + eo;
#pragma unroll
                        for (int ai = 0; ai < 2; ++ai) { pg8::u32x2 w; w.x = pg8::cvt_pk_bf16(acc[ai][bj][0][n][e], acc[ai][bj][1][n][e]); w.y = pg8::cvt_pk_bf16(acc[ai][bj][2][n][e], acc[ai][bj][3][n][e]); *(pg8::u32x2*)(cp + ai * oa) = w; }
                        eo += (unsigned)(((n == 1 && e == 3) ? 25 : 1) * 2 * ld); asm volatile("" : "+v"(eo) :: "memory"); }
        } else if (T <= 4 || T >= 8) {
            bf16_t* dst; int ld; float sc = 1.f;
            if (T == 9) { dst = (bf16_t*)(p.ws + WS_YFTL); ld = 256; }
            else if (T == 2) { dst = (bf16_t*)(p.ws + WS_GQK); ld = 256; if (wc < 2) sc = 0.17677669529663687f; }
            else if (T == 3) { dst = (bf16_t*)(p.ws + WS_GV); ld = 256; } else if (T == 4) { dst = (bf16_t*)(p.ws + WS_GG); ld = 256; } else { dst = (bf16_t*)(p.ws + WS_GD); ld = 32; }
            if (T != 8 || wc == 0) {
#pragma unroll
                for (int ai = 0; ai < 2; ++ai)
#pragma unroll
                    for (int m = 0; m < 4; ++m) { const size_t r = row0 + ai * 128 + m * 16;
#pragma unroll
                        for (int bj = 0; bj < 2; ++bj) { if (T == 8 && bj == 1) continue;
                            const f32x4 v0 = acc[ai][bj][m][0] * sc, v1 = acc[ai][bj][m][1] * sc;
                            pg8::u32x4 w; w.x = pg8::cvt_pk_bf16(v0[0], v0[1]); w.y = pg8::cvt_pk_bf16(v0[2], v0[3]); w.z = pg8::cvt_pk_bf16(v1[0], v1[1]); w.w = pg8::cvt_pk_bf16(v1[2], v1[3]);
                            *(pg8::u32x4*)(dst + r * ld + 64 * wc + 32 * bj + 8 * fq) = w; } }
            }
        } else if (T == 7 && wc >= 2) {
            bf16_t* dst = (bf16_t*)(p.ws + WS_AVT) + ((size_t)(b * 2 + (wc - 2)) * 64) * KEYS + (isctx ? 0 : CTXL);
            unsigned eo = (unsigned)(8 * fq * KEYS + t0);
#pragma unroll
            for (int bj = 0; bj < 2; ++bj)
#pragma unroll
                for (int n = 0; n < 2; ++n)
#pragma unroll
                    for (int e = 0; e < 4; ++e) { bf16_t* cp = dst + eo;
#pragma unroll
                        for (int ai = 0; ai < 2; ++ai)
#pragma unroll
                            for (int m = 0; m < 4; ++m) cp[ai * 128 + m * 16] = f2bf(acc[ai][bj][m][n][e]);
                        eo += (unsigned)(((n == 1 && e == 3) ? 25 : 1) * KEYS); asm volatile("" : "+v"(eo) :: "memory"); }
        } else {
            const bool isq = T != 7;
            const float* nw = isq ? p.q_norm : p.k_norm;
            f32x4 w4[2][2];
#pragma unroll
            for (int bj = 0; bj < 2; ++bj)
#pragma unroll
                for (int n = 0; n < 2; ++n) w4[bj][n] = *(const f32x4*)(nw + 32 * bj + 8 * fq + 4 * n);
            const float osc = isq ? QSCALE : 1.f;
            const float* ROPE = (const float*)(p.ws + WS_TAB) + 2048;
            const int half = fq >> 1;
            const int rbase = row0 - t0;
            int t = t0;
#pragma unroll
            for (int ai = 0; ai < 2; ++ai)
#pragma unroll
                for (int m = 0; m < 4; ++m) {
                    float ss = 0.f;
#pragma unroll
                    for (int bj = 0; bj < 2; ++bj)
#pragma unroll
                        for (int n = 0; n < 2; ++n) { const f32x4 v = acc[ai][bj][m][n]; ss += v[0] * v[0] + v[1] * v[1] + v[2] * v[2] + v[3] * v[3]; }
                    ss += __shfl_xor(ss, 16); ss += __shfl_xor(ss, 32);
                    const float rs = rsqrtf(ss * (1.f / 64.f) + EPS);
                    bf16_t* dst = isq ? (bf16_t*)(p.ws + WS_AQ) + (size_t)(rbase + t) * 512 + ((T - 5) * 4 + wc) * 64
                                      : (bf16_t*)(p.ws + WS_AK) + ((size_t)b * KEYS + (isctx ? 0 : CTXL) + t) * 128 + wc * 64;
#pragma unroll
                    for (int bj = 0; bj < 2; ++bj) {
                        f32x4 o[2];
#pragma unroll
                        for (int n = 0; n < 2; ++n) {
                            const f32x4 xv = acc[ai][bj][m][n] * rs * w4[bj][n];
                            if (!isctx) {
                                const int pos = bj == 0 ? (t >> 6) : (t & 63);
                                const f32x4* rp = (const f32x4*)(ROPE + 2 * (pos * 16 + 8 * (fq & 1) + 4 * n));
                                const f32x4 cs01 = rp[0], cs23 = rp[1];
                                f32x4 xp;
#pragma unroll
                                for (int e = 0; e < 4; ++e) xp[e] = __shfl_xor(xv[e], 32);
                                const float sg = half == 0 ? -1.f : 1.f;
                                o[n][0] = xv[0] * cs01[0] + sg * xp[0] * cs01[1]; o[n][1] = xv[1] * cs01[2] + sg * xp[1] * cs01[3];
                                o[n][2] = xv[2] * cs23[0] + sg * xp[2] * cs23[1]; o[n][3] = xv[3] * cs23[2] + sg * xp[3] * cs23[3];
                            } else o[n] = xv;
                            o[n] = o[n] * osc;
                        }
                        pg8::u32x4 w; w.x = pg8::cvt_pk_bf16(o[0][0], o[0][1]); w.y = pg8::cvt_pk_bf16(o[0][2], o[0][3]); w.z = pg8::cvt_pk_bf16(o[1][0], o[1][1]); w.w = pg8::cvt_pk_bf16(o[1][2], o[1][3]);
                        *(pg8::u32x4*)(dst + 32 * bj + 8 * fq) = w;
                    }
                    t += (m == 3) ? 80 : 16; asm volatile("" : "+v"(t) :: "memory");
                }
        }
    }
};
struct InProjSched {
    pg8::PlainOrder o; int K, l, ntl, ntc, nlat, total, G, c;
    __device__ __forceinline__ void init(int l_, int G_, int c_) { l = l_; G = G_; c = c_; K = D; ntl = 8; ntc = l_ == 0 ? 9 : 4; nlat = 64 * ntl; total = nlat + 8 * ntc; o.init(64 * 256, ntl * 256, G_, c_); }
    __device__ __forceinline__ bool next(int i, pg8::Unit& u) const {
        const int L = i * G + c; if (L >= total) return false;
        int tile;
        if (L < nlat) { o.next(i, u); tile = u.pn == 0 ? 9 : u.pn + 1; }
        else { const int idx = L - nlat, k = idx % ntc; u.pm = 64 + idx / ntc; tile = l == 0 ? k : (k < 2 ? 2 + k : (k == 2 ? 7 : 8)); u.a_off = 0; u.e = 0; u.cnt = 256; }
        u.pn = tile; u.b_off = (unsigned)(tile * 256 * K) * 2u; return true;
    }
    __device__ __forceinline__ void a_ready(const pg8::Unit&) const {}
    __device__ __forceinline__ unsigned a_row_off(const pg8::Unit& u, int rl, int K_) const {
        if (u.pn <= 1) rl = (rl & 0xc0) | (rl & 15) << 2 | ((rl >> 4) & 3);
        return o.a_row_off(u, rl, K_); }
};
__device__ __forceinline__ void p2_inproj_fast(const Params& p, int l, unsigned char* lds_raw) { PHASE_IDS;
    InProjSched S; S.init(l, gridDim.x, bidx_);
    EpiInProj E{{p.ws, p.q_norm + l * 64, p.k_norm + l * 64}, l};
    pg8::gemm_phase((PG8_LAS unsigned char*)lds_raw, (const bf16_t*)(p.ws + WS_HB), (const bf16_t*)(p.ws + WS_WIN) + (size_t)l * NIN * D, D, S, E);
    {
        const int G = gridDim.x, rem = S.total % G, first = rem == 0 ? 0 : rem, nb = G - first;
        if (bidx_ >= first) { const int gw0 = (bidx_ - first) * NWAVES + (tidx >> 6), ngw = nb * NWAVES, lane = tidx & 63;
            (void)gw0; (void)ngw; (void)lane; if (l == 0) convert_experts_b(p, 1, (bf16_t*)(p.ws + WS_Y), (bf16_t*)(p.ws + WS_WD1), 512, 768, bidx_ - first, nb, tidx, lds_raw); else convert_experts_b(p, 1, (bf16_t*)(p.ws + WS_Y), (bf16_t*)(p.ws + WS_WD1), 0, 512, bidx_ - first, nb, tidx, lds_raw); }
    }
}

struct MoeSched {
    const int* list; const int* tab;
    int G, c, total, dup; bool down;
    __device__ __forceinline__ bool next(int i, pg8::Unit& u) const {
        int e, rem;
        if (G == 256) {
            const int x = c & 7, ul = i * 32 + (c >> 3);
            const int n0 = tab[x + 1] - tab[x], n1 = tab[x + 9] - tab[x + 8];
            if (ul < n0) { e = x; rem = ul; } else if (ul < n0 + n1) { e = x + 8; rem = ul - n0; } else return false;
        } else {
            const int L = i * G + c; if (L >= total) return false;
            e = 0;
#pragma unroll
            for (int q = 1; q < NEXP; ++q) if (L >= tab[q]) e = q;
            rem = L - tab[e];
        }
        e = __builtin_amdgcn_readfirstlane(e); rem = __builtin_amdgcn_readfirstlane(rem);
        const int sg = tab[17 + e], cn = tab[33 + e];
        const int mtile = rem >> 2, pn = rem & 3;
        u.pm = mtile; u.pn = pn; u.e = e; u.cnt = __builtin_amdgcn_readfirstlane(cn - mtile * 256); u.a_off = (unsigned)__builtin_amdgcn_readfirstlane(sg + mtile * 256);
        u.b_off = down ? (unsigned)((e * 1024 + pn * 256) * DEXP) * 2u : (unsigned)((e * 1024 + pn * 256) * D) * 2u;
        return true;
    }
    __device__ __forceinline__ unsigned a_row_off(const pg8::Unit& u, int rl, int K) const {
        if (down) return (unsigned)((u.a_off + rl) * K) * 2u;
        const int idx = u.pm * 256 + (rl < u.cnt ? rl : u.cnt - 1);
        const int pair = list[u.e * NTOK + idx];
        return (unsigned)((pair >> 1) * K) * 2u;
    }
};
__device__ __forceinline__ int moe_tables(const unsigned* ctl, int l, int* tab, int tidx) {
    if (tidx == 0) { int u = 0, sgm = 0;
        for (int e = 0; e < NEXP; ++e) { const int n = (int)__hip_atomic_load(ctl + CW_CNT + (l * NEXP + e) * 64, __ATOMIC_RELAXED, __HIP_MEMORY_SCOPE_AGENT); const int mt = (n + 255) >> 8; tab[e] = u; tab[17 + e] = sgm; tab[33 + e] = n; u += mt * 4; sgm += mt * 256; }
        tab[16] = u; }
    __syncthreads();
    return __builtin_amdgcn_readfirstlane(tab[16]);
}
struct EpiGateUp {
    bf16_t* act;
    __device__ __forceinline__ void operator()(f32x4 (&acc)[2][2][4][2], const pg8::Unit& u, int wr, int wc, int fr, int fq) const {
        bf16_t* base = act + (size_t)(u.a_off + wr * 64 + fr) * DEXP + u.pn * 128 + wc * 32 + 8 * fq;
#pragma unroll
        for (int ai = 0; ai < 2; ++ai)
#pragma unroll
            for (int m = 0; m < 4; ++m) {
                f32x4 o[2];
#pragma unroll
                for (int n = 0; n < 2; ++n)
#pragma unroll
                    for (int e = 0; e < 4; ++e) { const float g = acc[ai][0][m][n][e]; o[n][e] = g * __builtin_amdgcn_rcpf(1.f + __expf(-g)) * acc[ai][1][m][n][e]; }
                pg8::u32x4 w; w.x = pg8::cvt_pk_bf16(o[0][0], o[0][1]); w.y = pg8::cvt_pk_bf16(o[0][2], o[0][3]); w.z = pg8::cvt_pk_bf16(o[1][0], o[1][1]); w.w = pg8::cvt_pk_bf16(o[1][2], o[1][3]);
                *(pg8::u32x4*)(base + (size_t)(ai * 128 + m * 16) * DEXP) = w;
            }
    }
};
struct EpiDown {
    bf16_t* Y; const int* list; const f32x4* route;
    __device__ __forceinline__ void operator()(f32x4 (&acc)[2][2][4][2], const pg8::Unit& u, int wr, int wc, int fr, int fq) const {
        asm volatile("" : "+v"(fr), "+v"(fq));
        const int rl0 = wr * 64 + fr;
        const int col = u.pn * 256 + wc * 32 + 8 * fq;
        int pair[8]; float w[8];
#pragma unroll
        for (int i = 0; i < 8; ++i) { const int rl = rl0 + (i >> 2) * 128 + (i & 3) * 16; pair[i] = rl < u.cnt ? list[u.e * NTOK + u.pm * 256 + rl] : -1; }
#pragma unroll
        for (int i = 0; i < 8; ++i) w[i] = pair[i] >= 0 ? ((const float*)(route + (pair[i] >> 1)))[2 + (pair[i] & 1)] : 0.f;
#pragma unroll
        for (int i = 0; i < 8; ++i) {
            if (pair[i] >= 0) {
                bf16_t* dst = Y + (size_t)pair[i] * D + col;
#pragma unroll
                for (int bj = 0; bj < 2; ++bj) { const f32x4 v0 = acc[i >> 2][bj][i & 3][0] * w[i], v1 = acc[i >> 2][bj][i & 3][1] * w[i];
                    pg8::u32x4 o; o.x = pg8::cvt_pk_bf16(v0[0], v0[1]); o.y = pg8::cvt_pk_bf16(v0[2], v0[3]); o.z = pg8::cvt_pk_bf16(v1[0], v1[1]); o.w = pg8::cvt_pk_bf16(v1[2], v1[3]);
                    *(pg8::u32x4*)(dst + bj * 128) = o; }
            }
        }
    }
};
__device__ __forceinline__ void p7_gateup_fast(const Params& p, int l, unsigned char* lds_raw) { PHASE_IDS;
    int* tab = (int*)(lds_raw + LDS_BYTES - 768);
    MoeSched S; S.list = (const int*)(p.ws + WS_LIST) + (size_t)l * NEXP * NTOK; S.tab = tab; S.G = gridDim.x; S.c = bidx_; S.down = false; S.dup = DUPN(9); S.total = moe_tables((const unsigned*)(p.ws + WS_CTL), l, tab, tidx);
    EpiGateUp E{(bf16_t*)(p.ws + WS_ACT)};
    pg8::gemm_phase((PG8_LAS unsigned char*)lds_raw, (const bf16_t*)(p.ws + WS_HB), (const bf16_t*)(p.ws + (l == 0 ? WS_WGU : WS_Y)), D, S, E);
}
__device__ __forceinline__ void p8_down_fast(const Params& p, int l, unsigned char* lds_raw) { PHASE_IDS;
    int* tab = (int*)(lds_raw + LDS_BYTES - 768);
    MoeSched S; S.list = (const int*)(p.ws + WS_LIST) + (size_t)l * NEXP * NTOK; S.tab = tab; S.G = gridDim.x; S.c = bidx_; S.down = true; S.dup = DUPN(10); S.total = moe_tables((const unsigned*)(p.ws + WS_CTL), l, tab, tidx);
    EpiDown E{(bf16_t*)(p.ws + WS_Y), (const int*)(p.ws + WS_LIST) + (size_t)l * NEXP * NTOK, (const f32x4*)(p.ws + WS_ROUTE)};
    pg8::gemm_phase((PG8_LAS unsigned char*)lds_raw, (const bf16_t*)(p.ws + WS_ACT), (const bf16_t*)(p.ws + (l == 0 ? WS_WD : WS_WD1)), DEXP, S, E);
}

struct FnetSched {
    int mtiles, nunits, G, c, dup;
    __device__ __forceinline__ bool next(int i, pg8::Unit& u) const {
        int L = i * G + c; if (L >= nunits * dup) return false; if (L >= nunits) L -= nunits;
        u.e = L / mtiles; u.pm = L % mtiles; u.pn = 0; u.cnt = 256; u.a_off = 0; u.b_off = 0; return true;
    }
    __device__ __forceinline__ unsigned a_row_off(const pg8::Unit& u, int rl, int K) const { return (unsigned)((u.pm * 256 + rl) * K) * 2u; }
};
struct FnetSchedK { FnetSched s; int K;
    __device__ __forceinline__ bool next(int i, pg8::Unit& u) const { if (!s.next(i, u)) return false; u.b_off = (unsigned)(u.e * 256 * K) * 2u; return true; }
    __device__ __forceinline__ unsigned a_row_off(const pg8::Unit& u, int rl, int K_) const { return s.a_row_off(u, rl, K_); }
};
struct EpiFnet {
    bf16_t* mix; int row0, rows_per_b; float scale;
    __device__ __forceinline__ void operator()(f32x4 (&acc)[2][2][4][2], const pg8::Unit& u, int wr, int wc, int fr, int fq) const {
        bf16_t* base = mix + (size_t)(row0 + u.e * rows_per_b + u.pm * 256 + wr * 64 + fr) * D + wc * 32 + 8 * fq;
#pragma unroll
        for (int ai = 0; ai < 2; ++ai)
#pragma unroll
            for (int m = 0; m < 4; ++m)
#pragma unroll
                for (int bj = 0; bj < 2; ++bj) { const f32x4 v0 = acc[ai][bj][m][0] * scale, v1 = acc[ai][bj][m][1] * scale;
                    pg8::u32x4 o; o.x = pg8::cvt_pk_bf16(v0[0], v0[1]); o.y = pg8::cvt_pk_bf16(v0[2], v0[3]); o.z = pg8::cvt_pk_bf16(v1[0], v1[1]); o.w = pg8::cvt_pk_bf16(v1[2], v1[3]);
                    *(pg8::u32x4*)(base + (size_t)(ai * 128 + m * 16) * D + bj * 128) = o; }
    }
};
__device__ __forceinline__ void p3_fnet_fast(const Params& p, int l, unsigned char* lds_raw) { PHASE_IDS;
    if (l == 0) {
        FnetSchedK S; S.s.dup = 1; S.s.mtiles = 1; S.s.nunits = 8; S.s.G = gridDim.x; S.s.c = ((int)gridDim.x - 1 - bidx_); S.K = 512;
        EpiFnet E{(bf16_t*)(p.ws + WS_HB), NL, CTXL, 0.0078125f};
        pg8::gemm_phase((PG8_LAS unsigned char*)lds_raw, (const bf16_t*)(p.ws + WS_DMATC), (const bf16_t*)(p.ws + WS_YFTC), 512, S, E);
    }
}
typedef float f32x16 __attribute__((ext_vector_type(16)));
typedef short s16x4 __attribute__((ext_vector_type(4)));
#define ATTN_THR 8.0f
__device__ __forceinline__ void attn_softmax(f32x16& p0, f32x16& p1, f32x16& o0, f32x16& o1, float& mref, float& lrow, pg8::u32x4 (&pf)[4], bool first) {
    float mx = p0[0];
#pragma unroll
    for (int r = 1; r < 16; ++r) mx = fmaxf(mx, p0[r]);
#pragma unroll
    for (int r = 0; r < 16; ++r) mx = fmaxf(mx, p1[r]);
    { auto rr = __builtin_amdgcn_permlane32_swap(__float_as_uint(mx), __float_as_uint(mx), false, false); mx = fmaxf(__uint_as_float(rr[0]), __uint_as_float(rr[1])); }
    if (first || __any(mx > ATTN_THR)) {
        const float delta = first ? mx : fmaxf(mx, 0.f), alpha = __builtin_amdgcn_exp2f(-delta);
        mref += delta; lrow *= alpha;
#pragma unroll
        for (int r = 0; r < 16; ++r) { p0[r] -= delta; p1[r] -= delta; o0[r] *= alpha; o1[r] *= alpha; }
    }
    float sum = 0.f;
#pragma unroll
    for (int r = 0; r < 16; ++r) { p0[r] = __builtin_amdgcn_exp2f(p0[r]); sum += p0[r]; }
#pragma unroll
    for (int r = 0; r < 16; ++r) { p1[r] = __builtin_amdgcn_exp2f(p1[r]); sum += p1[r]; }
    lrow += sum;
#pragma unroll
    for (int s = 0; s < 2; ++s) {
        pf[s].x = pg8::cvt_pk_bf16(p0[8 * s + 0], p0[8 * s + 1]); pf[s].y = pg8::cvt_pk_bf16(p0[8 * s + 2], p0[8 * s + 3]); pf[s].z = pg8::cvt_pk_bf16(p0[8 * s + 4], p0[8 * s + 5]); pf[s].w = pg8::cvt_pk_bf16(p0[8 * s + 6], p0[8 * s + 7]);
        pf[2 + s].x = pg8::cvt_pk_bf16(p1[8 * s + 0], p1[8 * s + 1]); pf[2 + s].y = pg8::cvt_pk_bf16(p1[8 * s + 2], p1[8 * s + 3]); pf[2 + s].z = pg8::cvt_pk_bf16(p1[8 * s + 4], p1[8 * s + 5]); pf[2 + s].w = pg8::cvt_pk_bf16(p1[8 * s + 6], p1[8 * s + 7]);
    }
}
__device__ __forceinline__ void attn_store(bf16_t* op, const f32x16& o0, const f32x16& o1, float lrow) {
    { auto rr = __builtin_amdgcn_permlane32_swap(__float_as_uint(lrow), __float_as_uint(lrow), false, false); lrow = __uint_as_float(rr[0]) + __uint_as_float(rr[1]); }
    const float inv = 1.f / lrow;
#pragma unroll
    for (int g = 0; g < 4; ++g) {
        pg8::u32x2 w0, w1;
        w0.x = pg8::cvt_pk_bf16(o0[4 * g] * inv, o0[4 * g + 1] * inv); w0.y = pg8::cvt_pk_bf16(o0[4 * g + 2] * inv, o0[4 * g + 3] * inv);
        w1.x = pg8::cvt_pk_bf16(o1[4 * g] * inv, o1[4 * g + 1] * inv); w1.y = pg8::cvt_pk_bf16(o1[4 * g + 2] * inv, o1[4 * g + 3] * inv);
        *(pg8::u32x2*)(op + 8 * g) = w0; *(pg8::u32x2*)(op + 32 + 8 * g) = w1;
    }
}
__device__ __forceinline__ void attn_unit(unsigned char* ws, unsigned char* lds_raw, int b, int kvh, int qrow0, int nkt, int tid) {
    typedef pg8::bf16x8 bf16x8;
    const int lane = tid & 63, wid = __builtin_amdgcn_readfirstlane(tid >> 6), r32 = lane & 31, hi = lane >> 5, h = kvh * 4 + (wid >> 1);
    const bf16_t* AQ = (const bf16_t*)(ws + WS_AQ); const bf16_t* AK = (const bf16_t*)(ws + WS_AK); const bf16_t* AVT = (const bf16_t*)(ws + WS_AVT);
    const int srow = wid * 8 + (lane >> 3), sx = (srow >> 1) & 7, sch = (lane & 7) ^ sx;
    const bf16_t* kg = AK + ((size_t)b * KEYS + srow) * 128 + kvh * 64 + sch * 8;
    const bf16_t* vg = AVT + ((size_t)(b * 2 + kvh) * 64 + srow) * KEYS + sch * 8;
    typedef __attribute__((address_space(3))) unsigned char lds_u8;
    lds_u8* Kb = (lds_u8*)lds_raw; lds_u8* Vb = Kb + 24576;
    const int kx = (r32 >> 1) & 7;
    const int krd = r32 * 128, vrd = r32 * 128 + hi * 8;
    const int qr = qrow0 + (wid & 1) * 64 + r32;
    lds_u8* Ql = Kb + 40960 + wid * 8192 + lane * 16;
    { const bf16_t* qp = AQ + (size_t)qr * 512 + h * 64 + hi * 8;
      bf16x8 qa[4], qb[4];
#pragma unroll
      for (int s = 0; s < 4; ++s) { qa[s] = *(const bf16x8*)(qp + s * 16); qb[s] = *(const bf16x8*)(qp + 32 * 512 + s * 16); }
      __syncthreads();
#pragma unroll
      for (int s = 0; s < 4; ++s) { *(LDSP(bf16x8))(Ql + s * 2048) = qa[s]; *(LDSP(bf16x8))(Ql + s * 2048 + 1024) = qb[s]; } }
    f32x16 oA0 = {}, oA1 = {}, oB0 = {}, oB1 = {};
    float mA = 0.f, lA = 0.f, mB = 0.f, lB = 0.f;
#define ATTN_DMA_K(t, koff) __builtin_amdgcn_global_load_lds((const unsigned*)(kg + (size_t)(t) * 64 * 128), (LDSP(unsigned))(Kb + (koff) + wid * 1024), 16, 0, 0)
#define ATTN_DMA_V(t, voff) __builtin_amdgcn_global_load_lds((const unsigned*)(vg + (t) * 64), (LDSP(unsigned))(Vb + (voff) + wid * 1024), 16, 0, 0)
    ATTN_DMA_K(0, 0); ATTN_DMA_V(0, 0); if (nkt > 1) ATTN_DMA_K(1, 8192);
    __syncthreads();
#define ATTN_QK2(koff) do { asm volatile("" : "+v"(Ql));     \
        { const float nA_ = -mA, nB_ = -mB; _Pragma("unroll") for (int r_ = 0; r_ < 16; ++r_) { pA0[r_] = nA_; pA1[r_] = nA_; pB0[r_] = nB_; pB1[r_] = nB_; } } \
        _Pragma("unroll") for (int s = 0; s < 4; ++s) { \
            const bf16x8 k0 = *(LDSP(const bf16x8))(Kb + (koff) + krd + (((2 * s + hi) ^ kx) << 4)); \
            const bf16x8 k1 = *(LDSP(const bf16x8))(Kb + (koff) + 4096 + krd + (((2 * s + hi) ^ kx) << 4)); \
            const bf16x8 qA = *(LDSP(const bf16x8))(Ql + s * 2048), qB = *(LDSP(const bf16x8))(Ql + s * 2048 + 1024); \
            pA0 = __builtin_amdgcn_mfma_f32_32x32x16_bf16(k0, qA, pA0, 0, 0, 0); \
            pA1 = __builtin_amdgcn_mfma_f32_32x32x16_bf16(k1, qA, pA1, 0, 0, 0); \
            pB0 = __builtin_amdgcn_mfma_f32_32x32x16_bf16(k0, qB, pB0, 0, 0, 0); \
            pB1 = __builtin_amdgcn_mfma_f32_32x32x16_bf16(k1, qB, pB1, 0, 0, 0); \
            asm volatile("" ::: "memory"); } } while (0)
#define ATTN_PV(vcur) do { _Pragma("unroll") for (int ks = 0; ks < 4; ++ks) { \
            const s16x4 a0 = *(LDSP(const s16x4))(Vb + (vcur) + vrd + (((2 * ks) ^ kx) << 4)); \
            const s16x4 a1 = *(LDSP(const s16x4))(Vb + (vcur) + vrd + (((2 * ks + 1) ^ kx) << 4)); \
            const s16x4 c0 = *(LDSP(const s16x4))(Vb + (vcur) + 4096 + vrd + (((2 * ks) ^ kx) << 4)); \
            const s16x4 c1 = *(LDSP(const s16x4))(Vb + (vcur) + 4096 + vrd + (((2 * ks + 1) ^ kx) << 4)); \
            const bf16x8 va = {a0[0], a0[1], a0[2], a0[3], a1[0], a1[1], a1[2], a1[3]}; \
            const bf16x8 vc = {c0[0], c0[1], c0[2], c0[3], c1[0], c1[1], c1[2], c1[3]}; \
            oA0 = __builtin_amdgcn_mfma_f32_32x32x16_bf16(va, __builtin_bit_cast(bf16x8, pfA[ks]), oA0, 0, 0, 0); \
            oA1 = __builtin_amdgcn_mfma_f32_32x32x16_bf16(vc, __builtin_bit_cast(bf16x8, pfA[ks]), oA1, 0, 0, 0); \
            oB0 = __builtin_amdgcn_mfma_f32_32x32x16_bf16(va, __builtin_bit_cast(bf16x8, pfB[ks]), oB0, 0, 0, 0); \
            oB1 = __builtin_amdgcn_mfma_f32_32x32x16_bf16(vc, __builtin_bit_cast(bf16x8, pfB[ks]), oB1, 0, 0, 0); \
            asm volatile("" ::: "memory"); } } while (0)
    pg8::u32x4 pfA[4], pfB[4];
    f32x16 pA0, pA1, pB0, pB1;
    int kc = 0, kn = 8192, kn2 = 16384, vcur = 0;
    if (wid < 4) {
        for (int t = 0; t < nkt; ++t) {
            if (t + 2 < nkt) ATTN_DMA_K(t + 2, kn2);
            if (t + 1 < nkt) ATTN_DMA_V(t + 1, 8192 - vcur);
            ATTN_QK2(kc);
            attn_softmax(pA0, pA1, oA0, oA1, mA, lA, pfA, t == 0);
            attn_softmax(pB0, pB1, oB0, oB1, mB, lB, pfB, t == 0);
            asm volatile("" ::: "memory");
            ATTN_PV(vcur);
            __syncthreads();
            { const int k0_ = kc; kc = kn; kn = kn2; kn2 = k0_; } vcur = 8192 - vcur;
        }
    } else {
        ATTN_QK2(0);
        for (int t = 0; t < nkt; ++t) {
            if (t + 2 < nkt) ATTN_DMA_K(t + 2, kn2);
            if (t + 1 < nkt) ATTN_DMA_V(t + 1, 8192 - vcur);
            attn_softmax(pA0, pA1, oA0, oA1, mA, lA, pfA, t == 0);
            attn_softmax(pB0, pB1, oB0, oB1, mB, lB, pfB, t == 0);
            asm volatile("" ::: "memory");
            ATTN_PV(vcur);
            if (t + 1 < nkt) ATTN_QK2(kn);
            __syncthreads();
            { const int k0_ = kc; kc = kn; kn = kn2; kn2 = k0_; } vcur = 8192 - vcur;
        }
    }
#undef ATTN_DMA_K
#undef ATTN_DMA_V
#undef ATTN_QK2
#undef ATTN_PV
    {
      const int t2 = otid(), l2 = t2 & 63, w2 = __builtin_amdgcn_readfirstlane(t2 >> 6);
      bf16_t* op = (bf16_t*)(ws + WS_HB) + (size_t)(qrow0 + (w2 & 1) * 64 + (l2 & 31)) * D + 512 + (kvh * 4 + (w2 >> 1)) * 64 + 4 * (l2 >> 5);
      attn_store(op, oA0, oA1, lA);
      attn_store(op + (size_t)32 * D, oB0, oB1, lB); }
}
__device__ __forceinline__ void p3_attn_fast(const Params& p, int l, unsigned char* lds_raw) { PHASE_IDS;
    const int G = gridDim.x;
    for (int u = bidx_; u < BATCH * 2 * 16; u += G) { const int rb = u & 15, kvh = (u >> 4) & 1, b = u >> 5; attn_unit(p.ws, lds_raw, b, kvh, b * SEQ + rb * 128, KEYS / 64, tidx); }
    if (l == 0) for (int u = bidx_; u < BATCH * 2 * 2; u += G) { const int rb = u & 1, kvh = (u >> 1) & 1, b = u >> 2; attn_unit(p.ws, lds_raw, b, kvh, NL + b * CTXL + rb * 128, CTXL / 64, tidx); }
}

struct GlaPrep { float cum[16], tot[16], q[16], k[16]; };
struct GlaIn { pg8::u32x4 gd[2], qk[4], gv[2]; };
__device__ __forceinline__ void gla_load(GlaIn& in, const unsigned char* ws, int row0, int h, int w4, int lane, int tg) {
    const int dir = w4 >> 1, kh = w4 & 1, row = row0 + lane;
    const bf16_t* GD = (const bf16_t*)(ws + WS_GD); const bf16_t* GQK = (const bf16_t*)(ws + WS_GQK); const bf16_t* GV = (const bf16_t*)(ws + WS_GV);
    in.gd[0] = *(const pg8::u32x4*)(GD + (size_t)row * 32 + dir * 16); in.gd[1] = *(const pg8::u32x4*)(GD + (size_t)row * 32 + dir * 16 + 8);
    const bf16_t* qp = GQK + (size_t)row * 256 + h * 32 + kh * 16;
    in.qk[0] = *(const pg8::u32x4*)qp; in.qk[1] = *(const pg8::u32x4*)(qp + 8); in.qk[2] = *(const pg8::u32x4*)(qp + 128); in.qk[3] = *(const pg8::u32x4*)(qp + 136);
    const int t = tg >> 2, c = tg & 3;
    in.gv[0] = *(const pg8::u32x4*)(GV + (size_t)(row0 + t) * 256 + h * 64 + 16 * c); in.gv[1] = *(const pg8::u32x4*)(GV + (size_t)(row0 + t) * 256 + h * 64 + 16 * c + 8);
}
__device__ __forceinline__ void gla_prep(GlaPrep& g, const GlaIn& in, const float* wlds, int h, int w4, int lane) {
    const int dir = w4 >> 1, kh = w4 & 1;
    float gd[16];
    { const unsigned w[8] = {in.gd[0].x, in.gd[0].y, in.gd[0].z, in.gd[0].w, in.gd[1].x, in.gd[1].y, in.gd[1].z, in.gd[1].w};
#pragma unroll
      for (int i = 0; i < 8; ++i) { gd[2 * i] = __uint_as_float(w[i] << 16); gd[2 * i + 1] = __uint_as_float(w[i] & 0xffff0000u); } }
    const float* wu = wlds + dir * 2048 + h * 32 + kh * 16;
    const float* bu = wlds + 4096 + dir * 128 + h * 32 + kh * 16;
#pragma unroll
    for (int kk = 0; kk < 16; ++kk) g.cum[kk] = bu[kk];
#pragma unroll
    for (int r = 0; r < 16; ++r) {
#pragma unroll
        for (int kk = 0; kk < 16; ++kk) g.cum[kk] = fmaf(gd[r], wu[r * 128 + kk], g.cum[kk]);
    }
#pragma unroll
    for (int kk = 0; kk < 16; ++kk) { const float z = g.cum[kk]; g.cum[kk] = (fminf(z, 0.f) - __logf(1.f + __expf(-fabsf(z)))) * (1.f / 16.f); }
#pragma unroll
    for (int off = 1; off < 64; off <<= 1) {
        const int src = dir == 0 ? lane - off : lane + off; const bool ok = (unsigned)src < 64u;
#pragma unroll
        for (int kk = 0; kk < 16; ++kk) {
            const float y = __shfl(g.cum[kk], src & 63);
            g.cum[kk] += ok ? y : 0.f;
        }
    }
#pragma unroll
    for (int kk = 0; kk < 16; ++kk) g.tot[kk] = __shfl(g.cum[kk], dir == 0 ? 63 : 0);
    { const unsigned wq[8] = {in.qk[0].x, in.qk[0].y, in.qk[0].z, in.qk[0].w, in.qk[1].x, in.qk[1].y, in.qk[1].z, in.qk[1].w}, wk[8] = {in.qk[2].x, in.qk[2].y, in.qk[2].z, in.qk[2].w, in.qk[3].x, in.qk[3].y, in.qk[3].z, in.qk[3].w};
#pragma unroll
      for (int i = 0; i < 8; ++i) { g.q[2 * i] = __uint_as_float(wq[i] << 16); g.q[2 * i + 1] = __uint_as_float(wq[i] & 0xffff0000u); g.k[2 * i] = __uint_as_float(wk[i] << 16); g.k[2 * i + 1] = __uint_as_float(wk[i] & 0xffff0000u); } }
}
__device__ __forceinline__ void gla_stage_w(float* wlds, const Params& p, int l, int tidx) {
    { f32x4 wv[2]; float bv = 0.f;
#pragma unroll
      for (int j = 0; j < 2; ++j) wv[j] = ((const f32x4*)(p.w_gup + (size_t)l * 4096))[tidx + NTHREADS * j];
      if (tidx < 256) bv = p.b_gg[l * 256 + tidx];
#pragma unroll
      for (int j = 0; j < 2; ++j) ((f32x4*)wlds)[tidx + NTHREADS * j] = wv[j];
      if (tidx < 256) wlds[4096 + tidx] = bv; }
    __syncthreads();
}
__device__ __forceinline__ void gla_write_vt(bf16_t* VT, const GlaIn& in, int tg) {
    const int t = tg >> 2, c = tg & 3;
    const unsigned w[8] = {in.gv[0].x, in.gv[0].y, in.gv[0].z, in.gv[0].w, in.gv[1].x, in.gv[1].y, in.gv[1].z, in.gv[1].w};
#pragma unroll
    for (int i = 0; i < 8; ++i) { VT[(16 * c + 2 * i) * 72 + t] = (bf16_t)(w[i] & 0xffffu); VT[(16 * c + 2 * i + 1) * 72 + t] = (bf16_t)(w[i] >> 16); }
}
__device__ __forceinline__ int gla_row0(int b, int cs) { return cs < 4 ? NL + b * CTXL + cs * 64 : b * SEQ + (cs - 4) * 64; }

__device__ __forceinline__ void p3_gla_local_fast(const Params& p, int l, unsigned char* lds_raw) { PHASE_IDS;
    typedef pg8::bf16x8 bf16x8;
    const int grp = __builtin_amdgcn_readfirstlane(tidx >> 8), tg = tidx & 255, w4 = __builtin_amdgcn_readfirstlane((tidx >> 6) & 3), lane = tidx & 63;
    bf16_t* KT = (bf16_t*)(lds_raw + grp * 32768);
    bf16_t* VT = KT + 2 * 32 * 72;
    float* AST = (float*)(p.ws + WS_AST); float* DEC = (float*)(p.ws + WS_DEC);
    float* wlds = (float*)(lds_raw + 65536); gla_stage_w(wlds, p, l, tidx);
    const int nitems = BATCH * NCHK * 4;
    const int G = gridDim.x, half = G >> 1, npairs = nitems / 2, nup = (G - half) * 4 < npairs ? (G - half) * 4 : npairs;
    const int myfirst = bidx_ >= half ? (bidx_ - half) : nup + bidx_, mystep = bidx_ >= half ? (G - half) : half, myend = bidx_ >= half ? nup : npairs;
    for (int pi = myfirst; pi < myend; pi += mystep) {
        const int it = pi * 2 + grp; const bool valid = it < nitems;
        const int h = it & 3, cs = (it >> 2) % NCHK, b = it / (4 * NCHK);
        const int dir = w4 >> 1, kh = w4 & 1;
        GlaIn in;
        if (valid) gla_load(in, p.ws, gla_row0(b, cs), h, w4, lane, tg);
        __syncthreads();
        if (valid) {
            GlaPrep g; gla_prep(g, in, wlds, h, w4, lane);
#pragma unroll
            for (int kk = 0; kk < 16; ++kk) KT[(dir * 32 + kh * 16 + kk) * 72 + lane] = f2bf(g.k[kk] * __expf(g.tot[kk] - g.cum[kk]));
            if (lane == 0) {
#pragma unroll
                for (int kk = 0; kk < 16; ++kk) DEC[((size_t)it * 2 + dir) * 32 + kh * 16 + kk] = __expf(g.tot[kk]);
            }
            gla_write_vt(VT, in, tg);
        }
        __syncthreads();
        if (valid) {
            const int r = lane & 15, q4 = lane >> 4, kt = kh;
            float* dst = AST + ((size_t)it * 2 + dir) * 2048;
#pragma unroll
            for (int vt = 0; vt < 4; ++vt) {
                f32x4 acc = {0.f, 0.f, 0.f, 0.f};
#pragma unroll
                for (int ks = 0; ks < 2; ++ks) {
                    const bf16x8 a = *(const bf16x8*)(KT + (dir * 32 + kt * 16 + r) * 72 + ks * 32 + q4 * 8);
                    const bf16x8 bb = *(const bf16x8*)(VT + (vt * 16 + r) * 72 + ks * 32 + q4 * 8);
                    acc = __builtin_amdgcn_mfma_f32_16x16x32_bf16(a, bb, acc, 0, 0, 0);
                }
                *(f32x4*)(dst + (vt * 16 + r) * 32 + kt * 16 + q4 * 4) = acc;
            }
        }
    }
}
__device__ __forceinline__ void p3_gla_scan_fast(const Params& p) { PHASE_IDS;
    const float* AST = (const float*)(p.ws + WS_AST); const float* DEC = (const float*)(p.ws + WS_DEC);
    bf16_t* ST = (bf16_t*)(p.ws + WS_ST);
    for (int i = GT; i < BATCH * 4 * 2 * 2048; i += NGT) {
        const int e = i & 2047, dir = (i >> 11) & 1, h = (i >> 12) & 3, b = i >> 14, k = e & 31;
        float a[NCHK], d[NCHK];
#pragma unroll
        for (int q = 0; q < NCHK; ++q) { const int cs = dir == 0 ? q : (q < 4 ? 3 - q : NCHK + 3 - q); const size_t id = (((size_t)b * NCHK + cs) * 4 + h) * 2 + dir; a[q] = AST[id * 2048 + e]; d[q] = DEC[id * 32 + k]; }
        float s = 0.f;
#pragma unroll
        for (int q = 0; q < NCHK; ++q) { const int cs = dir == 0 ? q : (q < 4 ? 3 - q : NCHK + 3 - q); const size_t id = (((size_t)b * NCHK + cs) * 4 + h) * 2 + dir; ST[id * 2048 + e] = f2bf(s); s = d[q] * s + a[q]; }
    }
}
__device__ __forceinline__ void p4_gla_out_fast(const Params& p, int l, unsigned char* lds_raw) { PHASE_IDS;
    typedef pg8::bf16x8 bf16x8;
    const int grp = __builtin_amdgcn_readfirstlane(tidx >> 8), tg = tidx & 255, w4 = __builtin_amdgcn_readfirstlane((tidx >> 6) & 3), lane = tidx & 63;
    bf16_t* QT = (bf16_t*)(lds_raw + grp * 58368);
    bf16_t* KL = QT + 2 * 64 * 40;
    bf16_t* SL = KL + 2 * 64 * 40;
    bf16_t* VT = SL + 2 * 64 * 40;
    bf16_t* ATT = VT + 64 * 72;
    bf16_t* GL = ATT + 64 * 72;
    const bf16_t* ST = (const bf16_t*)(p.ws + WS_ST); const bf16_t* GG = (const bf16_t*)(p.ws + WS_GG);
    bf16_t* MIX = (bf16_t*)(p.ws + WS_HB);
    float* wlds = (float*)(lds_raw + 116736); gla_stage_w(wlds, p, l, tidx);
    const int cs0 = l == 1 ? 4 : 0, ncs = NCHK - cs0, nitems = BATCH * ncs * 4;
    for (int pi = bidx_; pi * 2 < nitems; pi += gridDim.x) {
        const int itl = pi * 2 + grp; const bool valid = itl < nitems;
        const int h = itl & 3, cs = cs0 + (itl >> 2) % ncs, b = itl / (4 * ncs);
        const int it = (b * NCHK + cs) * 4 + h;
        const int dir = w4 >> 1, kh = w4 & 1;
        const int row0 = gla_row0(b, cs);
        GlaIn in; pg8::u32x4 st[2], gg[2];
        const int gr = tg >> 2, gc = tg & 3;
        if (valid) {
            gla_load(in, p.ws, row0, h, w4, lane, tg);
#pragma unroll
            for (int j = 0; j < 2; ++j) { const int pc = tg + 256 * j, d2 = pc >> 8, v = (pc >> 2) & 63, c = pc & 3; st[j] = *(const pg8::u32x4*)(ST + ((size_t)it * 2 + d2) * 2048 + v * 32 + c * 8); }
            gg[0] = *(const pg8::u32x4*)(GG + (size_t)(row0 + gr) * 256 + h * 64 + 16 * gc); gg[1] = *(const pg8::u32x4*)(GG + (size_t)(row0 + gr) * 256 + h * 64 + 16 * gc + 8);
        }
        __syncthreads();
        if (valid) {
            GlaPrep g; gla_prep(g, in, wlds, h, w4, lane);
            pg8::u32x4 wq[2], wk[2];
#pragma unroll
            for (int i = 0; i < 8; ++i) {
                const float e0 = __expf(g.cum[2 * i]), e1 = __expf(g.cum[2 * i + 1]);
                ((unsigned*)wq)[i] = pg8::cvt_pk_bf16(g.q[2 * i] * e0, g.q[2 * i + 1] * e1);
                ((unsigned*)wk)[i] = pg8::cvt_pk_bf16(g.k[2 * i] * __builtin_amdgcn_rcpf(e0), g.k[2 * i + 1] * __builtin_amdgcn_rcpf(e1));
            }
            *(pg8::u32x4*)(QT + (dir * 64 + lane) * 40 + kh * 16) = wq[0]; *(pg8::u32x4*)(QT + (dir * 64 + lane) * 40 + kh * 16 + 8) = wq[1];
            *(pg8::u32x4*)(KL + (dir * 64 + lane) * 40 + kh * 16) = wk[0]; *(pg8::u32x4*)(KL + (dir * 64 + lane) * 40 + kh * 16 + 8) = wk[1];
            gla_write_vt(VT, in, tg);
#pragma unroll
            for (int j = 0; j < 2; ++j) { const int pc = tg + 256 * j, d2 = pc >> 8, v = (pc >> 2) & 63, c = pc & 3; *(pg8::u32x4*)(SL + (d2 * 64 + v) * 40 + c * 8) = st[j]; }
            *(pg8::u32x4*)(GL + gr * 72 + 16 * gc) = gg[0]; *(pg8::u32x4*)(GL + gr * 72 + 16 * gc + 8) = gg[1];
        }
        __syncthreads();
        if (valid) {
            const int r = lane & 15, q4 = lane >> 4, i0 = 16 * w4;
            const bf16x8 aF = *(const bf16x8*)(QT + (0 * 64 + i0 + r) * 40 + q4 * 8), aB = *(const bf16x8*)(QT + (1 * 64 + i0 + r) * 40 + q4 * 8);
#pragma unroll
            for (int jt = 0; jt < 4; ++jt) {
                const bf16x8 bF = *(const bf16x8*)(KL + (0 * 64 + jt * 16 + r) * 40 + q4 * 8), bB = *(const bf16x8*)(KL + (1 * 64 + jt * 16 + r) * 40 + q4 * 8);
                const f32x4 z = {0.f, 0.f, 0.f, 0.f};
                const f32x4 F = __builtin_amdgcn_mfma_f32_16x16x32_bf16(aF, bF, z, 0, 0, 0), Bv = __builtin_amdgcn_mfma_f32_16x16x32_bf16(aB, bB, z, 0, 0, 0);
                const int j = jt * 16 + r;
#pragma unroll
                for (int e = 0; e < 4; ++e) { const int i = i0 + 4 * q4 + e; const float v = (j <= i ? F[e] : 0.f) + (j >= i ? Bv[e] : 0.f); ATT[i * 72 + j] = f2bf(v); }
            }
            __builtin_amdgcn_s_waitcnt(0);
            f32x4 o[4];
#pragma unroll
            for (int vt = 0; vt < 4; ++vt) {
                f32x4 acc = {0.f, 0.f, 0.f, 0.f};
#pragma unroll
                for (int ks = 0; ks < 2; ++ks) {
                    const bf16x8 a = *(const bf16x8*)(ATT + (i0 + r) * 72 + ks * 32 + q4 * 8);
                    const bf16x8 bb = *(const bf16x8*)(VT + (vt * 16 + r) * 72 + ks * 32 + q4 * 8);
                    acc = __builtin_amdgcn_mfma_f32_16x16x32_bf16(a, bb, acc, 0, 0, 0);
                }
                const bf16x8 sF = *(const bf16x8*)(SL + (0 * 64 + vt * 16 + r) * 40 + q4 * 8), sB = *(const bf16x8*)(SL + (1 * 64 + vt * 16 + r) * 40 + q4 * 8);
                acc = __builtin_amdgcn_mfma_f32_16x16x32_bf16(aF, sF, acc, 0, 0, 0);
                acc = __builtin_amdgcn_mfma_f32_16x16x32_bf16(aB, sB, acc, 0, 0, 0);
                o[vt] = acc;
            }
            float gn[4];
#pragma unroll
            for (int vt = 0; vt < 4; ++vt) gn[vt] = p.gla_norm[l * 64 + vt * 16 + r];
#pragma unroll
            for (int e = 0; e < 4; ++e) {
                float ss = o[0][e] * o[0][e] + o[1][e] * o[1][e] + o[2][e] * o[2][e] + o[3][e] * o[3][e];
                ss += __shfl_xor(ss, 1); ss += __shfl_xor(ss, 2); ss += __shfl_xor(ss, 4); ss += __shfl_xor(ss, 8);
                const float rs = rsqrtf(ss * (1.f / 64.f) + EPS);
                bf16_t* gl = GL + (i0 + 4 * q4 + e) * 72 + r;
#pragma unroll
                for (int vt = 0; vt < 4; ++vt) { const float gt = bf2f(gl[vt * 16]); gl[vt * 16] = f2bf(o[vt][e] * rs * gn[vt] * gt * __builtin_amdgcn_rcpf(1.f + __expf(-gt))); }
            }
        }
        __syncthreads();
        if (valid) { *(pg8::u32x4*)(MIX + (size_t)(row0 + gr) * D + 256 + h * 64 + 16 * gc) = *(const pg8::u32x4*)(GL + gr * 72 + 16 * gc); *(pg8::u32x4*)(MIX + (size_t)(row0 + gr) * D + 256 + h * 64 + 16 * gc + 8) = *(const pg8::u32x4*)(GL + gr * 72 + 16 * gc + 8); }
    }
}

constexpr size_t TAB_M1 = 16384, TAB_M2 = 24576, TAB_EC = 40960;
__device__ __forceinline__ void p3_fnet_fft(const Params& p, unsigned char* lds_raw) { PHASE_IDS;
    typedef pg8::bf16x8 bf16x8;
    const int lane = tidx & 63, w = __builtin_amdgcn_readfirstlane(tidx >> 6), j = lane & 15, q4 = lane >> 4;
    const float* TAB = (const float*)(p.ws + WS_TAB);
    const bf16_t* M1g = (const bf16_t*)(p.ws + WS_TAB + TAB_M1); const bf16_t* M2g = (const bf16_t*)(p.ws + WS_TAB + TAB_M2); const bf16_t* ECg = (const bf16_t*)(p.ws + WS_TAB + TAB_EC);
    const bf16_t* U = (const bf16_t*)(p.ws + WS_YFTL);
    bf16_t* MIX = (bf16_t*)(p.ws + WS_HB);
    const float scale = 0.0027621358640099515f;
    for (int it = bidx_; it < BATCH * 16; it += gridDim.x) {
        const int b = it >> 4, jb = it & 15;
        const bf16_t* M1 = M1g; const bf16_t* M2 = M2g; const bf16_t* EC = ECg; asm volatile("" : "+s"(M1), "+s"(M2), "+s"(EC));
        __syncthreads();
        {
            bf16x8 a1[4][2];
#pragma unroll
            for (int mt = 0; mt < 4; ++mt)
#pragma unroll
                for (int ks = 0; ks < 2; ++ks) a1[mt][ks] = *(const bf16x8*)(M1 + (16 * mt + j) * 64 + ks * 32 + 8 * q4);
            bf16x8 ec[2][2];
#pragma unroll
            for (int part = 0; part < 2; ++part)
#pragma unroll
                for (int ks = 0; ks < 2; ++ks) ec[part][ks] = *(const bf16x8*)(EC + part * 4096 + (16 * (jb & 3) + j) * 64 + ks * 32 + 8 * q4);
            const bf16_t* ub = U + ((size_t)b * SEQ + 64 * j + 8 * w) * 256 + (jb >> 2) * 64 + 8 * q4;
#pragma unroll
            for (int half = 0; half < 2; ++half) {
                bf16x8 ua[4][2][2];
#pragma unroll
                for (int ci = 0; ci < 4; ++ci)
#pragma unroll
                    for (int tl = 0; tl < 2; ++tl)
#pragma unroll
                        for (int ks = 0; ks < 2; ++ks) ua[ci][tl][ks] = *(const bf16x8*)(ub + (size_t)(1024 * tl + 4 * half + ci) * 256 + ks * 32);
                bf16x8 y[4][2];
#pragma unroll
                for (int ci = 0; ci < 4; ++ci)
#pragma unroll
                    for (int part = 0; part < 2; ++part) { f32x4 d[2];
#pragma unroll
                        for (int tl = 0; tl < 2; ++tl) { d[tl] = (f32x4){0.f, 0.f, 0.f, 0.f};
#pragma unroll
                            for (int ks = 0; ks < 2; ++ks) d[tl] = __builtin_amdgcn_mfma_f32_16x16x32_bf16(ua[ci][tl][ks], ec[part][ks], d[tl], 0, 0, 0); }
                        pg8::u32x4 pk; pk.x = pg8::cvt_pk_bf16_c(d[0][0], d[0][1]); pk.y = pg8::cvt_pk_bf16_c(d[0][2], d[0][3]); pk.z = pg8::cvt_pk_bf16_c(d[1][0], d[1][1]); pk.w = pg8::cvt_pk_bf16_c(d[1][2], d[1][3]);
                        y[ci][part] = __builtin_bit_cast(bf16x8, pk); }
                unsigned zp[2][2][4][2];
#pragma unroll
                for (int cp = 0; cp < 2; ++cp) {
                    float zr[2][2][4], zi[2][2][4];
#pragma unroll
                    for (int cq = 0; cq < 2; ++cq) {
                        const int ci = 2 * cp + cq; int c = 8 * w + 4 * half + ci; asm volatile("" : "+s"(c));
                        f32x4 acc[4];
#pragma unroll
                        for (int mt = 0; mt < 4; ++mt) { acc[mt] = (f32x4){0.f, 0.f, 0.f, 0.f};
#pragma unroll
                            for (int ks = 0; ks < 2; ++ks) acc[mt] = __builtin_amdgcn_mfma_f32_16x16x32_bf16(a1[mt][ks], y[ci][ks], acc[mt], 0, 0, 0); }
#pragma unroll
                        for (int m1 = 0; m1 < 2; ++m1)
#pragma unroll
                            for (int e = 0; e < 4; ++e) {
                                const int k1 = 16 * m1 + 4 * q4 + e, idx = k1 * c;
                                const float cs = TAB[idx], sn = TAB[(idx - 512) & 2047];
                                const float re = acc[m1][e], im = acc[2 + m1][e];
                                zr[cq][m1][e] = re * cs + im * sn; zi[cq][m1][e] = im * cs - re * sn;
                            }
                        asm volatile("" ::: "memory");
                    }
#pragma unroll
                    for (int m1 = 0; m1 < 2; ++m1)
#pragma unroll
                        for (int e = 0; e < 4; ++e) { zp[0][m1][e][cp] = pg8::cvt_pk_bf16(zr[0][m1][e], zr[1][m1][e]); zp[1][m1][e][cp] = pg8::cvt_pk_bf16(zi[0][m1][e], zi[1][m1][e]); }
                }
#pragma unroll
                for (int ri = 0; ri < 2; ++ri)
#pragma unroll
                    for (int m1 = 0; m1 < 2; ++m1)
#pragma unroll
                        for (int e = 0; e < 4; ++e) { const int k1 = 16 * m1 + 4 * q4 + e;
                            *(pg8::u32x2*)(lds_raw + ((ri * 32 + k1) * 16 + j) * 128 + ((w ^ ((j >> 1) & 7)) << 4) + half * 8) = (pg8::u32x2){zp[ri][m1][e][0], zp[ri][m1][e][1]}; }
                asm volatile("" ::: "memory");
            }
        }
        __syncthreads();
        {
            bf16x8 a2[4][4];
#pragma unroll
            for (int mt = 0; mt < 4; ++mt)
#pragma unroll
                for (int ks = 0; ks < 4; ++ks) a2[mt][ks] = *(const bf16x8*)(M2 + (16 * mt + j) * 128 + ks * 32 + 8 * q4);
#pragma unroll
            for (int kq = 0; kq < 4; ++kq) {
                const int k1 = 4 * w + kq;
                bf16x8 zb[4];
#pragma unroll
                for (int ks = 0; ks < 4; ++ks) zb[ks] = *(const bf16x8*)(lds_raw + (((ks >> 1) * 32 + k1) * 16 + j) * 128 + (((4 * (ks & 1) + q4) ^ ((j >> 1) & 7)) << 4));
                bf16_t* op = MIX + ((size_t)b * SEQ + k1 + 128 * q4) * D + 16 * jb + j;
#pragma unroll
                for (int mt = 0; mt < 4; ++mt) {
                    f32x4 acc = {0.f, 0.f, 0.f, 0.f};
#pragma unroll
                    for (int ks = 0; ks < 4; ++ks) acc = __builtin_amdgcn_mfma_f32_16x16x32_bf16(a2[mt][ks], zb[ks], acc, 0, 0, 0);
#pragma unroll
                    for (int e = 0; e < 4; ++e) op[(size_t)(32 * e) * D] = f2bf(acc[e] * scale);
                    op += (size_t)512 * D; asm volatile("" : "+v"(op) :: "memory");
                }
            }
        }
    }
}

#define STAMPG(n) do { if ((PROBE_A == (n) || PROBE_B == (n)) && blockIdx.x == 0 && threadIdx.x == 0) ((volatile unsigned long long*)(lds_raw + LDS_BYTES - 512))[PROBE_B == (n) ? 1 : 0] = __builtin_amdgcn_s_memrealtime(); } while (0)
#define LAS __attribute__((address_space(3)))
__host__ __device__ __forceinline__ int tile_pos(int lc) { return 128 * ((lc >> 5) & 1) + 32 * (lc >> 6) + (lc & 31); }
__device__ __forceinline__ int inproj_dest(int c) {
    int T, lc;
    if (c < C_GQ) { T = 9; lc = c; } else if (c < C_GV) { T = 2; lc = c - C_GQ; } else if (c < C_GG) { T = 3; lc = c - C_GV; } else if (c < C_GDF) { T = 4; lc = c - C_GG; }
    else if (c < C_AQ) { T = 8; lc = c - C_GDF; } else if (c < C_AQ + 256) { T = 5; lc = c - C_AQ; } else if (c < C_AK) { T = 6; lc = c - C_AQ - 256; } else { T = 7; lc = c - C_AK; }
    return T * 256 + tile_pos(lc);
}
__device__ __forceinline__ void p0a_fast(const Params& p, float* lds) { PHASE_IDS;
    const int lane = tidx & 63, wave = tidx >> 6;
    float* scr = lds + wave * 2304;
    bf16_t* WIN = (bf16_t*)(p.ws + WS_WIN); bf16_t* WOUT = (bf16_t*)(p.ws + WS_WOUT);
    {
        unsigned char* lds_b = (unsigned char*)lds;
        const int j = tidx & 15, r0 = tidx >> 4;
        for (int t = bidx_; t < 192; t += gridDim.x) {
            const bool isin = t < 128; const int q = isin ? t : t - 128;
            const int l = isin ? q >> 6 : q >> 5, kt = isin ? (q >> 3) & 7 : (q >> 2) & 7, nt = isin ? q & 7 : q & 3;
            const int ldw = isin ? DIN : D, n4 = nt * 256 + 4 * lane;
            const float* src = (isin ? p.w_in + (size_t)l * D * DIN : p.w_out + (size_t)l * D * D) + (size_t)(kt * 128 + 16 * wave) * ldw + (n4 < ldw ? n4 : 0);
            f32x4 v[16];
            cb_load(v, src, ldw);
            cb_to_lds(v, lds_b, wave, lane);
            __syncthreads();
#pragma unroll
            for (int i = 0; i < 8; ++i) { const int r = r0 + 32 * i, n = nt * 256 + r;
                const pg8::u32x4 x = *(LDSP(pg8::u32x4))(lds_b + r * CB_RS + 16 * j);
                if (n < ldw) { bf16_t* dst = isin ? WIN + ((size_t)l * NIN + inproj_dest(n)) * D : WOUT + ((size_t)l * D + n) * D; *(pg8::u32x4*)(dst + kt * 128 + 8 * j) = x; } }
            __syncthreads();
        }
    }
    STAMPG(42);
    { float sn, cs; sincos_r((float)lane * 0.09817477042468103f, sn, cs); scr[2 * lane] = cs; scr[2 * lane + 1] = sn; }
    float* tile = scr + 128;
    for (int it = GW; it < 16 * 4 * 16; it += NGW) {
        const int jq = it & 15, g = (it >> 4) & 3, kb = (it >> 6) & 15, l = 0;
        const float* W = p.w_in + (size_t)l * D * DIN;
        float yr[4], ys[4];
#pragma unroll
        for (int jj = 0; jj < 4; ++jj) { yr[jj] = 0.f; ys[jj] = 0.f; }
        for (int half = 0; half < 2; ++half) {
            __builtin_amdgcn_s_waitcnt(0); asm volatile("" ::: "memory");
            { float tv[32];
#pragma unroll
              for (int i = 0; i < 32; ++i) { const int kk = 2 * i + (lane >> 5); tv[i] = W[(size_t)(kb * 64 + kk) * DIN + g * 64 + half * 32 + (lane & 31)]; }
#pragma unroll
              for (int i = 0; i < 32; ++i) { const int kk = 2 * i + (lane >> 5); tile[kk * 33 + (lane & 31)] = tv[i]; } }
            __builtin_amdgcn_s_waitcnt(0); asm volatile("" ::: "memory");
#pragma unroll 4
            for (int cc = 0; cc < 32; ++cc) {
                const float u = tile[lane * 33 + cc]; const int c = half * 32 + cc;
#pragma unroll
                for (int jj = 0; jj < 4; ++jj) { const int m = ((jq * 4 + jj) * c) & 63; yr[jj] = fmaf(u, scr[2 * m], yr[jj]); ys[jj] = fmaf(u, scr[2 * m + 1], ys[jj]); }
            }
        }
#pragma unroll
        for (int jj = 0; jj < 4; ++jj) { const int j = jq * 4 + jj; const size_t row = (size_t)l * NIN + tile_pos(g * 64 + j);
            WIN[(row) * D + kb * 64 + lane] = f2bf(yr[jj]); WIN[(row + 256) * D + kb * 64 + lane] = f2bf(ys[jj]); }
    }
    STAMPG(43);
    for (int i = GT; i < 2 * 224 * (D / 8); i += NGT) {
        const int k8 = i & 127, lc = 32 + (i >> 7) % 224, l = i / (224 * 128);
        *(pg8::u32x4*)(WIN + ((size_t)l * NIN + 8 * 256 + tile_pos(lc)) * D + k8 * 8) = (pg8::u32x4){0u, 0u, 0u, 0u};
    }
    {
        bf16_t* DC = (bf16_t*)(p.ws + WS_DMATC);
        for (int i = GT; i < 256 * 512 / 8; i += NGT) {
            const int t8 = (i & 63) * 8, k = i >> 6; unsigned w[4];
#pragma unroll
            for (int q = 0; q < 4; ++q) { float v[2];
#pragma unroll
                for (int e = 0; e < 2; ++e) { const int tt = t8 + 2 * q + e, t = tt & 255; const int m = (k * t) & 255; float sn, cs; sincos_r((float)m * (6.283185307179586f / 256.f), sn, cs); v[e] = tt < 256 ? cs : -sn; }
                w[q] = pg8::cvt_pk_bf16(v[0], v[1]); }
            *(pg8::u32x4*)(DC + (size_t)k * 512 + t8) = (pg8::u32x4){w[0], w[1], w[2], w[3]};
        }
    }
    STAMPG(44);
}

#define XB_TMO      128
#define XB_XCNT(j)  (256  + 64 * (j))
#define XB_XSUB(j)  (1280 + 64 * (j))
#define XB_XGEN(j)  (2304 + 64 * (j))
#define XB_TOP      3328
#define XB_TOPGEN   3392
#define XCD_BAR_WORDS 3456
#define XB_SPIN_CAP (1u << 18)
__device__ __forceinline__ unsigned xb_ld(unsigned* p)              { return __hip_atomic_load(p, __ATOMIC_RELAXED, __HIP_MEMORY_SCOPE_AGENT); }
__device__ __forceinline__ unsigned xb_add(unsigned* p, unsigned v) { return __hip_atomic_fetch_add(p, v, __ATOMIC_RELAXED, __HIP_MEMORY_SCOPE_AGENT); }
__device__ __forceinline__ unsigned xb_xcc_id() { return (unsigned)__builtin_amdgcn_s_getreg((3 << 11) | 20) & 0xFu; }
#define XB_SPIN(cond, bar) do { unsigned _sp = 0; while (cond) { __builtin_amdgcn_s_sleep(1); \
    if ((++_sp & 255u) == 0u) { if (xb_ld(&(bar)[XB_TMO])) break; if (_sp > XB_SPIN_CAP) { atomicAdd(&(bar)[XB_TMO], 1u); break; } } } } while (0)
struct XcdBarrier { unsigned* bar; unsigned x; volatile __attribute__((address_space(3))) unsigned* st; };
__device__ __forceinline__ XcdBarrier xcd_barrier_post(unsigned* bar, volatile __attribute__((address_space(3))) unsigned* st) {
    XcdBarrier b; b.bar = bar; b.x = xb_xcc_id(); b.st = st;
    if (otid() == 0) (void)xb_add(&bar[XB_XCNT(b.x)], 1u);
    return b;
}
__device__ __forceinline__ void xcd_barrier_complete(unsigned* bar, unsigned x, unsigned& nloc, unsigned& nx) {
    const unsigned G = gridDim.x * gridDim.y * gridDim.z;
    unsigned sum, cnt, mine, sp = 0u;
    for (;;) {
        sum = 0u; cnt = 0u; mine = 0u;
#pragma unroll
        for (unsigned j = 0; j < 16; ++j) { const unsigned c = xb_ld(&bar[XB_XCNT(j)]); sum += c; cnt += (c > 0u) ? 1u : 0u; mine = (j == x) ? c : mine; }
        if (sum == G) break;
        __builtin_amdgcn_s_sleep(1);
        if ((++sp & 255u) == 0u) { if (xb_ld(&bar[XB_TMO])) break; if (sp > XB_SPIN_CAP) { atomicAdd(&bar[XB_TMO], 1u); break; } }
    }
    nloc = mine > 0u ? mine : 1u; nx = cnt > 0u ? cnt : 1u;
}
__device__ __forceinline__ void xcd_barrier(const XcdBarrier& b) {
    asm volatile("s_waitcnt vmcnt(0)" ::: "memory");
    __syncthreads();
    if (otid() == 0) {
        unsigned* bar = b.bar;
        __builtin_amdgcn_s_waitcnt(0);
        unsigned nloc = b.st[0], nx = b.st[1];
        if (nloc == 0u) { xcd_barrier_complete(bar, b.x, nloc, nx); b.st[0] = nloc; b.st[1] = nx; }
        const unsigned old = xb_add(&bar[XB_XSUB(b.x)], 1u);
        const unsigned gen = old / nloc;
        if (old + 1u == (gen + 1u) * nloc) {
            __builtin_amdgcn_fence(__ATOMIC_RELEASE, "agent");
            asm volatile("s_waitcnt vmcnt(0)" ::: "memory");
            const unsigned og = xb_add(&bar[XB_TOP], 1u);
            const unsigned tg = og / nx;
            if (og + 1u == (tg + 1u) * nx) xb_add(&bar[XB_TOPGEN], 1u);
            else XB_SPIN(xb_ld(&bar[XB_TOPGEN]) == tg, bar);
            __builtin_amdgcn_fence(__ATOMIC_ACQUIRE, "agent");
            xb_add(&bar[XB_XGEN(b.x)], 1u);
            asm volatile("s_waitcnt vmcnt(0)" ::: "memory");
        } else {
            XB_SPIN(xb_ld(&bar[XB_XGEN(b.x)]) == gen, bar);
            __builtin_amdgcn_fence(__ATOMIC_ACQUIRE, "agent");
            asm volatile("s_waitcnt vmcnt(0)" ::: "memory");
        }
    }
    __syncthreads();
}

__global__ void __launch_bounds__(NTHREADS) mega(Params p) {
    if ((threadIdx.x & 63) == 0) ((volatile __attribute__((address_space(3))) int*)((__attribute__((address_space(3))) unsigned char*)lds_raw + WTAB_OFF))[hw_wave_slot()] = threadIdx.x >> 6;
    __syncthreads();
    float* lds = (float*)lds_raw;
    cg::grid_group grid = cg::this_grid();
    volatile __attribute__((address_space(3))) unsigned* bst = (volatile __attribute__((address_space(3))) unsigned*)((__attribute__((address_space(3))) unsigned char*)lds_raw + LDS_BYTES - 1024);
    { const int t0_ = otid(); if (t0_ < 2) bst[t0_] = 0u; }
    __syncthreads();
    const XcdBarrier bar = xcd_barrier_post((unsigned*)(p.ws + WS_CTL), bst);
#define GSYNC() xcd_barrier(bar)
    volatile unsigned long long* tst = (volatile unsigned long long*)(lds_raw + LDS_BYTES - 512);
#define STAMP(n) do { if ((PROBE_A == (n) || PROBE_B == (n)) && blockIdx.x == 0 && threadIdx.x == 0) tst[PROBE_B == (n) ? 1 : 0] = __builtin_amdgcn_s_memrealtime(); } while (0)
    STAMP(0);
    p0a(p, lds); __syncthreads(); STAMP(40); p0a_fast(p, lds); STAMP(45); grid.sync(); STAMP(1);
    p0b(p); GSYNC(); STAMP(2);
#define LAYER(l) do { p1_norm1(p, l); GSYNC(); STAMP(3 + 9 * (l)); \
        p2_inproj_fast(p, l, lds_raw); GSYNC(); STAMP(4 + 9 * (l)); \
        p3_fnet_fft(p, lds_raw); __syncthreads(); STAMP(30 + 3 * (l)); p3_fnet_fast(p, l, lds_raw); __syncthreads(); STAMP(31 + 3 * (l)); p3_gla_local_fast(p, l, lds_raw); __syncthreads(); STAMP(32 + 3 * (l)); p3_attn_fast(p, l, lds_raw); GSYNC(); STAMP(5 + 9 * (l)); \
        p3_gla_scan_fast(p); GSYNC(); STAMP(6 + 9 * (l)); p4_gla_out_fast(p, l, lds_raw); GSYNC(); STAMP(7 + 9 * (l)); \
        p5_outproj_fast(p, l, lds_raw); GSYNC(); STAMP(8 + 9 * (l)); p6_norm2_router(p, l, lds); GSYNC(); STAMP(9 + 9 * (l)); \
        p7_gateup_fast(p, l, lds_raw); GSYNC(); STAMP(10 + 9 * (l)); p8_down_fast(p, l, lds_raw); GSYNC(); STAMP(11 + 9 * (l)); } while (0)
    LAYER(0);
    LAYER(1);
#undef LAYER
    p9_final(p);
    if (PROBE_A >= 0) { __syncthreads(); if (blockIdx.x == 0 && threadIdx.x == 0) { if (PROBE_B == 21) tst[1] = __builtin_amdgcn_s_memrealtime(); const unsigned long long dt = (tst[1] - tst[0]) * PROBE_K, t0 = __builtin_amdgcn_s_memrealtime(); while (__builtin_amdgcn_s_memrealtime() - t0 < dt) __builtin_amdgcn_s_sleep(8); } }
}

extern "C" void kernel_launch(void* const* d_in, const int* in_sizes, int n_in, void* d_out, int out_size, void* d_ws, size_t ws_size, hipStream_t stream) {
    static int grid_blocks = 0;
    if (!grid_blocks) {
        int dev = 0, cus = 0, per_cu = 0;
        hipGetDevice(&dev);
        hipDeviceGetAttribute(&cus, hipDeviceAttributeMultiprocessorCount, dev);
        hipFuncSetAttribute((const void*)mega, hipFuncAttributeMaxDynamicSharedMemorySize, LDS_BYTES);
        hipOccupancyMaxActiveBlocksPerMultiprocessor(&per_cu, (const void*)mega, NTHREADS, LDS_BYTES);
        if (per_cu < 1) { fprintf(stderr, "occupancy query says %d blocks/CU\n", per_cu); per_cu = 1; }
        grid_blocks = cus;
        if (n_in != 21 || ws_size < WS_END) fprintf(stderr, "unexpected n_in %d / ws_size %zu\n", n_in, ws_size);
    }
    hipMemsetAsync((char*)d_ws + WS_CTL, 0, 65536, stream);
    Params p{};
    const float** f = (const float**)&p;
    for (int i = 0; i < 21; ++i) f[i] = (const float*)d_in[i];
    p.out = (float*)d_out; p.ws = (unsigned char*)d_ws;
    void* args[] = {&p};
    hipError_t e = hipLaunchCooperativeKernel((const void*)mega, dim3(grid_blocks), dim3(NTHREADS), args, LDS_BYTES, stream);
    if (e != hipSuccess) fprintf(stderr, "cooperative launch failed: %s (grid %d)\n", hipGetErrorString(e), grid_blocks);
}
```

```cpp
#include <hip/hip_runtime.h>
#include <hip/hip_cooperative_groups.h>
#include <cstdio>
#include <cstdint>
namespace cg = cooperative_groups;

typedef unsigned short bf16_t;
typedef float f32x4 __attribute__((ext_vector_type(4)));

constexpr int D = 1024, BATCH = 8, SEQ = 2048, CTXL = 256, DEPTH = 2;
constexpr int NL = BATCH * SEQ, NC = BATCH * CTXL, NTOK = NL + NC;
constexpr int DIN = 1824;
constexpr int C_FN = 0, C_GQ = 256, C_GK = 384, C_GV = 512, C_GG = 768, C_GDF = 1024, C_GDB = 1040, C_AQ = 1056, C_AK = 1568, C_AV = 1696;
constexpr int KEYS = CTXL + SEQ;
constexpr int NCHK = 36;
constexpr int NEXP = 16, DEXP = 512;
constexpr float EPS = 1e-6f;
constexpr float QSCALE = 0.125f * 1.4426950408889634f;
constexpr int NWAVES = 8, NTHREADS = 512;
#ifndef DUP
#define DUP 0
#endif
#ifndef PROBE_A
#define PROBE_A -1
#endif
#ifndef PROBE_B
#define PROBE_B -1
#endif
#define PROBE_K 8
#define DUPN(id) ((DUP == (id)) ? 2 : 1)
#define GOLDEN_FNET 0
#define GOLDEN_ATTN 0
#define GOLDEN_GLA 0
constexpr int LDS_BYTES = 147456;

constexpr size_t MiB = 1u << 20;
constexpr size_t WS_CTL = 0;
constexpr size_t WS_MODP = 151 * MiB;
constexpr size_t WS_MOD = 9 * MiB;
constexpr size_t WS_TAB = 10 * MiB;
constexpr size_t WS_XC = 11 * MiB;
constexpr size_t WS_HB = 19 * MiB;
constexpr size_t WS_YFTL = 55 * MiB;
constexpr size_t WS_YFTC = 71 * MiB;
constexpr size_t WS_GQK = 73 * MiB;
constexpr size_t WS_GV = 82 * MiB;
constexpr size_t WS_GG = 91 * MiB;
constexpr size_t WS_GD = 100 * MiB;
constexpr size_t WS_AQ = 102 * MiB;
constexpr size_t WS_AK = 120 * MiB;
constexpr size_t WS_AVT = 125 * MiB;
constexpr size_t WS_AST = 130 * MiB;
constexpr size_t WS_DEC = 149 * MiB;
constexpr size_t WS_ROUTE = 150 * MiB;
constexpr size_t WS_Y = 151 * MiB;
constexpr size_t WS_WIN = 314 * MiB;
constexpr size_t WS_WOUT = 232 * MiB;
constexpr size_t WS_WGU = 236 * MiB;
constexpr size_t WS_WD = 268 * MiB;
constexpr size_t WS_WD1 = 284 * MiB;
constexpr size_t WS_DMATC = 300 * MiB;
constexpr size_t WS_LIST = 301 * MiB;
constexpr size_t WS_ST = 304 * MiB;
constexpr size_t WS_END = 324 * MiB;
constexpr size_t WS_ACT = WS_YFTL;
constexpr int CW_CNT = 8192;
constexpr int NIN = 2560;

struct Params {
    const float *x, *c, *ctx, *c_ctx, *w_ada, *b_ada, *norm_mix, *norm_ffn, *w_in, *w_gup, *b_gg, *gla_norm, *q_norm, *k_norm, *w_out, *w_router, *b_router, *w_eg, *w_eu, *w_ed, *final_norm;
    float* out;
    unsigned char* ws;
};

#define LDSP(T) __attribute__((address_space(3))) T*
namespace pg8 {
typedef short bf16x8 __attribute__((ext_vector_type(8)));
typedef unsigned u32x4 __attribute__((ext_vector_type(4)));
typedef unsigned u32x2 __attribute__((ext_vector_type(2)));
__device__ __forceinline__ unsigned cvt_pk_bf16(float lo, float hi) { unsigned r; asm volatile("v_cvt_pk_bf16_f32 %0, %1, %2" : "=v"(r) : "v"(lo), "v"(hi)); return r; }
typedef __bf16 bf16x2_c __attribute__((ext_vector_type(2)));
typedef float f32x2_c __attribute__((ext_vector_type(2)));
__device__ __forceinline__ unsigned cvt_pk_bf16_c(float lo, float hi) { f32x2_c v = {lo, hi}; return __builtin_bit_cast(unsigned, __builtin_convertvector(v, bf16x2_c)); }
}
__device__ __forceinline__ float bf2f(bf16_t v) { return __uint_as_float((unsigned)v << 16); }
__device__ __forceinline__ bf16_t f2bf(float f) { unsigned u = __float_as_uint(f); return (bf16_t)((u + 0x7fffu + ((u >> 16) & 1u)) >> 16); }
__device__ __forceinline__ float wave_sum(float v) {
#pragma unroll
    for (int o = 1; o < 64; o <<= 1) v += __shfl_xor(v, o);
    return v;
}
__device__ __forceinline__ float siluf(float v) { return v / (1.f + expf(-v)); }
__device__ __forceinline__ float sigmoidf(float v) { return 1.f / (1.f + expf(-v)); }
__device__ __forceinline__ float logsigmoidf(float z) { return fminf(z, 0.f) - log1pf(expf(-fabsf(z))); }
__device__ __forceinline__ void sincos_r(float x, float& s, float& c) {
    const float k = rintf(x * 0.63661977236758134f);
    float r = fmaf(k, -1.57079625129699707031f, x); r = fmaf(k, -7.54978995489188216e-8f, r);
    const int q = ((int)k) & 3;
    const float r2 = r * r;
    float sp = fmaf(r2, 2.7557314297e-6f, -1.9841270114e-4f); sp = fmaf(sp, r2, 8.3333337680e-3f); sp = fmaf(sp, r2, -1.6666667163e-1f); sp = fmaf(sp * r2, r, r);
    float cp = fmaf(r2, 2.4801587642e-5f, -1.3888889225e-3f); cp = fmaf(cp, r2, 4.1666667908e-2f); cp = fmaf(cp, r2, -0.5f); cp = fmaf(cp, r2, 1.f);
    const float ss = (q & 1) ? cp : sp, cc = (q & 1) ? sp : cp;
    s = (q & 2) ? -ss : ss; c = ((q + 1) & 2) ? -cc : cc;
}
struct RowInfo { int b, t, bidx, isctx; };
__device__ __forceinline__ RowInfo row_info(int r) { RowInfo ri; if (r < NL) { ri.b = r >> 11; ri.t = r & 2047; ri.bidx = ri.b; ri.isctx = 0; } else { const int q = r - NL; ri.b = q >> 8; ri.t = q & 255; ri.bidx = 8; ri.isctx = 1; } return ri; }

#define WTAB_OFF (LDS_BYTES - 256)
extern __shared__ __attribute__((aligned(16))) unsigned char lds_raw[];
__device__ __forceinline__ int hw_wave_slot() { return (int)__builtin_amdgcn_s_getreg((5 << 11) | 4) & 63; }
__device__ __forceinline__ int otid() {
    int l; asm volatile("v_mbcnt_lo_u32_b32 %0, -1, 0\n\tv_mbcnt_hi_u32_b32 %0, -1, %0" : "=v"(l));
    const int w = __builtin_amdgcn_readfirstlane(((volatile __attribute__((address_space(3))) int*)((__attribute__((address_space(3))) unsigned char*)lds_raw + WTAB_OFF))[hw_wave_slot()]);
    return w * 64 + l; }
__device__ __forceinline__ int obid() { int b = blockIdx.x; asm volatile("" : "+s"(b)); return b; }
#define PHASE_IDS const int tidx = otid(); const int bidx_ = obid(); (void)tidx; (void)bidx_
#define GW (bidx_ * NWAVES + (tidx >> 6))
#define NGW (gridDim.x * NWAVES)
#define GT (bidx_ * NTHREADS + tidx)
#define NGT (gridDim.x * NTHREADS)

__device__ __forceinline__ void p0a(const Params& p, float* lds) { PHASE_IDS;
    const int lane = tidx & 63;
    float* MODP = (float*)(p.ws + WS_MODP);
    float* sl = lds + 20000;
    { float cv[18];
#pragma unroll
      for (int q = 0; q < 18; ++q) { const int i = tidx + NTHREADS * q, j = i >> 10, k = i & 1023; cv[q] = j < 8 ? p.c[j * D + k] : p.c_ctx[k]; }
#pragma unroll
      for (int q = 0; q < 18; ++q) { const int i = tidx + NTHREADS * q, j = i >> 10, k = i & 1023; sl[k * 12 + j] = siluf(cv[q]); } }
    __syncthreads();
    for (int it = GW; it < 2 * 32 * 24; it += NGW) {
        const int l = it / (32 * 24), kc = (it / 24) % 32, cb = it % 24, col = cb * 256 + 4 * lane;
        f32x4 w[32];
        const float* wp = p.w_ada + ((size_t)l * D + kc * 32) * 6144 + col;
#pragma unroll
        for (int kk = 0; kk < 32; ++kk) w[kk] = *(const f32x4*)(wp + (size_t)kk * 6144);
        f32x4 acc[9];
#pragma unroll
        for (int j = 0; j < 9; ++j) acc[j] = (f32x4){0.f, 0.f, 0.f, 0.f};
#pragma unroll
        for (int kk = 0; kk < 32; ++kk) {
            const f32x4* sp = (const f32x4*)(sl + (kc * 32 + kk) * 12); const f32x4 s0 = sp[0], s1 = sp[1], s2 = sp[2];
            acc[0] += w[kk] * s0[0]; acc[1] += w[kk] * s0[1]; acc[2] += w[kk] * s0[2]; acc[3] += w[kk] * s0[3];
            acc[4] += w[kk] * s1[0]; acc[5] += w[kk] * s1[1]; acc[6] += w[kk] * s1[2]; acc[7] += w[kk] * s1[3];
            acc[8] += w[kk] * s2[0];
        }
#pragma unroll
        for (int j = 0; j < 9; ++j) *(f32x4*)(MODP + ((size_t)(l * 32 + kc) * 9 + j) * 6144 + col) = acc[j];
    }
    {
        bf16_t* M1 = (bf16_t*)(p.ws + WS_TAB + 16384); bf16_t* M2 = (bf16_t*)(p.ws + WS_TAB + 24576); bf16_t* EC = (bf16_t*)(p.ws + WS_TAB + 40960);
        for (int i = GT; i < 64 * 64 + 64 * 128 + 2 * 64 * 64; i += NGT) {
            if (i < 4096) { const int m = i >> 6, k = i & 63, rp = m >> 5, k1 = m & 31, part = k >> 5, sl = k & 31, r = ((sl >> 2) & 1) * 16 + 4 * (sl >> 3) + (sl & 3); float sn, cs; sincos_r((float)((k1 * r) & 31) * (6.283185307179586f / 32.f), sn, cs);
                M1[i] = f2bf(rp == 0 ? (part == 0 ? cs : -sn) : (part == 0 ? -sn : -cs)); }
            else if (i < 4096 + 8192) { const int q = i - 4096, k2 = q >> 7, kk = q & 127, ri = kk >> 6, c = kk & 63; float sn, cs; sincos_r((float)((k2 * c) & 63) * (6.283185307179586f / 64.f), sn, cs); M2[q] = f2bf(ri == 0 ? cs : sn); }
            else { const int q = i - 12288, part = q >> 12, jl = (q >> 6) & 63, ch = q & 63; float sn, cs; sincos_r((float)((jl * ch) & 63) * (6.283185307179586f / 64.f), sn, cs); EC[q] = f2bf(part == 0 ? cs : sn); }
        }
    }
    float* TAB = (float*)(p.ws + WS_TAB);
    for (int i = GT; i < 2048 + 1024; i += NGT) {
        if (i < 2048) { float s, c; sincos_r((float)i * (6.283185307179586f / 2048.f), s, c); TAB[i] = c; }
        else { const int q = i - 2048, pos = q >> 4, f = q & 15; const float inv = exp2f(-(float)f * (13.287712379549449f / 16.f)); float s, c; sincos_r((float)pos * inv, s, c); TAB[2048 + 2 * q] = c; TAB[2048 + 2 * q + 1] = s; }
    }
}
__device__ __forceinline__ void p0b(const Params& p) { PHASE_IDS;
    const float* MODP = (const float*)(p.ws + WS_MODP);
    float* MOD = (float*)(p.ws + WS_MOD);
    for (int i = GT; i < 2 * 9 * 6144; i += NGT) {
        const int l = i / (9 * 6144), j = (i / 6144) % 9, col = i % 6144;
        float s = p.b_ada[l * 6144 + col];
#pragma unroll
        for (int kc = 0; kc < 32; ++kc) s += MODP[((size_t)(l * 32 + kc) * 9 + j) * 6144 + col];
        MOD[i] = s;
    }
}

__device__ __forceinline__ float* xrow_ptr(const Params& p, int r) { return r < NL ? p.out + (size_t)r * D : (float*)(p.ws + WS_XC) + (size_t)(r - NL) * D; }
__device__ __forceinline__ const float* xin_ptr(const Params& p, int r) { return r < NL ? p.x + (size_t)r * D : p.ctx + (size_t)(r - NL) * D; }

constexpr int RPW = 3;
__device__ __forceinline__ f32x4 bf4_to_f4(pg8::u32x2 w) { f32x4 r; r[0] = __uint_as_float(w.x << 16); r[1] = __uint_as_float(w.x & 0xffff0000u); r[2] = __uint_as_float(w.y << 16); r[3] = __uint_as_float(w.y & 0xffff0000u); return r; }
__device__ __forceinline__ void p1_norm1(const Params& p, int l) { PHASE_IDS;
    const int lane = tidx & 63;
    const float* MOD = (const float*)(p.ws + WS_MOD);
    bf16_t* HB = (bf16_t*)(p.ws + WS_HB);
    const bf16_t* Y = (const bf16_t*)(p.ws + WS_Y);
    f32x4 nwv[4];
#pragma unroll
    for (int j = 0; j < 4; ++j) nwv[j] = *(const f32x4*)(p.norm_mix + l * D + 4 * lane + 256 * j);
    for (int r0 = GW * RPW; r0 < NTOK; r0 += NGW * RPW) {
        f32x4 v[RPW][4], gsc[4], gsh[4], gg2[4]; pg8::u32x2 y0[RPW][4], y1[RPW][4];
        const int gb = row_info(r0).bidx;
        { const float* mod0 = MOD + ((size_t)l * 9 + gb) * 6144;
#pragma unroll
          for (int j = 0; j < 4; ++j) { const int col = 4 * lane + 256 * j; gsc[j] = *(const f32x4*)(mod0 + D + col); gsh[j] = *(const f32x4*)(mod0 + col);
              if (l != 0) gg2[j] = *(const f32x4*)(MOD + ((size_t)(l - 1) * 9 + gb) * 6144 + 5 * D + col); } }
#pragma unroll
        for (int q = 0; q < RPW; ++q) { const int r = (r0 + q < NTOK) ? r0 + q : NTOK - 1;
#pragma unroll
            for (int j = 0; j < 4; ++j) { const int col = 4 * lane + 256 * j;
                if (l == 0) v[q][j] = *(const f32x4*)(xin_ptr(p, r) + col);
                else { v[q][j] = *(const f32x4*)(xrow_ptr(p, r) + col); y0[q][j] = *(const pg8::u32x2*)(Y + (size_t)(2 * r) * D + col); y1[q][j] = *(const pg8::u32x2*)(Y + (size_t)(2 * r + 1) * D + col); } } }
#pragma unroll
        for (int q = 0; q < RPW; ++q) { const int r = r0 + q; if (r >= NTOK) break;
            const RowInfo ri = row_info(r);
            f32x4 rsc[4], rsh[4], rg2[4];
#pragma unroll
            for (int j = 0; j < 4; ++j) { rsc[j] = gsc[j]; rsh[j] = gsh[j]; rg2[j] = gg2[j]; }
            if (ri.bidx != gb) {
                const float* mod = MOD + ((size_t)l * 9 + ri.bidx) * 6144;
#pragma unroll
                for (int j = 0; j < 4; ++j) { const int col = 4 * lane + 256 * j; rsc[j] = *(const f32x4*)(mod + D + col); rsh[j] = *(const f32x4*)(mod + col);
                    if (l != 0) rg2[j] = *(const f32x4*)(MOD + ((size_t)(l - 1) * 9 + ri.bidx) * 6144 + 5 * D + col); }
            }
            float ss = 0.f;
#pragma unroll
            for (int j = 0; j < 4; ++j) { const int col = 4 * lane + 256 * j;
                if (l != 0) { v[q][j] += rg2[j] * (bf4_to_f4(y0[q][j]) + bf4_to_f4(y1[q][j])); *(f32x4*)(xrow_ptr(p, r) + col) = v[q][j]; }
                ss += v[q][j][0] * v[q][j][0] + v[q][j][1] * v[q][j][1] + v[q][j][2] * v[q][j][2] + v[q][j][3] * v[q][j][3]; }
            const float rstd = rsqrtf(wave_sum(ss) * (1.f / D) + EPS);
#pragma unroll
            for (int j = 0; j < 4; ++j) { const int col = 4 * lane + 256 * j;
                const f32x4 nw = nwv[j];
                const f32x4 hv = v[q][j] * rstd * nw * (rsc[j] + 1.f) + rsh[j];
                pg8::u32x2 o; o.x = pg8::cvt_pk_bf16(hv[0], hv[1]); o.y = pg8::cvt_pk_bf16(hv[2], hv[3]);
                *(pg8::u32x2*)(HB + (size_t)r * D + col) = o; }
        }
    }
}

__device__ __forceinline__ void p6_norm2_router(const Params& p, int l, float* lds_unused) { PHASE_IDS;
    typedef pg8::bf16x8 bf16x8;
    typedef __attribute__((address_space(3))) unsigned char lds_u8;
    const int lane = tidx & 63, wave = __builtin_amdgcn_readfirstlane(tidx >> 6);
    const float* MOD = (const float*)(p.ws + WS_MOD);
    bf16_t* HB = (bf16_t*)(p.ws + WS_HB);
    f32x4* ROUTE = (f32x4*)(p.ws + WS_ROUTE);
    const int nrows = l == 0 ? NTOK : NL;
    const int rpb = (nrows + (int)gridDim.x - 1) / (int)gridDim.x, rbeg = bidx_ * rpb, rend = (rbeg + rpb < nrows) ? rbeg + rpb : nrows;
    constexpr int RS = 1032;
    lds_u8* L = (lds_u8*)lds_raw;
    LDSP(bf16_t) AH = (LDSP(bf16_t))(L); LDSP(bf16_t) AL = AH + 16 * RS; LDSP(bf16_t) WH = AL + 16 * RS; LDSP(bf16_t) WL = WH + 16 * RS;
    LDSP(float) PART = (LDSP(float))(L + 132096);
    LDSP(int) lcnt = (LDSP(int))(L + 140288); LDSP(int) lbase = lcnt + 16; LDSP(int) rroute = lbase + 16;
    if (tidx < 16) lcnt[tidx] = 0;
    {
        f32x4 wv[8];
#pragma unroll
        for (int j = 0; j < 8; ++j) wv[j] = ((const f32x4*)p.w_router)[tidx + NTHREADS * j];
#pragma unroll
        for (int j = 0; j < 8; ++j) { const int i4 = tidx + NTHREADS * j, k = i4 >> 2, e0 = (i4 & 3) * 4;
#pragma unroll
            for (int c = 0; c < 4; ++c) { const bf16_t hb = f2bf(wv[j][c]); WH[(e0 + c) * RS + k] = hb; WL[(e0 + c) * RS + k] = f2bf(wv[j][c] - bf2f(hb)); } }
    }
    const int nbatch = (rend - rbeg + 15) >> 4;
    f32x4 vn[2][4];
#pragma unroll
    for (int q = 0; q < 2; ++q) { const int r = (rbeg + wave * 2 + q < rend) ? rbeg + wave * 2 + q : rend - 1;
#pragma unroll
        for (int j = 0; j < 4; ++j) vn[q][j] = *(const f32x4*)(xrow_ptr(p, r) + 4 * lane + 256 * j); }
    f32x4 nwv[4];
#pragma unroll
    for (int j = 0; j < 4; ++j) nwv[j] = *(const f32x4*)(p.norm_ffn + l * D + 4 * lane + 256 * j);
    for (int bt = 0; bt < nbatch; ++bt) {
        const int r0 = rbeg + bt * 16 + wave * 2;
        f32x4 v[2][4], gsc[4], gsh[4];
        const int rl0 = r0 < rend ? r0 : rend - 1, gb = row_info(rl0).bidx;
        { const float* mod0 = MOD + ((size_t)l * 9 + gb) * 6144;
#pragma unroll
          for (int j = 0; j < 4; ++j) { const int col = 4 * lane + 256 * j; gsc[j] = *(const f32x4*)(mod0 + 4 * D + col); gsh[j] = *(const f32x4*)(mod0 + 3 * D + col); } }
#pragma unroll
        for (int q = 0; q < 2; ++q)
#pragma unroll
            for (int j = 0; j < 4; ++j) v[q][j] = vn[q][j];
        if (bt + 1 < nbatch) {
#pragma unroll
            for (int q = 0; q < 2; ++q) { const int r = (r0 + 16 + q < rend) ? r0 + 16 + q : rend - 1;
#pragma unroll
                for (int j = 0; j < 4; ++j) vn[q][j] = *(const f32x4*)(xrow_ptr(p, r) + 4 * lane + 256 * j); }
        }
#pragma unroll
        for (int j = 0; j < 4; ++j) gsc[j] = (gsc[j] + 1.f) * nwv[j];
#pragma unroll
        for (int q = 0; q < 2; ++q) { const int r = r0 + q;
            if (r < rend) {
                const RowInfo ri = row_info(r);
                float ss = 0.f;
#pragma unroll
                for (int j = 0; j < 4; ++j) ss += v[q][j][0] * v[q][j][0] + v[q][j][1] * v[q][j][1] + v[q][j][2] * v[q][j][2] + v[q][j][3] * v[q][j][3];
                const float rstd = rsqrtf(wave_sum(ss) * (1.f / D) + EPS);
                f32x4 rsc[4], rsh[4];
#pragma unroll
                for (int j = 0; j < 4; ++j) { rsc[j] = gsc[j]; rsh[j] = gsh[j]; }
                if (ri.bidx != gb) {
                    const float* mod = MOD + ((size_t)l * 9 + ri.bidx) * 6144;
#pragma unroll
                    for (int j = 0; j < 4; ++j) { const int col = 4 * lane + 256 * j; rsc[j] = (*(const f32x4*)(mod + 4 * D + col) + 1.f) * *(const f32x4*)(p.norm_ffn + l * D + col); rsh[j] = *(const f32x4*)(mod + 3 * D + col); }
                }
#pragma unroll
                for (int j = 0; j < 4; ++j) {
                    const int col = 4 * lane + 256 * j;
                    const f32x4 hv = v[q][j] * rstd * rsc[j] + rsh[j];
                    pg8::u32x2 hi; hi.x = pg8::cvt_pk_bf16(hv[0], hv[1]); hi.y = pg8::cvt_pk_bf16(hv[2], hv[3]);
                    *(pg8::u32x2*)(HB + (size_t)r * D + col) = hi;
                    pg8::u32x2 lo;
                    lo.x = pg8::cvt_pk_bf16(hv[0] - __uint_as_float(hi.x << 16), hv[1] - __uint_as_float(hi.x & 0xffff0000u));
                    lo.y = pg8::cvt_pk_bf16(hv[2] - __uint_as_float(hi.y << 16), hv[3] - __uint_as_float(hi.y & 0xffff0000u));
                    *(LDSP(pg8::u32x2))(AH + (wave * 2 + q) * RS + col) = hi; *(LDSP(pg8::u32x2))(AL + (wave * 2 + q) * RS + col) = lo;
                }
            }
        }
        __syncthreads();
        {
            const int rr = lane & 15, q4 = lane >> 4;
            f32x4 acc = {0.f, 0.f, 0.f, 0.f};
#pragma unroll
            for (int s4 = 0; s4 < 4; ++s4) { const int ko = (wave * 4 + s4) * 32 + 8 * q4;
                const bf16x8 ah = *(LDSP(const bf16x8))(AH + rr * RS + ko), al = *(LDSP(const bf16x8))(AL + rr * RS + ko);
                const bf16x8 wh = *(LDSP(const bf16x8))(WH + rr * RS + ko), wlo = *(LDSP(const bf16x8))(WL + rr * RS + ko);
                acc = __builtin_amdgcn_mfma_f32_16x16x32_bf16(ah, wh, acc, 0, 0, 0);
                acc = __builtin_amdgcn_mfma_f32_16x16x32_bf16(ah, wlo, acc, 0, 0, 0);
                acc = __builtin_amdgcn_mfma_f32_16x16x32_bf16(al, wh, acc, 0, 0, 0); }
#pragma unroll
            for (int e = 0; e < 4; ++e) PART[wave * 256 + (4 * q4 + e) * 16 + rr] = acc[e];
        }
        __syncthreads();
        if (wave == 0 && lane < 16) {
            const int r = rbeg + bt * 16 + lane;
            if (r < rend) {
                float s[16], sel[16];
#pragma unroll
                for (int e = 0; e < 16; ++e) { float lgt = 0.f;
#pragma unroll
                    for (int w8 = 0; w8 < 8; ++w8) lgt += PART[w8 * 256 + lane * 16 + e];
                    s[e] = __builtin_amdgcn_rcpf(1.f + __expf(-lgt)); sel[e] = s[e] + p.b_router[e]; }
                int bestg = 0; float bestscore = -1e30f;
#pragma unroll
                for (int g = 0; g < 4; ++g) {
                    const float a0 = sel[4 * g], a1 = sel[4 * g + 1], a2 = sel[4 * g + 2], a3 = sel[4 * g + 3];
                    const float t1x = fmaxf(a0, a1), t2x = fminf(a0, a1), t3x = fmaxf(a2, a3), t4x = fminf(a2, a3);
                    const float gs = fmaxf(t1x, t3x) + fmaxf(fmaxf(fminf(t1x, t3x), t2x), t4x);
                    if (gs > bestscore) { bestscore = gs; bestg = g; }
                }
                float c0 = sel[0], c1 = sel[1], c2 = sel[2], c3 = sel[3], u0 = s[0], u1 = s[1], u2 = s[2], u3 = s[3];
#pragma unroll
                for (int g = 1; g < 4; ++g) { const bool pick = bestg == g; c0 = pick ? sel[4 * g] : c0; c1 = pick ? sel[4 * g + 1] : c1; c2 = pick ? sel[4 * g + 2] : c2; c3 = pick ? sel[4 * g + 3] : c3;
                    u0 = pick ? s[4 * g] : u0; u1 = pick ? s[4 * g + 1] : u1; u2 = pick ? s[4 * g + 2] : u2; u3 = pick ? s[4 * g + 3] : u3; }
                int i1 = 0; float m1 = c0, s1 = u0;
                if (c1 > m1) { m1 = c1; i1 = 1; s1 = u1; }
                if (c2 > m1) { m1 = c2; i1 = 2; s1 = u2; }
                if (c3 > m1) { m1 = c3; i1 = 3; s1 = u3; }
                int i2 = -1; float m2 = -1e30f, s2 = 0.f;
                if (i1 != 0) { m2 = c0; i2 = 0; s2 = u0; }
                if (i1 != 1 && (i2 < 0 || c1 > m2)) { m2 = c1; i2 = 1; s2 = u1; }
                if (i1 != 2 && (i2 < 0 || c2 > m2)) { m2 = c2; i2 = 2; s2 = u2; }
                if (i1 != 3 && (i2 < 0 || c3 > m2)) { m2 = c3; i2 = 3; s2 = u3; }
                const int e1 = bestg * 4 + i1, e2 = bestg * 4 + i2; const float rw = __builtin_amdgcn_rcpf(s1 + s2);
                f32x4 rt; rt[0] = __int_as_float(e1); rt[1] = __int_as_float(e2); rt[2] = s1 * rw; rt[3] = s2 * rw; ROUTE[r] = rt;
                rroute[r - rbeg] = e1 | (e2 << 8); atomicAdd((int*)&lcnt[e1], 1); atomicAdd((int*)&lcnt[e2], 1);
            }
        }
    }
    __syncthreads();
    unsigned* ctl = (unsigned*)(p.ws + WS_CTL);
    if (tidx < 16) { lbase[tidx] = (int)__hip_atomic_fetch_add(ctl + CW_CNT + (l * NEXP + tidx) * 64, (unsigned)lcnt[tidx], __ATOMIC_RELAXED, __HIP_MEMORY_SCOPE_AGENT); lcnt[tidx] = 0; }
    __syncthreads();
    int* LIST = (int*)(p.ws + WS_LIST) + (size_t)l * NEXP * NTOK;
    if (tidx < rend - rbeg) {
        const int rr = rroute[tidx], r = rbeg + tidx;
#pragma unroll
        for (int slot = 0; slot < 2; ++slot) { const int e = (rr >> (8 * slot)) & 255; const int pos = lbase[e] + atomicAdd((int*)&lcnt[e], 1); LIST[e * NTOK + pos] = 2 * r + slot; }
    }
    __syncthreads();
}

__device__ __forceinline__ void p9_final(const Params& p) { PHASE_IDS;
    const int lane = tidx & 63;
    const float* MOD = (const float*)(p.ws + WS_MOD);
    const bf16_t* Y = (const bf16_t*)(p.ws + WS_Y);
    f32x4 nwv[4];
#pragma unroll
    for (int j = 0; j < 4; ++j) nwv[j] = *(const f32x4*)(p.final_norm + 4 * lane + 256 * j);
    for (int r0 = GW * RPW; r0 < NL; r0 += NGW * RPW) {
        f32x4 v[RPW][4], gg2[4]; pg8::u32x2 y0[RPW][4], y1[RPW][4];
        const int gb = r0 >> 11;
#pragma unroll
        for (int j = 0; j < 4; ++j) gg2[j] = *(const f32x4*)(MOD + ((size_t)(DEPTH - 1) * 9 + gb) * 6144 + 5 * D + 4 * lane + 256 * j);
#pragma unroll
        for (int q = 0; q < RPW; ++q) { const int r = (r0 + q < NL) ? r0 + q : NL - 1;
#pragma unroll
            for (int j = 0; j < 4; ++j) { const int col = 4 * lane + 256 * j;
                v[q][j] = *(const f32x4*)(p.out + (size_t)r * D + col); y0[q][j] = *(const pg8::u32x2*)(Y + (size_t)(2 * r) * D + col); y1[q][j] = *(const pg8::u32x2*)(Y + (size_t)(2 * r + 1) * D + col); } }
#pragma unroll
        for (int q = 0; q < RPW; ++q) { const int r = r0 + q; if (r >= NL) break;
            const int bidx = r >> 11;
            float ss = 0.f;
#pragma unroll
            for (int j = 0; j < 4; ++j) { const int col = 4 * lane + 256 * j;
                const f32x4 g2 = bidx == gb ? gg2[j] : *(const f32x4*)(MOD + ((size_t)(DEPTH - 1) * 9 + bidx) * 6144 + 5 * D + col);
                v[q][j] += g2 * (bf4_to_f4(y0[q][j]) + bf4_to_f4(y1[q][j]));
                ss += v[q][j][0] * v[q][j][0] + v[q][j][1] * v[q][j][1] + v[q][j][2] * v[q][j][2] + v[q][j][3] * v[q][j][3]; }
            const float rstd = rsqrtf(wave_sum(ss) * (1.f / D) + EPS);
#pragma unroll
            for (int j = 0; j < 4; ++j) { const int col = 4 * lane + 256 * j; *(f32x4*)(p.out + (size_t)r * D + col) = v[q][j] * rstd * nwv[j]; }
        }
    }
}

namespace pg8 {
#define PG8_LAS __attribute__((address_space(3)))
typedef short bf16x8 __attribute__((ext_vector_type(8)));
typedef unsigned u32x4 __attribute__((ext_vector_type(4)));
typedef unsigned u32x2 __attribute__((ext_vector_type(2)));
constexpr int BM = 256, BK = 64, HALF = 128, HTB = HALF * BK * 2, STAGE_BYTES = 8 * HTB;
__host__ __device__ __forceinline__ int lds_byte(int r, int c) { const int st = (r >> 4) * 2 + (c >> 5), rr = r & 15, cc = c & 31, ob = rr * 64 + cc * 2; return st * 1024 + (ob ^ (((ob >> 9) & 1) << 5)); }
__host__ __device__ __forceinline__ void stage_rc(int b, int& R, int& C) { const int st = b / 1024, sb = b % 1024, swz = sb ^ (((sb >> 9) & 1) << 5); R = (st >> 1) * 16 + swz / 64; C = (st & 1) * 32 + (swz % 64) / 2; }
__host__ __device__ __forceinline__ int perm32(int rho) { const int n = rho >> 4, i = rho & 15; return 8 * (i >> 2) + 4 * n + (i & 3); }
struct Unit { int pm, pn; unsigned a_off, b_off; int e, cnt; };

template <class Epi, class Sched>
__device__ __forceinline__ void gemm_phase(PG8_LAS unsigned char* lds, const bf16_t* A, const bf16_t* Bt, const int K, const Sched& S, const Epi& E) {
    const int tid = otid(), wid = __builtin_amdgcn_readfirstlane(tid >> 6), lane = tid & 63, wr = wid >> 2, wc = wid & 3, fr = lane & 15, fq = lane >> 4;
    const int nt = K / BK;
    int Ra[2]; unsigned Ca2[2], voffB[2];
#pragma unroll
    for (int i = 0; i < 2; ++i) { int R, C; stage_rc(tid * 16 + i * 8192, R, C); const int Rb = (R & ~31) + perm32(R & 31); Ra[i] = R; Ca2[i] = (unsigned)C * 2u; voffB[i] = (unsigned)(Rb * K + C) * 2u; }
    const size_t kstep = (size_t)(BK * 2);
    const size_t hstep = (size_t)HALF * K * 2;
    const unsigned ldsw = (unsigned)wid * 1024u;
    const int aoff = lds_byte(wr * 64 + fr, fq * 8), boff = lds_byte(wc * 32 + fr, fq * 8);
#define PG8_SA(b, h) (((b) * 2 + (h)) * HTB)
#define PG8_SB(b, h) ((4 + (b) * 2 + (h)) * HTB)
#define PG8_STAGE_B(bufoff, gbase) do { _Pragma("unroll") for (int _i = 0; _i < 2; ++_i) \
        __builtin_amdgcn_global_load_lds((const unsigned*)((const char*)(gbase) + voffB[_i]), (PG8_LAS unsigned*)(lds + (bufoff) + ldsw + _i * 8192), 16, 0, 0); } while (0)
#define PG8_STAGE_A(bufoff, kbyte, offs) do { _Pragma("unroll") for (int _i = 0; _i < 2; ++_i) \
        __builtin_amdgcn_global_load_lds((const unsigned*)(Ab + (size_t)(offs)[_i] + (size_t)(kbyte)), (PG8_LAS unsigned*)(lds + (bufoff) + ldsw + _i * 8192), 16, 0, 0); } while (0)
#define PG8_LDA(dst, b, h) do { _Pragma("unroll") for (int m = 0; m < 4; ++m) _Pragma("unroll") for (int k = 0; k < 2; ++k) dst[m][k] = *(const PG8_LAS bf16x8*)(lds + PG8_SA(b, h) + aoff + m * 2048 + k * 1024); } while (0)
#define PG8_LDB(dst, b, h) do { _Pragma("unroll") for (int n = 0; n < 2; ++n) _Pragma("unroll") for (int k = 0; k < 2; ++k) dst[n][k] = *(const PG8_LAS bf16x8*)(lds + PG8_SB(b, h) + boff + n * 2048 + k * 1024); } while (0)
#define PG8_MMA(ai, bj, At, Bt_) do { __builtin_amdgcn_s_setprio(1); _Pragma("unroll") for (int m = 0; m < 4; ++m) _Pragma("unroll") for (int n = 0; n < 2; ++n) _Pragma("unroll") for (int k = 0; k < 2; ++k) \
        acc[ai][bj][m][n] = __builtin_amdgcn_mfma_f32_16x16x32_bf16(Bt_[n][k], At[m][k], acc[ai][bj][m][n], 0, 0, 0); __builtin_amdgcn_s_setprio(0); } while (0)
#define PG8_WAIT_V(n) asm volatile("s_waitcnt vmcnt(" #n ")" ::: "memory")
#define PG8_WAIT_L(n) asm volatile("s_waitcnt lgkmcnt(" #n ")" ::: "memory")
#define PG8_BAR __builtin_amdgcn_s_barrier()
#define PG8_SCHED __builtin_amdgcn_sched_barrier(0)
    Unit cur, nxt; int ui = 0;
    if (!S.next(0, cur)) return;
    f32x4 acc[2][2][4][2];
#pragma unroll
    for (int a = 0; a < 2; ++a)
#pragma unroll
        for (int b = 0; b < 2; ++b)
#pragma unroll
            for (int m = 0; m < 4; ++m)
#pragma unroll
                for (int n = 0; n < 2; ++n) acc[a][b][m][n] = (f32x4){0.f, 0.f, 0.f, 0.f};
    bf16x8 At[4][2], B0[2][2], B1[2][2];
    const char* Ab = (const char*)A;
    unsigned ga0[2], ga1[2], gn0[2], gn1[2];
#pragma unroll
    for (int i = 0; i < 2; ++i) { ga0[i] = S.a_row_off(cur, Ra[i], K) + Ca2[i]; ga1[i] = S.a_row_off(cur, HALF + Ra[i], K) + Ca2[i]; }
    const char* cB = (const char*)Bt + cur.b_off;
    PG8_STAGE_B(PG8_SB(0, 0), cB); PG8_STAGE_B(PG8_SB(0, 1), cB + hstep); PG8_STAGE_A(PG8_SA(0, 0), 0, ga0); PG8_STAGE_A(PG8_SA(0, 1), 0, ga1);
    if (wr == 1) PG8_BAR;
    PG8_WAIT_V(2); PG8_BAR;
    PG8_STAGE_B(PG8_SB(1, 0), cB + kstep); PG8_STAGE_A(PG8_SA(1, 0), kstep, ga0); PG8_STAGE_B(PG8_SB(1, 1), cB + hstep + kstep);
    PG8_WAIT_V(6); PG8_BAR;
    for (;;) {
        const bool has_next = S.next(ui + 1, nxt);
        if (has_next) {
#pragma unroll
            for (int i = 0; i < 2; ++i) { gn0[i] = S.a_row_off(nxt, Ra[i], K) + Ca2[i]; gn1[i] = S.a_row_off(nxt, HALF + Ra[i], K) + Ca2[i]; }
        } else {
#pragma unroll
            for (int i = 0; i < 2; ++i) { gn0[i] = ga0[i]; gn1[i] = ga1[i]; }
        }
        const char* nB = has_next ? (const char*)Bt + nxt.b_off : cB;
        for (int t = 0; t < nt; t += 2) {
            const bool last = (t == nt - 2);
            const size_t k1 = (size_t)(t + 1) * kstep;
            unsigned o20[2], o21[2];
#pragma unroll
            for (int i = 0; i < 2; ++i) { o20[i] = last ? gn0[i] : ga0[i]; o21[i] = last ? gn1[i] : ga1[i]; }
            const size_t k2 = last ? 0 : (size_t)(t + 2) * kstep, k3 = k2 + kstep;
            const char* b2 = last ? nB : cB + (size_t)(t + 2) * kstep; const char* b3 = b2 + kstep;
            PG8_LDB(B0, 0, 0); PG8_LDB(B1, 0, 1); PG8_SCHED; PG8_LDA(At, 0, 0); PG8_STAGE_A(PG8_SA(1, 1), k1, ga1);
            PG8_WAIT_V(8); PG8_WAIT_L(0); PG8_BAR; PG8_MMA(0, 0, At, B0); PG8_MMA(0, 1, At, B1); PG8_BAR; PG8_SCHED;
            PG8_LDA(At, 0, 1); PG8_STAGE_B(PG8_SB(0, 0), b2); PG8_STAGE_B(PG8_SB(0, 1), b2 + hstep); PG8_STAGE_A(PG8_SA(0, 0), k2, o20);
            PG8_WAIT_V(8); PG8_WAIT_L(0); PG8_BAR; PG8_MMA(1, 0, At, B0); PG8_MMA(1, 1, At, B1); PG8_BAR; PG8_SCHED;
            PG8_LDB(B0, 1, 0); PG8_LDB(B1, 1, 1); PG8_SCHED; PG8_LDA(At, 1, 0); PG8_STAGE_A(PG8_SA(0, 1), k2, o21);
            PG8_WAIT_V(8); PG8_WAIT_L(0); PG8_BAR; PG8_MMA(0, 0, At, B0); PG8_MMA(0, 1, At, B1); PG8_BAR; PG8_SCHED;
            PG8_LDA(At, 1, 1); PG8_STAGE_B(PG8_SB(1, 0), b3); PG8_STAGE_B(PG8_SB(1, 1), b3 + hstep); PG8_STAGE_A(PG8_SA(1, 0), k3, o20);
            PG8_WAIT_V(8); PG8_WAIT_L(0); PG8_BAR; PG8_MMA(1, 0, At, B0); PG8_MMA(1, 1, At, B1); PG8_BAR; PG8_SCHED;
        }
        if (wr == 0) PG8_BAR;
        E(acc, cur, wr, wc, fr, fq);
        if (!has_next) break;
#pragma unroll
        for (int a = 0; a < 2; ++a)
#pragma unroll
            for (int b = 0; b < 2; ++b)
#pragma unroll
                for (int m = 0; m < 4; ++m)
#pragma unroll
                    for (int n = 0; n < 2; ++n) acc[a][b][m][n] = (f32x4){0.f, 0.f, 0.f, 0.f};
        cur = nxt; cB = nB; ++ui;
#pragma unroll
        for (int i = 0; i < 2; ++i) { ga0[i] = gn0[i]; ga1[i] = gn1[i]; }
        if (wr == 1) PG8_BAR;
    }
    PG8_WAIT_V(0);
    PG8_BAR;
#undef PG8_SA
#undef PG8_SB
#undef PG8_STAGE_A
#undef PG8_STAGE_B
#undef PG8_LDA
#undef PG8_LDB
#undef PG8_MMA
#undef PG8_WAIT_V
#undef PG8_WAIT_L
#undef PG8_BAR
#undef PG8_SCHED
}

struct PlainOrder {
    int nM, nN, nwg, G, c;
    __device__ void init(int M, int N, int G_, int c_) { nM = M / BM; nN = N / BM; nwg = nM * nN; G = G_; c = c_; }
    __device__ __forceinline__ bool next(int i, Unit& u, int dup = 1) const {
        int L = i * G + c; if (L >= nwg * dup) return false; if (L >= nwg) L -= nwg;
        int wgid = L; { const int q = nwg / 8, r = nwg % 8, xcd = wgid % 8, off = wgid / 8; wgid = (xcd < r ? xcd * (q + 1) : r * (q + 1) + (xcd - r) * q) + off; }
        const int nig = 8 * nN, gid = wgid / nig, fm = gid * 8, gsz = (nM - fm) < 8 ? (nM - fm) : 8;
        u.pm = fm + ((wgid % nig) % gsz); u.pn = (wgid % nig) / gsz; u.a_off = 0; u.b_off = 0; u.e = 0; u.cnt = 256; return true;
    }
    __device__ __forceinline__ unsigned a_row_off(const Unit& u, int rl, int K) const { return (unsigned)((u.pm * BM + rl) * K) * 2u; }
};
}
struct PlainSched {
    pg8::PlainOrder o; int K; int dup; bool fperm;
    __device__ __forceinline__ bool next(int i, pg8::Unit& u) const { if (!o.next(i, u, dup)) return false; u.b_off = (unsigned)(u.pn * 256 * K) * 2u; return true; }
    __device__ __forceinline__ unsigned a_row_off(const pg8::Unit& u, int rl, int K_) const {
        if (fperm && u.pn <= 1) rl = u.pm < 64 ? (((rl >> 4) & 3) << 6 | (rl >> 7) << 5 | ((rl >> 6) & 1) << 4 | (rl & 15)) : ((rl & 0xc0) | (rl & 15) << 2 | ((rl >> 4) & 3));
        return o.a_row_off(u, rl, K_); }
};

__device__ __forceinline__ void conv_item4(const float* W, int ldw, int k0, int n, bool valid, bf16_t* dst_row0  , int ldt) {
    f32x4 v[16];
    const float* src = W + (size_t)k0 * ldw + (valid ? n : 0);
#pragma unroll
    for (int i = 0; i < 16; ++i) v[i] = *(const f32x4*)(src + (size_t)i * ldw);
    if (valid) {
#pragma unroll
        for (int c = 0; c < 4; ++c) {
            pg8::u32x4 o0, o1;
            o0.x = pg8::cvt_pk_bf16(v[0][c], v[1][c]); o0.y = pg8::cvt_pk_bf16(v[2][c], v[3][c]); o0.z = pg8::cvt_pk_bf16(v[4][c], v[5][c]); o0.w = pg8::cvt_pk_bf16(v[6][c], v[7][c]);
            o1.x = pg8::cvt_pk_bf16(v[8][c], v[9][c]); o1.y = pg8::cvt_pk_bf16(v[10][c], v[11][c]); o1.z = pg8::cvt_pk_bf16(v[12][c], v[13][c]); o1.w = pg8::cvt_pk_bf16(v[14][c], v[15][c]);
            *(pg8::u32x4*)(dst_row0 + (size_t)c * ldt) = o0; *(pg8::u32x4*)(dst_row0 + (size_t)c * ldt + 8) = o1;
        }
    }
}
__device__ __forceinline__ void conv_tile64(const float* src  , int ldw, bf16_t* dst  ) {
    float v[64];
#pragma unroll
    for (int i = 0; i < 64; ++i) v[i] = src[(size_t)i * ldw];
#pragma unroll
    for (int q = 0; q < 8; ++q) {
        pg8::u32x4 o; o.x = pg8::cvt_pk_bf16(v[8 * q], v[8 * q + 1]); o.y = pg8::cvt_pk_bf16(v[8 * q + 2], v[8 * q + 3]); o.z = pg8::cvt_pk_bf16(v[8 * q + 4], v[8 * q + 5]); o.w = pg8::cvt_pk_bf16(v[8 * q + 6], v[8 * q + 7]);
        *(pg8::u32x4*)(dst + 8 * q) = o;
    }
}
constexpr int CB_RS = 272;
constexpr int CB_BUF = 256 * CB_RS;
__device__ __forceinline__ void cb_load(f32x4 (&v)[16], const float* src, int ldw) {
#pragma unroll
    for (int i = 0; i < 16; ++i) v[i] = *(const f32x4*)(src + (size_t)i * ldw);
}
__device__ __forceinline__ void cb_to_lds(const f32x4 (&v)[16], unsigned char* buf, int w, int lane) {
#pragma unroll
    for (int c = 0; c < 4; ++c) {
        pg8::u32x4 o0, o1;
        o0.x = pg8::cvt_pk_bf16(v[0][c], v[1][c]); o0.y = pg8::cvt_pk_bf16(v[2][c], v[3][c]); o0.z = pg8::cvt_pk_bf16(v[4][c], v[5][c]); o0.w = pg8::cvt_pk_bf16(v[6][c], v[7][c]);
        o1.x = pg8::cvt_pk_bf16(v[8][c], v[9][c]); o1.y = pg8::cvt_pk_bf16(v[10][c], v[11][c]); o1.z = pg8::cvt_pk_bf16(v[12][c], v[13][c]); o1.w = pg8::cvt_pk_bf16(v[14][c], v[15][c]);
        LDSP(pg8::u32x4) q = (LDSP(pg8::u32x4))(buf + (4 * lane + c) * CB_RS + 32 * w);
        q[0] = o0; q[1] = o1;
    }
}
constexpr int CW_DYN = 12000;
__device__ __forceinline__ void convert_experts_dyn(const Params& p, int l, bf16_t* WGU, bf16_t* WD, int t0, int t1, int site, int tidx, unsigned char* lds_raw) {
    const int lane = tidx & 63, w = tidx >> 6, j = tidx & 15, r0 = tidx >> 4;
    unsigned* ctr = (unsigned*)(p.ws + WS_CTL) + CW_DYN + 64 * site;
    volatile int* slot = (volatile int*)(lds_raw + LDS_BYTES - 480);
    int par = 0;
    for (;;) {
        if (tidx == 0) *slot = t0 + (int)atomicAdd(ctr, 1u);
        __syncthreads();
        const int t = *slot;
        if (t >= t1) break;
        const float* src; int ldw; bf16_t* dst; int ldd, rsplit;
        if (t < 512) { const int nt = t & 1, kt = (t >> 1) & 7, e = (t >> 4) & 15, part = t >> 8;
            src = (part == 0 ? p.w_eg : p.w_eu) + ((size_t)(l * NEXP + e) * D + kt * 128 + 16 * w) * DEXP + nt * 256 + 4 * lane; ldw = DEXP;
            dst = WGU + ((size_t)e * 1024 + nt * 512 + part * 128) * D + kt * 128; ldd = D; rsplit = 128; }
        else { const int q = t - 512, nt = q & 3, kt = (q >> 2) & 3, e = (q >> 4) & 15;
            src = p.w_ed + ((size_t)(l * NEXP + e) * DEXP + kt * 128 + 16 * w) * D + nt * 256 + 4 * lane; ldw = D;
            dst = WD + ((size_t)e * 1024 + nt * 256) * DEXP + kt * 128; ldd = DEXP; rsplit = 0; }
        f32x4 v[16];
        cb_load(v, src, ldw);
        unsigned char* buf = lds_raw + par * CB_BUF; par ^= 1;
        cb_to_lds(v, buf, w, lane);
        __syncthreads();
#pragma unroll
        for (int i = 0; i < 8; ++i) { const int r = r0 + 32 * i;
            const pg8::u32x4 x = *(LDSP(pg8::u32x4))(buf + r * CB_RS + 16 * j);
            *(pg8::u32x4*)(dst + (size_t)(r + (r & rsplit)) * ldd + 8 * j) = x; }
    }
}
__device__ __forceinline__ void convert_gateup(const Params& p, int l, bf16_t* WGU, int gw0, int ngw, int lane) {
    for (int it = gw0; it < 2 * NEXP * 16 * 8; it += ngw) {
        const int nb = it & 7, kb = (it >> 3) & 15, e = (it >> 7) & 15, part = it >> 11, n = nb * 64 + lane;
        const float* W = (part == 0 ? p.w_eg : p.w_eu) + (size_t)(l * NEXP + e) * D * DEXP;
        conv_tile64(W + (size_t)(kb * 64) * DEXP + n, DEXP, WGU + ((size_t)e * 1024 + (n >> 7) * 256 + part * 128 + (n & 127)) * D + kb * 64);
    }
}
__device__ __forceinline__ void convert_down(const Params& p, int l, bf16_t* WD, int gw0, int ngw, int lane) {
    for (int it = gw0; it < NEXP * 8 * 16; it += ngw) {
        const int nb = it & 15, kb = (it >> 4) & 7, e = it >> 7, n = nb * 64 + lane;
        conv_tile64(p.w_ed + ((size_t)(l * NEXP + e) * DEXP + kb * 64) * D + n, D, WD + ((size_t)e * 1024 + n) * DEXP + kb * 64);
    }
}
struct EpiOutProj {
    const float* xs_lat; const float* xs_ctx; float* xd_lat; float* xd_ctx; const float* g1;
    __device__ __forceinline__ void operator()(const f32x4 (&acc)[2][2][4][2], const pg8::Unit& u, int wr, int wc, int fr, int fq) const {
        const int row0 = u.pm * 256 + wr * 64 + fr, col0 = u.pn * 256 + wc * 32 + 8 * fq;
        const bool isctx = u.pm >= 64; const int bidx = isctx ? 8 : (u.pm >> 3);
        const float* xs = isctx ? xs_ctx - (size_t)NL * D : xs_lat; float* xd = isctx ? xd_ctx - (size_t)NL * D : xd_lat;
        f32x4 g[2][2];
#pragma unroll
        for (int bj = 0; bj < 2; ++bj)
#pragma unroll
            for (int n = 0; n < 2; ++n) g[bj][n] = *(const f32x4*)(g1 + (size_t)bidx * 6144 + col0 + bj * 128 + 4 * n);
#pragma unroll
        for (int ai = 0; ai < 2; ++ai)
#pragma unroll
            for (int m = 0; m < 4; ++m) {
                const size_t ro = (size_t)(row0 + ai * 128 + m * 16) * D + col0;
#pragma unroll
                for (int bj = 0; bj < 2; ++bj)
#pragma unroll
                    for (int n = 0; n < 2; ++n) { const f32x4 xv = *(const f32x4*)(xs + ro + bj * 128 + 4 * n); *(f32x4*)(xd + ro + bj * 128 + 4 * n) = xv + g[bj][n] * acc[ai][bj][m][n]; }
            }
    }
};
__device__ __forceinline__ void p5_outproj_fast(const Params& p, int l, unsigned char* lds_raw) { PHASE_IDS;
    PlainSched S; S.K = D; S.fperm = false; S.dup = (l == 0 ? DUPN(8) : 1); S.o.init(l == 0 ? NTOK : NL, D, gridDim.x, bidx_);
    EpiOutProj E{l == 0 ? p.x : p.out, l == 0 ? p.ctx : (const float*)(p.ws + WS_XC), p.out, (float*)(p.ws + WS_XC), (const float*)(p.ws + WS_MOD) + (size_t)l * 9 * 6144 + 2 * D};
    pg8::gemm_phase((PG8_LAS unsigned char*)lds_raw, (const bf16_t*)(p.ws + WS_HB), (const bf16_t*)(p.ws + WS_WOUT) + (size_t)l * D * D, D, S, E);
    if (l == 0) convert_experts_dyn(p, 0, (bf16_t*)(p.ws + WS_WGU), (bf16_t*)(p.ws + WS_WD), 0, 768, 0, tidx, lds_raw);
}

#define PIN_ACC(acc) do { _Pragma("unroll") for (int a_ = 0; a_ < 2; ++a_) _Pragma("unroll") for (int b_ = 0; b_ < 2; ++b_) _Pragma("unroll") for (int m_ = 0; m_ < 4; ++m_) \
    asm volatile("" : "+v"(acc[a_][b_][m_][0]), "+v"(acc[a_][b_][m_][1])); } while (0)
struct EpiInProj {
    struct { unsigned char* ws; const float* q_norm; const float* k_norm; } p; int l;
    __device__ __forceinline__ void operator()(f32x4 (&acc)[2][2][4][2], const pg8::Unit& u, int wr, int wc, int fr, int fq) const {
        asm volatile("" : "+v"(fr), "+v"(fq));
        const int T = u.pn;
        const bool isctx = u.pm >= 64; const int b = isctx ? u.pm - 64 : (u.pm >> 3); const int t0 = (isctx ? 0 : (u.pm & 7) * 256) + wr * 64 + fr;
        const int row0 = u.pm * 256 + wr * 64 + fr;
        if (T <= 1) {
            bf16_t* dst = isctx ? (bf16_t*)(p.ws + WS_YFTC) + ((size_t)b * 256 * 2 + T) * CTXL + 64 * wr + 4 * fr
                                : (bf16_t*)(p.ws + WS_YFTL) + ((size_t)b * 256 * 2 + T) * SEQ + (16 * wr + fr) * 32 + 4 * (u.pm & 7);
            const int ld = isctx ? CTXL : SEQ, oa = isctx ? 128 : 1024;
            unsigned eo = (unsigned)((64 * wc + 8 * fq) * 2 * ld);
#pragma unroll
            for (int bj = 0; bj < 2; ++bj)
#pragma unroll
                for (int n = 0; n < 2; ++n)
#pragma unroll
                    for (int e = 0; e < 4; ++e) { bf16_t* cp = dst + eo;
#pragma unroll
                        for (int ai = 0; ai < 2; ++ai) { pg8::u32x2 w; w.x = pg8::cvt_pk_bf16(acc[ai][bj][0][n][e], acc[ai][bj][1][n][e]); w.y = pg8::cvt_pk_bf16(acc[ai][bj][2][n][e], acc[ai][bj][3][n][e]); *(pg8::u32x2*)(cp + ai * oa) = w; }
                        eo += (unsigned)(((n == 1 && e == 3) ? 25 : 1) * 2 * ld); asm volatile("" : "+v"(eo) :: "memory"); }
        } else if (T <= 4 || T >= 8) {
            bf16_t* dst; int ld; float sc = 1.f;
            if (T == 9) { dst = (bf16_t*)(p.ws + WS_YFTL); ld = 256; }
            else if (T == 2) { dst = (bf16_t*)(p.ws + WS_GQK); ld = 256; if (wc < 2) sc = 0.17677669529663687f; }
            else if (T == 3) { dst = (bf16_t*)(p.ws + WS_GV); ld = 256; } else if (T == 4) { dst = (bf16_t*)(p.ws + WS_GG); ld = 256; } else { dst = (bf16_t*)(p.ws + WS_GD); ld = 32; }
            if (T != 8 || wc == 0) {
#pragma unroll
                for (int ai = 0; ai < 2; ++ai)
#pragma unroll
                    for (int m = 0; m < 4; ++m) { const size_t r = row0 + ai * 128 + m * 16;
#pragma unroll
                        for (int bj = 0; bj < 2; ++bj) { if (T == 8 && bj == 1) continue;
                            const f32x4 v0 = acc[ai][bj][m][0] * sc, v1 = acc[ai][bj][m][1] * sc;
                            pg8::u32x4 w; w.x = pg8::cvt_pk_bf16(v0[0], v0[1]); w.y = pg8::cvt_pk_bf16(v0[2], v0[3]); w.z = pg8::cvt_pk_bf16(v1[0], v1[1]); w.w = pg8::cvt_pk_bf16(v1[2], v1[3]);
                            *(pg8::u32x4*)(dst + r * ld + 64 * wc + 32 * bj + 8 * fq) = w; } }
            }
        } else if (T == 7 && wc >= 2) {
            bf16_t* dst = (bf16_t*)(p.ws + WS_AVT) + ((size_t)(b * 2 + (wc - 2)) * 64) * KEYS + (isctx ? 0 : CTXL);
            unsigned eo = (unsigned)(8 * fq * KEYS + t0);
#pragma unroll
            for (int bj = 0; bj < 2; ++bj)
#pragma unroll
                for (int n = 0; n < 2; ++n)
#pragma unroll
                    for (int e = 0; e < 4; ++e) { bf16_t* cp = dst + eo;
#pragma unroll
                        for (int ai = 0; ai < 2; ++ai)
#pragma unroll
                            for (int m = 0; m < 4; ++m) cp[ai * 128 + m * 16] = f2bf(acc[ai][bj][m][n][e]);
                        eo += (unsigned)(((n == 1 && e == 3) ? 25 : 1) * KEYS); asm volatile("" : "+v"(eo) :: "memory"); }
        } else {
            const bool isq = T != 7;
            const float* nw = isq ? p.q_norm : p.k_norm;
            f32x4 w4[2][2];
#pragma unroll
            for (int bj = 0; bj < 2; ++bj)
#pragma unroll
                for (int n = 0; n < 2; ++n) w4[bj][n] = *(const f32x4*)(nw + 32 * bj + 8 * fq + 4 * n);
            const float osc = isq ? QSCALE : 1.f;
            const float* ROPE = (const float*)(p.ws + WS_TAB) + 2048;
            const int half = fq >> 1;
            const int rbase = row0 - t0;
            int t = t0;
#pragma unroll
            for (int ai = 0; ai < 2; ++ai)
#pragma unroll
                for (int m = 0; m < 4; ++m) {
                    float ss = 0.f;
#pragma unroll
                    for (int bj = 0; bj < 2; ++bj)
#pragma unroll
                        for (int n = 0; n < 2; ++n) { const f32x4 v = acc[ai][bj][m][n]; ss += v[0] * v[0] + v[1] * v[1] + v[2] * v[2] + v[3] * v[3]; }
                    ss += __shfl_xor(ss, 16); ss += __shfl_xor(ss, 32);
                    const float rs = rsqrtf(ss * (1.f / 64.f) + EPS);
                    bf16_t* dst = isq ? (bf16_t*)(p.ws + WS_AQ) + (size_t)(rbase + t) * 512 + ((T - 5) * 4 + wc) * 64
                                      : (bf16_t*)(p.ws + WS_AK) + ((size_t)b * KEYS + (isctx ? 0 : CTXL) + t) * 128 + wc * 64;
#pragma unroll
                    for (int bj = 0; bj < 2; ++bj) {
                        f32x4 o[2];
#pragma unroll
                        for (int n = 0; n < 2; ++n) {
                            const f32x4 xv = acc[ai][bj][m][n] * rs * w4[bj][n];
                            if (!isctx) {
                                const int pos = bj == 0 ? (t >> 6) : (t & 63);
                                const f32x4* rp = (const f32x4*)(ROPE + 2 * (pos * 16 + 8 * (fq & 1) + 4 * n));
                                const f32x4 cs01 = rp[0], cs23 = rp[1];
                                f32x4 xp;
#pragma unroll
                                for (int e = 0; e < 4; ++e) xp[e] = __shfl_xor(xv[e], 32);
                                const float sg = half == 0 ? -1.f : 1.f;
                                o[n][0] = xv[0] * cs01[0] + sg * xp[0] * cs01[1]; o[n][1] = xv[1] * cs01[2] + sg * xp[1] * cs01[3];
                                o[n][2] = xv[2] * cs23[0] + sg * xp[2] * cs23[1]; o[n][3] = xv[3] * cs23[2] + sg * xp[3] * cs23[3];
                            } else o[n] = xv;
                            o[n] = o[n] * osc;
                        }
                        pg8::u32x4 w; w.x = pg8::cvt_pk_bf16(o[0][0], o[0][1]); w.y = pg8::cvt_pk_bf16(o[0][2], o[0][3]); w.z = pg8::cvt_pk_bf16(o[1][0], o[1][1]); w.w = pg8::cvt_pk_bf16(o[1][2], o[1][3]);
                        *(pg8::u32x4*)(dst + 32 * bj + 8 * fq) = w;
                    }
                    t += (m == 3) ? 80 : 16; asm volatile("" : "+v"(t) :: "memory");
                }
        }
    }
};
struct InProjSched {
    pg8::PlainOrder o; int K, l, ntl, ntc, nlat, total, G, c;
    __device__ __forceinline__ void init(int l_, int G_, int c_) { l = l_; G = G_; c = c_; K = D; ntl = 8; ntc = l_ == 0 ? 9 : 4; nlat = 64 * ntl; total = nlat + 8 * ntc; o.init(64 * 256, ntl * 256, G_, c_); }
    __device__ __forceinline__ bool next(int i, pg8::Unit& u) const {
        const int L = i * G + c; if (L >= total) return false;
        int tile;
        if (L < nlat) { o.next(i, u); tile = u.pn == 0 ? 9 : u.pn + 1; }
        else { const int idx = L - nlat, k = idx % ntc; u.pm = 64 + idx / ntc; tile = l == 0 ? k : (k < 2 ? 2 + k : (k == 2 ? 7 : 8)); u.a_off = 0; u.e = 0; u.cnt = 256; }
        u.pn = tile; u.b_off = (unsigned)(tile * 256 * K) * 2u; return true;
    }
    __device__ __forceinline__ void a_ready(const pg8::Unit&) const {}
    __device__ __forceinline__ unsigned a_row_off(const pg8::Unit& u, int rl, int K_) const {
        if (u.pn <= 1) rl = (rl & 0xc0) | (rl & 15) << 2 | ((rl >> 4) & 3);
        return o.a_row_off(u, rl, K_); }
};
__device__ __forceinline__ void p2_inproj_fast(const Params& p, int l, unsigned char* lds_raw) { PHASE_IDS;
    InProjSched S; S.init(l, gridDim.x, bidx_);
    EpiInProj E{{p.ws, p.q_norm + l * 64, p.k_norm + l * 64}, l};
    pg8::gemm_phase((PG8_LAS unsigned char*)lds_raw, (const bf16_t*)(p.ws + WS_HB), (const bf16_t*)(p.ws + WS_WIN) + (size_t)l * NIN * D, D, S, E);
    if (l == 0) convert_experts_dyn(p, 1, (bf16_t*)(p.ws + WS_Y), (bf16_t*)(p.ws + WS_WD1), 512, 768, 1, tidx, lds_raw); else convert_experts_dyn(p, 1, (bf16_t*)(p.ws + WS_Y), (bf16_t*)(p.ws + WS_WD1), 0, 512, 2, tidx, lds_raw);
}

struct MoeSched {
    const int* list; const int* tab;
    int G, c, total, dup; bool down;
    __device__ __forceinline__ bool next(int i, pg8::Unit& u) const {
        int e, rem;
        if (G == 256) {
            const int x = c & 7, ul = i * 32 + (c >> 3);
            const int n0 = tab[x + 1] - tab[x], n1 = tab[x + 9] - tab[x + 8];
            if (ul < n0) { e = x; rem = ul; } else if (ul < n0 + n1) { e = x + 8; rem = ul - n0; } else return false;
        } else {
            const int L = i * G + c; if (L >= total) return false;
            e = 0;
#pragma unroll
            for (int q = 1; q < NEXP; ++q) if (L >= tab[q]) e = q;
            rem = L - tab[e];
        }
        e = __builtin_amdgcn_readfirstlane(e); rem = __builtin_amdgcn_readfirstlane(rem);
        const int sg = tab[17 + e], cn = tab[33 + e];
        const int mtile = rem >> 2, pn = rem & 3;
        u.pm = mtile; u.pn = pn; u.e = e; u.cnt = __builtin_amdgcn_readfirstlane(cn - mtile * 256); u.a_off = (unsigned)__builtin_amdgcn_readfirstlane(sg + mtile * 256);
        u.b_off = down ? (unsigned)((e * 1024 + pn * 256) * DEXP) * 2u : (unsigned)((e * 1024 + pn * 256) * D) * 2u;
        return true;
    }
    __device__ __forceinline__ unsigned a_row_off(const pg8::Unit& u, int rl, int K) const {
        if (down) return (unsigned)((u.a_off + rl) * K) * 2u;
        const int idx = u.pm * 256 + (rl < u.cnt ? rl : u.cnt - 1);
        const int pair = list[u.e * NTOK + idx];
        return (unsigned)((pair >> 1) * K) * 2u;
    }
};
__device__ __forceinline__ int moe_tables(const unsigned* ctl, int l, int* tab, int tidx) {
    if (tidx == 0) { int u = 0, sgm = 0;
        for (int e = 0; e < NEXP; ++e) { const int n = (int)__hip_atomic_load(ctl + CW_CNT + (l * NEXP + e) * 64, __ATOMIC_RELAXED, __HIP_MEMORY_SCOPE_AGENT); const int mt = (n + 255) >> 8; tab[e] = u; tab[17 + e] = sgm; tab[33 + e] = n; u += mt * 4; sgm += mt * 256; }
        tab[16] = u; }
    __syncthreads();
    return __builtin_amdgcn_readfirstlane(tab[16]);
}
struct EpiGateUp {
    bf16_t* act;
    __device__ __forceinline__ void operator()(f32x4 (&acc)[2][2][4][2], const pg8::Unit& u, int wr, int wc, int fr, int fq) const {
        bf16_t* base = act + (size_t)(u.a_off + wr * 64 + fr) * DEXP + u.pn * 128 + wc * 32 + 8 * fq;
#pragma unroll
        for (int ai = 0; ai < 2; ++ai)
#pragma unroll
            for (int m = 0; m < 4; ++m) {
                f32x4 o[2];
#pragma unroll
                for (int n = 0; n < 2; ++n)
#pragma unroll
                    for (int e = 0; e < 4; ++e) { const float g = acc[ai][0][m][n][e]; o[n][e] = g * __builtin_amdgcn_rcpf(1.f + __expf(-g)) * acc[ai][1][m][n][e]; }
                pg8::u32x4 w; w.x = pg8::cvt_pk_bf16(o[0][0], o[0][1]); w.y = pg8::cvt_pk_bf16(o[0][2], o[0][3]); w.z = pg8::cvt_pk_bf16(o[1][0], o[1][1]); w.w = pg8::cvt_pk_bf16(o[1][2], o[1][3]);
                *(pg8::u32x4*)(base + (size_t)(ai * 128 + m * 16) * DEXP) = w;
            }
    }
};
struct EpiDown {
    bf16_t* Y; const int* list; const f32x4* route;
    __device__ __forceinline__ void operator()(f32x4 (&acc)[2][2][4][2], const pg8::Unit& u, int wr, int wc, int fr, int fq) const {
        asm volatile("" : "+v"(fr), "+v"(fq));
        const int rl0 = wr * 64 + fr;
        const int col = u.pn * 256 + wc * 32 + 8 * fq;
        int pair[8]; float w[8];
#pragma unroll
        for (int i = 0; i < 8; ++i) { const int rl = rl0 + (i >> 2) * 128 + (i & 3) * 16; pair[i] = rl < u.cnt ? list[u.e * NTOK + u.pm * 256 + rl] : -1; }
#pragma unroll
        for (int i = 0; i < 8; ++i) w[i] = pair[i] >= 0 ? ((const float*)(route + (pair[i] >> 1)))[2 + (pair[i] & 1)] : 0.f;
#pragma unroll
        for (int i = 0; i < 8; ++i) {
            if (pair[i] >= 0) {
                bf16_t* dst = Y + (size_t)pair[i] * D + col;
#pragma unroll
                for (int bj = 0; bj < 2; ++bj) { const f32x4 v0 = acc[i >> 2][bj][i & 3][0] * w[i], v1 = acc[i >> 2][bj][i & 3][1] * w[i];
                    pg8::u32x4 o; o.x = pg8::cvt_pk_bf16(v0[0], v0[1]); o.y = pg8::cvt_pk_bf16(v0[2], v0[3]); o.z = pg8::cvt_pk_bf16(v1[0], v1[1]); o.w = pg8::cvt_pk_bf16(v1[2], v1[3]);
                    *(pg8::u32x4*)(dst + bj * 128) = o; }
            }
        }
    }
};
__device__ __forceinline__ void p7_gateup_fast(const Params& p, int l, unsigned char* lds_raw) { PHASE_IDS;
    int* tab = (int*)(lds_raw + LDS_BYTES - 768);
    MoeSched S; S.list = (const int*)(p.ws + WS_LIST) + (size_t)l * NEXP * NTOK; S.tab = tab; S.G = gridDim.x; S.c = bidx_; S.down = false; S.dup = DUPN(9); S.total = moe_tables((const unsigned*)(p.ws + WS_CTL), l, tab, tidx);
    EpiGateUp E{(bf16_t*)(p.ws + WS_ACT)};
    pg8::gemm_phase((PG8_LAS unsigned char*)lds_raw, (const bf16_t*)(p.ws + WS_HB), (const bf16_t*)(p.ws + (l == 0 ? WS_WGU : WS_Y)), D, S, E);
}
__device__ __forceinline__ void p8_down_fast(const Params& p, int l, unsigned char* lds_raw) { PHASE_IDS;
    int* tab = (int*)(lds_raw + LDS_BYTES - 768);
    MoeSched S; S.list = (const int*)(p.ws + WS_LIST) + (size_t)l * NEXP * NTOK; S.tab = tab; S.G = gridDim.x; S.c = bidx_; S.down = true; S.dup = DUPN(10); S.total = moe_tables((const unsigned*)(p.ws + WS_CTL), l, tab, tidx);
    EpiDown E{(bf16_t*)(p.ws + WS_Y), (const int*)(p.ws + WS_LIST) + (size_t)l * NEXP * NTOK, (const f32x4*)(p.ws + WS_ROUTE)};
    pg8::gemm_phase((PG8_LAS unsigned char*)lds_raw, (const bf16_t*)(p.ws + WS_ACT), (const bf16_t*)(p.ws + (l == 0 ? WS_WD : WS_WD1)), DEXP, S, E);
}

struct FnetSched {
    int mtiles, nunits, G, c, dup;
    __device__ __forceinline__ bool next(int i, pg8::Unit& u) const {
        int L = i * G + c; if (L >= nunits * dup) return false; if (L >= nunits) L -= nunits;
        u.e = L / mtiles; u.pm = L % mtiles; u.pn = 0; u.cnt = 256; u.a_off = 0; u.b_off = 0; return true;
    }
    __device__ __forceinline__ unsigned a_row_off(const pg8::Unit& u, int rl, int K) const { return (unsigned)((u.pm * 256 + rl) * K) * 2u; }
};
struct FnetSchedK { FnetSched s; int K;
    __device__ __forceinline__ bool next(int i, pg8::Unit& u) const { if (!s.next(i, u)) return false; u.b_off = (unsigned)(u.e * 256 * K) * 2u; return true; }
    __device__ __forceinline__ unsigned a_row_off(const pg8::Unit& u, int rl, int K_) const { return s.a_row_off(u, rl, K_); }
};
struct EpiFnet {
    bf16_t* mix; int row0, rows_per_b; float scale;
    __device__ __forceinline__ void operator()(f32x4 (&acc)[2][2][4][2], const pg8::Unit& u, int wr, int wc, int fr, int fq) const {
        bf16_t* base = mix + (size_t)(row0 + u.e * rows_per_b + u.pm * 256 + wr * 64 + fr) * D + wc * 32 + 8 * fq;
#pragma unroll
        for (int ai = 0; ai < 2; ++ai)
#pragma unroll
            for (int m = 0; m < 4; ++m)
#pragma unroll
                for (int bj = 0; bj < 2; ++bj) { const f32x4 v0 = acc[ai][bj][m][0] * scale, v1 = acc[ai][bj][m][1] * scale;
                    pg8::u32x4 o; o.x = pg8::cvt_pk_bf16(v0[0], v0[1]); o.y = pg8::cvt_pk_bf16(v0[2], v0[3]); o.z = pg8::cvt_pk_bf16(v1[0], v1[1]); o.w = pg8::cvt_pk_bf16(v1[2], v1[3]);
                    *(pg8::u32x4*)(base + (size_t)(ai * 128 + m * 16) * D + bj * 128) = o; }
    }
};
__device__ __forceinline__ void p3_fnet_fast(const Params& p, int l, unsigned char* lds_raw) { PHASE_IDS;
    if (l == 0) {
        FnetSchedK S; S.s.dup = 1; S.s.mtiles = 1; S.s.nunits = 8; S.s.G = gridDim.x; S.s.c = ((int)gridDim.x - 1 - bidx_); S.K = 512;
        EpiFnet E{(bf16_t*)(p.ws + WS_HB), NL, CTXL, 0.0078125f};
        pg8::gemm_phase((PG8_LAS unsigned char*)lds_raw, (const bf16_t*)(p.ws + WS_DMATC), (const bf16_t*)(p.ws + WS_YFTC), 512, S, E);
    }
}
typedef float f32x16 __attribute__((ext_vector_type(16)));
typedef short s16x4 __attribute__((ext_vector_type(4)));
#define ATTN_THR 8.0f
__device__ __forceinline__ void attn_softmax(f32x16& p0, f32x16& p1, f32x16& o0, f32x16& o1, float& mref, float& lrow, pg8::u32x4 (&pf)[4], bool first) {
    float mx = p0[0];
#pragma unroll
    for (int r = 1; r < 16; ++r) mx = fmaxf(mx, p0[r]);
#pragma unroll
    for (int r = 0; r < 16; ++r) mx = fmaxf(mx, p1[r]);
    { auto rr = __builtin_amdgcn_permlane32_swap(__float_as_uint(mx), __float_as_uint(mx), false, false); mx = fmaxf(__uint_as_float(rr[0]), __uint_as_float(rr[1])); }
    if (first || __any(mx > ATTN_THR)) {
        const float delta = first ? mx : fmaxf(mx, 0.f), alpha = __builtin_amdgcn_exp2f(-delta);
        mref += delta; lrow *= alpha;
#pragma unroll
        for (int r = 0; r < 16; ++r) { p0[r] -= delta; p1[r] -= delta; o0[r] *= alpha; o1[r] *= alpha; }
    }
    float sum = 0.f;
#pragma unroll
    for (int r = 0; r < 16; ++r) { p0[r] = __builtin_amdgcn_exp2f(p0[r]); sum += p0[r]; }
#pragma unroll
    for (int r = 0; r < 16; ++r) { p1[r] = __builtin_amdgcn_exp2f(p1[r]); sum += p1[r]; }
    lrow += sum;
#pragma unroll
    for (int s = 0; s < 2; ++s) {
        pf[s].x = pg8::cvt_pk_bf16(p0[8 * s + 0], p0[8 * s + 1]); pf[s].y = pg8::cvt_pk_bf16(p0[8 * s + 2], p0[8 * s + 3]); pf[s].z = pg8::cvt_pk_bf16(p0[8 * s + 4], p0[8 * s + 5]); pf[s].w = pg8::cvt_pk_bf16(p0[8 * s + 6], p0[8 * s + 7]);
        pf[2 + s].x = pg8::cvt_pk_bf16(p1[8 * s + 0], p1[8 * s + 1]); pf[2 + s].y = pg8::cvt_pk_bf16(p1[8 * s + 2], p1[8 * s + 3]); pf[2 + s].z = pg8::cvt_pk_bf16(p1[8 * s + 4], p1[8 * s + 5]); pf[2 + s].w = pg8::cvt_pk_bf16(p1[8 * s + 6], p1[8 * s + 7]);
    }
}
__device__ __forceinline__ void attn_store(bf16_t* op, const f32x16& o0, const f32x16& o1, float lrow) {
    { auto rr = __builtin_amdgcn_permlane32_swap(__float_as_uint(lrow), __float_as_uint(lrow), false, false); lrow = __uint_as_float(rr[0]) + __uint_as_float(rr[1]); }
    const float inv = 1.f / lrow;
#pragma unroll
    for (int g = 0; g < 4; ++g) {
        pg8::u32x2 w0, w1;
        w0.x = pg8::cvt_pk_bf16(o0[4 * g] * inv, o0[4 * g + 1] * inv); w0.y = pg8::cvt_pk_bf16(o0[4 * g + 2] * inv, o0[4 * g + 3] * inv);
        w1.x = pg8::cvt_pk_bf16(o1[4 * g] * inv, o1[4 * g + 1] * inv); w1.y = pg8::cvt_pk_bf16(o1[4 * g + 2] * inv, o1[4 * g + 3] * inv);
        *(pg8::u32x2*)(op + 8 * g) = w0; *(pg8::u32x2*)(op + 32 + 8 * g) = w1;
    }
}
__device__ __forceinline__ void attn_unit(unsigned char* ws, unsigned char* lds_raw, int b, int kvh, int qrow0, int nkt, int tid) {
    typedef pg8::bf16x8 bf16x8;
    const int lane = tid & 63, wid = __builtin_amdgcn_readfirstlane(tid >> 6), r32 = lane & 31, hi = lane >> 5, h = kvh * 4 + (wid >> 1);
    const bf16_t* AQ = (const bf16_t*)(ws + WS_AQ); const bf16_t* AK = (const bf16_t*)(ws + WS_AK); const bf16_t* AVT = (const bf16_t*)(ws + WS_AVT);
    const int srow = wid * 8 + (lane >> 3), sx = (srow >> 1) & 7, sch = (lane & 7) ^ sx;
    const bf16_t* kg = AK + ((size_t)b * KEYS + srow) * 128 + kvh * 64 + sch * 8;
    const bf16_t* vg = AVT + ((size_t)(b * 2 + kvh) * 64 + srow) * KEYS + sch * 8;
    typedef __attribute__((address_space(3))) unsigned char lds_u8;
    lds_u8* Kb = (lds_u8*)lds_raw; lds_u8* Vb = Kb + 24576;
    const int kx = (r32 >> 1) & 7;
    const int krd = r32 * 128, vrd = r32 * 128 + hi * 8;
    const int qr = qrow0 + (wid & 1) * 64 + r32;
    lds_u8* Ql = Kb + 40960 + wid * 8192 + lane * 16;
    { const bf16_t* qp = AQ + (size_t)qr * 512 + h * 64 + hi * 8;
      bf16x8 qa[4], qb[4];
#pragma unroll
      for (int s = 0; s < 4; ++s) { qa[s] = *(const bf16x8*)(qp + s * 16); qb[s] = *(const bf16x8*)(qp + 32 * 512 + s * 16); }
      __syncthreads();
#pragma unroll
      for (int s = 0; s < 4; ++s) { *(LDSP(bf16x8))(Ql + s * 2048) = qa[s]; *(LDSP(bf16x8))(Ql + s * 2048 + 1024) = qb[s]; } }
    f32x16 oA0 = {}, oA1 = {}, oB0 = {}, oB1 = {};
    float mA = 0.f, lA = 0.f, mB = 0.f, lB = 0.f;
#define ATTN_DMA_K(t, koff) __builtin_amdgcn_global_load_lds((const unsigned*)(kg + (size_t)(t) * 64 * 128), (LDSP(unsigned))(Kb + (koff) + wid * 1024), 16, 0, 0)
#define ATTN_DMA_V(t, voff) __builtin_amdgcn_global_load_lds((const unsigned*)(vg + (t) * 64), (LDSP(unsigned))(Vb + (voff) + wid * 1024), 16, 0, 0)
    ATTN_DMA_K(0, 0); ATTN_DMA_V(0, 0); if (nkt > 1) ATTN_DMA_K(1, 8192);
    __syncthreads();
#define ATTN_QK2(koff) do { asm volatile("" : "+v"(Ql));     \
        { const float nA_ = -mA, nB_ = -mB; _Pragma("unroll") for (int r_ = 0; r_ < 16; ++r_) { pA0[r_] = nA_; pA1[r_] = nA_; pB0[r_] = nB_; pB1[r_] = nB_; } } \
        _Pragma("unroll") for (int s = 0; s < 4; ++s) { \
            const bf16x8 k0 = *(LDSP(const bf16x8))(Kb + (koff) + krd + (((2 * s + hi) ^ kx) << 4)); \
            const bf16x8 k1 = *(LDSP(const bf16x8))(Kb + (koff) + 4096 + krd + (((2 * s + hi) ^ kx) << 4)); \
            const bf16x8 qA = *(LDSP(const bf16x8))(Ql + s * 2048), qB = *(LDSP(const bf16x8))(Ql + s * 2048 + 1024); \
            pA0 = __builtin_amdgcn_mfma_f32_32x32x16_bf16(k0, qA, pA0, 0, 0, 0); \
            pA1 = __builtin_amdgcn_mfma_f32_32x32x16_bf16(k1, qA, pA1, 0, 0, 0); \
            pB0 = __builtin_amdgcn_mfma_f32_32x32x16_bf16(k0, qB, pB0, 0, 0, 0); \
            pB1 = __builtin_amdgcn_mfma_f32_32x32x16_bf16(k1, qB, pB1, 0, 0, 0); \
            asm volatile("" ::: "memory"); } } while (0)
#define ATTN_PV(vcur) do { _Pragma("unroll") for (int ks = 0; ks < 4; ++ks) { \
            const s16x4 a0 = *(LDSP(const s16x4))(Vb + (vcur) + vrd + (((2 * ks) ^ kx) << 4)); \
            const s16x4 a1 = *(LDSP(const s16x4))(Vb + (vcur) + vrd + (((2 * ks + 1) ^ kx) << 4)); \
            const s16x4 c0 = *(LDSP(const s16x4))(Vb + (vcur) + 4096 + vrd + (((2 * ks) ^ kx) << 4)); \
            const s16x4 c1 = *(LDSP(const s16x4))(Vb + (vcur) + 4096 + vrd + (((2 * ks + 1) ^ kx) << 4)); \
            const bf16x8 va = {a0[0], a0[1], a0[2], a0[3], a1[0], a1[1], a1[2], a1[3]}; \
            const bf16x8 vc = {c0[0], c0[1], c0[2], c0[3], c1[0], c1[1], c1[2], c1[3]}; \
            oA0 = __builtin_amdgcn_mfma_f32_32x32x16_bf16(va, __builtin_bit_cast(bf16x8, pfA[ks]), oA0, 0, 0, 0); \
            oA1 = __builtin_amdgcn_mfma_f32_32x32x16_bf16(vc, __builtin_bit_cast(bf16x8, pfA[ks]), oA1, 0, 0, 0); \
            oB0 = __builtin_amdgcn_mfma_f32_32x32x16_bf16(va, __builtin_bit_cast(bf16x8, pfB[ks]), oB0, 0, 0, 0); \
            oB1 = __builtin_amdgcn_mfma_f32_32x32x16_bf16(vc, __builtin_bit_cast(bf16x8, pfB[ks]), oB1, 0, 0, 0); \
            asm volatile("" ::: "memory"); } } while (0)
    pg8::u32x4 pfA[4], pfB[4];
    f32x16 pA0, pA1, pB0, pB1;
    int kc = 0, kn = 8192, kn2 = 16384, vcur = 0;
    if (wid < 4) {
        for (int t = 0; t < nkt; ++t) {
            if (t + 2 < nkt) ATTN_DMA_K(t + 2, kn2);
            if (t + 1 < nkt) ATTN_DMA_V(t + 1, 8192 - vcur);
            ATTN_QK2(kc);
            attn_softmax(pA0, pA1, oA0, oA1, mA, lA, pfA, t == 0);
            attn_softmax(pB0, pB1, oB0, oB1, mB, lB, pfB, t == 0);
            asm volatile("" ::: "memory");
            ATTN_PV(vcur);
            __syncthreads();
            { const int k0_ = kc; kc = kn; kn = kn2; kn2 = k0_; } vcur = 8192 - vcur;
        }
    } else {
        ATTN_QK2(0);
        for (int t = 0; t < nkt; ++t) {
            if (t + 2 < nkt) ATTN_DMA_K(t + 2, kn2);
            if (t + 1 < nkt) ATTN_DMA_V(t + 1, 8192 - vcur);
            attn_softmax(pA0, pA1, oA0, oA1, mA, lA, pfA, t == 0);
            attn_softmax(pB0, pB1, oB0, oB1, mB, lB, pfB, t == 0);
            asm volatile("" ::: "memory");
            ATTN_PV(vcur);
            if (t + 1 < nkt) ATTN_QK2(kn);
            __syncthreads();
            { const int k0_ = kc; kc = kn; kn = kn2; kn2 = k0_; } vcur = 8192 - vcur;
        }
    }
#undef ATTN_DMA_K
#undef ATTN_DMA_V
#undef ATTN_QK2
#undef ATTN_PV
    {
      const int t2 = otid(), l2 = t2 & 63, w2 = __builtin_amdgcn_readfirstlane(t2 >> 6);
      bf16_t* op = (bf16_t*)(ws + WS_HB) + (size_t)(qrow0 + (w2 & 1) * 64 + (l2 & 31)) * D + 512 + (kvh * 4 + (w2 >> 1)) * 64 + 4 * (l2 >> 5);
      attn_store(op, oA0, oA1, lA);
      attn_store(op + (size_t)32 * D, oB0, oB1, lB); }
}
__device__ __forceinline__ void p3_attn_fast(const Params& p, int l, unsigned char* lds_raw) { PHASE_IDS;
    const int G = gridDim.x;
    for (int u = bidx_; u < BATCH * 2 * 16; u += G) { const int rb = u & 15, kvh = (u >> 4) & 1, b = u >> 5; attn_unit(p.ws, lds_raw, b, kvh, b * SEQ + rb * 128, KEYS / 64, tidx); }
    if (l == 0) for (int u = bidx_; u < BATCH * 2 * 2; u += G) { const int rb = u & 1, kvh = (u >> 1) & 1, b = u >> 2; attn_unit(p.ws, lds_raw, b, kvh, NL + b * CTXL + rb * 128, CTXL / 64, tidx); }
}

struct GlaPrep { float cum[16], tot[16], q[16], k[16]; };
struct GlaIn { pg8::u32x4 gd[2], qk[4], gv[2]; };
__device__ __forceinline__ void gla_load(GlaIn& in, const unsigned char* ws, int row0, int h, int w4, int lane, int tg) {
    const int dir = w4 >> 1, kh = w4 & 1, row = row0 + lane;
    const bf16_t* GD = (const bf16_t*)(ws + WS_GD); const bf16_t* GQK = (const bf16_t*)(ws + WS_GQK); const bf16_t* GV = (const bf16_t*)(ws + WS_GV);
    in.gd[0] = *(const pg8::u32x4*)(GD + (size_t)row * 32 + dir * 16); in.gd[1] = *(const pg8::u32x4*)(GD + (size_t)row * 32 + dir * 16 + 8);
    const bf16_t* qp = GQK + (size_t)row * 256 + h * 32 + kh * 16;
    in.qk[0] = *(const pg8::u32x4*)qp; in.qk[1] = *(const pg8::u32x4*)(qp + 8); in.qk[2] = *(const pg8::u32x4*)(qp + 128); in.qk[3] = *(const pg8::u32x4*)(qp + 136);
    const int t = tg >> 2, c = tg & 3;
    in.gv[0] = *(const pg8::u32x4*)(GV + (size_t)(row0 + t) * 256 + h * 64 + 16 * c); in.gv[1] = *(const pg8::u32x4*)(GV + (size_t)(row0 + t) * 256 + h * 64 + 16 * c + 8);
}
__device__ __forceinline__ void gla_prep(GlaPrep& g, const GlaIn& in, const float* wlds, int h, int w4, int lane) {
    const int dir = w4 >> 1, kh = w4 & 1;
    float gd[16];
    { const unsigned w[8] = {in.gd[0].x, in.gd[0].y, in.gd[0].z, in.gd[0].w, in.gd[1].x, in.gd[1].y, in.gd[1].z, in.gd[1].w};
#pragma unroll
      for (int i = 0; i < 8; ++i) { gd[2 * i] = __uint_as_float(w[i] << 16); gd[2 * i + 1] = __uint_as_float(w[i] & 0xffff0000u); } }
    const float* wu = wlds + dir * 2048 + h * 32 + kh * 16;
    const float* bu = wlds + 4096 + dir * 128 + h * 32 + kh * 16;
#pragma unroll
    for (int kk = 0; kk < 16; ++kk) g.cum[kk] = bu[kk];
#pragma unroll
    for (int r = 0; r < 16; ++r) {
#pragma unroll
        for (int kk = 0; kk < 16; ++kk) g.cum[kk] = fmaf(gd[r], wu[r * 128 + kk], g.cum[kk]);
    }
#pragma unroll
    for (int kk = 0; kk < 16; ++kk) { const float z = g.cum[kk]; g.cum[kk] = (fminf(z, 0.f) - __logf(1.f + __expf(-fabsf(z)))) * (1.f / 16.f); }
#pragma unroll
    for (int off = 1; off < 64; off <<= 1) {
        const int src = dir == 0 ? lane - off : lane + off; const bool ok = (unsigned)src < 64u;
#pragma unroll
        for (int kk = 0; kk < 16; ++kk) {
            const float y = __shfl(g.cum[kk], src & 63);
            g.cum[kk] += ok ? y : 0.f;
        }
    }
#pragma unroll
    for (int kk = 0; kk < 16; ++kk) g.tot[kk] = __shfl(g.cum[kk], dir == 0 ? 63 : 0);
    { const unsigned wq[8] = {in.qk[0].x, in.qk[0].y, in.qk[0].z, in.qk[0].w, in.qk[1].x, in.qk[1].y, in.qk[1].z, in.qk[1].w}, wk[8] = {in.qk[2].x, in.qk[2].y, in.qk[2].z, in.qk[2].w, in.qk[3].x, in.qk[3].y, in.qk[3].z, in.qk[3].w};
#pragma unroll
      for (int i = 0; i < 8; ++i) { g.q[2 * i] = __uint_as_float(wq[i] << 16); g.q[2 * i + 1] = __uint_as_float(wq[i] & 0xffff0000u); g.k[2 * i] = __uint_as_float(wk[i] << 16); g.k[2 * i + 1] = __uint_as_float(wk[i] & 0xffff0000u); } }
}
__device__ __forceinline__ void gla_stage_w(float* wlds, const Params& p, int l, int tidx) {
    { f32x4 wv[2]; float bv = 0.f;
#pragma unroll
      for (int j = 0; j < 2; ++j) wv[j] = ((const f32x4*)(p.w_gup + (size_t)l * 4096))[tidx + NTHREADS * j];
      if (tidx < 256) bv = p.b_gg[l * 256 + tidx];
#pragma unroll
      for (int j = 0; j < 2; ++j) ((f32x4*)wlds)[tidx + NTHREADS * j] = wv[j];
      if (tidx < 256) wlds[4096 + tidx] = bv; }
    __syncthreads();
}
__device__ __forceinline__ void gla_write_vt(bf16_t* VT, const GlaIn& in, int tg) {
    const int t = tg >> 2, c = tg & 3;
    const unsigned w[8] = {in.gv[0].x, in.gv[0].y, in.gv[0].z, in.gv[0].w, in.gv[1].x, in.gv[1].y, in.gv[1].z, in.gv[1].w};
#pragma unroll
    for (int i = 0; i < 8; ++i) { VT[(16 * c + 2 * i) * 72 + t] = (bf16_t)(w[i] & 0xffffu); VT[(16 * c + 2 * i + 1) * 72 + t] = (bf16_t)(w[i] >> 16); }
}
__device__ __forceinline__ int gla_row0(int b, int cs) { return cs < 4 ? NL + b * CTXL + cs * 64 : b * SEQ + (cs - 4) * 64; }

__device__ __forceinline__ void p3_gla_local_fast(const Params& p, int l, unsigned char* lds_raw) { PHASE_IDS;
    typedef pg8::bf16x8 bf16x8;
    const int grp = __builtin_amdgcn_readfirstlane(tidx >> 8), tg = tidx & 255, w4 = __builtin_amdgcn_readfirstlane((tidx >> 6) & 3), lane = tidx & 63;
    bf16_t* KT = (bf16_t*)(lds_raw + grp * 32768);
    bf16_t* VT = KT + 2 * 32 * 72;
    float* AST = (float*)(p.ws + WS_AST); float* DEC = (float*)(p.ws + WS_DEC);
    float* wlds = (float*)(lds_raw + 65536); gla_stage_w(wlds, p, l, tidx);
    const int nitems = BATCH * NCHK * 4;
    const int G = gridDim.x, half = G >> 1, npairs = nitems / 2, nup = (G - half) * 4 < npairs ? (G - half) * 4 : npairs;
    const int myfirst = bidx_ >= half ? (bidx_ - half) : nup + bidx_, mystep = bidx_ >= half ? (G - half) : half, myend = bidx_ >= half ? nup : npairs;
    for (int pi = myfirst; pi < myend; pi += mystep) {
        const int it = pi * 2 + grp; const bool valid = it < nitems;
        const int h = it & 3, cs = (it >> 2) % NCHK, b = it / (4 * NCHK);
        const int dir = w4 >> 1, kh = w4 & 1;
        GlaIn in;
        if (valid) gla_load(in, p.ws, gla_row0(b, cs), h, w4, lane, tg);
        __syncthreads();
        if (valid) {
            GlaPrep g; gla_prep(g, in, wlds, h, w4, lane);
#pragma unroll
            for (int kk = 0; kk < 16; ++kk) KT[(dir * 32 + kh * 16 + kk) * 72 + lane] = f2bf(g.k[kk] * __expf(g.tot[kk] - g.cum[kk]));
            if (lane == 0) {
#pragma unroll
                for (int kk = 0; kk < 16; ++kk) DEC[((size_t)it * 2 + dir) * 32 + kh * 16 + kk] = __expf(g.tot[kk]);
            }
            gla_write_vt(VT, in, tg);
        }
        __syncthreads();
        if (valid) {
            const int r = lane & 15, q4 = lane >> 4, kt = kh;
            float* dst = AST + ((size_t)it * 2 + dir) * 2048;
#pragma unroll
            for (int vt = 0; vt < 4; ++vt) {
                f32x4 acc = {0.f, 0.f, 0.f, 0.f};
#pragma unroll
                for (int ks = 0; ks < 2; ++ks) {
                    const bf16x8 a = *(const bf16x8*)(KT + (dir * 32 + kt * 16 + r) * 72 + ks * 32 + q4 * 8);
                    const bf16x8 bb = *(const bf16x8*)(VT + (vt * 16 + r) * 72 + ks * 32 + q4 * 8);
                    acc = __builtin_amdgcn_mfma_f32_16x16x32_bf16(a, bb, acc, 0, 0, 0);
                }
                *(f32x4*)(dst + (vt * 16 + r) * 32 + kt * 16 + q4 * 4) = acc;
            }
        }
    }
}
__device__ __forceinline__ void p3_gla_scan_fast(const Params& p) { PHASE_IDS;
    const float* AST = (const float*)(p.ws + WS_AST); const float* DEC = (const float*)(p.ws + WS_DEC);
    bf16_t* ST = (bf16_t*)(p.ws + WS_ST);
    for (int i = GT; i < BATCH * 4 * 2 * 2048; i += NGT) {
        const int e = i & 2047, dir = (i >> 11) & 1, h = (i >> 12) & 3, b = i >> 14, k = e & 31;
        float a[NCHK], d[NCHK];
#pragma unroll
        for (int q = 0; q < NCHK; ++q) { const int cs = dir == 0 ? q : (q < 4 ? 3 - q : NCHK + 3 - q); const size_t id = (((size_t)b * NCHK + cs) * 4 + h) * 2 + dir; a[q] = AST[id * 2048 + e]; d[q] = DEC[id * 32 + k]; }
        float s = 0.f;
#pragma unroll
        for (int q = 0; q < NCHK; ++q) { const int cs = dir == 0 ? q : (q < 4 ? 3 - q : NCHK + 3 - q); const size_t id = (((size_t)b * NCHK + cs) * 4 + h) * 2 + dir; ST[id * 2048 + e] = f2bf(s); s = d[q] * s + a[q]; }
    }
}
__device__ __forceinline__ void p4_gla_out_fast(const Params& p, int l, unsigned char* lds_raw) { PHASE_IDS;
    typedef pg8::bf16x8 bf16x8;
    const int grp = __builtin_amdgcn_readfirstlane(tidx >> 8), tg = tidx & 255, w4 = __builtin_amdgcn_readfirstlane((tidx >> 6) & 3), lane = tidx & 63;
    bf16_t* QT = (bf16_t*)(lds_raw + grp * 58368);
    bf16_t* KL = QT + 2 * 64 * 40;
    bf16_t* SL = KL + 2 * 64 * 40;
    bf16_t* VT = SL + 2 * 64 * 40;
    bf16_t* ATT = VT + 64 * 72;
    bf16_t* GL = ATT + 64 * 72;
    const bf16_t* ST = (const bf16_t*)(p.ws + WS_ST); const bf16_t* GG = (const bf16_t*)(p.ws + WS_GG);
    bf16_t* MIX = (bf16_t*)(p.ws + WS_HB);
    float* wlds = (float*)(lds_raw + 116736); gla_stage_w(wlds, p, l, tidx);
    const int cs0 = l == 1 ? 4 : 0, ncs = NCHK - cs0, nitems = BATCH * ncs * 4;
    for (int pi = bidx_; pi * 2 < nitems; pi += gridDim.x) {
        const int itl = pi * 2 + grp; const bool valid = itl < nitems;
        const int h = itl & 3, cs = cs0 + (itl >> 2) % ncs, b = itl / (4 * ncs);
        const int it = (b * NCHK + cs) * 4 + h;
        const int dir = w4 >> 1, kh = w4 & 1;
        const int row0 = gla_row0(b, cs);
        GlaIn in; pg8::u32x4 st[2], gg[2];
        const int gr = tg >> 2, gc = tg & 3;
        if (valid) {
            gla_load(in, p.ws, row0, h, w4, lane, tg);
#pragma unroll
            for (int j = 0; j < 2; ++j) { const int pc = tg + 256 * j, d2 = pc >> 8, v = (pc >> 2) & 63, c = pc & 3; st[j] = *(const pg8::u32x4*)(ST + ((size_t)it * 2 + d2) * 2048 + v * 32 + c * 8); }
            gg[0] = *(const pg8::u32x4*)(GG + (size_t)(row0 + gr) * 256 + h * 64 + 16 * gc); gg[1] = *(const pg8::u32x4*)(GG + (size_t)(row0 + gr) * 256 + h * 64 + 16 * gc + 8);
        }
        __syncthreads();
        if (valid) {
            GlaPrep g; gla_prep(g, in, wlds, h, w4, lane);
            pg8::u32x4 wq[2], wk[2];
#pragma unroll
            for (int i = 0; i < 8; ++i) {
                const float e0 = __expf(g.cum[2 * i]), e1 = __expf(g.cum[2 * i + 1]);
                ((unsigned*)wq)[i] = pg8::cvt_pk_bf16(g.q[2 * i] * e0, g.q[2 * i + 1] * e1);
                ((unsigned*)wk)[i] = pg8::cvt_pk_bf16(g.k[2 * i] * __builtin_amdgcn_rcpf(e0), g.k[2 * i + 1] * __builtin_amdgcn_rcpf(e1));
            }
            *(pg8::u32x4*)(QT + (dir * 64 + lane) * 40 + kh * 16) = wq[0]; *(pg8::u32x4*)(QT + (dir * 64 + lane) * 40 + kh * 16 + 8) = wq[1];
            *(pg8::u32x4*)(KL + (dir * 64 + lane) * 40 + kh * 16) = wk[0]; *(pg8::u32x4*)(KL + (dir * 64 + lane) * 40 + kh * 16 + 8) = wk[1];
            gla_write_vt(VT, in, tg);
#pragma unroll
            for (int j = 0; j < 2; ++j) { const int pc = tg + 256 * j, d2 = pc >> 8, v = (pc >> 2) & 63, c = pc & 3; *(pg8::u32x4*)(SL + (d2 * 64 + v) * 40 + c * 8) = st[j]; }
            *(pg8::u32x4*)(GL + gr * 72 + 16 * gc) = gg[0]; *(pg8::u32x4*)(GL + gr * 72 + 16 * gc + 8) = gg[1];
        }
        __syncthreads();
        if (valid) {
            const int r = lane & 15, q4 = lane >> 4, i0 = 16 * w4;
            const bf16x8 aF = *(const bf16x8*)(QT + (0 * 64 + i0 + r) * 40 + q4 * 8), aB = *(const bf16x8*)(QT + (1 * 64 + i0 + r) * 40 + q4 * 8);
#pragma unroll
            for (int jt = 0; jt < 4; ++jt) {
                const bf16x8 bF = *(const bf16x8*)(KL + (0 * 64 + jt * 16 + r) * 40 + q4 * 8), bB = *(const bf16x8*)(KL + (1 * 64 + jt * 16 + r) * 40 + q4 * 8);
                const f32x4 z = {0.f, 0.f, 0.f, 0.f};
                const f32x4 F = __builtin_amdgcn_mfma_f32_16x16x32_bf16(aF, bF, z, 0, 0, 0), Bv = __builtin_amdgcn_mfma_f32_16x16x32_bf16(aB, bB, z, 0, 0, 0);
                const int j = jt * 16 + r;
#pragma unroll
                for (int e = 0; e < 4; ++e) { const int i = i0 + 4 * q4 + e; const float v = (j <= i ? F[e] : 0.f) + (j >= i ? Bv[e] : 0.f); ATT[i * 72 + j] = f2bf(v); }
            }
            __builtin_amdgcn_s_waitcnt(0);
            f32x4 o[4];
#pragma unroll
            for (int vt = 0; vt < 4; ++vt) {
                f32x4 acc = {0.f, 0.f, 0.f, 0.f};
#pragma unroll
                for (int ks = 0; ks < 2; ++ks) {
                    const bf16x8 a = *(const bf16x8*)(ATT + (i0 + r) * 72 + ks * 32 + q4 * 8);
                    const bf16x8 bb = *(const bf16x8*)(VT + (vt * 16 + r) * 72 + ks * 32 + q4 * 8);
                    acc = __builtin_amdgcn_mfma_f32_16x16x32_bf16(a, bb, acc, 0, 0, 0);
                }
                const bf16x8 sF = *(const bf16x8*)(SL + (0 * 64 + vt * 16 + r) * 40 + q4 * 8), sB = *(const bf16x8*)(SL + (1 * 64 + vt * 16 + r) * 40 + q4 * 8);
                acc = __builtin_amdgcn_mfma_f32_16x16x32_bf16(aF, sF, acc, 0, 0, 0);
                acc = __builtin_amdgcn_mfma_f32_16x16x32_bf16(aB, sB, acc, 0, 0, 0);
                o[vt] = acc;
            }
            float gn[4];
#pragma unroll
            for (int vt = 0; vt < 4; ++vt) gn[vt] = p.gla_norm[l * 64 + vt * 16 + r];
#pragma unroll
            for (int e = 0; e < 4; ++e) {
                float ss = o[0][e] * o[0][e] + o[1][e] * o[1][e] + o[2][e] * o[2][e] + o[3][e] * o[3][e];
                ss += __shfl_xor(ss, 1); ss += __shfl_xor(ss, 2); ss += __shfl_xor(ss, 4); ss += __shfl_xor(ss, 8);
                const float rs = rsqrtf(ss * (1.f / 64.f) + EPS);
                bf16_t* gl = GL + (i0 + 4 * q4 + e) * 72 + r;
#pragma unroll
                for (int vt = 0; vt < 4; ++vt) { const float gt = bf2f(gl[vt * 16]); gl[vt * 16] = f2bf(o[vt][e] * rs * gn[vt] * gt * __builtin_amdgcn_rcpf(1.f + __expf(-gt))); }
            }
        }
        __syncthreads();
        if (valid) { *(pg8::u32x4*)(MIX + (size_t)(row0 + gr) * D + 256 + h * 64 + 16 * gc) = *(const pg8::u32x4*)(GL + gr * 72 + 16 * gc); *(pg8::u32x4*)(MIX + (size_t)(row0 + gr) * D + 256 + h * 64 + 16 * gc + 8) = *(const pg8::u32x4*)(GL + gr * 72 + 16 * gc + 8); }
    }
}

constexpr size_t TAB_M1 = 16384, TAB_M2 = 24576, TAB_EC = 40960;
__device__ __forceinline__ void p3_fnet_fft(const Params& p, unsigned char* lds_raw) { PHASE_IDS;
    typedef pg8::bf16x8 bf16x8;
    const int lane = tidx & 63, w = __builtin_amdgcn_readfirstlane(tidx >> 6), j = lane & 15, q4 = lane >> 4;
    const float* TAB = (const float*)(p.ws + WS_TAB);
    const bf16_t* M1g = (const bf16_t*)(p.ws + WS_TAB + TAB_M1); const bf16_t* M2g = (const bf16_t*)(p.ws + WS_TAB + TAB_M2); const bf16_t* ECg = (const bf16_t*)(p.ws + WS_TAB + TAB_EC);
    const bf16_t* U = (const bf16_t*)(p.ws + WS_YFTL);
    bf16_t* MIX = (bf16_t*)(p.ws + WS_HB);
    const float scale = 0.0027621358640099515f;
    for (int it = bidx_; it < BATCH * 16; it += gridDim.x) {
        const int b = it >> 4, jb = it & 15;
        const bf16_t* M1 = M1g; const bf16_t* M2 = M2g; const bf16_t* EC = ECg; asm volatile("" : "+s"(M1), "+s"(M2), "+s"(EC));
        __syncthreads();
        {
            bf16x8 a1[4][2];
#pragma unroll
            for (int mt = 0; mt < 4; ++mt)
#pragma unroll
                for (int ks = 0; ks < 2; ++ks) a1[mt][ks] = *(const bf16x8*)(M1 + (16 * mt + j) * 64 + ks * 32 + 8 * q4);
            bf16x8 ec[2][2];
#pragma unroll
            for (int part = 0; part < 2; ++part)
#pragma unroll
                for (int ks = 0; ks < 2; ++ks) ec[part][ks] = *(const bf16x8*)(EC + part * 4096 + (16 * (jb & 3) + j) * 64 + ks * 32 + 8 * q4);
            const bf16_t* ub = U + ((size_t)b * SEQ + 64 * j + 8 * w) * 256 + (jb >> 2) * 64 + 8 * q4;
#pragma unroll
            for (int half = 0; half < 2; ++half) {
                bf16x8 ua[4][2][2];
#pragma unroll
                for (int ci = 0; ci < 4; ++ci)
#pragma unroll
                    for (int tl = 0; tl < 2; ++tl)
#pragma unroll
                        for (int ks = 0; ks < 2; ++ks) ua[ci][tl][ks] = *(const bf16x8*)(ub + (size_t)(1024 * tl + 4 * half + ci) * 256 + ks * 32);
                bf16x8 y[4][2];
#pragma unroll
                for (int ci = 0; ci < 4; ++ci)
#pragma unroll
                    for (int part = 0; part < 2; ++part) { f32x4 d[2];
#pragma unroll
                        for (int tl = 0; tl < 2; ++tl) { d[tl] = (f32x4){0.f, 0.f, 0.f, 0.f};
#pragma unroll
                            for (int ks = 0; ks < 2; ++ks) d[tl] = __builtin_amdgcn_mfma_f32_16x16x32_bf16(ua[ci][tl][ks], ec[part][ks], d[tl], 0, 0, 0); }
                        pg8::u32x4 pk; pk.x = pg8::cvt_pk_bf16_c(d[0][0], d[0][1]); pk.y = pg8::cvt_pk_bf16_c(d[0][2], d[0][3]); pk.z = pg8::cvt_pk_bf16_c(d[1][0], d[1][1]); pk.w = pg8::cvt_pk_bf16_c(d[1][2], d[1][3]);
                        y[ci][part] = __builtin_bit_cast(bf16x8, pk); }
                unsigned zp[2][2][4][2];
#pragma unroll
                for (int cp = 0; cp < 2; ++cp) {
                    float zr[2][2][4], zi[2][2][4];
#pragma unroll
                    for (int cq = 0; cq < 2; ++cq) {
                        const int ci = 2 * cp + cq; int c = 8 * w + 4 * half + ci; asm volatile("" : "+s"(c));
                        f32x4 acc[4];
#pragma unroll
                        for (int mt = 0; mt < 4; ++mt) { acc[mt] = (f32x4){0.f, 0.f, 0.f, 0.f};
#pragma unroll
                            for (int ks = 0; ks < 2; ++ks) acc[mt] = __builtin_amdgcn_mfma_f32_16x16x32_bf16(a1[mt][ks], y[ci][ks], acc[mt], 0, 0, 0); }
#pragma unroll
                        for (int m1 = 0; m1 < 2; ++m1)
#pragma unroll
                            for (int e = 0; e < 4; ++e) {
                                const int k1 = 16 * m1 + 4 * q4 + e, idx = k1 * c;
                                const float cs = TAB[idx], sn = TAB[(idx - 512) & 2047];
                                const float re = acc[m1][e], im = acc[2 + m1][e];
                                zr[cq][m1][e] = re * cs + im * sn; zi[cq][m1][e] = im * cs - re * sn;
                            }
                        asm volatile("" ::: "memory");
                    }
#pragma unroll
                    for (int m1 = 0; m1 < 2; ++m1)
#pragma unroll
                        for (int e = 0; e < 4; ++e) { zp[0][m1][e][cp] = pg8::cvt_pk_bf16(zr[0][m1][e], zr[1][m1][e]); zp[1][m1][e][cp] = pg8::cvt_pk_bf16(zi[0][m1][e], zi[1][m1][e]); }
                }
#pragma unroll
                for (int ri = 0; ri < 2; ++ri)
#pragma unroll
                    for (int m1 = 0; m1 < 2; ++m1)
#pragma unroll
                        for (int e = 0; e < 4; ++e) { const int k1 = 16 * m1 + 4 * q4 + e;
                            *(pg8::u32x2*)(lds_raw + ((ri * 32 + k1) * 16 + j) * 128 + ((w ^ ((j >> 1) & 7)) << 4) + half * 8) = (pg8::u32x2){zp[ri][m1][e][0], zp[ri][m1][e][1]}; }
                asm volatile("" ::: "memory");
            }
        }
        __syncthreads();
        {
            bf16x8 a2[4][4];
#pragma unroll
            for (int mt = 0; mt < 4; ++mt)
#pragma unroll
                for (int ks = 0; ks < 4; ++ks) a2[mt][ks] = *(const bf16x8*)(M2 + (16 * mt + j) * 128 + ks * 32 + 8 * q4);
#pragma unroll
            for (int kq = 0; kq < 4; ++kq) {
                const int k1 = 4 * w + kq;
                bf16x8 zb[4];
#pragma unroll
                for (int ks = 0; ks < 4; ++ks) zb[ks] = *(const bf16x8*)(lds_raw + (((ks >> 1) * 32 + k1) * 16 + j) * 128 + (((4 * (ks & 1) + q4) ^ ((j >> 1) & 7)) << 4));
                bf16_t* op = MIX + ((size_t)b * SEQ + k1 + 128 * q4) * D + 16 * jb + j;
#pragma unroll
                for (int mt = 0; mt < 4; ++mt) {
                    f32x4 acc = {0.f, 0.f, 0.f, 0.f};
#pragma unroll
                    for (int ks = 0; ks < 4; ++ks) acc = __builtin_amdgcn_mfma_f32_16x16x32_bf16(a2[mt][ks], zb[ks], acc, 0, 0, 0);
#pragma unroll
                    for (int e = 0; e < 4; ++e) op[(size_t)(32 * e) * D] = f2bf(acc[e] * scale);
                    op += (size_t)512 * D; asm volatile("" : "+v"(op) :: "memory");
                }
            }
        }
    }
}

#define STAMPG(n) do { if ((PROBE_A == (n) || PROBE_B == (n)) && blockIdx.x == 0 && threadIdx.x == 0) ((volatile unsigned long long*)(lds_raw + LDS_BYTES - 512))[PROBE_B == (n) ? 1 : 0] = __builtin_amdgcn_s_memrealtime(); } while (0)
#define LAS __attribute__((address_space(3)))
__host__ __device__ __forceinline__ int tile_pos(int lc) { return 128 * ((lc >> 5) & 1) + 32 * (lc >> 6) + (lc & 31); }
__device__ __forceinline__ int inproj_dest(int c) {
    int T, lc;
    if (c < C_GQ) { T = 9; lc = c; } else if (c < C_GV) { T = 2; lc = c - C_GQ; } else if (c < C_GG) { T = 3; lc = c - C_GV; } else if (c < C_GDF) { T = 4; lc = c - C_GG; }
    else if (c < C_AQ) { T = 8; lc = c - C_GDF; } else if (c < C_AQ + 256) { T = 5; lc = c - C_AQ; } else if (c < C_AK) { T = 6; lc = c - C_AQ - 256; } else { T = 7; lc = c - C_AK; }
    return T * 256 + tile_pos(lc);
}
__device__ __forceinline__ void p0a_fast(const Params& p, float* lds) { PHASE_IDS;
    const int lane = tidx & 63, wave = tidx >> 6;
    float* scr = lds + wave * 2304;
    bf16_t* WIN = (bf16_t*)(p.ws + WS_WIN); bf16_t* WOUT = (bf16_t*)(p.ws + WS_WOUT);
    {
        unsigned char* lds_b = (unsigned char*)lds;
        const int j = tidx & 15, r0 = tidx >> 4;
        for (int t = bidx_; t < 192; t += gridDim.x) {
            const bool isin = t < 128; const int q = isin ? t : t - 128;
            const int l = isin ? q >> 6 : q >> 5, kt = isin ? (q >> 3) & 7 : (q >> 2) & 7, nt = isin ? q & 7 : q & 3;
            const int ldw = isin ? DIN : D, n4 = nt * 256 + 4 * lane;
            const float* src = (isin ? p.w_in + (size_t)l * D * DIN : p.w_out + (size_t)l * D * D) + (size_t)(kt * 128 + 16 * wave) * ldw + (n4 < ldw ? n4 : 0);
            f32x4 v[16];
            cb_load(v, src, ldw);
            cb_to_lds(v, lds_b, wave, lane);
            __syncthreads();
#pragma unroll
            for (int i = 0; i < 8; ++i) { const int r = r0 + 32 * i, n = nt * 256 + r;
                const pg8::u32x4 x = *(LDSP(pg8::u32x4))(lds_b + r * CB_RS + 16 * j);
                if (n < ldw) { bf16_t* dst = isin ? WIN + ((size_t)l * NIN + inproj_dest(n)) * D : WOUT + ((size_t)l * D + n) * D; *(pg8::u32x4*)(dst + kt * 128 + 8 * j) = x; } }
            __syncthreads();
        }
    }
    STAMPG(42);
    { float sn, cs; sincos_r((float)lane * 0.09817477042468103f, sn, cs); scr[2 * lane] = cs; scr[2 * lane + 1] = sn; }
    float* tile = scr + 128;
    for (int it = GW; it < 16 * 4 * 16; it += NGW) {
        const int jq = it & 15, g = (it >> 4) & 3, kb = (it >> 6) & 15, l = 0;
        const float* W = p.w_in + (size_t)l * D * DIN;
        float yr[4], ys[4];
#pragma unroll
        for (int jj = 0; jj < 4; ++jj) { yr[jj] = 0.f; ys[jj] = 0.f; }
        for (int half = 0; half < 2; ++half) {
            __builtin_amdgcn_s_waitcnt(0); asm volatile("" ::: "memory");
            { float tv[32];
#pragma unroll
              for (int i = 0; i < 32; ++i) { const int kk = 2 * i + (lane >> 5); tv[i] = W[(size_t)(kb * 64 + kk) * DIN + g * 64 + half * 32 + (lane & 31)]; }
#pragma unroll
              for (int i = 0; i < 32; ++i) { const int kk = 2 * i + (lane >> 5); tile[kk * 33 + (lane & 31)] = tv[i]; } }
            __builtin_amdgcn_s_waitcnt(0); asm volatile("" ::: "memory");
#pragma unroll 4
            for (int cc = 0; cc < 32; ++cc) {
                const float u = tile[lane * 33 + cc]; const int c = half * 32 + cc;
#pragma unroll
                for (int jj = 0; jj < 4; ++jj) { const int m = ((jq * 4 + jj) * c) & 63; yr[jj] = fmaf(u, scr[2 * m], yr[jj]); ys[jj] = fmaf(u, scr[2 * m + 1], ys[jj]); }
            }
        }
#pragma unroll
        for (int jj = 0; jj < 4; ++jj) { const int j = jq * 4 + jj; const size_t row = (size_t)l * NIN + tile_pos(g * 64 + j);
            WIN[(row) * D + kb * 64 + lane] = f2bf(yr[jj]); WIN[(row + 256) * D + kb * 64 + lane] = f2bf(ys[jj]); }
    }
    STAMPG(43);
    for (int i = GT; i < 2 * 224 * (D / 8); i += NGT) {
        const int k8 = i & 127, lc = 32 + (i >> 7) % 224, l = i / (224 * 128);
        *(pg8::u32x4*)(WIN + ((size_t)l * NIN + 8 * 256 + tile_pos(lc)) * D + k8 * 8) = (pg8::u32x4){0u, 0u, 0u, 0u};
    }
    {
        bf16_t* DC = (bf16_t*)(p.ws + WS_DMATC);
        for (int i = GT; i < 256 * 512 / 8; i += NGT) {
            const int t8 = (i & 63) * 8, k = i >> 6; unsigned w[4];
#pragma unroll
            for (int q = 0; q < 4; ++q) { float v[2];
#pragma unroll
                for (int e = 0; e < 2; ++e) { const int tt = t8 + 2 * q + e, t = tt & 255; const int m = (k * t) & 255; float sn, cs; sincos_r((float)m * (6.283185307179586f / 256.f), sn, cs); v[e] = tt < 256 ? cs : -sn; }
                w[q] = pg8::cvt_pk_bf16(v[0], v[1]); }
            *(pg8::u32x4*)(DC + (size_t)k * 512 + t8) = (pg8::u32x4){w[0], w[1], w[2], w[3]};
        }
    }
    STAMPG(44);
}

#define XB_TMO      128
#define XB_XCNT(j)  (256  + 64 * (j))
#define XB_XSUB(j)  (1280 + 64 * (j))
#define XB_XGEN(j)  (2304 + 64 * (j))
#define XB_TOP      3328
#define XB_TOPGEN   3392
#define XCD_BAR_WORDS 3456
#define XB_SPIN_CAP (1u << 18)
__device__ __forceinline__ unsigned xb_ld(unsigned* p)              { return __hip_atomic_load(p, __ATOMIC_RELAXED, __HIP_MEMORY_SCOPE_AGENT); }
__device__ __forceinline__ unsigned xb_add(unsigned* p, unsigned v) { return __hip_atomic_fetch_add(p, v, __ATOMIC_RELAXED, __HIP_MEMORY_SCOPE_AGENT); }
__device__ __forceinline__ unsigned xb_xcc_id() { return (unsigned)__builtin_amdgcn_s_getreg((3 << 11) | 20) & 0xFu; }
#define XB_SPIN(cond, bar) do { unsigned _sp = 0; while (cond) { __builtin_amdgcn_s_sleep(1); \
    if ((++_sp & 255u) == 0u) { if (xb_ld(&(bar)[XB_TMO])) break; if (_sp > XB_SPIN_CAP) { atomicAdd(&(bar)[XB_TMO], 1u); break; } } } } while (0)
struct XcdBarrier { unsigned* bar; unsigned x; volatile __attribute__((address_space(3))) unsigned* st; };
__device__ __forceinline__ XcdBarrier xcd_barrier_post(unsigned* bar, volatile __attribute__((address_space(3))) unsigned* st) {
    XcdBarrier b; b.bar = bar; b.x = xb_xcc_id(); b.st = st;
    if (otid() == 0) (void)xb_add(&bar[XB_XCNT(b.x)], 1u);
    return b;
}
__device__ __forceinline__ void xcd_barrier_complete(unsigned* bar, unsigned x, unsigned& nloc, unsigned& nx) {
    const unsigned G = gridDim.x * gridDim.y * gridDim.z;
    unsigned sum, cnt, mine, sp = 0u;
    for (;;) {
        sum = 0u; cnt = 0u; mine = 0u;
#pragma unroll
        for (unsigned j = 0; j < 16; ++j) { const unsigned c = xb_ld(&bar[XB_XCNT(j)]); sum += c; cnt += (c > 0u) ? 1u : 0u; mine = (j == x) ? c : mine; }
        if (sum == G) break;
        __builtin_amdgcn_s_sleep(1);
        if ((++sp & 255u) == 0u) { if (xb_ld(&bar[XB_TMO])) break; if (sp > XB_SPIN_CAP) { atomicAdd(&bar[XB_TMO], 1u); break; } }
    }
    nloc = mine > 0u ? mine : 1u; nx = cnt > 0u ? cnt : 1u;
}
__device__ __forceinline__ void xcd_barrier(const XcdBarrier& b) {
    asm volatile("s_waitcnt vmcnt(0)" ::: "memory");
    __syncthreads();
    if (otid() == 0) {
        unsigned* bar = b.bar;
        __builtin_amdgcn_s_waitcnt(0);
        unsigned nloc = b.st[0], nx = b.st[1];
        if (nloc == 0u) { xcd_barrier_complete(bar, b.x, nloc, nx); b.st[0] = nloc; b.st[1] = nx; }
        const unsigned old = xb_add(&bar[XB_XSUB(b.x)], 1u);
        const unsigned gen = old / nloc;
        if (old + 1u == (gen + 1u) * nloc) {
            __builtin_amdgcn_fence(__ATOMIC_RELEASE, "agent");
            asm volatile("s_waitcnt vmcnt(0)" ::: "memory");
            const unsigned og = xb_add(&bar[XB_TOP], 1u);
            const unsigned tg = og / nx;
            if (og + 1u == (tg + 1u) * nx) xb_add(&bar[XB_TOPGEN], 1u);
            else XB_SPIN(xb_ld(&bar[XB_TOPGEN]) == tg, bar);
            __builtin_amdgcn_fence(__ATOMIC_ACQUIRE, "agent");
            xb_add(&bar[XB_XGEN(b.x)], 1u);
            asm volatile("s_waitcnt vmcnt(0)" ::: "memory");
        } else {
            XB_SPIN(xb_ld(&bar[XB_XGEN(b.x)]) == gen, bar);
            __builtin_amdgcn_fence(__ATOMIC_ACQUIRE, "agent");
            asm volatile("s_waitcnt vmcnt(0)" ::: "memory");
        }
    }
    __syncthreads();
}

__global__ void __launch_bounds__(NTHREADS) mega(Params p) {
    if ((threadIdx.x & 63) == 0) ((volatile __attribute__((address_space(3))) int*)((__attribute__((address_space(3))) unsigned char*)lds_raw + WTAB_OFF))[hw_wave_slot()] = threadIdx.x >> 6;
    __syncthreads();
    float* lds = (float*)lds_raw;
    cg::grid_group grid = cg::this_grid();
    volatile __attribute__((address_space(3))) unsigned* bst = (volatile __attribute__((address_space(3))) unsigned*)((__attribute__((address_space(3))) unsigned char*)lds_raw + LDS_BYTES - 1024);
    { const int t0_ = otid(); if (t0_ < 2) bst[t0_] = 0u; }
    __syncthreads();
    const XcdBarrier bar = xcd_barrier_post((unsigned*)(p.ws + WS_CTL), bst);
#define GSYNC() xcd_barrier(bar)
    volatile unsigned long long* tst = (volatile unsigned long long*)(lds_raw + LDS_BYTES - 512);
#define STAMP(n) do { if ((PROBE_A == (n) || PROBE_B == (n)) && blockIdx.x == 0 && threadIdx.x == 0) tst[PROBE_B == (n) ? 1 : 0] = __builtin_amdgcn_s_memrealtime(); } while (0)
    STAMP(0);
    p0a(p, lds); __syncthreads(); STAMP(40); p0a_fast(p, lds); STAMP(45); grid.sync(); STAMP(1);
    p0b(p); GSYNC(); STAMP(2);
#define LAYER(l) do { p1_norm1(p, l); GSYNC(); STAMP(3 + 9 * (l)); \
        p2_inproj_fast(p, l, lds_raw); GSYNC(); STAMP(4 + 9 * (l)); \
        p3_fnet_fft(p, lds_raw); __syncthreads(); STAMP(30 + 3 * (l)); p3_fnet_fast(p, l, lds_raw); __syncthreads(); STAMP(31 + 3 * (l)); p3_gla_local_fast(p, l, lds_raw); __syncthreads(); STAMP(32 + 3 * (l)); p3_attn_fast(p, l, lds_raw); GSYNC(); STAMP(5 + 9 * (l)); \
        p3_gla_scan_fast(p); GSYNC(); STAMP(6 + 9 * (l)); p4_gla_out_fast(p, l, lds_raw); GSYNC(); STAMP(7 + 9 * (l)); \
        p5_outproj_fast(p, l, lds_raw); GSYNC(); STAMP(8 + 9 * (l)); p6_norm2_router(p, l, lds); GSYNC(); STAMP(9 + 9 * (l)); \
        p7_gateup_fast(p, l, lds_raw); GSYNC(); STAMP(10 + 9 * (l)); p8_down_fast(p, l, lds_raw); GSYNC(); STAMP(11 + 9 * (l)); } while (0)
    LAYER(0);
    LAYER(1);
#undef LAYER
    p9_final(p);
    if (PROBE_A >= 0) { __syncthreads(); if (blockIdx.x == 0 && threadIdx.x == 0) { if (PROBE_B == 21) tst[1] = __builtin_amdgcn_s_memrealtime(); const unsigned long long dt = (tst[1] - tst[0]) * PROBE_K, t0 = __builtin_amdgcn_s_memrealtime(); while (__builtin_amdgcn_s_memrealtime() - t0 < dt) __builtin_amdgcn_s_sleep(8); } }
}

extern "C" void kernel_launch(void* const* d_in, const int* in_sizes, int n_in, void* d_out, int out_size, void* d_ws, size_t ws_size, hipStream_t stream) {
    static int grid_blocks = 0;
    if (!grid_blocks) {
        int dev = 0, cus = 0, per_cu = 0;
        hipGetDevice(&dev);
        hipDeviceGetAttribute(&cus, hipDeviceAttributeMultiprocessorCount, dev);
        hipFuncSetAttribute((const void*)mega, hipFuncAttributeMaxDynamicSharedMemorySize, LDS_BYTES);
        hipOccupancyMaxActiveBlocksPerMultiprocessor(&per_cu, (const void*)mega, NTHREADS, LDS_BYTES);
        if (per_cu < 1) { fprintf(stderr, "occupancy query says %d blocks/CU\n", per_cu); per_cu = 1; }
        grid_blocks = cus;
        if (n_in != 21 || ws_size < WS_END) fprintf(stderr, "unexpected n_in %d / ws_size %zu\n", n_in, ws_size);
    }
    hipMemsetAsync((char*)d_ws + WS_CTL, 0, 65536, stream);
    Params p{};
    const float** f = (const float**)&p;
    for (int i = 0; i < 21; ++i) f[i] = (const float*)d_in[i];
    p.out = (float*)d_out; p.ws = (unsigned char*)d_ws;
    void* args[] = {&p};
    hipError_t e = hipLaunchCooperativeKernel((const void*)mega, dim3(grid_blocks), dim3(NTHREADS), args, LDS_BYTES, stream);
    if (e != hipSuccess) fprintf(stderr, "cooperative launch failed: %s (grid %d)\n", hipGetErrorString(e), grid_blocks);
}
```

```cpp
#include <hip/hip_runtime.h>
#include <hip/hip_cooperative_groups.h>
#include <cstdio>
#include <cstdint>
namespace cg = cooperative_groups;

typedef unsigned short bf16_t;
typedef float f32x4 __attribute__((ext_vector_type(4)));

constexpr int D = 1024, BATCH = 8, SEQ = 2048, CTXL = 256, DEPTH = 2;
constexpr int NL = BATCH * SEQ, NC = BATCH * CTXL, NTOK = NL + NC;
constexpr int DIN = 1824;
constexpr int C_FN = 0, C_GQ = 256, C_GK = 384, C_GV = 512, C_GG = 768, C_GDF = 1024, C_GDB = 1040, C_AQ = 1056, C_AK = 1568, C_AV = 1696;
constexpr int KEYS = CTXL + SEQ;
constexpr int NCHK = 36;
constexpr int NEXP = 16, DEXP = 512;
constexpr float EPS = 1e-6f;
constexpr float QSCALE = 0.125f * 1.4426950408889634f;
constexpr int NWAVES = 8, NTHREADS = 512;
#ifndef DUP
#define DUP 0
#endif
#ifndef PROBE_A
#define PROBE_A -1
#endif
#ifndef PROBE_B
#define PROBE_B -1
#endif
#define PROBE_K 8
#define DUPN(id) ((DUP == (id)) ? 2 : 1)
#define GOLDEN_FNET 0
#define GOLDEN_ATTN 0
#define GOLDEN_GLA 0
constexpr int LDS_BYTES = 147456;

constexpr size_t MiB = 1u << 20;
constexpr size_t WS_CTL = 0;
constexpr size_t WS_MODP = 151 * MiB;
constexpr size_t WS_MOD = 9 * MiB;
constexpr size_t WS_TAB = 10 * MiB;
constexpr size_t WS_XC = 11 * MiB;
constexpr size_t WS_HB = 19 * MiB;
constexpr size_t WS_YFTL = 55 * MiB;
constexpr size_t WS_YFTC = 71 * MiB;
constexpr size_t WS_GQK = 73 * MiB;
constexpr size_t WS_GV = 82 * MiB;
constexpr size_t WS_GG = 91 * MiB;
constexpr size_t WS_GD = 100 * MiB;
constexpr size_t WS_AQ = 102 * MiB;
constexpr size_t WS_AK = 120 * MiB;
constexpr size_t WS_AVT = 125 * MiB;
constexpr size_t WS_AST = 130 * MiB;
constexpr size_t WS_DEC = 149 * MiB;
constexpr size_t WS_ROUTE = 150 * MiB;
constexpr size_t WS_Y = 151 * MiB;
constexpr size_t WS_WIN = 314 * MiB;
constexpr size_t WS_WOUT = 232 * MiB;
constexpr size_t WS_WGU = 236 * MiB;
constexpr size_t WS_WD = 268 * MiB;
constexpr size_t WS_WD1 = 284 * MiB;
constexpr size_t WS_DMATC = 300 * MiB;
constexpr size_t WS_LIST = 301 * MiB;
constexpr size_t WS_ST = 304 * MiB;
constexpr size_t WS_END = 324 * MiB;
constexpr size_t WS_ACT = WS_YFTL;
constexpr int CW_CNT = 8192;
constexpr int NIN = 2560;

struct Params {
    const float *x, *c, *ctx, *c_ctx, *w_ada, *b_ada, *norm_mix, *norm_ffn, *w_in, *w_gup, *b_gg, *gla_norm, *q_norm, *k_norm, *w_out, *w_router, *b_router, *w_eg, *w_eu, *w_ed, *final_norm;
    float* out;
    unsigned char* ws;
};

#define LDSP(T) __attribute__((address_space(3))) T*
namespace pg8 {
typedef short bf16x8 __attribute__((ext_vector_type(8)));
typedef unsigned u32x4 __attribute__((ext_vector_type(4)));
typedef unsigned u32x2 __attribute__((ext_vector_type(2)));
__device__ __forceinline__ unsigned cvt_pk_bf16(float lo, float hi) { unsigned r; asm volatile("v_cvt_pk_bf16_f32 %0, %1, %2" : "=v"(r) : "v"(lo), "v"(hi)); return r; }
typedef __bf16 bf16x2_c __attribute__((ext_vector_type(2)));
typedef float f32x2_c __attribute__((ext_vector_type(2)));
__device__ __forceinline__ unsigned cvt_pk_bf16_c(float lo, float hi) { f32x2_c v = {lo, hi}; return __builtin_bit_cast(unsigned, __builtin_convertvector(v, bf16x2_c)); }
}
__device__ __forceinline__ float bf2f(bf16_t v) { return __uint_as_float((unsigned)v << 16); }
__device__ __forceinline__ bf16_t f2bf(float f) { unsigned u = __float_as_uint(f); return (bf16_t)((u + 0x7fffu + ((u >> 16) & 1u)) >> 16); }
__device__ __forceinline__ float wave_sum(float v) {
#pragma unroll
    for (int o = 1; o < 64; o <<= 1) v += __shfl_xor(v, o);
    return v;
}
__device__ __forceinline__ float siluf(float v) { return v / (1.f + expf(-v)); }
__device__ __forceinline__ float sigmoidf(float v) { return 1.f / (1.f + expf(-v)); }
__device__ __forceinline__ float logsigmoidf(float z) { return fminf(z, 0.f) - log1pf(expf(-fabsf(z))); }
__device__ __forceinline__ void sincos_r(float x, float& s, float& c) {
    const float k = rintf(x * 0.63661977236758134f);
    float r = fmaf(k, -1.57079625129699707031f, x); r = fmaf(k, -7.54978995489188216e-8f, r);
    const int q = ((int)k) & 3;
    const float r2 = r * r;
    float sp = fmaf(r2, 2.7557314297e-6f, -1.9841270114e-4f); sp = fmaf(sp, r2, 8.3333337680e-3f); sp = fmaf(sp, r2, -1.6666667163e-1f); sp = fmaf(sp * r2, r, r);
    float cp = fmaf(r2, 2.4801587642e-5f, -1.3888889225e-3f); cp = fmaf(cp, r2, 4.1666667908e-2f); cp = fmaf(cp, r2, -0.5f); cp = fmaf(cp, r2, 1.f);
    const float ss = (q & 1) ? cp : sp, cc = (q & 1) ? sp : cp;
    s = (q & 2) ? -ss : ss; c = ((q + 1) & 2) ? -cc : cc;
}
struct RowInfo { int b, t, bidx, isctx; };
__device__ __forceinline__ RowInfo row_info(int r) { RowInfo ri; if (r < NL) { ri.b = r >> 11; ri.t = r & 2047; ri.bidx = ri.b; ri.isctx = 0; } else { const int q = r - NL; ri.b = q >> 8; ri.t = q & 255; ri.bidx = 8; ri.isctx = 1; } return ri; }

#define WTAB_OFF (LDS_BYTES - 256)
extern __shared__ __attribute__((aligned(16))) unsigned char lds_raw[];
__device__ __forceinline__ int hw_wave_slot() { return (int)__builtin_amdgcn_s_getreg((5 << 11) | 4) & 63; }
__device__ __forceinline__ int otid() {
    int l; asm volatile("v_mbcnt_lo_u32_b32 %0, -1, 0\n\tv_mbcnt_hi_u32_b32 %0, -1, %0" : "=v"(l));
    const int w = __builtin_amdgcn_readfirstlane(((volatile __attribute__((address_space(3))) int*)((__attribute__((address_space(3))) unsigned char*)lds_raw + WTAB_OFF))[hw_wave_slot()]);
    return w * 64 + l; }
__device__ __forceinline__ int obid() { int b = blockIdx.x; asm volatile("" : "+s"(b)); return b; }
#define PHASE_IDS const int tidx = otid(); const int bidx_ = obid(); (void)tidx; (void)bidx_
#define GW (bidx_ * NWAVES + (tidx >> 6))
#define NGW (gridDim.x * NWAVES)
#define GT (bidx_ * NTHREADS + tidx)
#define NGT (gridDim.x * NTHREADS)

__device__ __forceinline__ void p0a(const Params& p, float* lds) { PHASE_IDS;
    const int lane = tidx & 63;
    float* MODP = (float*)(p.ws + WS_MODP);
    float* sl = lds + 20000;
    { float cv[18];
#pragma unroll
      for (int q = 0; q < 18; ++q) { const int i = tidx + NTHREADS * q, j = i >> 10, k = i & 1023; cv[q] = j < 8 ? p.c[j * D + k] : p.c_ctx[k]; }
#pragma unroll
      for (int q = 0; q < 18; ++q) { const int i = tidx + NTHREADS * q, j = i >> 10, k = i & 1023; sl[k * 12 + j] = siluf(cv[q]); } }
    __syncthreads();
    for (int it = GW; it < 2 * 32 * 24; it += NGW) {
        const int l = it / (32 * 24), kc = (it / 24) % 32, cb = it % 24, col = cb * 256 + 4 * lane;
        f32x4 w[32];
        const float* wp = p.w_ada + ((size_t)l * D + kc * 32) * 6144 + col;
#pragma unroll
        for (int kk = 0; kk < 32; ++kk) w[kk] = *(const f32x4*)(wp + (size_t)kk * 6144);
        f32x4 acc[9];
#pragma unroll
        for (int j = 0; j < 9; ++j) acc[j] = (f32x4){0.f, 0.f, 0.f, 0.f};
#pragma unroll
        for (int kk = 0; kk < 32; ++kk) {
            const f32x4* sp = (const f32x4*)(sl + (kc * 32 + kk) * 12); const f32x4 s0 = sp[0], s1 = sp[1], s2 = sp[2];
            acc[0] += w[kk] * s0[0]; acc[1] += w[kk] * s0[1]; acc[2] += w[kk] * s0[2]; acc[3] += w[kk] * s0[3];
            acc[4] += w[kk] * s1[0]; acc[5] += w[kk] * s1[1]; acc[6] += w[kk] * s1[2]; acc[7] += w[kk] * s1[3];
            acc[8] += w[kk] * s2[0];
        }
#pragma unroll
        for (int j = 0; j < 9; ++j) *(f32x4*)(MODP + ((size_t)(l * 32 + kc) * 9 + j) * 6144 + col) = acc[j];
    }
    {
        bf16_t* M1 = (bf16_t*)(p.ws + WS_TAB + 16384); bf16_t* M2 = (bf16_t*)(p.ws + WS_TAB + 24576); bf16_t* EC = (bf16_t*)(p.ws + WS_TAB + 40960);
        for (int i = GT; i < 64 * 64 + 64 * 128 + 2 * 64 * 64; i += NGT) {
            if (i < 4096) { const int m = i >> 6, k = i & 63, rp = m >> 5, k1 = m & 31, part = k >> 5, sl = k & 31, r = ((sl >> 2) & 1) * 16 + 4 * (sl >> 3) + (sl & 3); float sn, cs; sincos_r((float)((k1 * r) & 31) * (6.283185307179586f / 32.f), sn, cs);
                M1[i] = f2bf(rp == 0 ? (part == 0 ? cs : -sn) : (part == 0 ? -sn : -cs)); }
            else if (i < 4096 + 8192) { const int q = i - 4096, k2 = q >> 7, kk = q & 127, ri = kk >> 6, c = kk & 63; float sn, cs; sincos_r((float)((k2 * c) & 63) * (6.283185307179586f / 64.f), sn, cs); M2[q] = f2bf(ri == 0 ? cs : sn); }
            else { const int q = i - 12288, part = q >> 12, jl = (q >> 6) & 63, ch = q & 63; float sn, cs; sincos_r((float)((jl * ch) & 63) * (6.283185307179586f / 64.f), sn, cs); EC[q] = f2bf(part == 0 ? cs : sn); }
        }
    }
    float* TAB = (float*)(p.ws + WS_TAB);
    for (int i = GT; i < 2048 + 1024; i += NGT) {
        if (i < 2048) { float s, c; sincos_r((float)i * (6.283185307179586f / 2048.f), s, c); TAB[i] = c; }
        else { const int q = i - 2048, pos = q >> 4, f = q & 15; const float inv = exp2f(-(float)f * (13.287712379549449f / 16.f)); float s, c; sincos_r((float)pos * inv, s, c); TAB[2048 + 2 * q] = c; TAB[2048 + 2 * q + 1] = s; }
    }
}
__device__ __forceinline__ void p0b(const Params& p) { PHASE_IDS;
    const float* MODP = (const float*)(p.ws + WS_MODP);
    float* MOD = (float*)(p.ws + WS_MOD);
    for (int i = GT; i < 2 * 9 * 6144; i += NGT) {
        const int l = i / (9 * 6144), j = (i / 6144) % 9, col = i % 6144;
        float s = p.b_ada[l * 6144 + col];
#pragma unroll
        for (int kc = 0; kc < 32; ++kc) s += MODP[((size_t)(l * 32 + kc) * 9 + j) * 6144 + col];
        MOD[i] = s;
    }
}

__device__ __forceinline__ float* xrow_ptr(const Params& p, int r) { return r < NL ? p.out + (size_t)r * D : (float*)(p.ws + WS_XC) + (size_t)(r - NL) * D; }
__device__ __forceinline__ const float* xin_ptr(const Params& p, int r) { return r < NL ? p.x + (size_t)r * D : p.ctx + (size_t)(r - NL) * D; }

constexpr int RPW = 3;
__device__ __forceinline__ f32x4 bf4_to_f4(pg8::u32x2 w) { f32x4 r; r[0] = __uint_as_float(w.x << 16); r[1] = __uint_as_float(w.x & 0xffff0000u); r[2] = __uint_as_float(w.y << 16); r[3] = __uint_as_float(w.y & 0xffff0000u); return r; }
constexpr int P1_RS = 2064;
constexpr int P1_WOFF = 32 * P1_RS;
__device__ __forceinline__ void p1_stage_w(const Params& p, int l, unsigned char* lds_raw, int t, int nthr) {
    const bf16_t* Wg = (const bf16_t*)(p.ws + WS_WIN) + ((size_t)l * NIN + 8 * 256) * D;
    for (int c = t; c < 32 * 128; c += nthr) { const int n = c >> 7, k8 = c & 127;
        *(LDSP(pg8::u32x4))(lds_raw + P1_WOFF + n * P1_RS + k8 * 16) = *(const pg8::u32x4*)(Wg + (size_t)n * D + k8 * 8); }
}
__device__ __forceinline__ void p1_norm1(const Params& p, int l, unsigned char* lds_raw) { PHASE_IDS;
    const int lane = tidx & 63, wv = __builtin_amdgcn_readfirstlane(tidx >> 6);
    bf16_t* GD = (bf16_t*)(p.ws + WS_GD);
    const float* MOD = (const float*)(p.ws + WS_MOD);
    bf16_t* HB = (bf16_t*)(p.ws + WS_HB);
    const bf16_t* Y = (const bf16_t*)(p.ws + WS_Y);
    f32x4 nwv[4];
#pragma unroll
    for (int j = 0; j < 4; ++j) nwv[j] = *(const f32x4*)(p.norm_mix + l * D + 4 * lane + 256 * j);
    for (int rb0 = bidx_ * NWAVES * RPW; rb0 < NTOK; rb0 += NGW * RPW) {
        const int r0 = rb0 + wv * RPW;
        f32x4 v[RPW][4], gsc[4], gsh[4], gg2[4]; pg8::u32x2 y0[RPW][4], y1[RPW][4];
        const int gb = row_info(r0 < NTOK ? r0 : NTOK - 1).bidx;
        { const float* mod0 = MOD + ((size_t)l * 9 + gb) * 6144;
#pragma unroll
          for (int j = 0; j < 4; ++j) { const int col = 4 * lane + 256 * j; gsc[j] = *(const f32x4*)(mod0 + D + col); gsh[j] = *(const f32x4*)(mod0 + col);
              if (l != 0) gg2[j] = *(const f32x4*)(MOD + ((size_t)(l - 1) * 9 + gb) * 6144 + 5 * D + col); } }
#pragma unroll
        for (int q = 0; q < RPW; ++q) { const int r = (r0 + q < NTOK) ? r0 + q : NTOK - 1;
#pragma unroll
            for (int j = 0; j < 4; ++j) { const int col = 4 * lane + 256 * j;
                if (l == 0) v[q][j] = *(const f32x4*)(xin_ptr(p, r) + col);
                else { v[q][j] = *(const f32x4*)(xrow_ptr(p, r) + col); y0[q][j] = *(const pg8::u32x2*)(Y + (size_t)(2 * r) * D + col); y1[q][j] = *(const pg8::u32x2*)(Y + (size_t)(2 * r + 1) * D + col); } } }
#pragma unroll
        for (int q = 0; q < RPW; ++q) { const int r = r0 + q; if (r >= NTOK) break;
            const RowInfo ri = row_info(r);
            f32x4 rsc[4], rsh[4], rg2[4];
#pragma unroll
            for (int j = 0; j < 4; ++j) { rsc[j] = gsc[j]; rsh[j] = gsh[j]; rg2[j] = gg2[j]; }
            if (ri.bidx != gb) {
                const float* mod = MOD + ((size_t)l * 9 + ri.bidx) * 6144;
#pragma unroll
                for (int j = 0; j < 4; ++j) { const int col = 4 * lane + 256 * j; rsc[j] = *(const f32x4*)(mod + D + col); rsh[j] = *(const f32x4*)(mod + col);
                    if (l != 0) rg2[j] = *(const f32x4*)(MOD + ((size_t)(l - 1) * 9 + ri.bidx) * 6144 + 5 * D + col); }
            }
            float ss = 0.f;
#pragma unroll
            for (int j = 0; j < 4; ++j) { const int col = 4 * lane + 256 * j;
                if (l != 0) { v[q][j] += rg2[j] * (bf4_to_f4(y0[q][j]) + bf4_to_f4(y1[q][j])); *(f32x4*)(xrow_ptr(p, r) + col) = v[q][j]; }
                ss += v[q][j][0] * v[q][j][0] + v[q][j][1] * v[q][j][1] + v[q][j][2] * v[q][j][2] + v[q][j][3] * v[q][j][3]; }
            const float rstd = rsqrtf(wave_sum(ss) * (1.f / D) + EPS);
#pragma unroll
            for (int j = 0; j < 4; ++j) { const int col = 4 * lane + 256 * j;
                const f32x4 nw = nwv[j];
                const f32x4 hv = v[q][j] * rstd * nw * (rsc[j] + 1.f) + rsh[j];
                pg8::u32x2 o; o.x = pg8::cvt_pk_bf16(hv[0], hv[1]); o.y = pg8::cvt_pk_bf16(hv[2], hv[3]);
                *(pg8::u32x2*)(HB + (size_t)r * D + col) = o;
                *(LDSP(pg8::u32x2))(lds_raw + (wv * RPW + q) * P1_RS + col * 2) = o; }
        }
        __syncthreads();
        if (wv < 4) {
            const int mi = wv >> 1, ni = wv & 1, fr = lane & 15, q4 = lane >> 4;
            f32x4 acc = {0.f, 0.f, 0.f, 0.f};
#pragma unroll 8
            for (int ks = 0; ks < 32; ++ks) {
                const pg8::bf16x8 a = *(LDSP(const pg8::bf16x8))(lds_raw + (16 * mi + fr) * P1_RS + ks * 64 + 16 * q4);
                const pg8::bf16x8 b = *(LDSP(const pg8::bf16x8))(lds_raw + P1_WOFF + (16 * ni + fr) * P1_RS + ks * 64 + 16 * q4);
                acc = __builtin_amdgcn_mfma_f32_16x16x32_bf16(a, b, acc, 0, 0, 0);
            }
#pragma unroll
            for (int i = 0; i < 4; ++i) { const int rl = 16 * mi + 4 * q4 + i, r = rb0 + rl;
                if (rl < NWAVES * RPW && r < NTOK) GD[(size_t)r * 32 + 16 * ni + fr] = f2bf(acc[i]); }
        }
        __syncthreads();
    }
}

__device__ __forceinline__ void p6_stage_router(const Params& p, int t, int nthr) {
    constexpr int RS = 1032;
    LDSP(bf16_t) WH = (LDSP(bf16_t))((__attribute__((address_space(3))) unsigned char*)lds_raw) + 2 * 16 * RS; LDSP(bf16_t) WL = WH + 16 * RS;
    for (int i4 = t; i4 < 4096; i4 += nthr) { const f32x4 wv = ((const f32x4*)p.w_router)[i4]; const int k = i4 >> 2, e0 = (i4 & 3) * 4;
#pragma unroll
        for (int c = 0; c < 4; ++c) { const bf16_t hb = f2bf(wv[c]); WH[(e0 + c) * RS + k] = hb; WL[(e0 + c) * RS + k] = f2bf(wv[c] - bf2f(hb)); } }
}
__device__ __forceinline__ void p6_norm2_router(const Params& p, int l, float* lds_unused) { PHASE_IDS;
    typedef pg8::bf16x8 bf16x8;
    typedef __attribute__((address_space(3))) unsigned char lds_u8;
    const int lane = tidx & 63, wave = __builtin_amdgcn_readfirstlane(tidx >> 6);
    const float* MOD = (const float*)(p.ws + WS_MOD);
    bf16_t* HB = (bf16_t*)(p.ws + WS_HB);
    f32x4* ROUTE = (f32x4*)(p.ws + WS_ROUTE);
    const int nrows = l == 0 ? NTOK : NL;
    const int rpb = (nrows + (int)gridDim.x - 1) / (int)gridDim.x, rbeg = bidx_ * rpb, rend = (rbeg + rpb < nrows) ? rbeg + rpb : nrows;
    constexpr int RS = 1032;
    lds_u8* L = (lds_u8*)lds_raw;
    LDSP(bf16_t) AH = (LDSP(bf16_t))(L); LDSP(bf16_t) AL = AH + 16 * RS; LDSP(bf16_t) WH = AL + 16 * RS; LDSP(bf16_t) WL = WH + 16 * RS;
    LDSP(float) PART = (LDSP(float))(L + 132096);
    LDSP(int) lcnt = (LDSP(int))(L + 140288); LDSP(int) lbase = lcnt + 16; LDSP(int) rroute = lbase + 16;
    if (tidx < 16) lcnt[tidx] = 0;
    const int nbatch = (rend - rbeg + 15) >> 4;
    f32x4 vn[2][4];
#pragma unroll
    for (int q = 0; q < 2; ++q) { const int r = (rbeg + wave * 2 + q < rend) ? rbeg + wave * 2 + q : rend - 1;
#pragma unroll
        for (int j = 0; j < 4; ++j) vn[q][j] = *(const f32x4*)(xrow_ptr(p, r) + 4 * lane + 256 * j); }
    f32x4 nwv[4];
#pragma unroll
    for (int j = 0; j < 4; ++j) nwv[j] = *(const f32x4*)(p.norm_ffn + l * D + 4 * lane + 256 * j);
    for (int bt = 0; bt < nbatch; ++bt) {
        const int r0 = rbeg + bt * 16 + wave * 2;
        f32x4 v[2][4], gsc[4], gsh[4];
        const int rl0 = r0 < rend ? r0 : rend - 1, gb = row_info(rl0).bidx;
        { const float* mod0 = MOD + ((size_t)l * 9 + gb) * 6144;
#pragma unroll
          for (int j = 0; j < 4; ++j) { const int col = 4 * lane + 256 * j; gsc[j] = *(const f32x4*)(mod0 + 4 * D + col); gsh[j] = *(const f32x4*)(mod0 + 3 * D + col); } }
#pragma unroll
        for (int q = 0; q < 2; ++q)
#pragma unroll
            for (int j = 0; j < 4; ++j) v[q][j] = vn[q][j];
        if (bt + 1 < nbatch) {
#pragma unroll
            for (int q = 0; q < 2; ++q) { const int r = (r0 + 16 + q < rend) ? r0 + 16 + q : rend - 1;
#pragma unroll
                for (int j = 0; j < 4; ++j) vn[q][j] = *(const f32x4*)(xrow_ptr(p, r) + 4 * lane + 256 * j); }
        }
#pragma unroll
        for (int j = 0; j < 4; ++j) gsc[j] = (gsc[j] + 1.f) * nwv[j];
#pragma unroll
        for (int q = 0; q < 2; ++q) { const int r = r0 + q;
            if (r < rend) {
                const RowInfo ri = row_info(r);
                float ss = 0.f;
#pragma unroll
                for (int j = 0; j < 4; ++j) ss += v[q][j][0] * v[q][j][0] + v[q][j][1] * v[q][j][1] + v[q][j][2] * v[q][j][2] + v[q][j][3] * v[q][j][3];
                const float rstd = rsqrtf(wave_sum(ss) * (1.f / D) + EPS);
                f32x4 rsc[4], rsh[4];
#pragma unroll
                for (int j = 0; j < 4; ++j) { rsc[j] = gsc[j]; rsh[j] = gsh[j]; }
                if (ri.bidx != gb) {
                    const float* mod = MOD + ((size_t)l * 9 + ri.bidx) * 6144;
#pragma unroll
                    for (int j = 0; j < 4; ++j) { const int col = 4 * lane + 256 * j; rsc[j] = (*(const f32x4*)(mod + 4 * D + col) + 1.f) * *(const f32x4*)(p.norm_ffn + l * D + col); rsh[j] = *(const f32x4*)(mod + 3 * D + col); }
                }
#pragma unroll
                for (int j = 0; j < 4; ++j) {
                    const int col = 4 * lane + 256 * j;
                    const f32x4 hv = v[q][j] * rstd * rsc[j] + rsh[j];
                    pg8::u32x2 hi; hi.x = pg8::cvt_pk_bf16(hv[0], hv[1]); hi.y = pg8::cvt_pk_bf16(hv[2], hv[3]);
                    *(pg8::u32x2*)(HB + (size_t)r * D + col) = hi;
                    pg8::u32x2 lo;
                    lo.x = pg8::cvt_pk_bf16(hv[0] - __uint_as_float(hi.x << 16), hv[1] - __uint_as_float(hi.x & 0xffff0000u));
                    lo.y = pg8::cvt_pk_bf16(hv[2] - __uint_as_float(hi.y << 16), hv[3] - __uint_as_float(hi.y & 0xffff0000u));
                    *(LDSP(pg8::u32x2))(AH + (wave * 2 + q) * RS + col) = hi; *(LDSP(pg8::u32x2))(AL + (wave * 2 + q) * RS + col) = lo;
                }
            }
        }
        __syncthreads();
        {
            const int rr = lane & 15, q4 = lane >> 4;
            f32x4 acc = {0.f, 0.f, 0.f, 0.f};
#pragma unroll
            for (int s4 = 0; s4 < 4; ++s4) { const int ko = (wave * 4 + s4) * 32 + 8 * q4;
                const bf16x8 ah = *(LDSP(const bf16x8))(AH + rr * RS + ko), al = *(LDSP(const bf16x8))(AL + rr * RS + ko);
                const bf16x8 wh = *(LDSP(const bf16x8))(WH + rr * RS + ko), wlo = *(LDSP(const bf16x8))(WL + rr * RS + ko);
                acc = __builtin_amdgcn_mfma_f32_16x16x32_bf16(ah, wh, acc, 0, 0, 0);
                acc = __builtin_amdgcn_mfma_f32_16x16x32_bf16(ah, wlo, acc, 0, 0, 0);
                acc = __builtin_amdgcn_mfma_f32_16x16x32_bf16(al, wh, acc, 0, 0, 0); }
#pragma unroll
            for (int e = 0; e < 4; ++e) PART[wave * 256 + (4 * q4 + e) * 16 + rr] = acc[e];
        }
        __syncthreads();
        if (wave == 0 && lane < 32) {
            const int r = rbeg + bt * 16 + (lane & 15), hf = lane >> 4;
            if (r < rend) {
                float s[16], sel[16];
#pragma unroll
                for (int e = 0; e < 16; ++e) { float lgt = 0.f;
#pragma unroll
                    for (int w8 = 0; w8 < 4; ++w8) lgt += PART[(hf * 4 + w8) * 256 + (lane & 15) * 16 + e];
                    const float oth = __shfl_xor(lgt, 16); lgt = hf ? oth + lgt : lgt + oth;
                    s[e] = __builtin_amdgcn_rcpf(1.f + __expf(-lgt)); sel[e] = s[e] + p.b_router[e]; }
              if (hf == 0) {
                int bestg = 0; float bestscore = -1e30f;
#pragma unroll
                for (int g = 0; g < 4; ++g) {
                    const float a0 = sel[4 * g], a1 = sel[4 * g + 1], a2 = sel[4 * g + 2], a3 = sel[4 * g + 3];
                    const float t1x = fmaxf(a0, a1), t2x = fminf(a0, a1), t3x = fmaxf(a2, a3), t4x = fminf(a2, a3);
                    const float gs = fmaxf(t1x, t3x) + fmaxf(fmaxf(fminf(t1x, t3x), t2x), t4x);
                    if (gs > bestscore) { bestscore = gs; bestg = g; }
                }
                float c0 = sel[0], c1 = sel[1], c2 = sel[2], c3 = sel[3], u0 = s[0], u1 = s[1], u2 = s[2], u3 = s[3];
#pragma unroll
                for (int g = 1; g < 4; ++g) { const bool pick = bestg == g; c0 = pick ? sel[4 * g] : c0; c1 = pick ? sel[4 * g + 1] : c1; c2 = pick ? sel[4 * g + 2] : c2; c3 = pick ? sel[4 * g + 3] : c3;
                    u0 = pick ? s[4 * g] : u0; u1 = pick ? s[4 * g + 1] : u1; u2 = pick ? s[4 * g + 2] : u2; u3 = pick ? s[4 * g + 3] : u3; }
                int i1 = 0; float m1 = c0, s1 = u0;
                if (c1 > m1) { m1 = c1; i1 = 1; s1 = u1; }
                if (c2 > m1) { m1 = c2; i1 = 2; s1 = u2; }
                if (c3 > m1) { m1 = c3; i1 = 3; s1 = u3; }
                int i2 = -1; float m2 = -1e30f, s2 = 0.f;
                if (i1 != 0) { m2 = c0; i2 = 0; s2 = u0; }
                if (i1 != 1 && (i2 < 0 || c1 > m2)) { m2 = c1; i2 = 1; s2 = u1; }
                if (i1 != 2 && (i2 < 0 || c2 > m2)) { m2 = c2; i2 = 2; s2 = u2; }
                if (i1 != 3 && (i2 < 0 || c3 > m2)) { m2 = c3; i2 = 3; s2 = u3; }
                const int e1 = bestg * 4 + i1, e2 = bestg * 4 + i2; const float rw = __builtin_amdgcn_rcpf(s1 + s2);
                f32x4 rt; rt[0] = __int_as_float(e1); rt[1] = __int_as_float(e2); rt[2] = s1 * rw; rt[3] = s2 * rw; ROUTE[r] = rt;
                rroute[r - rbeg] = e1 | (e2 << 8); atomicAdd((int*)&lcnt[e1], 1); atomicAdd((int*)&lcnt[e2], 1);
              }
            }
        }
    }
    __syncthreads();
    unsigned* ctl = (unsigned*)(p.ws + WS_CTL);
    if (tidx < 16) { lbase[tidx] = (int)__hip_atomic_fetch_add(ctl + CW_CNT + (l * NEXP + tidx) * 64, (unsigned)lcnt[tidx], __ATOMIC_RELAXED, __HIP_MEMORY_SCOPE_AGENT); lcnt[tidx] = 0; }
    __syncthreads();
    int* LIST = (int*)(p.ws + WS_LIST) + (size_t)l * NEXP * NTOK;
    if (tidx < rend - rbeg) {
        const int rr = rroute[tidx], r = rbeg + tidx;
#pragma unroll
        for (int slot = 0; slot < 2; ++slot) { const int e = (rr >> (8 * slot)) & 255; const int pos = lbase[e] + atomicAdd((int*)&lcnt[e], 1); LIST[e * NTOK + pos] = 2 * r + slot; }
    }
    __syncthreads();
}

__device__ __forceinline__ void p9_final(const Params& p) { PHASE_IDS;
    const int lane = tidx & 63;
    const float* MOD = (const float*)(p.ws + WS_MOD);
    const bf16_t* Y = (const bf16_t*)(p.ws + WS_Y);
    f32x4 nwv[4];
#pragma unroll
    for (int j = 0; j < 4; ++j) nwv[j] = *(const f32x4*)(p.final_norm + 4 * lane + 256 * j);
    for (int r0 = GW * RPW; r0 < NL; r0 += NGW * RPW) {
        f32x4 v[RPW][4], gg2[4]; pg8::u32x2 y0[RPW][4], y1[RPW][4];
        const int gb = r0 >> 11;
#pragma unroll
        for (int j = 0; j < 4; ++j) gg2[j] = *(const f32x4*)(MOD + ((size_t)(DEPTH - 1) * 9 + gb) * 6144 + 5 * D + 4 * lane + 256 * j);
#pragma unroll
        for (int q = 0; q < RPW; ++q) { const int r = (r0 + q < NL) ? r0 + q : NL - 1;
#pragma unroll
            for (int j = 0; j < 4; ++j) { const int col = 4 * lane + 256 * j;
                v[q][j] = *(const f32x4*)(p.out + (size_t)r * D + col); y0[q][j] = *(const pg8::u32x2*)(Y + (size_t)(2 * r) * D + col); y1[q][j] = *(const pg8::u32x2*)(Y + (size_t)(2 * r + 1) * D + col); } }
#pragma unroll
        for (int q = 0; q < RPW; ++q) { const int r = r0 + q; if (r >= NL) break;
            const int bidx = r >> 11;
            float ss = 0.f;
#pragma unroll
            for (int j = 0; j < 4; ++j) { const int col = 4 * lane + 256 * j;
                const f32x4 g2 = bidx == gb ? gg2[j] : *(const f32x4*)(MOD + ((size_t)(DEPTH - 1) * 9 + bidx) * 6144 + 5 * D + col);
                v[q][j] += g2 * (bf4_to_f4(y0[q][j]) + bf4_to_f4(y1[q][j]));
                ss += v[q][j][0] * v[q][j][0] + v[q][j][1] * v[q][j][1] + v[q][j][2] * v[q][j][2] + v[q][j][3] * v[q][j][3]; }
            const float rstd = rsqrtf(wave_sum(ss) * (1.f / D) + EPS);
#pragma unroll
            for (int j = 0; j < 4; ++j) { const int col = 4 * lane + 256 * j; *(f32x4*)(p.out + (size_t)r * D + col) = v[q][j] * rstd * nwv[j]; }
        }
    }
}

namespace pg8 {
#define PG8_LAS __attribute__((address_space(3)))
typedef short bf16x8 __attribute__((ext_vector_type(8)));
typedef unsigned u32x4 __attribute__((ext_vector_type(4)));
typedef unsigned u32x2 __attribute__((ext_vector_type(2)));
constexpr int BM = 256, BK = 64, HALF = 128, HTB = HALF * BK * 2, STAGE_BYTES = 8 * HTB;
__host__ __device__ __forceinline__ int lds_byte(int r, int c) { const int st = (r >> 4) * 2 + (c >> 5), rr = r & 15, cc = c & 31, ob = rr * 64 + cc * 2; return st * 1024 + (ob ^ (((ob >> 9) & 1) << 5)); }
__host__ __device__ __forceinline__ void stage_rc(int b, int& R, int& C) { const int st = b / 1024, sb = b % 1024, swz = sb ^ (((sb >> 9) & 1) << 5); R = (st >> 1) * 16 + swz / 64; C = (st & 1) * 32 + (swz % 64) / 2; }
__host__ __device__ __forceinline__ int perm32(int rho) { const int n = rho >> 4, i = rho & 15; return 8 * (i >> 2) + 4 * n + (i & 3); }
struct Unit { int pm, pn; unsigned a_off, b_off; int e, cnt; };

template <class Epi, class Sched>
__device__ __forceinline__ void gemm_phase(PG8_LAS unsigned char* lds, const bf16_t* A, const bf16_t* Bt, const int K, const Sched& S, const Epi& E) {
    const int tid = otid(), wid = __builtin_amdgcn_readfirstlane(tid >> 6), lane = tid & 63, wr = wid >> 2, wc = wid & 3, fr = lane & 15, fq = lane >> 4;
    const int nt = K / BK;
    int Ra[2]; unsigned Ca2[2], voffB[2];
#pragma unroll
    for (int i = 0; i < 2; ++i) { int R, C; stage_rc(tid * 16 + i * 8192, R, C); const int Rb = (R & ~31) + perm32(R & 31); Ra[i] = R; Ca2[i] = (unsigned)C * 2u; voffB[i] = (unsigned)(Rb * K + C) * 2u; }
    const size_t kstep = (size_t)(BK * 2);
    const size_t hstep = (size_t)HALF * K * 2;
    const unsigned ldsw = (unsigned)wid * 1024u;
    const int aoff = lds_byte(wr * 64 + fr, fq * 8), boff = lds_byte(wc * 32 + fr, fq * 8);
#define PG8_SA(b, h) (((b) * 2 + (h)) * HTB)
#define PG8_SB(b, h) ((4 + (b) * 2 + (h)) * HTB)
#define PG8_STAGE_B(bufoff, gbase) do { _Pragma("unroll") for (int _i = 0; _i < 2; ++_i) \
        __builtin_amdgcn_global_load_lds((const unsigned*)((const char*)(gbase) + voffB[_i]), (PG8_LAS unsigned*)(lds + (bufoff) + ldsw + _i * 8192), 16, 0, 0); } while (0)
#define PG8_STAGE_A(bufoff, kbyte, offs) do { _Pragma("unroll") for (int _i = 0; _i < 2; ++_i) \
        __builtin_amdgcn_global_load_lds((const unsigned*)(Ab + (size_t)(offs)[_i] + (size_t)(kbyte)), (PG8_LAS unsigned*)(lds + (bufoff) + ldsw + _i * 8192), 16, 0, 0); } while (0)
#define PG8_LDA(dst, b, h) do { _Pragma("unroll") for (int m = 0; m < 4; ++m) _Pragma("unroll") for (int k = 0; k < 2; ++k) dst[m][k] = *(const PG8_LAS bf16x8*)(lds + PG8_SA(b, h) + aoff + m * 2048 + k * 1024); } while (0)
#define PG8_LDB(dst, b, h) do { _Pragma("unroll") for (int n = 0; n < 2; ++n) _Pragma("unroll") for (int k = 0; k < 2; ++k) dst[n][k] = *(const PG8_LAS bf16x8*)(lds + PG8_SB(b, h) + boff + n * 2048 + k * 1024); } while (0)
#define PG8_MMA(ai, bj, At, Bt_) do { __builtin_amdgcn_s_setprio(1); _Pragma("unroll") for (int m = 0; m < 4; ++m) _Pragma("unroll") for (int n = 0; n < 2; ++n) _Pragma("unroll") for (int k = 0; k < 2; ++k) \
        acc[ai][bj][m][n] = __builtin_amdgcn_mfma_f32_16x16x32_bf16(Bt_[n][k], At[m][k], acc[ai][bj][m][n], 0, 0, 0); __builtin_amdgcn_s_setprio(0); } while (0)
#define PG8_WAIT_V(n) asm volatile("s_waitcnt vmcnt(" #n ")" ::: "memory")
#define PG8_WAIT_L(n) asm volatile("s_waitcnt lgkmcnt(" #n ")" ::: "memory")
#define PG8_BAR __builtin_amdgcn_s_barrier()
#define PG8_SCHED __builtin_amdgcn_sched_barrier(0)
    Unit cur, nxt; int ui = 0;
    if (!S.next(0, cur)) return;
    f32x4 acc[2][2][4][2];
#pragma unroll
    for (int a = 0; a < 2; ++a)
#pragma unroll
        for (int b = 0; b < 2; ++b)
#pragma unroll
            for (int m = 0; m < 4; ++m)
#pragma unroll
                for (int n = 0; n < 2; ++n) acc[a][b][m][n] = (f32x4){0.f, 0.f, 0.f, 0.f};
    bf16x8 At[4][2], B0[2][2], B1[2][2];
    const char* Ab = (const char*)A;
    unsigned ga0[2], ga1[2], gn0[2], gn1[2];
#pragma unroll
    for (int i = 0; i < 2; ++i) { ga0[i] = S.a_row_off(cur, Ra[i], K) + Ca2[i]; ga1[i] = S.a_row_off(cur, HALF + Ra[i], K) + Ca2[i]; }
    const char* cB = (const char*)Bt + cur.b_off;
    PG8_STAGE_B(PG8_SB(0, 0), cB); PG8_STAGE_B(PG8_SB(0, 1), cB + hstep); PG8_STAGE_A(PG8_SA(0, 0), 0, ga0); PG8_STAGE_A(PG8_SA(0, 1), 0, ga1);
    if (wr == 1) PG8_BAR;
    PG8_WAIT_V(2); PG8_BAR;
    PG8_STAGE_B(PG8_SB(1, 0), cB + kstep); PG8_STAGE_A(PG8_SA(1, 0), kstep, ga0); PG8_STAGE_B(PG8_SB(1, 1), cB + hstep + kstep);
    PG8_WAIT_V(6); PG8_BAR;
    for (;;) {
        const bool has_next = S.next(ui + 1, nxt);
        if (has_next) {
#pragma unroll
            for (int i = 0; i < 2; ++i) { gn0[i] = S.a_row_off(nxt, Ra[i], K) + Ca2[i]; gn1[i] = S.a_row_off(nxt, HALF + Ra[i], K) + Ca2[i]; }
        } else {
#pragma unroll
            for (int i = 0; i < 2; ++i) { gn0[i] = ga0[i]; gn1[i] = ga1[i]; }
        }
        const char* nB = has_next ? (const char*)Bt + nxt.b_off : cB;
        for (int t = 0; t < nt; t += 2) {
            const bool last = (t == nt - 2);
            const size_t k1 = (size_t)(t + 1) * kstep;
            unsigned o20[2], o21[2];
#pragma unroll
            for (int i = 0; i < 2; ++i) { o20[i] = last ? gn0[i] : ga0[i]; o21[i] = last ? gn1[i] : ga1[i]; }
            const size_t k2 = last ? 0 : (size_t)(t + 2) * kstep, k3 = k2 + kstep;
            const char* b2 = last ? nB : cB + (size_t)(t + 2) * kstep; const char* b3 = b2 + kstep;
            PG8_LDB(B0, 0, 0); PG8_LDB(B1, 0, 1); PG8_SCHED; PG8_LDA(At, 0, 0); PG8_STAGE_A(PG8_SA(1, 1), k1, ga1);
            PG8_WAIT_V(8); PG8_WAIT_L(0); PG8_BAR; PG8_MMA(0, 0, At, B0); PG8_MMA(0, 1, At, B1); PG8_BAR; PG8_SCHED;
            PG8_LDA(At, 0, 1); PG8_STAGE_B(PG8_SB(0, 0), b2); PG8_STAGE_B(PG8_SB(0, 1), b2 + hstep); PG8_STAGE_A(PG8_SA(0, 0), k2, o20);
            PG8_WAIT_V(8); PG8_WAIT_L(0); PG8_BAR; PG8_MMA(1, 0, At, B0); PG8_MMA(1, 1, At, B1); PG8_BAR; PG8_SCHED;
            PG8_LDB(B0, 1, 0); PG8_LDB(B1, 1, 1); PG8_SCHED; PG8_LDA(At, 1, 0); PG8_STAGE_A(PG8_SA(0, 1), k2, o21);
            PG8_WAIT_V(8); PG8_WAIT_L(0); PG8_BAR; PG8_MMA(0, 0, At, B0); PG8_MMA(0, 1, At, B1); PG8_BAR; PG8_SCHED;
            PG8_LDA(At, 1, 1); PG8_STAGE_B(PG8_SB(1, 0), b3); PG8_STAGE_B(PG8_SB(1, 1), b3 + hstep); PG8_STAGE_A(PG8_SA(1, 0), k3, o20);
            PG8_WAIT_V(8); PG8_WAIT_L(0); PG8_BAR; PG8_MMA(1, 0, At, B0); PG8_MMA(1, 1, At, B1); PG8_BAR; PG8_SCHED;
        }
        if (wr == 0) PG8_BAR;
        E(acc, cur, wr, wc, fr, fq);
        if (!has_next) break;
#pragma unroll
        for (int a = 0; a < 2; ++a)
#pragma unroll
            for (int b = 0; b < 2; ++b)
#pragma unroll
                for (int m = 0; m < 4; ++m)
#pragma unroll
                    for (int n = 0; n < 2; ++n) acc[a][b][m][n] = (f32x4){0.f, 0.f, 0.f, 0.f};
        cur = nxt; cB = nB; ++ui;
#pragma unroll
        for (int i = 0; i < 2; ++i) { ga0[i] = gn0[i]; ga1[i] = gn1[i]; }
        if (wr == 1) PG8_BAR;
    }
    PG8_WAIT_V(0);
    PG8_BAR;
#undef PG8_SA
#undef PG8_SB
#undef PG8_STAGE_A
#undef PG8_STAGE_B
#undef PG8_LDA
#undef PG8_LDB
#undef PG8_MMA
#undef PG8_WAIT_V
#undef PG8_WAIT_L
#undef PG8_BAR
#undef PG8_SCHED
}

struct PlainOrder {
    int nM, nN, nwg, G, c;
    __device__ void init(int M, int N, int G_, int c_) { nM = M / BM; nN = N / BM; nwg = nM * nN; G = G_; c = c_; }
    __device__ __forceinline__ bool next(int i, Unit& u, int dup = 1) const {
        int L = i * G + c; if (L >= nwg * dup) return false; if (L >= nwg) L -= nwg;
        int wgid = L; { const int q = nwg / 8, r = nwg % 8, xcd = wgid % 8, off = wgid / 8; wgid = (xcd < r ? xcd * (q + 1) : r * (q + 1) + (xcd - r) * q) + off; }
        const int nig = 8 * nN, gid = wgid / nig, fm = gid * 8, gsz = (nM - fm) < 8 ? (nM - fm) : 8;
        u.pm = fm + ((wgid % nig) % gsz); u.pn = (wgid % nig) / gsz; u.a_off = 0; u.b_off = 0; u.e = 0; u.cnt = 256; return true;
    }
    __device__ __forceinline__ unsigned a_row_off(const Unit& u, int rl, int K) const { return (unsigned)((u.pm * BM + rl) * K) * 2u; }
};
}
struct PlainSched {
    pg8::PlainOrder o; int K; int dup; bool fperm;
    __device__ __forceinline__ bool next(int i, pg8::Unit& u) const { if (!o.next(i, u, dup)) return false; u.b_off = (unsigned)(u.pn * 256 * K) * 2u; return true; }
    __device__ __forceinline__ unsigned a_row_off(const pg8::Unit& u, int rl, int K_) const {
        if (fperm && u.pn <= 1) rl = u.pm < 64 ? (((rl >> 4) & 3) << 6 | (rl >> 7) << 5 | ((rl >> 6) & 1) << 4 | (rl & 15)) : ((rl & 0xc0) | (rl & 15) << 2 | ((rl >> 4) & 3));
        return o.a_row_off(u, rl, K_); }
};

__device__ __forceinline__ void conv_item4(const float* W, int ldw, int k0, int n, bool valid, bf16_t* dst_row0  , int ldt) {
    f32x4 v[16];
    const float* src = W + (size_t)k0 * ldw + (valid ? n : 0);
#pragma unroll
    for (int i = 0; i < 16; ++i) v[i] = *(const f32x4*)(src + (size_t)i * ldw);
    if (valid) {
#pragma unroll
        for (int c = 0; c < 4; ++c) {
            pg8::u32x4 o0, o1;
            o0.x = pg8::cvt_pk_bf16(v[0][c], v[1][c]); o0.y = pg8::cvt_pk_bf16(v[2][c], v[3][c]); o0.z = pg8::cvt_pk_bf16(v[4][c], v[5][c]); o0.w = pg8::cvt_pk_bf16(v[6][c], v[7][c]);
            o1.x = pg8::cvt_pk_bf16(v[8][c], v[9][c]); o1.y = pg8::cvt_pk_bf16(v[10][c], v[11][c]); o1.z = pg8::cvt_pk_bf16(v[12][c], v[13][c]); o1.w = pg8::cvt_pk_bf16(v[14][c], v[15][c]);
            *(pg8::u32x4*)(dst_row0 + (size_t)c * ldt) = o0; *(pg8::u32x4*)(dst_row0 + (size_t)c * ldt + 8) = o1;
        }
    }
}
__device__ __forceinline__ void conv_tile64(const float* src  , int ldw, bf16_t* dst  ) {
    float v[64];
#pragma unroll
    for (int i = 0; i < 64; ++i) v[i] = src[(size_t)i * ldw];
#pragma unroll
    for (int q = 0; q < 8; ++q) {
        pg8::u32x4 o; o.x = pg8::cvt_pk_bf16(v[8 * q], v[8 * q + 1]); o.y = pg8::cvt_pk_bf16(v[8 * q + 2], v[8 * q + 3]); o.z = pg8::cvt_pk_bf16(v[8 * q + 4], v[8 * q + 5]); o.w = pg8::cvt_pk_bf16(v[8 * q + 6], v[8 * q + 7]);
        *(pg8::u32x4*)(dst + 8 * q) = o;
    }
}
constexpr int CB_RS = 272;
constexpr int CB_BUF = 256 * CB_RS;
__device__ __forceinline__ void cb_load(f32x4 (&v)[16], const float* src, int ldw) {
#pragma unroll
    for (int i = 0; i < 16; ++i) v[i] = *(const f32x4*)(src + (size_t)i * ldw);
}
__device__ __forceinline__ void cb_to_lds(const f32x4 (&v)[16], unsigned char* buf, int w, int lane) {
#pragma unroll
    for (int c = 0; c < 4; ++c) {
        pg8::u32x4 o0, o1;
        o0.x = pg8::cvt_pk_bf16(v[0][c], v[1][c]); o0.y = pg8::cvt_pk_bf16(v[2][c], v[3][c]); o0.z = pg8::cvt_pk_bf16(v[4][c], v[5][c]); o0.w = pg8::cvt_pk_bf16(v[6][c], v[7][c]);
        o1.x = pg8::cvt_pk_bf16(v[8][c], v[9][c]); o1.y = pg8::cvt_pk_bf16(v[10][c], v[11][c]); o1.z = pg8::cvt_pk_bf16(v[12][c], v[13][c]); o1.w = pg8::cvt_pk_bf16(v[14][c], v[15][c]);
        LDSP(pg8::u32x4) q = (LDSP(pg8::u32x4))(buf + (4 * lane + c) * CB_RS + 32 * w);
        q[0] = o0; q[1] = o1;
    }
}
constexpr int CW_DYN = 12000;
__device__ __forceinline__ void convert_experts_dyn(const Params& p, int l, bf16_t* WGU, bf16_t* WD, int t0, int t1, int site, int tidx, unsigned char* lds_raw) {
    const int lane = tidx & 63, w = tidx >> 6, j = tidx & 15, r0 = tidx >> 4;
    unsigned* ctr = (unsigned*)(p.ws + WS_CTL) + CW_DYN + 64 * site;
    volatile int* slot = (volatile int*)(lds_raw + LDS_BYTES - 480);
    int par = 0;
    for (;;) {
        if (tidx == 0) *slot = t0 + (int)atomicAdd(ctr, 1u);
        __syncthreads();
        const int t = *slot;
        if (t >= t1) break;
        const float* src; int ldw; bf16_t* dst; int ldd, rsplit;
        if (t < 512) { const int nt = t & 1, kt = (t >> 1) & 7, e = (t >> 4) & 15, part = t >> 8;
            src = (part == 0 ? p.w_eg : p.w_eu) + ((size_t)(l * NEXP + e) * D + kt * 128 + 16 * w) * DEXP + nt * 256 + 4 * lane; ldw = DEXP;
            dst = WGU + ((size_t)e * 1024 + nt * 512 + part * 128) * D + kt * 128; ldd = D; rsplit = 128; }
        else { const int q = t - 512, nt = q & 3, kt = (q >> 2) & 3, e = (q >> 4) & 15;
            src = p.w_ed + ((size_t)(l * NEXP + e) * DEXP + kt * 128 + 16 * w) * D + nt * 256 + 4 * lane; ldw = D;
            dst = WD + ((size_t)e * 1024 + nt * 256) * DEXP + kt * 128; ldd = DEXP; rsplit = 0; }
        f32x4 v[16];
        cb_load(v, src, ldw);
        unsigned char* buf = lds_raw + par * CB_BUF; par ^= 1;
        cb_to_lds(v, buf, w, lane);
        __syncthreads();
#pragma unroll
        for (int i = 0; i < 8; ++i) { const int r = r0 + 32 * i;
            const pg8::u32x4 x = *(LDSP(pg8::u32x4))(buf + r * CB_RS + 16 * j);
            *(pg8::u32x4*)(dst + (size_t)(r + (r & rsplit)) * ldd + 8 * j) = x; }
    }
}
__device__ __forceinline__ void convert_gateup(const Params& p, int l, bf16_t* WGU, int gw0, int ngw, int lane) {
    for (int it = gw0; it < 2 * NEXP * 16 * 8; it += ngw) {
        const int nb = it & 7, kb = (it >> 3) & 15, e = (it >> 7) & 15, part = it >> 11, n = nb * 64 + lane;
        const float* W = (part == 0 ? p.w_eg : p.w_eu) + (size_t)(l * NEXP + e) * D * DEXP;
        conv_tile64(W + (size_t)(kb * 64) * DEXP + n, DEXP, WGU + ((size_t)e * 1024 + (n >> 7) * 256 + part * 128 + (n & 127)) * D + kb * 64);
    }
}
__device__ __forceinline__ void convert_down(const Params& p, int l, bf16_t* WD, int gw0, int ngw, int lane) {
    for (int it = gw0; it < NEXP * 8 * 16; it += ngw) {
        const int nb = it & 15, kb = (it >> 4) & 7, e = it >> 7, n = nb * 64 + lane;
        conv_tile64(p.w_ed + ((size_t)(l * NEXP + e) * DEXP + kb * 64) * D + n, D, WD + ((size_t)e * 1024 + n) * DEXP + kb * 64);
    }
}
struct EpiOutProj {
    const float* xs_lat; const float* xs_ctx; float* xd_lat; float* xd_ctx; const float* g1;
    __device__ __forceinline__ void operator()(const f32x4 (&acc)[2][2][4][2], const pg8::Unit& u, int wr, int wc, int fr, int fq) const {
        const int row0 = u.pm * 256 + wr * 64 + fr, col0 = u.pn * 256 + wc * 32 + 8 * fq;
        const bool isctx = u.pm >= 64; const int bidx = isctx ? 8 : (u.pm >> 3);
        const float* xs = isctx ? xs_ctx - (size_t)NL * D : xs_lat; float* xd = isctx ? xd_ctx - (size_t)NL * D : xd_lat;
        f32x4 g[2][2];
#pragma unroll
        for (int bj = 0; bj < 2; ++bj)
#pragma unroll
            for (int n = 0; n < 2; ++n) g[bj][n] = *(const f32x4*)(g1 + (size_t)bidx * 6144 + col0 + bj * 128 + 4 * n);
#pragma unroll
        for (int ai = 0; ai < 2; ++ai)
#pragma unroll
            for (int m = 0; m < 4; ++m) {
                const size_t ro = (size_t)(row0 + ai * 128 + m * 16) * D + col0;
#pragma unroll
                for (int bj = 0; bj < 2; ++bj)
#pragma unroll
                    for (int n = 0; n < 2; ++n) { const f32x4 xv = *(const f32x4*)(xs + ro + bj * 128 + 4 * n); *(f32x4*)(xd + ro + bj * 128 + 4 * n) = xv + g[bj][n] * acc[ai][bj][m][n]; }
            }
    }
};
__device__ __forceinline__ void p5_outproj_fast(const Params& p, int l, unsigned char* lds_raw) { PHASE_IDS;
    PlainSched S; S.K = D; S.fperm = false; S.dup = (l == 0 ? DUPN(8) : 1); S.o.init(l == 0 ? NTOK : NL, D, gridDim.x, bidx_);
    EpiOutProj E{l == 0 ? p.x : p.out, l == 0 ? p.ctx : (const float*)(p.ws + WS_XC), p.out, (float*)(p.ws + WS_XC), (const float*)(p.ws + WS_MOD) + (size_t)l * 9 * 6144 + 2 * D};
    pg8::gemm_phase((PG8_LAS unsigned char*)lds_raw, (const bf16_t*)(p.ws + WS_HB), (const bf16_t*)(p.ws + WS_WOUT) + (size_t)l * D * D, D, S, E);
    if (l == 0) { convert_experts_dyn(p, 0, (bf16_t*)(p.ws + WS_WGU), (bf16_t*)(p.ws + WS_WD), 0, 768, 0, tidx, lds_raw); }
}

#define PIN_ACC(acc) do { _Pragma("unroll") for (int a_ = 0; a_ < 2; ++a_) _Pragma("unroll") for (int b_ = 0; b_ < 2; ++b_) _Pragma("unroll") for (int m_ = 0; m_ < 4; ++m_) \
    asm volatile("" : "+v"(acc[a_][b_][m_][0]), "+v"(acc[a_][b_][m_][1])); } while (0)
struct EpiInProj {
    struct { unsigned char* ws; const float* q_norm; const float* k_norm; } p; int l;
    __device__ __forceinline__ void operator()(f32x4 (&acc)[2][2][4][2], const pg8::Unit& u, int wr, int wc, int fr, int fq) const {
        asm volatile("" : "+v"(fr), "+v"(fq));
        const int T = u.pn;
        const bool isctx = u.pm >= 64; const int b = isctx ? u.pm - 64 : (u.pm >> 3); const int t0 = (isctx ? 0 : (u.pm & 7) * 256) + wr * 64 + fr;
        const int row0 = u.pm * 256 + wr * 64 + fr;
        if (T <= 1) {
            bf16_t* dst = isctx ? (bf16_t*)(p.ws + WS_YFTC) + ((size_t)b * 256 * 2 + T) * CTXL + 64 * wr + 4 * fr
                                : (bf16_t*)(p.ws + WS_YFTL) + ((size_t)b * 256 * 2 + T) * SEQ + (16 * wr + fr) * 32 + 4 * (u.pm & 7);
            const int ld = isctx ? CTXL : SEQ, oa = isctx ? 128 : 1024;
            unsigned eo = (unsigned)((64 * wc + 8 * fq) * 2 * ld);
#pragma unroll
            for (int bj = 0; bj < 2; ++bj)
#pragma unroll
                for (int n = 0; n < 2; ++n)
#pragma unroll
                    for (int e = 0; e < 4; ++e) { bf16_t* cp = dst + eo;
#pragma unroll
                        for (int ai = 0; ai < 2; ++ai) { pg8::u32x2 w; w.x = pg8::cvt_pk_bf16(acc[ai][bj][0][n][e], acc[ai][bj][1][n][e]); w.y = pg8::cvt_pk_bf16(acc[ai][bj][2][n][e], acc[ai][bj][3][n][e]); *(pg8::u32x2*)(cp + ai * oa) = w; }
                        eo += (unsigned)(((n == 1 && e == 3) ? 25 : 1) * 2 * ld); asm volatile("" : "+v"(eo) :: "memory"); }
        } else if (T <= 4 || T >= 8) {
            bf16_t* dst; int ld; float sc = 1.f;
            if (T == 9) { dst = (bf16_t*)(p.ws + WS_YFTL); ld = 256; }
            else if (T == 2) { dst = (bf16_t*)(p.ws + WS_GQK); ld = 256; if (wc < 2) sc = 0.17677669529663687f; }
            else if (T == 3) { dst = (bf16_t*)(p.ws + WS_GV); ld = 256; } else if (T == 4) { dst = (bf16_t*)(p.ws + WS_GG); ld = 256; } else { dst = (bf16_t*)(p.ws + WS_GD); ld = 32; }
            if (T != 8 || wc == 0) {
#pragma unroll
                for (int ai = 0; ai < 2; ++ai)
#pragma unroll
                    for (int m = 0; m < 4; ++m) { const size_t r = row0 + ai * 128 + m * 16;
#pragma unroll
                        for (int bj = 0; bj < 2; ++bj) { if (T == 8 && bj == 1) continue;
                            const f32x4 v0 = acc[ai][bj][m][0] * sc, v1 = acc[ai][bj][m][1] * sc;
                            pg8::u32x4 w; w.x = pg8::cvt_pk_bf16(v0[0], v0[1]); w.y = pg8::cvt_pk_bf16(v0[2], v0[3]); w.z = pg8::cvt_pk_bf16(v1[0], v1[1]); w.w = pg8::cvt_pk_bf16(v1[2], v1[3]);
                            *(pg8::u32x4*)(dst + r * ld + 64 * wc + 32 * bj + 8 * fq) = w; } }
            }
        } else if (T == 7 && wc >= 2) {
            bf16_t* dst = (bf16_t*)(p.ws + WS_AVT) + ((size_t)(b * 2 + (wc - 2)) * 64) * KEYS + (isctx ? 0 : CTXL);
            unsigned eo = (unsigned)(8 * fq * KEYS + t0);
#pragma unroll
            for (int bj = 0; bj < 2; ++bj)
#pragma unroll
                for (int n = 0; n < 2; ++n)
#pragma unroll
                    for (int e = 0; e < 4; ++e) { bf16_t* cp = dst + eo;
#pragma unroll
                        for (int ai = 0; ai < 2; ++ai)
#pragma unroll
                            for (int m = 0; m < 4; ++m) cp[ai * 128 + m * 16] = f2bf(acc[ai][bj][m][n][e]);
                        eo += (unsigned)(((n == 1 && e == 3) ? 25 : 1) * KEYS); asm volatile("" : "+v"(eo) :: "memory"); }
        } else {
            const bool isq = T != 7;
            const float* nw = isq ? p.q_norm : p.k_norm;
            f32x4 w4[2][2];
#pragma unroll
            for (int bj = 0; bj < 2; ++bj)
#pragma unroll
                for (int n = 0; n < 2; ++n) w4[bj][n] = *(const f32x4*)(nw + 32 * bj + 8 * fq + 4 * n);
            const float osc = isq ? QSCALE : 1.f;
            const float* ROPE = (const float*)(p.ws + WS_TAB) + 2048;
            const int half = fq >> 1;
            const int rbase = row0 - t0;
            int t = t0;
#pragma unroll
            for (int ai = 0; ai < 2; ++ai)
#pragma unroll
                for (int m = 0; m < 4; ++m) {
                    float ss = 0.f;
#pragma unroll
                    for (int bj = 0; bj < 2; ++bj)
#pragma unroll
                        for (int n = 0; n < 2; ++n) { const f32x4 v = acc[ai][bj][m][n]; ss += v[0] * v[0] + v[1] * v[1] + v[2] * v[2] + v[3] * v[3]; }
                    ss += __shfl_xor(ss, 16); ss += __shfl_xor(ss, 32);
                    const float rs = rsqrtf(ss * (1.f / 64.f) + EPS);
                    bf16_t* dst = isq ? (bf16_t*)(p.ws + WS_AQ) + (size_t)(rbase + t) * 512 + ((T - 5) * 4 + wc) * 64
                                      : (bf16_t*)(p.ws + WS_AK) + ((size_t)b * KEYS + (isctx ? 0 : CTXL) + t) * 128 + wc * 64;
#pragma unroll
                    for (int bj = 0; bj < 2; ++bj) {
                        f32x4 o[2];
#pragma unroll
                        for (int n = 0; n < 2; ++n) {
                            const f32x4 xv = acc[ai][bj][m][n] * rs * w4[bj][n];
                            if (!isctx) {
                                const int pos = bj == 0 ? (t >> 6) : (t & 63);
                                const f32x4* rp = (const f32x4*)(ROPE + 2 * (pos * 16 + 8 * (fq & 1) + 4 * n));
                                const f32x4 cs01 = rp[0], cs23 = rp[1];
                                f32x4 xp;
#pragma unroll
                                for (int e = 0; e < 4; ++e) xp[e] = __shfl_xor(xv[e], 32);
                                const float sg = half == 0 ? -1.f : 1.f;
                                o[n][0] = xv[0] * cs01[0] + sg * xp[0] * cs01[1]; o[n][1] = xv[1] * cs01[2] + sg * xp[1] * cs01[3];
                                o[n][2] = xv[2] * cs23[0] + sg * xp[2] * cs23[1]; o[n][3] = xv[3] * cs23[2] + sg * xp[3] * cs23[3];
                            } else o[n] = xv;
                            o[n] = o[n] * osc;
                        }
                        pg8::u32x4 w; w.x = pg8::cvt_pk_bf16(o[0][0], o[0][1]); w.y = pg8::cvt_pk_bf16(o[0][2], o[0][3]); w.z = pg8::cvt_pk_bf16(o[1][0], o[1][1]); w.w = pg8::cvt_pk_bf16(o[1][2], o[1][3]);
                        *(pg8::u32x4*)(dst + 32 * bj + 8 * fq) = w;
                    }
                    t += (m == 3) ? 80 : 16; asm volatile("" : "+v"(t) :: "memory");
                }
        }
    }
};
struct InProjSched {
    pg8::PlainOrder o; int K, l, ntl, ntc, nlat, total, G, c;
    __device__ __forceinline__ void init(int l_, int G_, int c_) { l = l_; G = G_; c = c_; K = D; ntl = 7; ntc = l_ == 0 ? 8 : 3; nlat = 64 * ntl; total = nlat + 8 * ntc; o.init(64 * 256, ntl * 256, G_, c_); }
    __device__ __forceinline__ bool next(int i, pg8::Unit& u) const {
        const int L = i * G + c; if (L >= total) return false;
        int tile;
        if (L < nlat) { o.next(i, u); tile = u.pn == 0 ? 9 : u.pn + 1; }
        else { const int idx = L - nlat, k = idx % ntc; u.pm = 64 + idx / ntc; tile = l == 0 ? k : (k < 2 ? 2 + k : 7); u.a_off = 0; u.e = 0; u.cnt = 256; }
        u.pn = tile; u.b_off = (unsigned)(tile * 256 * K) * 2u; return true;
    }
    __device__ __forceinline__ void a_ready(const pg8::Unit&) const {}
    __device__ __forceinline__ unsigned a_row_off(const pg8::Unit& u, int rl, int K_) const {
        if (u.pn <= 1) rl = (rl & 0xc0) | (rl & 15) << 2 | ((rl >> 4) & 3);
        return o.a_row_off(u, rl, K_); }
};
__device__ __forceinline__ void p2_inproj_fast(const Params& p, int l, unsigned char* lds_raw) { PHASE_IDS;
    InProjSched S; S.init(l, gridDim.x, bidx_);
    EpiInProj E{{p.ws, p.q_norm + l * 64, p.k_norm + l * 64}, l};
    pg8::gemm_phase((PG8_LAS unsigned char*)lds_raw, (const bf16_t*)(p.ws + WS_HB), (const bf16_t*)(p.ws + WS_WIN) + (size_t)l * NIN * D, D, S, E);
    if (l != 0) convert_experts_dyn(p, 1, (bf16_t*)(p.ws + WS_Y), (bf16_t*)(p.ws + WS_WD1), 0, 768, 2, tidx, lds_raw);
}

struct MoeSched {
    const int* list; const int* tab;
    int G, c, total, dup; bool down;
    __device__ __forceinline__ bool next(int i, pg8::Unit& u) const {
        int e, rem;
        if (G == 256) {
            const int x = c & 7, ul = i * 32 + (c >> 3);
            const int n0 = tab[x + 1] - tab[x], n1 = tab[x + 9] - tab[x + 8];
            if (ul < n0) { e = x; rem = ul; } else if (ul < n0 + n1) { e = x + 8; rem = ul - n0; } else return false;
        } else {
            const int L = i * G + c; if (L >= total) return false;
            e = 0;
#pragma unroll
            for (int q = 1; q < NEXP; ++q) if (L >= tab[q]) e = q;
            rem = L - tab[e];
        }
        e = __builtin_amdgcn_readfirstlane(e); rem = __builtin_amdgcn_readfirstlane(rem);
        const int sg = tab[17 + e], cn = tab[33 + e];
        const int mtile = rem >> 2, pn = rem & 3;
        u.pm = mtile; u.pn = pn; u.e = e; u.cnt = __builtin_amdgcn_readfirstlane(cn - mtile * 256); u.a_off = (unsigned)__builtin_amdgcn_readfirstlane(sg + mtile * 256);
        u.b_off = down ? (unsigned)((e * 1024 + pn * 256) * DEXP) * 2u : (unsigned)((e * 1024 + pn * 256) * D) * 2u;
        return true;
    }
    __device__ __forceinline__ unsigned a_row_off(const pg8::Unit& u, int rl, int K) const {
        if (down) return (unsigned)((u.a_off + rl) * K) * 2u;
        const int idx = u.pm * 256 + (rl < u.cnt ? rl : u.cnt - 1);
        const int pair = list[u.e * NTOK + idx];
        return (unsigned)((pair >> 1) * K) * 2u;
    }
};
__device__ __forceinline__ int moe_tables(const unsigned* ctl, int l, int* tab, int tidx) {
    if (tidx < 64) {
        const int e = tidx & 15;
        const int n = (int)__hip_atomic_load(ctl + CW_CNT + (l * NEXP + e) * 64, __ATOMIC_RELAXED, __HIP_MEMORY_SCOPE_AGENT), mt = (n + 255) >> 8;
        int inc = mt;
#pragma unroll
        for (int o = 1; o < 16; o <<= 1) { const int v = __shfl_up(inc, o, 16); if ((tidx & 15) >= o) inc += v; }
        const int pre = inc - mt;
        if (tidx < 16) { tab[e] = pre * 4; tab[17 + e] = pre * 256; tab[33 + e] = n; if (e == 15) tab[16] = inc * 4; }
    }
    __syncthreads();
    return __builtin_amdgcn_readfirstlane(tab[16]);
}
struct EpiGateUp {
    bf16_t* act;
    __device__ __forceinline__ void operator()(f32x4 (&acc)[2][2][4][2], const pg8::Unit& u, int wr, int wc, int fr, int fq) const {
        bf16_t* base = act + (size_t)(u.a_off + wr * 64 + fr) * DEXP + u.pn * 128 + wc * 32 + 8 * fq;
#pragma unroll
        for (int ai = 0; ai < 2; ++ai)
#pragma unroll
            for (int m = 0; m < 4; ++m) {
                f32x4 o[2];
#pragma unroll
                for (int n = 0; n < 2; ++n)
#pragma unroll
                    for (int e = 0; e < 4; ++e) { const float g = acc[ai][0][m][n][e]; o[n][e] = g * __builtin_amdgcn_rcpf(1.f + __expf(-g)) * acc[ai][1][m][n][e]; }
                pg8::u32x4 w; w.x = pg8::cvt_pk_bf16(o[0][0], o[0][1]); w.y = pg8::cvt_pk_bf16(o[0][2], o[0][3]); w.z = pg8::cvt_pk_bf16(o[1][0], o[1][1]); w.w = pg8::cvt_pk_bf16(o[1][2], o[1][3]);
                *(pg8::u32x4*)(base + (size_t)(ai * 128 + m * 16) * DEXP) = w;
            }
    }
};
struct EpiDown {
    bf16_t* Y; const int* list; const f32x4* route;
    __device__ __forceinline__ void operator()(f32x4 (&acc)[2][2][4][2], const pg8::Unit& u, int wr, int wc, int fr, int fq) const {
        asm volatile("" : "+v"(fr), "+v"(fq));
        const int rl0 = wr * 64 + fr;
        const int col = u.pn * 256 + wc * 32 + 8 * fq;
        int pair[8]; float w[8];
#pragma unroll
        for (int i = 0; i < 8; ++i) { const int rl = rl0 + (i >> 2) * 128 + (i & 3) * 16; pair[i] = rl < u.cnt ? list[u.e * NTOK + u.pm * 256 + rl] : -1; }
#pragma unroll
        for (int i = 0; i < 8; ++i) w[i] = pair[i] >= 0 ? ((const float*)(route + (pair[i] >> 1)))[2 + (pair[i] & 1)] : 0.f;
#pragma unroll
        for (int i = 0; i < 8; ++i) {
            if (pair[i] >= 0) {
                bf16_t* dst = Y + (size_t)pair[i] * D + col;
#pragma unroll
                for (int bj = 0; bj < 2; ++bj) { const f32x4 v0 = acc[i >> 2][bj][i & 3][0] * w[i], v1 = acc[i >> 2][bj][i & 3][1] * w[i];
                    pg8::u32x4 o; o.x = pg8::cvt_pk_bf16(v0[0], v0[1]); o.y = pg8::cvt_pk_bf16(v0[2], v0[3]); o.z = pg8::cvt_pk_bf16(v1[0], v1[1]); o.w = pg8::cvt_pk_bf16(v1[2], v1[3]);
                    *(pg8::u32x4*)(dst + bj * 128) = o; }
            }
        }
    }
};
__device__ __forceinline__ void p7_gateup_fast(const Params& p, int l, unsigned char* lds_raw) { PHASE_IDS;
    int* tab = (int*)(lds_raw + LDS_BYTES - 768);
    MoeSched S; S.list = (const int*)(p.ws + WS_LIST) + (size_t)l * NEXP * NTOK; S.tab = tab; S.G = gridDim.x; S.c = bidx_; S.down = false; S.dup = DUPN(9); S.total = moe_tables((const unsigned*)(p.ws + WS_CTL), l, tab, tidx);
    EpiGateUp E{(bf16_t*)(p.ws + WS_ACT)};
    pg8::gemm_phase((PG8_LAS unsigned char*)lds_raw, (const bf16_t*)(p.ws + WS_HB), (const bf16_t*)(p.ws + (l == 0 ? WS_WGU : WS_Y)), D, S, E);
}
__device__ __forceinline__ void p8_down_fast(const Params& p, int l, unsigned char* lds_raw) { PHASE_IDS;
    int* tab = (int*)(lds_raw + LDS_BYTES - 768);
    MoeSched S; S.list = (const int*)(p.ws + WS_LIST) + (size_t)l * NEXP * NTOK; S.tab = tab; S.G = gridDim.x; S.c = bidx_; S.down = true; S.dup = DUPN(10); S.total = __builtin_amdgcn_readfirstlane(tab[16]);
    EpiDown E{(bf16_t*)(p.ws + WS_Y), (const int*)(p.ws + WS_LIST) + (size_t)l * NEXP * NTOK, (const f32x4*)(p.ws + WS_ROUTE)};
    pg8::gemm_phase((PG8_LAS unsigned char*)lds_raw, (const bf16_t*)(p.ws + WS_ACT), (const bf16_t*)(p.ws + (l == 0 ? WS_WD : WS_WD1)), DEXP, S, E);
}

struct FnetSched {
    int mtiles, nunits, G, c, dup;
    __device__ __forceinline__ bool next(int i, pg8::Unit& u) const {
        int L = i * G + c; if (L >= nunits * dup) return false; if (L >= nunits) L -= nunits;
        u.e = L / mtiles; u.pm = L % mtiles; u.pn = 0; u.cnt = 256; u.a_off = 0; u.b_off = 0; return true;
    }
    __device__ __forceinline__ unsigned a_row_off(const pg8::Unit& u, int rl, int K) const { return (unsigned)((u.pm * 256 + rl) * K) * 2u; }
};
struct FnetSchedK { FnetSched s; int K;
    __device__ __forceinline__ bool next(int i, pg8::Unit& u) const { if (!s.next(i, u)) return false; u.b_off = (unsigned)(u.e * 256 * K) * 2u; return true; }
    __device__ __forceinline__ unsigned a_row_off(const pg8::Unit& u, int rl, int K_) const { return s.a_row_off(u, rl, K_); }
};
struct EpiFnet {
    bf16_t* mix; int row0, rows_per_b; float scale;
    __device__ __forceinline__ void operator()(f32x4 (&acc)[2][2][4][2], const pg8::Unit& u, int wr, int wc, int fr, int fq) const {
        bf16_t* base = mix + (size_t)(row0 + u.e * rows_per_b + u.pm * 256 + wr * 64 + fr) * D + wc * 32 + 8 * fq;
#pragma unroll
        for (int ai = 0; ai < 2; ++ai)
#pragma unroll
            for (int m = 0; m < 4; ++m)
#pragma unroll
                for (int bj = 0; bj < 2; ++bj) { const f32x4 v0 = acc[ai][bj][m][0] * scale, v1 = acc[ai][bj][m][1] * scale;
                    pg8::u32x4 o; o.x = pg8::cvt_pk_bf16(v0[0], v0[1]); o.y = pg8::cvt_pk_bf16(v0[2], v0[3]); o.z = pg8::cvt_pk_bf16(v1[0], v1[1]); o.w = pg8::cvt_pk_bf16(v1[2], v1[3]);
                    *(pg8::u32x4*)(base + (size_t)(ai * 128 + m * 16) * D + bj * 128) = o; }
    }
};
__device__ __forceinline__ void p3_fnet_fast(const Params& p, int l, unsigned char* lds_raw) { PHASE_IDS;
    if (l == 0) {
        FnetSchedK S; S.s.dup = 1; S.s.mtiles = 1; S.s.nunits = 8; S.s.G = gridDim.x; S.s.c = (bidx_ + (int)gridDim.x - 3 * ((int)gridDim.x >> 3)) % (int)gridDim.x;
        S.K = 512;
        EpiFnet E{(bf16_t*)(p.ws + WS_HB), NL, CTXL, 0.0078125f};
        pg8::gemm_phase((PG8_LAS unsigned char*)lds_raw, (const bf16_t*)(p.ws + WS_DMATC), (const bf16_t*)(p.ws + WS_YFTC), 512, S, E);
    }
}
typedef float f32x16 __attribute__((ext_vector_type(16)));
typedef short s16x4 __attribute__((ext_vector_type(4)));
#define ATTN_THR 40.0f
__device__ __forceinline__ void attn_softmax(f32x16& p0, f32x16& p1, f32x16& o0, f32x16& o1, float& mref, float& lrow, pg8::u32x4 (&pf)[4], bool first, bool nomax) {
  if (!nomax) {
    float mx = p0[0];
#pragma unroll
    for (int r = 1; r < 16; ++r) mx = fmaxf(mx, p0[r]);
#pragma unroll
    for (int r = 0; r < 16; ++r) mx = fmaxf(mx, p1[r]);
    { auto rr = __builtin_amdgcn_permlane32_swap(__float_as_uint(mx), __float_as_uint(mx), false, false); mx = fmaxf(__uint_as_float(rr[0]), __uint_as_float(rr[1])); }
    if (__any(mx > ATTN_THR) || (first && __any(mx < -ATTN_THR))) {
        const float delta = first ? mx : fmaxf(mx, 0.f), alpha = __builtin_amdgcn_exp2f(-delta);
        mref += delta; lrow *= alpha;
#pragma unroll
        for (int r = 0; r < 16; ++r) { p0[r] -= delta; p1[r] -= delta; o0[r] *= alpha; o1[r] *= alpha; }
    }
  }
    float sum = 0.f;
#pragma unroll
    for (int r = 0; r < 16; ++r) { p0[r] = __builtin_amdgcn_exp2f(p0[r]); sum += p0[r]; }
#pragma unroll
    for (int r = 0; r < 16; ++r) { p1[r] = __builtin_amdgcn_exp2f(p1[r]); sum += p1[r]; }
    lrow += sum;
#pragma unroll
    for (int s = 0; s < 2; ++s) {
        pf[s].x = pg8::cvt_pk_bf16(p0[8 * s + 0], p0[8 * s + 1]); pf[s].y = pg8::cvt_pk_bf16(p0[8 * s + 2], p0[8 * s + 3]); pf[s].z = pg8::cvt_pk_bf16(p0[8 * s + 4], p0[8 * s + 5]); pf[s].w = pg8::cvt_pk_bf16(p0[8 * s + 6], p0[8 * s + 7]);
        pf[2 + s].x = pg8::cvt_pk_bf16(p1[8 * s + 0], p1[8 * s + 1]); pf[2 + s].y = pg8::cvt_pk_bf16(p1[8 * s + 2], p1[8 * s + 3]); pf[2 + s].z = pg8::cvt_pk_bf16(p1[8 * s + 4], p1[8 * s + 5]); pf[2 + s].w = pg8::cvt_pk_bf16(p1[8 * s + 6], p1[8 * s + 7]);
    }
}
__device__ __forceinline__ void attn_store(bf16_t* op, const f32x16& o0, const f32x16& o1, float lrow) {
    { auto rr = __builtin_amdgcn_permlane32_swap(__float_as_uint(lrow), __float_as_uint(lrow), false, false); lrow = __uint_as_float(rr[0]) + __uint_as_float(rr[1]); }
    const float inv = 1.f / lrow;
#pragma unroll
    for (int g = 0; g < 4; ++g) {
        pg8::u32x2 w0, w1;
        w0.x = pg8::cvt_pk_bf16(o0[4 * g] * inv, o0[4 * g + 1] * inv); w0.y = pg8::cvt_pk_bf16(o0[4 * g + 2] * inv, o0[4 * g + 3] * inv);
        w1.x = pg8::cvt_pk_bf16(o1[4 * g] * inv, o1[4 * g + 1] * inv); w1.y = pg8::cvt_pk_bf16(o1[4 * g + 2] * inv, o1[4 * g + 3] * inv);
        *(pg8::u32x2*)(op + 8 * g) = w0; *(pg8::u32x2*)(op + 32 + 8 * g) = w1;
    }
}
__device__ __forceinline__ void attn_unit(unsigned char* ws, unsigned char* lds_raw, int b, int kvh, int qrow0, int nkt, int tid, bool nomax) {
    typedef pg8::bf16x8 bf16x8;
    const int lane = tid & 63, wid = __builtin_amdgcn_readfirstlane(tid >> 6), r32 = lane & 31, hi = lane >> 5, h = kvh * 4 + (wid >> 1);
    const bf16_t* AQ = (const bf16_t*)(ws + WS_AQ); const bf16_t* AK = (const bf16_t*)(ws + WS_AK); const bf16_t* AVT = (const bf16_t*)(ws + WS_AVT);
    const int srow = wid * 8 + (lane >> 3), sx = (srow >> 1) & 7, sch = (lane & 7) ^ sx;
    const bf16_t* kg = AK + ((size_t)b * KEYS + srow) * 128 + kvh * 64 + sch * 8;
    const bf16_t* vg = AVT + ((size_t)(b * 2 + kvh) * 64 + srow) * KEYS + sch * 8;
    typedef __attribute__((address_space(3))) unsigned char lds_u8;
    lds_u8* Kb = (lds_u8*)lds_raw; lds_u8* Vb = Kb + 24576;
    const int kx = (r32 >> 1) & 7;
    const int krd = r32 * 128, vrd = r32 * 128 + hi * 8;
    const int qr = qrow0 + (wid & 1) * 64 + r32;
    lds_u8* Ql = Kb + 40960 + wid * 8192 + lane * 16;
    { const bf16_t* qp = AQ + (size_t)qr * 512 + h * 64 + hi * 8;
      bf16x8 qa[4], qb[4];
#pragma unroll
      for (int s = 0; s < 4; ++s) { qa[s] = *(const bf16x8*)(qp + s * 16); qb[s] = *(const bf16x8*)(qp + 32 * 512 + s * 16); }
      __syncthreads();
#pragma unroll
      for (int s = 0; s < 4; ++s) { *(LDSP(bf16x8))(Ql + s * 2048) = qa[s]; *(LDSP(bf16x8))(Ql + s * 2048 + 1024) = qb[s]; } }
    f32x16 oA0 = {}, oA1 = {}, oB0 = {}, oB1 = {};
    float mA = 0.f, lA = 0.f, mB = 0.f, lB = 0.f;
#define ATTN_DMA_K(t, koff) __builtin_amdgcn_global_load_lds((const unsigned*)(kg + (size_t)(t) * 64 * 128), (LDSP(unsigned))(Kb + (koff) + wid * 1024), 16, 0, 0)
#define ATTN_DMA_V(t, voff) __builtin_amdgcn_global_load_lds((const unsigned*)(vg + (t) * 64), (LDSP(unsigned))(Vb + (voff) + wid * 1024), 16, 0, 0)
    ATTN_DMA_K(0, 0); ATTN_DMA_V(0, 0); if (nkt > 1) ATTN_DMA_K(1, 8192);
    __syncthreads();
#define ATTN_QK2(koff) do { asm volatile("" : "+v"(Ql));     \
        const bool slow_ = __any(mA != 0.f || mB != 0.f);        \
        if (slow_) { const float nA_ = -mA, nB_ = -mB; _Pragma("unroll") for (int r_ = 0; r_ < 16; ++r_) { pA0[r_] = nA_; pA1[r_] = nA_; pB0[r_] = nB_; pB1[r_] = nB_; } } \
        _Pragma("unroll") for (int s = 0; s < 4; ++s) { \
            const bf16x8 k0 = *(LDSP(const bf16x8))(Kb + (koff) + krd + (((2 * s + hi) ^ kx) << 4)); \
            const bf16x8 k1 = *(LDSP(const bf16x8))(Kb + (koff) + 4096 + krd + (((2 * s + hi) ^ kx) << 4)); \
            const bf16x8 qA = *(LDSP(const bf16x8))(Ql + s * 2048), qB = *(LDSP(const bf16x8))(Ql + s * 2048 + 1024); \
            pA0 = __builtin_amdgcn_mfma_f32_32x32x16_bf16(k0, qA, (s == 0 && !slow_) ? (f32x16){} : pA0, 0, 0, 0); \
            pA1 = __builtin_amdgcn_mfma_f32_32x32x16_bf16(k1, qA, (s == 0 && !slow_) ? (f32x16){} : pA1, 0, 0, 0); \
            pB0 = __builtin_amdgcn_mfma_f32_32x32x16_bf16(k0, qB, (s == 0 && !slow_) ? (f32x16){} : pB0, 0, 0, 0); \
            pB1 = __builtin_amdgcn_mfma_f32_32x32x16_bf16(k1, qB, (s == 0 && !slow_) ? (f32x16){} : pB1, 0, 0, 0); \
            asm volatile("" ::: "memory"); } } while (0)
#define ATTN_PV(vcur) do { _Pragma("unroll") for (int ks = 0; ks < 4; ++ks) { \
            const s16x4 a0 = *(LDSP(const s16x4))(Vb + (vcur) + vrd + (((2 * ks) ^ kx) << 4)); \
            const s16x4 a1 = *(LDSP(const s16x4))(Vb + (vcur) + vrd + (((2 * ks + 1) ^ kx) << 4)); \
            const s16x4 c0 = *(LDSP(const s16x4))(Vb + (vcur) + 4096 + vrd + (((2 * ks) ^ kx) << 4)); \
            const s16x4 c1 = *(LDSP(const s16x4))(Vb + (vcur) + 4096 + vrd + (((2 * ks + 1) ^ kx) << 4)); \
            const bf16x8 va = {a0[0], a0[1], a0[2], a0[3], a1[0], a1[1], a1[2], a1[3]}; \
            const bf16x8 vc = {c0[0], c0[1], c0[2], c0[3], c1[0], c1[1], c1[2], c1[3]}; \
            oA0 = __builtin_amdgcn_mfma_f32_32x32x16_bf16(va, __builtin_bit_cast(bf16x8, pfA[ks]), oA0, 0, 0, 0); \
            oA1 = __builtin_amdgcn_mfma_f32_32x32x16_bf16(vc, __builtin_bit_cast(bf16x8, pfA[ks]), oA1, 0, 0, 0); \
            oB0 = __builtin_amdgcn_mfma_f32_32x32x16_bf16(va, __builtin_bit_cast(bf16x8, pfB[ks]), oB0, 0, 0, 0); \
            oB1 = __builtin_amdgcn_mfma_f32_32x32x16_bf16(vc, __builtin_bit_cast(bf16x8, pfB[ks]), oB1, 0, 0, 0); \
            asm volatile("" ::: "memory"); } } while (0)
    pg8::u32x4 pfA[4], pfB[4];
    f32x16 pA0, pA1, pB0, pB1;
    int kc = 0, kn = 8192, kn2 = 16384, vcur = 0;
    if (wid < 4) {
        for (int t = 0; t < nkt; ++t) {
            if (t + 2 < nkt) ATTN_DMA_K(t + 2, kn2);
            if (t + 1 < nkt) ATTN_DMA_V(t + 1, 8192 - vcur);
            ATTN_QK2(kc);
            attn_softmax(pA0, pA1, oA0, oA1, mA, lA, pfA, t == 0, nomax);
            attn_softmax(pB0, pB1, oB0, oB1, mB, lB, pfB, t == 0, nomax);
            asm volatile("" ::: "memory");
            ATTN_PV(vcur);
            __syncthreads();
            { const int k0_ = kc; kc = kn; kn = kn2; kn2 = k0_; } vcur = 8192 - vcur;
        }
    } else {
        ATTN_QK2(0);
        for (int t = 0; t < nkt; ++t) {
            if (t + 2 < nkt) ATTN_DMA_K(t + 2, kn2);
            if (t + 1 < nkt) ATTN_DMA_V(t + 1, 8192 - vcur);
            attn_softmax(pA0, pA1, oA0, oA1, mA, lA, pfA, t == 0, nomax);
            attn_softmax(pB0, pB1, oB0, oB1, mB, lB, pfB, t == 0, nomax);
            asm volatile("" ::: "memory");
            ATTN_PV(vcur);
            if (t + 1 < nkt) ATTN_QK2(kn);
            __syncthreads();
            { const int k0_ = kc; kc = kn; kn = kn2; kn2 = k0_; } vcur = 8192 - vcur;
        }
    }
#undef ATTN_DMA_K
#undef ATTN_DMA_V
#undef ATTN_QK2
#undef ATTN_PV
    {
      const int t2 = otid(), l2 = t2 & 63, w2 = __builtin_amdgcn_readfirstlane(t2 >> 6);
      bf16_t* op = (bf16_t*)(ws + WS_HB) + (size_t)(qrow0 + (w2 & 1) * 64 + (l2 & 31)) * D + 512 + (kvh * 4 + (w2 >> 1)) * 64 + 4 * (l2 >> 5);
      attn_store(op, oA0, oA1, lA);
      attn_store(op + (size_t)32 * D, oB0, oB1, lB); }
}
__device__ __forceinline__ void p3_attn_fast(const Params& p, int l, unsigned char* lds_raw) { PHASE_IDS;
    const int G = gridDim.x;
    bool nomax;
    { float mq = fabsf(p.q_norm[l * 64 + (tidx & 63)]), mk = fabsf(p.k_norm[l * 64 + (tidx & 63)]);
#pragma unroll
      for (int o = 1; o < 64; o <<= 1) { mq = fmaxf(mq, __shfl_xor(mq, o)); mk = fmaxf(mk, __shfl_xor(mk, o)); }
      nomax = __builtin_amdgcn_readfirstlane((int)(11.72f * mq * mk <= ATTN_THR)) != 0; }
    for (int u = bidx_; u < BATCH * 2 * 16; u += G) { const int rb = u & 15, kvh = (u >> 4) & 1, b = u >> 5; attn_unit(p.ws, lds_raw, b, kvh, b * SEQ + rb * 128, KEYS / 64, tidx, nomax); }
    if (l == 0) for (int u = (bidx_ + G - (G >> 2)) % G; u < BATCH * 2 * 2; u += G) {
        const int rb = u & 1, kvh = (u >> 1) & 1, b = u >> 2; attn_unit(p.ws, lds_raw, b, kvh, NL + b * CTXL + rb * 128, CTXL / 64, tidx, nomax); }
}

struct GlaPrep { float cum[16], tot[16], q[16], k[16]; };
struct GlaIn { pg8::u32x4 gd[2], qk[4], gv[2]; };
__device__ __forceinline__ void gla_load(GlaIn& in, const unsigned char* ws, int row0, int h, int w4, int lane, int tg) {
    const int dir = w4 >> 1, kh = w4 & 1, row = row0 + lane;
    const bf16_t* GD = (const bf16_t*)(ws + WS_GD); const bf16_t* GQK = (const bf16_t*)(ws + WS_GQK); const bf16_t* GV = (const bf16_t*)(ws + WS_GV);
    in.gd[0] = *(const pg8::u32x4*)(GD + (size_t)row * 32 + dir * 16); in.gd[1] = *(const pg8::u32x4*)(GD + (size_t)row * 32 + dir * 16 + 8);
    const bf16_t* qp = GQK + (size_t)row * 256 + h * 32 + kh * 16;
    in.qk[0] = *(const pg8::u32x4*)qp; in.qk[1] = *(const pg8::u32x4*)(qp + 8); in.qk[2] = *(const pg8::u32x4*)(qp + 128); in.qk[3] = *(const pg8::u32x4*)(qp + 136);
    const int t = tg >> 2, c = tg & 3;
    in.gv[0] = *(const pg8::u32x4*)(GV + (size_t)(row0 + t) * 256 + h * 64 + 16 * c); in.gv[1] = *(const pg8::u32x4*)(GV + (size_t)(row0 + t) * 256 + h * 64 + 16 * c + 8);
}
__device__ __forceinline__ void gla_prep(GlaPrep& g, const GlaIn& in, const float* wlds, int h, int w4, int lane) {
    const int dir = w4 >> 1, kh = w4 & 1;
    float gd[16];
    { const unsigned w[8] = {in.gd[0].x, in.gd[0].y, in.gd[0].z, in.gd[0].w, in.gd[1].x, in.gd[1].y, in.gd[1].z, in.gd[1].w};
#pragma unroll
      for (int i = 0; i < 8; ++i) { gd[2 * i] = __uint_as_float(w[i] << 16); gd[2 * i + 1] = __uint_as_float(w[i] & 0xffff0000u); } }
    const float* wu = wlds + dir * 2048 + h * 32 + kh * 16;
    const float* bu = wlds + 4096 + dir * 128 + h * 32 + kh * 16;
#pragma unroll
    for (int kk = 0; kk < 16; ++kk) g.cum[kk] = bu[kk];
#pragma unroll
    for (int r = 0; r < 16; ++r) {
#pragma unroll
        for (int kk = 0; kk < 16; ++kk) g.cum[kk] = fmaf(gd[r], wu[r * 128 + kk], g.cum[kk]);
    }
#pragma unroll
    for (int kk = 0; kk < 16; ++kk) { const float z = g.cum[kk]; g.cum[kk] = (fminf(z, 0.f) - __logf(1.f + __expf(-fabsf(z)))) * (1.f / 16.f); }
#pragma unroll
    for (int off = 1; off < 64; off <<= 1) {
        const int src = dir == 0 ? lane - off : lane + off; const bool ok = (unsigned)src < 64u;
#pragma unroll
        for (int kk = 0; kk < 16; ++kk) {
            const float y = __shfl(g.cum[kk], src & 63);
            g.cum[kk] += ok ? y : 0.f;
        }
    }
#pragma unroll
    for (int kk = 0; kk < 16; ++kk) g.tot[kk] = __shfl(g.cum[kk], dir == 0 ? 63 : 0);
    { const unsigned wq[8] = {in.qk[0].x, in.qk[0].y, in.qk[0].z, in.qk[0].w, in.qk[1].x, in.qk[1].y, in.qk[1].z, in.qk[1].w}, wk[8] = {in.qk[2].x, in.qk[2].y, in.qk[2].z, in.qk[2].w, in.qk[3].x, in.qk[3].y, in.qk[3].z, in.qk[3].w};
#pragma unroll
      for (int i = 0; i < 8; ++i) { g.q[2 * i] = __uint_as_float(wq[i] << 16); g.q[2 * i + 1] = __uint_as_float(wq[i] & 0xffff0000u); g.k[2 * i] = __uint_as_float(wk[i] << 16); g.k[2 * i + 1] = __uint_as_float(wk[i] & 0xffff0000u); } }
}
__device__ __forceinline__ void gla_stage_w_t(float* wlds, const Params& p, int l, int t, int nthr) {
    for (int i = t; i < 1024; i += nthr) ((f32x4*)wlds)[i] = ((const f32x4*)(p.w_gup + (size_t)l * 4096))[i];
    for (int i = t; i < 256; i += nthr) wlds[4096 + i] = p.b_gg[l * 256 + i];
}
__device__ __forceinline__ void gla_stage_w(float* wlds, const Params& p, int l, int tidx) {
    { f32x4 wv[2]; float bv = 0.f;
#pragma unroll
      for (int j = 0; j < 2; ++j) wv[j] = ((const f32x4*)(p.w_gup + (size_t)l * 4096))[tidx + NTHREADS * j];
      if (tidx < 256) bv = p.b_gg[l * 256 + tidx];
#pragma unroll
      for (int j = 0; j < 2; ++j) ((f32x4*)wlds)[tidx + NTHREADS * j] = wv[j];
      if (tidx < 256) wlds[4096 + tidx] = bv; }
    __syncthreads();
}
__device__ __forceinline__ void gla_write_vt(bf16_t* VT, const GlaIn& in, int tg) {
    const int t = tg >> 2, c = tg & 3;
    const unsigned w[8] = {in.gv[0].x, in.gv[0].y, in.gv[0].z, in.gv[0].w, in.gv[1].x, in.gv[1].y, in.gv[1].z, in.gv[1].w};
#pragma unroll
    for (int i = 0; i < 8; ++i) { VT[(16 * c + 2 * i) * 72 + t] = (bf16_t)(w[i] & 0xffffu); VT[(16 * c + 2 * i + 1) * 72 + t] = (bf16_t)(w[i] >> 16); }
}
__device__ __forceinline__ int gla_row0(int b, int cs) { return cs < 4 ? NL + b * CTXL + cs * 64 : b * SEQ + (cs - 4) * 64; }

__device__ __forceinline__ void p3_gla_local_fast(const Params& p, int l, unsigned char* lds_raw) { PHASE_IDS;
    typedef pg8::bf16x8 bf16x8;
    const int grp = __builtin_amdgcn_readfirstlane(tidx >> 8), tg = tidx & 255, w4 = __builtin_amdgcn_readfirstlane((tidx >> 6) & 3), lane = tidx & 63;
    bf16_t* KT = (bf16_t*)(lds_raw + grp * 32768);
    bf16_t* VT = KT + 2 * 32 * 72;
    float* AST = (float*)(p.ws + WS_AST); float* DEC = (float*)(p.ws + WS_DEC);
    float* wlds = (float*)(lds_raw + 65536); gla_stage_w(wlds, p, l, tidx);
    const int nitems = BATCH * NCHK * 4;
    const int G = gridDim.x, half = G >> 1, npairs = nitems / 2, nup = (G - half) * 4 < npairs ? (G - half) * 4 : npairs;
    const int myfirst = bidx_ >= half ? (bidx_ - half) : nup + bidx_, mystep = bidx_ >= half ? (G - half) : half, myend = bidx_ >= half ? nup : npairs;
    for (int pi = myfirst; pi < myend; pi += mystep) {
        const int it = pi * 2 + grp; const bool valid = it < nitems;
        const int h = it & 3, cs = (it >> 2) % NCHK, b = it / (4 * NCHK);
        const int dir = w4 >> 1, kh = w4 & 1;
        GlaIn in;
        if (valid) gla_load(in, p.ws, gla_row0(b, cs), h, w4, lane, tg);
        __syncthreads();
        if (valid) {
            GlaPrep g; gla_prep(g, in, wlds, h, w4, lane);
#pragma unroll
            for (int kk = 0; kk < 16; ++kk) KT[(dir * 32 + kh * 16 + kk) * 72 + lane] = f2bf(g.k[kk] * __expf(g.tot[kk] - g.cum[kk]));
            if (lane == 0) {
#pragma unroll
                for (int kk = 0; kk < 16; ++kk) DEC[((size_t)it * 2 + dir) * 32 + kh * 16 + kk] = __expf(g.tot[kk]);
            }
            gla_write_vt(VT, in, tg);
        }
        __syncthreads();
        if (valid) {
            const int r = lane & 15, q4 = lane >> 4, kt = kh;
            float* dst = AST + ((size_t)it * 2 + dir) * 2048;
#pragma unroll
            for (int vt = 0; vt < 4; ++vt) {
                f32x4 acc = {0.f, 0.f, 0.f, 0.f};
#pragma unroll
                for (int ks = 0; ks < 2; ++ks) {
                    const bf16x8 a = *(const bf16x8*)(KT + (dir * 32 + kt * 16 + r) * 72 + ks * 32 + q4 * 8);
                    const bf16x8 bb = *(const bf16x8*)(VT + (vt * 16 + r) * 72 + ks * 32 + q4 * 8);
                    acc = __builtin_amdgcn_mfma_f32_16x16x32_bf16(a, bb, acc, 0, 0, 0);
                }
                *(f32x4*)(dst + (vt * 16 + r) * 32 + kt * 16 + q4 * 4) = acc;
            }
        }
    }
}
__device__ __forceinline__ void p3_gla_scan_fast(const Params& p) { PHASE_IDS;
    const float* AST = (const float*)(p.ws + WS_AST); const float* DEC = (const float*)(p.ws + WS_DEC);
    bf16_t* ST = (bf16_t*)(p.ws + WS_ST);
    for (int i = GT; i < BATCH * 4 * 2 * 2048; i += NGT) {
        const int e = i & 2047, dir = (i >> 11) & 1, h = (i >> 12) & 3, b = i >> 14, k = e & 31;
        float a[NCHK], d[NCHK];
#pragma unroll
        for (int q = 0; q < NCHK; ++q) { const int cs = dir == 0 ? q : (q < 4 ? 3 - q : NCHK + 3 - q); const size_t id = (((size_t)b * NCHK + cs) * 4 + h) * 2 + dir; a[q] = AST[id * 2048 + e]; d[q] = DEC[id * 32 + k]; }
        float s = 0.f;
#pragma unroll
        for (int q = 0; q < NCHK; ++q) { const int cs = dir == 0 ? q : (q < 4 ? 3 - q : NCHK + 3 - q); const size_t id = (((size_t)b * NCHK + cs) * 4 + h) * 2 + dir; ST[id * 2048 + e] = f2bf(s); s = d[q] * s + a[q]; }
    }
}
__device__ __forceinline__ void p4_gla_out_fast(const Params& p, int l, unsigned char* lds_raw) { PHASE_IDS;
    typedef pg8::bf16x8 bf16x8;
    const int grp = __builtin_amdgcn_readfirstlane(tidx >> 8), tg = tidx & 255, w4 = __builtin_amdgcn_readfirstlane((tidx >> 6) & 3), lane = tidx & 63;
    bf16_t* QT = (bf16_t*)(lds_raw + grp * 58368);
    bf16_t* KL = QT + 2 * 64 * 40;
    bf16_t* SL = KL + 2 * 64 * 40;
    bf16_t* VT = SL + 2 * 64 * 40;
    bf16_t* ATT = VT + 64 * 72;
    bf16_t* GL = ATT + 64 * 72;
    const bf16_t* ST = (const bf16_t*)(p.ws + WS_ST); const bf16_t* GG = (const bf16_t*)(p.ws + WS_GG);
    bf16_t* MIX = (bf16_t*)(p.ws + WS_HB);
    float* wlds = (float*)(lds_raw + 116736);
    const int cs0 = l == 1 ? 4 : 0, ncs = NCHK - cs0, nitems = BATCH * ncs * 4;
    for (int pi = bidx_; pi * 2 < nitems; pi += gridDim.x) {
        const int itl = pi * 2 + grp; const bool valid = itl < nitems;
        const int h = itl & 3, cs = cs0 + (itl >> 2) % ncs, b = itl / (4 * ncs);
        const int it = (b * NCHK + cs) * 4 + h;
        const int dir = w4 >> 1, kh = w4 & 1;
        const int row0 = gla_row0(b, cs);
        GlaIn in; pg8::u32x4 st[2], gg[2];
        const int gr = tg >> 2, gc = tg & 3;
        if (valid) {
            gla_load(in, p.ws, row0, h, w4, lane, tg);
#pragma unroll
            for (int j = 0; j < 2; ++j) { const int pc = tg + 256 * j, d2 = pc >> 8, v = (pc >> 2) & 63, c = pc & 3; st[j] = *(const pg8::u32x4*)(ST + ((size_t)it * 2 + d2) * 2048 + v * 32 + c * 8); }
            gg[0] = *(const pg8::u32x4*)(GG + (size_t)(row0 + gr) * 256 + h * 64 + 16 * gc); gg[1] = *(const pg8::u32x4*)(GG + (size_t)(row0 + gr) * 256 + h * 64 + 16 * gc + 8);
        }
        __syncthreads();
        if (valid) {
            GlaPrep g; gla_prep(g, in, wlds, h, w4, lane);
            pg8::u32x4 wq[2], wk[2];
#pragma unroll
            for (int i = 0; i < 8; ++i) {
                const float e0 = __expf(g.cum[2 * i]), e1 = __expf(g.cum[2 * i + 1]);
                ((unsigned*)wq)[i] = pg8::cvt_pk_bf16(g.q[2 * i] * e0, g.q[2 * i + 1] * e1);
                ((unsigned*)wk)[i] = pg8::cvt_pk_bf16(g.k[2 * i] * __builtin_amdgcn_rcpf(e0), g.k[2 * i + 1] * __builtin_amdgcn_rcpf(e1));
            }
            *(pg8::u32x4*)(QT + (dir * 64 + lane) * 40 + kh * 16) = wq[0]; *(pg8::u32x4*)(QT + (dir * 64 + lane) * 40 + kh * 16 + 8) = wq[1];
            *(pg8::u32x4*)(KL + (dir * 64 + lane) * 40 + kh * 16) = wk[0]; *(pg8::u32x4*)(KL + (dir * 64 + lane) * 40 + kh * 16 + 8) = wk[1];
            gla_write_vt(VT, in, tg);
#pragma unroll
            for (int j = 0; j < 2; ++j) { const int pc = tg + 256 * j, d2 = pc >> 8, v = (pc >> 2) & 63, c = pc & 3; *(pg8::u32x4*)(SL + (d2 * 64 + v) * 40 + c * 8) = st[j]; }
            *(pg8::u32x4*)(GL + gr * 72 + 16 * gc) = gg[0]; *(pg8::u32x4*)(GL + gr * 72 + 16 * gc + 8) = gg[1];
        }
        __syncthreads();
        if (valid) {
            const int r = lane & 15, q4 = lane >> 4, i0 = 16 * w4;
            const bf16x8 aF = *(const bf16x8*)(QT + (0 * 64 + i0 + r) * 40 + q4 * 8), aB = *(const bf16x8*)(QT + (1 * 64 + i0 + r) * 40 + q4 * 8);
#pragma unroll
            for (int jt = 0; jt < 4; ++jt) {
                const bf16x8 bF = *(const bf16x8*)(KL + (0 * 64 + jt * 16 + r) * 40 + q4 * 8), bB = *(const bf16x8*)(KL + (1 * 64 + jt * 16 + r) * 40 + q4 * 8);
                const f32x4 z = {0.f, 0.f, 0.f, 0.f};
                const f32x4 F = __builtin_amdgcn_mfma_f32_16x16x32_bf16(aF, bF, z, 0, 0, 0), Bv = __builtin_amdgcn_mfma_f32_16x16x32_bf16(aB, bB, z, 0, 0, 0);
                const int j = jt * 16 + r;
#pragma unroll
                for (int e = 0; e < 4; ++e) { const int i = i0 + 4 * q4 + e; const float v = (j <= i ? F[e] : 0.f) + (j >= i ? Bv[e] : 0.f); ATT[i * 72 + j] = f2bf(v); }
            }
            __builtin_amdgcn_s_waitcnt(0);
            f32x4 o[4];
#pragma unroll
            for (int vt = 0; vt < 4; ++vt) {
                f32x4 acc = {0.f, 0.f, 0.f, 0.f};
#pragma unroll
                for (int ks = 0; ks < 2; ++ks) {
                    const bf16x8 a = *(const bf16x8*)(ATT + (i0 + r) * 72 + ks * 32 + q4 * 8);
                    const bf16x8 bb = *(const bf16x8*)(VT + (vt * 16 + r) * 72 + ks * 32 + q4 * 8);
                    acc = __builtin_amdgcn_mfma_f32_16x16x32_bf16(a, bb, acc, 0, 0, 0);
                }
                const bf16x8 sF = *(const bf16x8*)(SL + (0 * 64 + vt * 16 + r) * 40 + q4 * 8), sB = *(const bf16x8*)(SL + (1 * 64 + vt * 16 + r) * 40 + q4 * 8);
                acc = __builtin_amdgcn_mfma_f32_16x16x32_bf16(aF, sF, acc, 0, 0, 0);
                acc = __builtin_amdgcn_mfma_f32_16x16x32_bf16(aB, sB, acc, 0, 0, 0);
                o[vt] = acc;
            }
            float gn[4];
#pragma unroll
            for (int vt = 0; vt < 4; ++vt) gn[vt] = p.gla_norm[l * 64 + vt * 16 + r];
#pragma unroll
            for (int e = 0; e < 4; ++e) {
                float ss = o[0][e] * o[0][e] + o[1][e] * o[1][e] + o[2][e] * o[2][e] + o[3][e] * o[3][e];
                ss += __shfl_xor(ss, 1); ss += __shfl_xor(ss, 2); ss += __shfl_xor(ss, 4); ss += __shfl_xor(ss, 8);
                const float rs = rsqrtf(ss * (1.f / 64.f) + EPS);
                bf16_t* gl = GL + (i0 + 4 * q4 + e) * 72 + r;
#pragma unroll
                for (int vt = 0; vt < 4; ++vt) { const float gt = bf2f(gl[vt * 16]); gl[vt * 16] = f2bf(o[vt][e] * rs * gn[vt] * gt * __builtin_amdgcn_rcpf(1.f + __expf(-gt))); }
            }
        }
        __syncthreads();
        if (valid) { *(pg8::u32x4*)(MIX + (size_t)(row0 + gr) * D + 256 + h * 64 + 16 * gc) = *(const pg8::u32x4*)(GL + gr * 72 + 16 * gc); *(pg8::u32x4*)(MIX + (size_t)(row0 + gr) * D + 256 + h * 64 + 16 * gc + 8) = *(const pg8::u32x4*)(GL + gr * 72 + 16 * gc + 8); }
    }
}

constexpr size_t TAB_M1 = 16384, TAB_M2 = 24576, TAB_EC = 40960;
__device__ __forceinline__ void p3_fnet_fft(const Params& p, unsigned char* lds_raw) { PHASE_IDS;
    typedef pg8::bf16x8 bf16x8;
    const int lane = tidx & 63, w = __builtin_amdgcn_readfirstlane(tidx >> 6), j = lane & 15, q4 = lane >> 4;
    const float* TAB = (const float*)(p.ws + WS_TAB);
    const bf16_t* M1g = (const bf16_t*)(p.ws + WS_TAB + TAB_M1); const bf16_t* M2g = (const bf16_t*)(p.ws + WS_TAB + TAB_M2); const bf16_t* ECg = (const bf16_t*)(p.ws + WS_TAB + TAB_EC);
    const bf16_t* U = (const bf16_t*)(p.ws + WS_YFTL);
    bf16_t* MIX = (bf16_t*)(p.ws + WS_HB);
    const float scale = 0.0027621358640099515f;
    for (int it = bidx_; it < BATCH * 16; it += gridDim.x) {
        const int b = it >> 4, jb = it & 15;
        const bf16_t* M1 = M1g; const bf16_t* M2 = M2g; const bf16_t* EC = ECg; asm volatile("" : "+s"(M1), "+s"(M2), "+s"(EC));
        __syncthreads();
        {
            bf16x8 a1[4][2];
#pragma unroll
            for (int mt = 0; mt < 4; ++mt)
#pragma unroll
                for (int ks = 0; ks < 2; ++ks) a1[mt][ks] = *(const bf16x8*)(M1 + (16 * mt + j) * 64 + ks * 32 + 8 * q4);
            bf16x8 ec[2][2];
#pragma unroll
            for (int part = 0; part < 2; ++part)
#pragma unroll
                for (int ks = 0; ks < 2; ++ks) ec[part][ks] = *(const bf16x8*)(EC + part * 4096 + (16 * (jb & 3) + j) * 64 + ks * 32 + 8 * q4);
            const bf16_t* ub = U + ((size_t)b * SEQ + 64 * j + 8 * w) * 256 + (jb >> 2) * 64 + 8 * q4;
#pragma unroll
            for (int half = 0; half < 2; ++half) {
                bf16x8 ua[4][2][2];
#pragma unroll
                for (int ci = 0; ci < 4; ++ci)
#pragma unroll
                    for (int tl = 0; tl < 2; ++tl)
#pragma unroll
                        for (int ks = 0; ks < 2; ++ks) ua[ci][tl][ks] = *(const bf16x8*)(ub + (size_t)(1024 * tl + 4 * half + ci) * 256 + ks * 32);
                bf16x8 y[4][2];
#pragma unroll
                for (int ci = 0; ci < 4; ++ci)
#pragma unroll
                    for (int part = 0; part < 2; ++part) { f32x4 d[2];
#pragma unroll
                        for (int tl = 0; tl < 2; ++tl) { d[tl] = (f32x4){0.f, 0.f, 0.f, 0.f};
#pragma unroll
                            for (int ks = 0; ks < 2; ++ks) d[tl] = __builtin_amdgcn_mfma_f32_16x16x32_bf16(ua[ci][tl][ks], ec[part][ks], d[tl], 0, 0, 0); }
                        pg8::u32x4 pk; pk.x = pg8::cvt_pk_bf16_c(d[0][0], d[0][1]); pk.y = pg8::cvt_pk_bf16_c(d[0][2], d[0][3]); pk.z = pg8::cvt_pk_bf16_c(d[1][0], d[1][1]); pk.w = pg8::cvt_pk_bf16_c(d[1][2], d[1][3]);
                        y[ci][part] = __builtin_bit_cast(bf16x8, pk); }
                unsigned zp[2][2][4][2];
#pragma unroll
                for (int cp = 0; cp < 2; ++cp) {
                    float zr[2][2][4], zi[2][2][4];
#pragma unroll
                    for (int cq = 0; cq < 2; ++cq) {
                        const int ci = 2 * cp + cq; int c = 8 * w + 4 * half + ci; asm volatile("" : "+s"(c));
                        f32x4 acc[4];
#pragma unroll
                        for (int mt = 0; mt < 4; ++mt) { acc[mt] = (f32x4){0.f, 0.f, 0.f, 0.f};
#pragma unroll
                            for (int ks = 0; ks < 2; ++ks) acc[mt] = __builtin_amdgcn_mfma_f32_16x16x32_bf16(a1[mt][ks], y[ci][ks], acc[mt], 0, 0, 0); }
#pragma unroll
                        for (int m1 = 0; m1 < 2; ++m1)
#pragma unroll
                            for (int e = 0; e < 4; ++e) {
                                const int k1 = 16 * m1 + 4 * q4 + e, idx = k1 * c;
                                const float cs = TAB[idx], sn = TAB[(idx - 512) & 2047];
                                const float re = acc[m1][e], im = acc[2 + m1][e];
                                zr[cq][m1][e] = re * cs + im * sn; zi[cq][m1][e] = im * cs - re * sn;
                            }
                        asm volatile("" ::: "memory");
                    }
#pragma unroll
                    for (int m1 = 0; m1 < 2; ++m1)
#pragma unroll
                        for (int e = 0; e < 4; ++e) { zp[0][m1][e][cp] = pg8::cvt_pk_bf16(zr[0][m1][e], zr[1][m1][e]); zp[1][m1][e][cp] = pg8::cvt_pk_bf16(zi[0][m1][e], zi[1][m1][e]); }
                }
#pragma unroll
                for (int ri = 0; ri < 2; ++ri)
#pragma unroll
                    for (int m1 = 0; m1 < 2; ++m1)
#pragma unroll
                        for (int e = 0; e < 4; ++e) { const int k1 = 16 * m1 + 4 * q4 + e;
                            *(pg8::u32x2*)(lds_raw + ((ri * 32 + k1) * 16 + j) * 128 + ((w ^ ((j >> 1) & 7)) << 4) + half * 8) = (pg8::u32x2){zp[ri][m1][e][0], zp[ri][m1][e][1]}; }
                asm volatile("" ::: "memory");
            }
        }
        __syncthreads();
        {
            bf16x8 a2[4][4];
#pragma unroll
            for (int mt = 0; mt < 4; ++mt)
#pragma unroll
                for (int ks = 0; ks < 4; ++ks) a2[mt][ks] = *(const bf16x8*)(M2 + (16 * mt + j) * 128 + ks * 32 + 8 * q4);
#pragma unroll
            for (int kq = 0; kq < 4; ++kq) {
                const int k1 = 4 * w + kq;
                bf16x8 zb[4];
#pragma unroll
                for (int ks = 0; ks < 4; ++ks) zb[ks] = *(const bf16x8*)(lds_raw + (((ks >> 1) * 32 + k1) * 16 + j) * 128 + (((4 * (ks & 1) + q4) ^ ((j >> 1) & 7)) << 4));
                bf16_t* op = MIX + ((size_t)b * SEQ + k1 + 128 * q4) * D + 16 * jb + j;
#pragma unroll
                for (int mt = 0; mt < 4; ++mt) {
                    f32x4 acc = {0.f, 0.f, 0.f, 0.f};
#pragma unroll
                    for (int ks = 0; ks < 4; ++ks) acc = __builtin_amdgcn_mfma_f32_16x16x32_bf16(a2[mt][ks], zb[ks], acc, 0, 0, 0);
                    {
                        const float v0 = acc[0] * scale, v1 = acc[1] * scale, v2 = acc[2] * scale, v3 = acc[3] * scale;
                        const bool odd = (j & 1) != 0;
                        const float r0 = __shfl_xor(odd ? v0 : v2, 1), r1 = __shfl_xor(odd ? v1 : v3, 1);
                        bf16_t* oq = odd ? op - 1 + (size_t)64 * D : op;
                        *(unsigned*)oq = odd ? pg8::cvt_pk_bf16(r0, v2) : pg8::cvt_pk_bf16(v0, r0);
                        *(unsigned*)(oq + (size_t)32 * D) = odd ? pg8::cvt_pk_bf16(r1, v3) : pg8::cvt_pk_bf16(v1, r1); }
                    op += (size_t)512 * D; asm volatile("" : "+v"(op) :: "memory");
                }
            }
        }
    }
}

#define STAMPG(n) do { if ((PROBE_A == (n) || PROBE_B == (n)) && blockIdx.x == 0 && threadIdx.x == 0) ((volatile unsigned long long*)(lds_raw + LDS_BYTES - 512))[PROBE_B == (n) ? 1 : 0] = __builtin_amdgcn_s_memrealtime(); } while (0)
#define LAS __attribute__((address_space(3)))
__host__ __device__ __forceinline__ int tile_pos(int lc) { return 128 * ((lc >> 5) & 1) + 32 * (lc >> 6) + (lc & 31); }
__device__ __forceinline__ int inproj_dest(int c) {
    int T, lc;
    if (c < C_GQ) { T = 9; lc = c; } else if (c < C_GV) { T = 2; lc = c - C_GQ; } else if (c < C_GG) { T = 3; lc = c - C_GV; } else if (c < C_GDF) { T = 4; lc = c - C_GG; }
    else if (c < C_AQ) { T = 8; lc = c - C_GDF; } else if (c < C_AQ + 256) { T = 5; lc = c - C_AQ; } else if (c < C_AK) { T = 6; lc = c - C_AQ - 256; } else { T = 7; lc = c - C_AK; }
    return T * 256 + tile_pos(lc);
}
__device__ __forceinline__ void p0a_fast(const Params& p, float* lds) { PHASE_IDS;
    const int lane = tidx & 63, wave = tidx >> 6;
    float* scr = lds + wave * 2304;
    bf16_t* WIN = (bf16_t*)(p.ws + WS_WIN); bf16_t* WOUT = (bf16_t*)(p.ws + WS_WOUT);
    {
        unsigned char* lds_b = (unsigned char*)lds;
        const int j = tidx & 15, r0 = tidx >> 4;
        for (int t = bidx_; t < 192; t += gridDim.x) {
            const bool isin = t < 128; const int q = isin ? t : t - 128;
            const int l = isin ? q >> 6 : q >> 5, kt = isin ? (q >> 3) & 7 : (q >> 2) & 7, nt = isin ? q & 7 : q & 3;
            const int ldw = isin ? DIN : D, n4 = nt * 256 + 4 * lane;
            const float* src = (isin ? p.w_in + (size_t)l * D * DIN : p.w_out + (size_t)l * D * D) + (size_t)(kt * 128 + 16 * wave) * ldw + (n4 < ldw ? n4 : 0);
            f32x4 v[16];
            cb_load(v, src, ldw);
            cb_to_lds(v, lds_b, wave, lane);
            __syncthreads();
#pragma unroll
            for (int i = 0; i < 8; ++i) { const int r = r0 + 32 * i, n = nt * 256 + r;
                const pg8::u32x4 x = *(LDSP(pg8::u32x4))(lds_b + r * CB_RS + 16 * j);
                if (n < ldw) { bf16_t* dst = isin ? WIN + ((size_t)l * NIN + inproj_dest(n)) * D : WOUT + ((size_t)l * D + n) * D; *(pg8::u32x4*)(dst + kt * 128 + 8 * j) = x; } }
            __syncthreads();
        }
    }
    STAMPG(42);
    { float sn, cs; sincos_r((float)lane * 0.09817477042468103f, sn, cs); scr[2 * lane] = cs; scr[2 * lane + 1] = sn; }
    float* tile = scr + 128;
    for (int it = GW; it < 16 * 4 * 16; it += NGW) {
        const int jq = it & 15, g = (it >> 4) & 3, kb = (it >> 6) & 15, l = 0;
        const float* W = p.w_in + (size_t)l * D * DIN;
        float yr[4], ys[4];
#pragma unroll
        for (int jj = 0; jj < 4; ++jj) { yr[jj] = 0.f; ys[jj] = 0.f; }
        for (int half = 0; half < 2; ++half) {
            __builtin_amdgcn_s_waitcnt(0); asm volatile("" ::: "memory");
            { float tv[32];
#pragma unroll
              for (int i = 0; i < 32; ++i) { const int kk = 2 * i + (lane >> 5); tv[i] = W[(size_t)(kb * 64 + kk) * DIN + g * 64 + half * 32 + (lane & 31)]; }
#pragma unroll
              for (int i = 0; i < 32; ++i) { const int kk = 2 * i + (lane >> 5); tile[kk * 33 + (lane & 31)] = tv[i]; } }
            __builtin_amdgcn_s_waitcnt(0); asm volatile("" ::: "memory");
#pragma unroll 4
            for (int cc = 0; cc < 32; ++cc) {
                const float u = tile[lane * 33 + cc]; const int c = half * 32 + cc;
#pragma unroll
                for (int jj = 0; jj < 4; ++jj) { const int m = ((jq * 4 + jj) * c) & 63; yr[jj] = fmaf(u, scr[2 * m], yr[jj]); ys[jj] = fmaf(u, scr[2 * m + 1], ys[jj]); }
            }
        }
#pragma unroll
        for (int jj = 0; jj < 4; ++jj) { const int j = jq * 4 + jj; const size_t row = (size_t)l * NIN + tile_pos(g * 64 + j);
            WIN[(row) * D + kb * 64 + lane] = f2bf(yr[jj]); WIN[(row + 256) * D + kb * 64 + lane] = f2bf(ys[jj]); }
    }
    STAMPG(43);
    for (int i = GT; i < 2 * 224 * (D / 8); i += NGT) {
        const int k8 = i & 127, lc = 32 + (i >> 7) % 224, l = i / (224 * 128);
        *(pg8::u32x4*)(WIN + ((size_t)l * NIN + 8 * 256 + tile_pos(lc)) * D + k8 * 8) = (pg8::u32x4){0u, 0u, 0u, 0u};
    }
    {
        bf16_t* DC = (bf16_t*)(p.ws + WS_DMATC);
        for (int i = GT; i < 256 * 512 / 8; i += NGT) {
            const int t8 = (i & 63) * 8, k = i >> 6; unsigned w[4];
#pragma unroll
            for (int q = 0; q < 4; ++q) { float v[2];
#pragma unroll
                for (int e = 0; e < 2; ++e) { const int tt = t8 + 2 * q + e, t = tt & 255; const int m = (k * t) & 255; float sn, cs; sincos_r((float)m * (6.283185307179586f / 256.f), sn, cs); v[e] = tt < 256 ? cs : -sn; }
                w[q] = pg8::cvt_pk_bf16(v[0], v[1]); }
            *(pg8::u32x4*)(DC + (size_t)k * 512 + t8) = (pg8::u32x4){w[0], w[1], w[2], w[3]};
        }
    }
    STAMPG(44);
}

#define XB_TMO      128
#define XB_XCNT(j)  (256  + 64 * (j))
#define XB_XSUB(j)  (1280 + 64 * (j))
#define XB_XGEN(j)  (2304 + 64 * (j))
#define XB_TOP      3328
#define XB_TOPGEN   3392
#define XCD_BAR_WORDS 3456
#define XB_SPIN_CAP (1u << 18)
__device__ __forceinline__ unsigned xb_ld(unsigned* p)              { return __hip_atomic_load(p, __ATOMIC_RELAXED, __HIP_MEMORY_SCOPE_AGENT); }
__device__ __forceinline__ unsigned xb_add(unsigned* p, unsigned v) { return __hip_atomic_fetch_add(p, v, __ATOMIC_RELAXED, __HIP_MEMORY_SCOPE_AGENT); }
__device__ __forceinline__ unsigned xb_xcc_id() { return (unsigned)__builtin_amdgcn_s_getreg((3 << 11) | 20) & 0xFu; }
#define XB_SPIN(cond, bar) do { unsigned _sp = 0; while (cond) { __builtin_amdgcn_s_sleep(1); \
    if ((++_sp & 255u) == 0u) { if (xb_ld(&(bar)[XB_TMO])) break; if (_sp > XB_SPIN_CAP) { atomicAdd(&(bar)[XB_TMO], 1u); break; } } } } while (0)
struct XcdBarrier { unsigned* bar; unsigned x; volatile __attribute__((address_space(3))) unsigned* st; };
__device__ __forceinline__ XcdBarrier xcd_barrier_post(unsigned* bar, volatile __attribute__((address_space(3))) unsigned* st) {
    XcdBarrier b; b.bar = bar; b.x = xb_xcc_id(); b.st = st;
    if (otid() == 0) (void)xb_add(&bar[XB_XCNT(b.x)], 1u);
    return b;
}
__device__ __forceinline__ void xcd_barrier_complete(unsigned* bar, unsigned x, unsigned& nloc, unsigned& nx) {
    const unsigned G = gridDim.x * gridDim.y * gridDim.z;
    unsigned sum, cnt, mine, sp = 0u;
    for (;;) {
        sum = 0u; cnt = 0u; mine = 0u;
#pragma unroll
        for (unsigned j = 0; j < 16; ++j) { const unsigned c = xb_ld(&bar[XB_XCNT(j)]); sum += c; cnt += (c > 0u) ? 1u : 0u; mine = (j == x) ? c : mine; }
        if (sum == G) break;
        __builtin_amdgcn_s_sleep(1);
        if ((++sp & 255u) == 0u) { if (xb_ld(&bar[XB_TMO])) break; if (sp > XB_SPIN_CAP) { atomicAdd(&bar[XB_TMO], 1u); break; } }
    }
    nloc = mine > 0u ? mine : 1u; nx = cnt > 0u ? cnt : 1u;
}
__device__ __forceinline__ void xcd_barrier_core(const XcdBarrier& b, bool leader) {
    if (leader) {
        unsigned* bar = b.bar;
        __builtin_amdgcn_s_waitcnt(0);
        unsigned nloc = b.st[0], nx = b.st[1];
        if (nloc == 0u) { xcd_barrier_complete(bar, b.x, nloc, nx); b.st[0] = nloc; b.st[1] = nx; }
        const unsigned old = xb_add(&bar[XB_XSUB(b.x)], 1u);
        const unsigned gen = old / nloc;
        if (old + 1u == (gen + 1u) * nloc) {
            __builtin_amdgcn_fence(__ATOMIC_RELEASE, "agent");
            asm volatile("s_waitcnt vmcnt(0)" ::: "memory");
            const unsigned og = xb_add(&bar[XB_TOP], 1u);
            const unsigned tg = og / nx;
            if (og + 1u == (tg + 1u) * nx) xb_add(&bar[XB_TOPGEN], 1u);
            else XB_SPIN(xb_ld(&bar[XB_TOPGEN]) == tg, bar);
            __builtin_amdgcn_fence(__ATOMIC_ACQUIRE, "agent");
            xb_add(&bar[XB_XGEN(b.x)], 1u);
            asm volatile("s_waitcnt vmcnt(0)" ::: "memory");
        } else {
            XB_SPIN(xb_ld(&bar[XB_XGEN(b.x)]) == gen, bar);
            __builtin_amdgcn_fence(__ATOMIC_ACQUIRE, "agent");
            asm volatile("s_waitcnt vmcnt(0)" ::: "memory");
        }
    }
}
__device__ __forceinline__ void xcd_barrier(const XcdBarrier& b) {
    asm volatile("s_waitcnt vmcnt(0)" ::: "memory");
    __syncthreads();
    xcd_barrier_core(b, otid() == 0);
    __syncthreads();
}
#define GSYNC_STAGE(code) do { asm volatile("s_waitcnt vmcnt(0)" ::: "memory"); __syncthreads(); \
        if (threadIdx.x < 64) xcd_barrier_core(bar, threadIdx.x == 0); else { const int st_ = (int)threadIdx.x - 64; code; } \
        __syncthreads(); } while (0)

__global__ void __launch_bounds__(NTHREADS) mega(Params p) {
    if ((threadIdx.x & 63) == 0) ((volatile __attribute__((address_space(3))) int*)((__attribute__((address_space(3))) unsigned char*)lds_raw + WTAB_OFF))[hw_wave_slot()] = threadIdx.x >> 6;
    __syncthreads();
    float* lds = (float*)lds_raw;
    cg::grid_group grid = cg::this_grid();
    volatile __attribute__((address_space(3))) unsigned* bst = (volatile __attribute__((address_space(3))) unsigned*)((__attribute__((address_space(3))) unsigned char*)lds_raw + LDS_BYTES - 1024);
    { const int t0_ = otid(); if (t0_ < 2) bst[t0_] = 0u; }
    __syncthreads();
    const XcdBarrier bar = xcd_barrier_post((unsigned*)(p.ws + WS_CTL), bst);
#define GSYNC() xcd_barrier(bar)
    volatile unsigned long long* tst = (volatile unsigned long long*)(lds_raw + LDS_BYTES - 512);
#define STAMP(n) do { if ((PROBE_A == (n) || PROBE_B == (n)) && blockIdx.x == 0 && threadIdx.x == 0) tst[PROBE_B == (n) ? 1 : 0] = __builtin_amdgcn_s_memrealtime(); } while (0)
    STAMP(0);
    p0a(p, lds); __syncthreads(); STAMP(40); p0a_fast(p, lds); STAMP(45); grid.sync(); STAMP(1);
    p0b(p); GSYNC_STAGE(p1_stage_w(p, 0, lds_raw, st_, 448)); STAMP(2);
#define LAYER(l) do { p1_norm1(p, l, lds_raw); GSYNC(); STAMP(3 + 9 * (l)); \
        p2_inproj_fast(p, l, lds_raw); GSYNC(); STAMP(4 + 9 * (l)); \
        p3_fnet_fft(p, lds_raw); __syncthreads(); STAMP(30 + 3 * (l)); p3_fnet_fast(p, l, lds_raw); __syncthreads(); STAMP(31 + 3 * (l)); p3_gla_local_fast(p, l, lds_raw); __syncthreads(); STAMP(32 + 3 * (l)); p3_attn_fast(p, l, lds_raw); GSYNC(); STAMP(5 + 9 * (l)); \
        p3_gla_scan_fast(p); GSYNC_STAGE(gla_stage_w_t((float*)(lds_raw + 116736), p, l, st_, 448)); STAMP(6 + 9 * (l)); p4_gla_out_fast(p, l, lds_raw); GSYNC(); STAMP(7 + 9 * (l)); \
        p5_outproj_fast(p, l, lds_raw); GSYNC_STAGE(p6_stage_router(p, st_, 448)); STAMP(8 + 9 * (l)); p6_norm2_router(p, l, lds); GSYNC(); STAMP(9 + 9 * (l)); \
        p7_gateup_fast(p, l, lds_raw); GSYNC(); STAMP(10 + 9 * (l)); p8_down_fast(p, l, lds_raw); if ((l) == 0) GSYNC_STAGE(p1_stage_w(p, 1, lds_raw, st_, 448)); else GSYNC(); STAMP(11 + 9 * (l)); } while (0)
    LAYER(0);
    LAYER(1);
#undef LAYER
    p9_final(p);
    if (PROBE_A >= 0) { __syncthreads(); if (blockIdx.x == 0 && threadIdx.x == 0) { if (PROBE_B == 21) tst[1] = __builtin_amdgcn_s_memrealtime(); const unsigned long long dt = (tst[1] - tst[0]) * PROBE_K, t0 = __builtin_amdgcn_s_memrealtime(); while (__builtin_amdgcn_s_memrealtime() - t0 < dt) __builtin_amdgcn_s_sleep(8); } }
}

extern "C" void kernel_launch(void* const* d_in, const int* in_sizes, int n_in, void* d_out, int out_size, void* d_ws, size_t ws_size, hipStream_t stream) {
    static int grid_blocks = 0;
    if (!grid_blocks) {
        int dev = 0, cus = 0, per_cu = 0;
        hipGetDevice(&dev);
        hipDeviceGetAttribute(&cus, hipDeviceAttributeMultiprocessorCount, dev);
        hipFuncSetAttribute((const void*)mega, hipFuncAttributeMaxDynamicSharedMemorySize, LDS_BYTES);
        hipOccupancyMaxActiveBlocksPerMultiprocessor(&per_cu, (const void*)mega, NTHREADS, LDS_BYTES);
        if (per_cu < 1) { fprintf(stderr, "occupancy query says %d blocks/CU\n", per_cu); per_cu = 1; }
        grid_blocks = cus;
        if (n_in != 21 || ws_size < WS_END) fprintf(stderr, "unexpected n_in %d / ws_size %zu\n", n_in, ws_size);
    }
    hipMemsetAsync((char*)d_ws + WS_CTL, 0, 65536, stream);
    Params p{};
    const float** f = (const float**)&p;
    for (int i = 0; i < 21; ++i) f[i] = (const float*)d_in[i];
    p.out = (float*)d_out; p.ws = (unsigned char*)d_ws;
    void* args[] = {&p};
    hipError_t e = hipLaunchCooperativeKernel((const void*)mega, dim3(grid_blocks), dim3(NTHREADS), args, LDS_BYTES, stream);
    if (e != hipSuccess) fprintf(stderr, "cooperative launch failed: %s (grid %d)\n", hipGetErrorString(e), grid_blocks);
}
```
